# Optimizing an MI355X kernel written in HIP

```python
import math
import jax, jax.numpy as jnp
from jax import lax
import numpy as np

D_MODEL = 1024
BATCH = 8
SEQ = 2048
DEPTH = 2

CTX_LEN = 256
GRID_W = 64
HEAD_DIM = 64
AXIS_DIM = HEAD_DIM // 2
ROPE_BASE = 10000.0
RMS_EPS = 1e-6
Q_BLOCK = 128
WINDOW = 128

A_HEADS = 4
A_QK_DIM = 2 * HEAD_DIM
A_V_DIM = 2 * HEAD_DIM
B_HEADS = 4
B_KV_HEADS = 2
B_GROUP = B_HEADS // B_KV_HEADS
C_HEADS = 4
C_KV_HEADS = 2
C_GROUP = C_HEADS // C_KV_HEADS

A_WIDTH = A_HEADS * A_V_DIM
B_WIDTH = B_HEADS * HEAD_DIM
C_WIDTH = C_HEADS * HEAD_DIM
MIX_WIDTH = A_WIDTH + B_WIDTH + C_WIDTH
Q_SIZES = (A_HEADS * A_QK_DIM, B_HEADS * HEAD_DIM, C_HEADS * HEAD_DIM)
KV_SIZES = (A_HEADS * A_QK_DIM, A_HEADS * A_V_DIM,
            B_KV_HEADS * HEAD_DIM, B_KV_HEADS * HEAD_DIM,
            C_KV_HEADS * HEAD_DIM, C_KV_HEADS * HEAD_DIM)
Q_COLS = sum(Q_SIZES)
KV_COLS = sum(KV_SIZES)
IN_COLS = Q_COLS + KV_COLS

N_EXPERTS = 16
N_GROUPS = 4
EXPERTS_PER_GROUP = N_EXPERTS // N_GROUPS
TOP_K = 2
D_EXPERT = 256

kernel_name = 'hybrid_dit_parallel_heads_moe'


def _offsets(sizes):
    out, acc = [], 0
    for s in sizes[:-1]:
        acc += s
        out.append(acc)
    return out


def rms_norm(x, g):
    xf = x.astype(jnp.float32)
    y = xf * lax.rsqrt(jnp.mean(xf * xf, axis=-1, keepdims=True) + RMS_EPS)
    return (y * g.astype(jnp.float32)).astype(x.dtype)


def rope_tables(seq_len):
    rows = seq_len // GRID_W
    row_pos = jnp.repeat(jnp.arange(rows, dtype=jnp.float32), GRID_W)
    col_pos = jnp.tile(jnp.arange(GRID_W, dtype=jnp.float32), rows)
    inv_freq = ROPE_BASE ** (-jnp.arange(0, AXIS_DIM, 2, dtype=jnp.float32) / AXIS_DIM)
    ang_r = row_pos[:, None] * inv_freq[None, :]
    ang_c = col_pos[:, None] * inv_freq[None, :]
    return (jnp.cos(ang_r), jnp.sin(ang_r), jnp.cos(ang_c), jnp.sin(ang_c))


def _rot(x, cos, sin):
    x1, x2 = jnp.split(x, 2, axis=-1)
    cos = cos.astype(x.dtype)
    sin = sin.astype(x.dtype)
    return jnp.concatenate([x1 * cos - x2 * sin, x1 * sin + x2 * cos], axis=-1)


def apply_rope_2d(x, rope):
    cos_r, sin_r, cos_c, sin_c = rope
    x_row, x_col = jnp.split(x, 2, axis=-1)
    return jnp.concatenate([_rot(x_row, cos_r, sin_r), _rot(x_col, cos_c, sin_c)], axis=-1)


def to_query_blocks(q):
    *lead, s, d = q.shape
    return jnp.moveaxis(q.reshape(*lead, s // Q_BLOCK, Q_BLOCK, d), -3, 0)


def from_query_blocks(o):
    o = jnp.moveaxis(o, 0, -3)
    *lead, nb, qb, d = o.shape
    return o.reshape(*lead, nb * qb, d)


def diff_attention(q, k, v, lam):
    kf = k.astype(jnp.float32)
    scale = HEAD_DIM ** -0.5

    def block(qb):
        s = jnp.einsum('bhiqd,bhikd->bhiqk', qb.astype(jnp.float32), kf) * scale
        p = jax.nn.softmax(s, axis=-1)
        w = p[:, :, 0] - lam * p[:, :, 1]
        return jnp.einsum('bhqk,bhkv->bhqv', w.astype(v.dtype), v)

    return from_query_blocks(lax.map(block, to_query_blocks(q)))


def gqa_attention(q, k, v, sink=None):
    kf = k.astype(jnp.float32)
    scale = HEAD_DIM ** -0.5

    def block(qb):
        s = jnp.einsum('bhgqd,bhkd->bhgqk', qb.astype(jnp.float32), kf) * scale
        if sink is not None:
            sk = jnp.broadcast_to(sink.astype(jnp.float32)[None, :, :, None, None], s.shape[:-1] + (1,))
            p = jax.nn.softmax(jnp.concatenate([s, sk], axis=-1), axis=-1)[..., :-1]
        else:
            p = jax.nn.softmax(s, axis=-1)
        return jnp.einsum('bhgqk,bhkd->bhgqd', p.astype(v.dtype), v)

    return from_query_blocks(lax.map(block, to_query_blocks(q)))


def window_attention(q, k, v, kc, vc, sink):
    B, Hkv, G, S, dh = q.shape
    nb = S // Q_BLOCK
    L = kc.shape[2]

    def band(t):
        tp = jnp.pad(t, ((0, 0), (0, 0), (WINDOW, WINDOW), (0, 0)))
        tp = tp.reshape(B, Hkv, nb + 2, Q_BLOCK, t.shape[-1])
        return jnp.concatenate([tp[:, :, :-2], tp[:, :, 1:-1], tp[:, :, 2:]], axis=3)

    kb, vb = band(k), band(v)
    qb = q.reshape(B, Hkv, G, nb, Q_BLOCK, dh).astype(jnp.float32)
    scale = HEAD_DIM ** -0.5
    s_band = jnp.einsum('bhgnqd,bhnkd->bhgnqk', qb, kb.astype(jnp.float32)) * scale
    blk = jnp.arange(nb)[:, None, None] * Q_BLOCK
    q_pos = blk + jnp.arange(Q_BLOCK)[None, :, None]
    k_pos = blk - WINDOW + jnp.arange(3 * Q_BLOCK)[None, None, :]
    valid = (jnp.abs(k_pos - q_pos) <= WINDOW) & (k_pos >= 0) & (k_pos < S)
    s_band = jnp.where(valid, s_band, -jnp.inf)
    s_ctx = jnp.einsum('bhgnqd,bhkd->bhgnqk', qb, kc.astype(jnp.float32)) * scale
    s_sink = jnp.broadcast_to(sink.astype(jnp.float32)[None, :, :, None, None, None], s_ctx.shape[:-1] + (1,))
    p = jax.nn.softmax(jnp.concatenate([s_ctx, s_band, s_sink], axis=-1), axis=-1)
    p_ctx = p[..., :L].astype(v.dtype)
    p_band = p[..., L:L + 3 * Q_BLOCK].astype(v.dtype)
    out = (jnp.einsum('bhgnqk,bhkd->bhgnqd', p_ctx, vc)
           + jnp.einsum('bhgnqk,bhnkd->bhgnqd', p_band, vb))
    return out.reshape(B, Hkv, G, S, dh)


def heads_a_qk(t):
    B, n, _ = t.shape
    return t.reshape(B, n, A_HEADS, 2, HEAD_DIM).transpose(0, 2, 3, 1, 4)


def heads_kv(t, heads, dim):
    B, n, _ = t.shape
    return t.reshape(B, n, heads, dim).transpose(0, 2, 1, 3)


def heads_gq(t, hkv, g):
    B, n, _ = t.shape
    return t.reshape(B, n, hkv, g, HEAD_DIM).transpose(0, 2, 3, 1, 4)


def merge_h(o):
    B, H, n, d = o.shape
    return o.transpose(0, 2, 1, 3).reshape(B, n, H * d)


def merge_gq(o):
    B, Hkv, G, n, d = o.shape
    return o.transpose(0, 3, 1, 2, 4).reshape(B, n, Hkv * G * d)


def split_kv(kv):
    kA, vA, kB, vB, kC, vC = jnp.split(kv, _offsets(KV_SIZES), axis=-1)
    return (heads_a_qk(kA), heads_kv(vA, A_HEADS, A_V_DIM),
            heads_kv(kB, B_KV_HEADS, HEAD_DIM), heads_kv(vB, B_KV_HEADS, HEAD_DIM),
            heads_kv(kC, C_KV_HEADS, HEAD_DIM), heads_kv(vC, C_KV_HEADS, HEAD_DIM))


def split_q(q):
    qA, qB, qC = jnp.split(q, _offsets(Q_SIZES), axis=-1)
    return heads_a_qk(qA), heads_gq(qB, B_KV_HEADS, B_GROUP), heads_gq(qC, C_KV_HEADS, C_GROUP)


def token_mixers(hx, hc, w_in, lam_q1, lam_k1, lam_q2, lam_k2, subln_g, q_norm_g, k_norm_g,
                 sink, lambda_init, rope, with_ctx):
    px = hx @ w_in
    qAx, qBx, qCx = split_q(px[..., :Q_COLS])
    kAx, vAx, kBx, vBx, kCx, vCx = split_kv(px[..., Q_COLS:])
    kAc, vAc, kBc, vBc, kCc, vCc = split_kv(hc @ w_in[:, Q_COLS:])

    f32 = jnp.float32
    lam = (jnp.exp(jnp.sum(lam_q1.astype(f32) * lam_k1.astype(f32)))
           - jnp.exp(jnp.sum(lam_q2.astype(f32) * lam_k2.astype(f32))) + lambda_init)
    sink_hg = sink.reshape(C_KV_HEADS, C_GROUP)
    kBc = rms_norm(kBc, k_norm_g)

    oA = diff_attention(apply_rope_2d(qAx, rope),
                        jnp.concatenate([kAc, apply_rope_2d(kAx, rope)], axis=-2),
                        jnp.concatenate([vAc, vAx], axis=-2), lam)
    oA = rms_norm(oA, subln_g) * (1.0 - lambda_init)
    oB = gqa_attention(apply_rope_2d(rms_norm(qBx, q_norm_g), rope),
                       jnp.concatenate([kBc, apply_rope_2d(rms_norm(kBx, k_norm_g), rope)], axis=-2),
                       jnp.concatenate([vBc, vBx], axis=-2))
    oC = window_attention(apply_rope_2d(qCx, rope), apply_rope_2d(kCx, rope), vCx, kCc, vCc, sink_hg)
    mix_x = jnp.concatenate([merge_h(oA), merge_gq(oB), merge_gq(oC)], axis=-1)

    if not with_ctx:
        return mix_x, None
    qAc, qBc, qCc = split_q(hc @ w_in[:, :Q_COLS])
    oAc = rms_norm(diff_attention(qAc, kAc, vAc, lam), subln_g) * (1.0 - lambda_init)
    oBc = gqa_attention(rms_norm(qBc, q_norm_g), kBc, vBc)
    oCc = gqa_attention(qCc, kCc, vCc, sink_hg)
    mix_c = jnp.concatenate([merge_h(oAc), merge_gq(oBc), merge_gq(oCc)], axis=-1)
    return mix_x, mix_c


def moe_ffn(h, w_router, router_bias, w_gate, w_up, w_down):
    shape = h.shape
    t = h.reshape(-1, shape[-1])
    f32 = jnp.float32
    scores = jax.nn.sigmoid(t.astype(f32) @ w_router.astype(f32))
    sel = (scores + router_bias.astype(f32)).reshape(-1, N_GROUPS, EXPERTS_PER_GROUP)
    group_score = jnp.sum(lax.top_k(sel, 2)[0], axis=-1)
    best_group = jnp.argmax(group_score, axis=-1)
    in_group = jnp.take_along_axis(sel, best_group[:, None, None], axis=1)[:, 0]
    _, local = lax.top_k(in_group, TOP_K)
    expert_idx = best_group[:, None] * EXPERTS_PER_GROUP + local
    w = jnp.take_along_axis(scores, expert_idx, axis=-1)
    w = w / jnp.sum(w, axis=-1, keepdims=True)
    gates = jnp.sum(jax.nn.one_hot(expert_idx, N_EXPERTS, dtype=f32) * w[..., None], axis=1).astype(t.dtype)
    out = jnp.zeros_like(t)
    for e in range(N_EXPERTS):
        hid = jax.nn.silu(t @ w_gate[e]) * (t @ w_up[e])
        out = out + gates[:, e:e + 1] * (hid @ w_down[e])
    return out.reshape(shape)


def setup_inputs(seed: int = 0) -> dict:
    key = jax.random.key(seed)
    ks = jax.random.split(key, 24)
    f32 = jnp.float32
    D = D_MODEL

    def nrm(k, shape, s):
        return jax.random.normal(k, shape, f32) * s

    return {
        'x': nrm(ks[0], (BATCH, SEQ, D), 1.0),
        'c': nrm(ks[1], (BATCH, D), 1.0),
        'ctx': nrm(ks[2], (BATCH, CTX_LEN, D), 1.0),
        'c_ctx': nrm(ks[3], (D,), 1.0),
        'w_ada': nrm(ks[4], (DEPTH, D, 6 * D), 0.5 * D ** -0.5),
        'b_ada': nrm(ks[5], (DEPTH, 6 * D), 0.02),
        'norm1_g': 1.0 + nrm(ks[6], (DEPTH, D), 0.02),
        'norm2_g': 1.0 + nrm(ks[7], (DEPTH, D), 0.02),
        'w_in': nrm(ks[8], (DEPTH, D, IN_COLS), D ** -0.5),
        'w_out': nrm(ks[9], (DEPTH, MIX_WIDTH, D), MIX_WIDTH ** -0.5),
        'lam_q1': nrm(ks[10], (DEPTH, HEAD_DIM), 0.1),
        'lam_k1': nrm(ks[11], (DEPTH, HEAD_DIM), 0.1),
        'lam_q2': nrm(ks[12], (DEPTH, HEAD_DIM), 0.1),
        'lam_k2': nrm(ks[13], (DEPTH, HEAD_DIM), 0.1),
        'subln_g': 1.0 + nrm(ks[14], (DEPTH, A_V_DIM), 0.02),
        'q_norm_g': 1.0 + nrm(ks[15], (DEPTH, HEAD_DIM), 0.02),
        'k_norm_g': 1.0 + nrm(ks[16], (DEPTH, HEAD_DIM), 0.02),
        'sink': nrm(ks[17], (DEPTH, C_HEADS), 0.5),
        'w_router': nrm(ks[18], (D, N_EXPERTS), D ** -0.5),
        'router_bias': nrm(ks[19], (N_EXPERTS,), 0.01),
        'w_gate': nrm(ks[20], (DEPTH, N_EXPERTS, D, D_EXPERT), D ** -0.5),
        'w_up': nrm(ks[21], (DEPTH, N_EXPERTS, D, D_EXPERT), D ** -0.5),
        'w_down': nrm(ks[22], (DEPTH, N_EXPERTS, D_EXPERT, D), D_EXPERT ** -0.5),
        'final_g': 1.0 + nrm(ks[23], (D,), 0.02),
    }


def reference(x, c, ctx, c_ctx, w_ada, b_ada, norm1_g, norm2_g, w_in, w_out,
              lam_q1, lam_k1, lam_q2, lam_k2, subln_g, q_norm_g, k_norm_g, sink,
              w_router, router_bias, w_gate, w_up, w_down, final_g):
    rope = rope_tables(x.shape[1])
    silu_c = jax.nn.silu(c)
    silu_cc = jax.nn.silu(c_ctx)
    for l in range(DEPTH):
        last = l == DEPTH - 1
        lambda_init = 0.8 - 0.6 * math.exp(-0.3 * l)
        mod = jnp.split(silu_c @ w_ada[l] + b_ada[l], 6, axis=-1)
        sh1, sc1, g1, sh2, sc2, g2 = [m[:, None, :] for m in mod]
        csh1, csc1, cg1, csh2, csc2, cg2 = jnp.split(silu_cc @ w_ada[l] + b_ada[l], 6, axis=-1)

        hx = rms_norm(x, norm1_g[l]) * (1 + sc1) + sh1
        hc = rms_norm(ctx, norm1_g[l]) * (1 + csc1) + csh1
        mix_x, mix_c = token_mixers(hx, hc, w_in[l], lam_q1[l], lam_k1[l], lam_q2[l], lam_k2[l],
                                    subln_g[l], q_norm_g[l], k_norm_g[l], sink[l],
                                    lambda_init, rope, not last)
        x = x + g1 * (mix_x @ w_out[l])
        hx = rms_norm(x, norm2_g[l]) * (1 + sc2) + sh2
        x = x + g2 * moe_ffn(hx, w_router, router_bias, w_gate[l], w_up[l], w_down[l])

        if not last:
            ctx = ctx + cg1 * (mix_c @ w_out[l])
            hc = rms_norm(ctx, norm2_g[l]) * (1 + csc2) + csh2
            ctx = ctx + cg2 * moe_ffn(hc, w_router, router_bias, w_gate[l], w_up[l], w_down[l])
    return rms_norm(x, final_g)
```

```cpp
#include <hip/hip_runtime.h>
#include <hip/hip_cooperative_groups.h>
#include <stdint.h>
#include <stdio.h>

namespace cg = cooperative_groups;

#define DI __device__ __forceinline__
typedef unsigned short bf16_t;
typedef short bf16x8 __attribute__((ext_vector_type(8)));
typedef float f32x16 __attribute__((ext_vector_type(16)));
typedef float f32x4 __attribute__((ext_vector_type(4)));
typedef float f32x2 __attribute__((ext_vector_type(2)));
typedef unsigned u32x4 __attribute__((ext_vector_type(4)));
typedef unsigned u32x2 __attribute__((ext_vector_type(2)));

constexpr int NB = 8, SEQ = 2048, CTXL = 256, TPB = SEQ + CTXL  , NTOK = NB * TPB  ;
constexpr int DM = 1024, INC = 2560, NEXP = 16, DEXP = 256;
constexpr int NQU = 16, NKU = 12, NVR = 768;
constexpr int NTHREADS = 256;
constexpr float RMS_EPS = 1e-6f;
constexpr float QSCALE = 0.125f * 1.4426950408889634f;

constexpr size_t OFF_CTL  = 0;
constexpr size_t OFF_MOD  = 4096;
constexpr size_t OFF_ROPE = OFF_MOD + (size_t)2 * 9 * 6144 * 4;
constexpr size_t OFF_WIN  = OFF_ROPE + (size_t)2048 * 64 * 8;
constexpr size_t OFF_WOUT = OFF_WIN + (size_t)2 * 2560 * 1024 * 2;
constexpr size_t OFF_WGU  = OFF_WOUT + (size_t)2 * 1024 * 1024 * 2;
constexpr size_t OFF_WD   = OFF_WGU + (size_t)2 * 16 * 512 * 1024 * 2;
constexpr size_t OFF_HX   = OFF_WD + (size_t)2 * 16 * 1024 * 256 * 2;
constexpr size_t OFF_QB   = OFF_HX + (size_t)NTOK * DM * 2;
constexpr size_t OFF_KB   = OFF_QB + (size_t)NB * NQU * TPB * 64 * 2;
constexpr size_t OFF_VT   = OFF_KB + (size_t)NB * NKU * TPB * 64 * 2;
constexpr size_t OFF_Y    = OFF_QB;
constexpr size_t OFF_XC   = OFF_VT + (size_t)NB * NVR * TPB * 2;
constexpr size_t HB_ROWS  = 2 * NTOK + NEXP * 128;
constexpr size_t OFF_HB   = OFF_XC + (size_t)NB * CTXL * DM * 4;
constexpr size_t OFF_LIST = OFF_HB + HB_ROWS * DEXP * 2;
constexpr size_t OFF_TOKW = OFF_LIST + (size_t)NEXP * NTOK * 4;
constexpr size_t WS_END   = OFF_TOKW + (size_t)2 * NTOK * 4;
static_assert(WS_END <= (size_t)256 * 1024 * 1024, "workspace");
static_assert((size_t)2 * NTOK * DM * 2 <= OFF_XC - OFF_QB, "Y alias");

struct Params {
    const float *x, *c, *ctx, *c_ctx, *w_ada, *b_ada, *norm1_g, *norm2_g, *w_in, *w_out, *lam_q1, *lam_k1, *lam_q2, *lam_k2,
        *subln_g, *q_norm_g, *k_norm_g, *sink, *w_router, *router_bias, *w_gate, *w_up, *w_down, *final_g;
    float* out;
    unsigned char* ws;
};

DI float bf2f(bf16_t b) { return __uint_as_float(((unsigned)b) << 16); }
DI bf16_t f2bf(float f) { unsigned u = __float_as_uint(f); return (bf16_t)((u + 0x7fffu + ((u >> 16) & 1u)) >> 16); }
DI unsigned pk2(float lo, float hi) { return (unsigned)f2bf(lo) | ((unsigned)f2bf(hi) << 16); }
DI int crow(int reg, int h) { return (reg & 3) + 8 * (reg >> 2) + 4 * h; }
DI float wave_sum(float v) {
#pragma unroll
    for (int o = 1; o < 64; o <<= 1) v += __shfl_xor(v, o);
    return v;
}
DI float silu(float v) { return v / (1.f + expf(-v)); }
DI float* resid_row(const Params& P, int b, int p) {
    return p < CTXL ? (float*)(P.ws + OFF_XC) + (size_t)(b * CTXL + p) * DM : P.out + (size_t)(b * SEQ + p - CTXL) * DM;
}
DI const float* input_row(const Params& P, int b, int p) {
    return p < CTXL ? P.ctx + (size_t)(b * CTXL + p) * DM : P.x + (size_t)(b * SEQ + p - CTXL) * DM;
}
DI const float* mod_row(const Params& P, int l, int mr) { return (const float*)(P.ws + OFF_MOD) + (size_t)(l * 9 + mr) * 6144; }

template <class RowFn>
DI void transpose_item(float* s  , const float* W, int N, int k0, int n0, bf16_t* dst, int ldd, RowFn drow) {
    const int t = threadIdx.x;
    __syncthreads();
#pragma unroll
    for (int i = 0; i < 16; ++i) { const int r = (t >> 6) + 4 * i, cc = t & 63; s[r * 65 + cc] = W[(size_t)(k0 + r) * N + n0 + cc]; }
    __syncthreads();
    const int n = t >> 2, kc = (t & 3) * 16;
    u32x4 o0, o1;
    o0.x = pk2(s[(kc + 0) * 65 + n], s[(kc + 1) * 65 + n]);   o0.y = pk2(s[(kc + 2) * 65 + n], s[(kc + 3) * 65 + n]);
    o0.z = pk2(s[(kc + 4) * 65 + n], s[(kc + 5) * 65 + n]);   o0.w = pk2(s[(kc + 6) * 65 + n], s[(kc + 7) * 65 + n]);
    o1.x = pk2(s[(kc + 8) * 65 + n], s[(kc + 9) * 65 + n]);   o1.y = pk2(s[(kc + 10) * 65 + n], s[(kc + 11) * 65 + n]);
    o1.z = pk2(s[(kc + 12) * 65 + n], s[(kc + 13) * 65 + n]); o1.w = pk2(s[(kc + 14) * 65 + n], s[(kc + 15) * 65 + n]);
    bf16_t* d = dst + (size_t)drow(n0 + n) * ldd + k0 + kc;
    *(u32x4*)d = o0; *(u32x4*)(d + 8) = o1;
}

DI void phase_prologue(const Params& P, int bid, int nb, char* smem) {
    const int t = threadIdx.x;
    float* s = (float*)smem;
    constexpr int I_IN = 2 * 16 * 40, I_OUT = 2 * 16 * 16, I_G = 32 * 16 * 4, I_U = I_G, I_D = 32 * 4 * 16;
    constexpr int I_MOD = 2 * 384, I_ROPE = 512;
    constexpr int NITEMS = I_IN + I_OUT + I_G + I_U + I_D + I_MOD + I_ROPE + 1;
    for (int it = bid; it < NITEMS; it += nb) {
        int r = it;
        if (r < I_IN) { const int l = r / 640, q = r % 640, kb = q / 40, nbk = q % 40;
            transpose_item(s, P.w_in + (size_t)l * DM * INC, INC, kb * 64, nbk * 64, (bf16_t*)(P.ws + OFF_WIN) + (size_t)l * INC * DM, DM, [](int n) { return n; });
            continue; }
        r -= I_IN;
        if (r < I_OUT) { const int l = r / 256, q = r % 256, kb = q / 16, nbk = q % 16;
            transpose_item(s, P.w_out + (size_t)l * DM * DM, DM, kb * 64, nbk * 64, (bf16_t*)(P.ws + OFF_WOUT) + (size_t)l * DM * DM, DM, [](int n) { return n; });
            continue; }
        r -= I_OUT;
        if (r < I_G) { const int le = r / 64, q = r % 64, kb = q / 4, nbk = q % 4;
            transpose_item(s, P.w_gate + (size_t)le * DM * DEXP, DEXP, kb * 64, nbk * 64, (bf16_t*)(P.ws + OFF_WGU) + (size_t)le * 512 * DM, DM, [](int n) { return (n >> 5) * 64 + (n & 31); });
            continue; }
        r -= I_G;
        if (r < I_U) { const int le = r / 64, q = r % 64, kb = q / 4, nbk = q % 4;
            transpose_item(s, P.w_up + (size_t)le * DM * DEXP, DEXP, kb * 64, nbk * 64, (bf16_t*)(P.ws + OFF_WGU) + (size_t)le * 512 * DM, DM, [](int n) { return (n >> 5) * 64 + 32 + (n & 31); });
            continue; }
        r -= I_U;
        if (r < I_D) { const int le = r / 64, q = r % 64, kb = q / 16, nbk = q % 16;
            transpose_item(s, P.w_down + (size_t)le * DEXP * DM, DM, kb * 64, nbk * 64, (bf16_t*)(P.ws + OFF_WD) + (size_t)le * DM * DEXP, DEXP, [](int n) { return n; });
            continue; }
        r -= I_D;
        if (r < I_MOD) {
            const int l = r / 384, col0 = (r % 384) * 16;
            const int cc = t & 15, kg = t >> 4;
            float acc[9];
#pragma unroll
            for (int i = 0; i < 9; ++i) acc[i] = 0.f;
            const float* W = P.w_ada + (size_t)l * DM * 6144 + col0 + cc;
            for (int kk = 0; kk < 64; ++kk) {
                const int k = kg * 64 + kk;
                const float w = W[(size_t)k * 6144];
#pragma unroll
                for (int i = 0; i < 8; ++i) acc[i] += silu(P.c[i * DM + k]) * w;
                acc[8] += silu(P.c_ctx[k]) * w;
            }
            __syncthreads();
#pragma unroll
            for (int i = 0; i < 9; ++i) s[(i * 16 + kg) * 16 + cc] = acc[i];
            __syncthreads();
            if (t < 144) { const int i = t >> 4, c2 = t & 15; float a = P.b_ada[l * 6144 + col0 + c2];
                for (int g = 0; g < 16; ++g) a += s[(i * 16 + g) * 16 + c2];
                ((float*)(P.ws + OFF_MOD))[(size_t)(l * 9 + i) * 6144 + col0 + c2] = a; }
            continue; }
        r -= I_MOD;
        if (r < I_ROPE) {
            const int idx = r * 256 + t, tt = idx >> 6, d = idx & 63;
            const int pos = d < 32 ? (tt >> 6) : (tt & 63), j = d & 15;
            const float invf = powf(10000.f, -(float)j / 16.f);
            const float ang = (float)pos * invf;
            float sn, cs; sincosf(ang, &sn, &cs);
            f32x2 o; o.x = cs; o.y = (d & 16) ? sn : -sn;
            ((f32x2*)(P.ws + OFF_ROPE))[idx] = o;
            continue; }
        if (t < 64) ((int*)(P.ws + OFF_CTL))[t] = 0;
    }
}

DI void phase_norm1(const Params& P, int l, int bid, int nb) {
    const int lane = threadIdx.x & 63, wave = threadIdx.x >> 6;
    const bf16_t* Y = (const bf16_t*)(P.ws + OFF_Y);
    bf16_t* HX = (bf16_t*)(P.ws + OFF_HX);
    for (int tok = bid * 4 + wave; tok < NTOK; tok += nb * 4) {
        const int b = tok / TPB, p = tok % TPB, mr = p < CTXL ? 8 : b;
        f32x4 v[4];
        if (l == 0) {
            const f32x4* src = (const f32x4*)input_row(P, b, p) + lane;
#pragma unroll
            for (int j = 0; j < 4; ++j) v[j] = src[64 * j];
        } else {
            f32x4* xr = (f32x4*)resid_row(P, b, p) + lane;
            const u32x2* y0 = (const u32x2*)(Y + (size_t)(2 * tok) * DM) + lane;
            const u32x2* y1 = (const u32x2*)(Y + (size_t)(2 * tok + 1) * DM) + lane;
            const f32x4* g2 = (const f32x4*)(mod_row(P, l - 1, mr) + 5120) + lane;
#pragma unroll
            for (int j = 0; j < 4; ++j) {
                const f32x4 xv = xr[64 * j], g = g2[64 * j]; const u32x2 a = y0[64 * j], c2 = y1[64 * j];
                f32x4 yv;
                yv.x = __uint_as_float(a.x << 16) + __uint_as_float(c2.x << 16);
                yv.y = __uint_as_float(a.x & 0xffff0000u) + __uint_as_float(c2.x & 0xffff0000u);
                yv.z = __uint_as_float(a.y << 16) + __uint_as_float(c2.y << 16);
                yv.w = __uint_as_float(a.y & 0xffff0000u) + __uint_as_float(c2.y & 0xffff0000u);
                v[j] = xv + g * yv;
                xr[64 * j] = v[j];
            }
        }
        float ss = 0.f;
#pragma unroll
        for (int j = 0; j < 4; ++j) ss += (v[j].x * v[j].x + v[j].y * v[j].y) + (v[j].z * v[j].z + v[j].w * v[j].w);
        const float r = rsqrtf(wave_sum(ss) * (1.f / DM) + RMS_EPS);
        const float* md = mod_row(P, l, mr);
        const f32x4* gn = (const f32x4*)(P.norm1_g + l * DM) + lane;
        const f32x4* sh = (const f32x4*)(md) + lane;
        const f32x4* sc = (const f32x4*)(md + 1024) + lane;
        u32x2* o = (u32x2*)(HX + (size_t)tok * DM) + lane;
#pragma unroll
        for (int j = 0; j < 4; ++j) {
            const f32x4 g = gn[64 * j], s1 = sc[64 * j], h1 = sh[64 * j];
            f32x4 y;
            y.x = v[j].x * r * g.x * (1.f + s1.x) + h1.x; y.y = v[j].y * r * g.y * (1.f + s1.y) + h1.y;
            y.z = v[j].z * r * g.z * (1.f + s1.z) + h1.z; y.w = v[j].w * r * g.w * (1.f + s1.w) + h1.w;
            u32x2 w; w.x = pk2(y.x, y.y); w.y = pk2(y.z, y.w);
            o[64 * j] = w;
        }
    }
}

DI void phase_final(const Params& P, int bid, int nb) {
    const int lane = threadIdx.x & 63, wave = threadIdx.x >> 6;
    const bf16_t* Y = (const bf16_t*)(P.ws + OFF_Y);
    for (int r = bid * 4 + wave; r < NB * SEQ; r += nb * 4) {
        const int b = r / SEQ, p = CTXL + r % SEQ, tok = b * TPB + p;
        f32x4* xr = (f32x4*)resid_row(P, b, p) + lane;
        const u32x2* y0 = (const u32x2*)(Y + (size_t)(2 * tok) * DM) + lane;
        const u32x2* y1 = (const u32x2*)(Y + (size_t)(2 * tok + 1) * DM) + lane;
        const f32x4* g2 = (const f32x4*)(mod_row(P, 1, b) + 5120) + lane;
        f32x4 v[4]; float ss = 0.f;
#pragma unroll
        for (int j = 0; j < 4; ++j) {
            const f32x4 xv = xr[64 * j], g = g2[64 * j]; const u32x2 a = y0[64 * j], c2 = y1[64 * j];
            f32x4 yv;
            yv.x = __uint_as_float(a.x << 16) + __uint_as_float(c2.x << 16);
            yv.y = __uint_as_float(a.x & 0xffff0000u) + __uint_as_float(c2.x & 0xffff0000u);
            yv.z = __uint_as_float(a.y << 16) + __uint_as_float(c2.y << 16);
            yv.w = __uint_as_float(a.y & 0xffff0000u) + __uint_as_float(c2.y & 0xffff0000u);
            v[j] = xv + g * yv;
            ss += (v[j].x * v[j].x + v[j].y * v[j].y) + (v[j].z * v[j].z + v[j].w * v[j].w);
        }
        const float rr = rsqrtf(wave_sum(ss) * (1.f / DM) + RMS_EPS);
        const f32x4* fg = (const f32x4*)P.final_g + lane;
#pragma unroll
        for (int j = 0; j < 4; ++j) { const f32x4 g = fg[64 * j]; xr[64 * j] = v[j] * rr * g; }
    }
}

DI void gemm_core(char* smem, const bf16_t* const (&ap)[4], const bf16_t* const (&bp)[4], int K, f32x16 (&acc)[2][2]) {
    const int t = threadIdx.x, lane = t & 63, wave = t >> 6, wr = wave >> 1, wc = wave & 1, h = lane >> 5;
    char* sA = smem; char* sB = smem + 16384;
    const int c = t & 7, row0 = t >> 3;
    const int woff = row0 * 128 + ((c ^ ((row0 >> 1) & 7)) << 4);
    const int sw = (lane >> 1) & 7;
    const int ra_off = (wr * 64 + (lane & 31)) * 128, rb_off = (wc * 64 + (lane & 31)) * 128;
    u32x4 ra[4], rb[4];
#pragma unroll
    for (int i = 0; i < 4; ++i) { ra[i] = *(const u32x4*)(ap[i]); rb[i] = *(const u32x4*)(bp[i]); }
#pragma unroll
    for (int mt = 0; mt < 2; ++mt)
#pragma unroll
        for (int nt = 0; nt < 2; ++nt)
#pragma unroll
            for (int i = 0; i < 16; ++i) acc[mt][nt][i] = 0.f;
    const int nk = K >> 6;
    for (int kt = 0; kt < nk; ++kt) {
        __syncthreads();
#pragma unroll
        for (int i = 0; i < 4; ++i) { *(u32x4*)(sA + woff + i * 4096) = ra[i]; *(u32x4*)(sB + woff + i * 4096) = rb[i]; }
        __syncthreads();
        if (kt + 1 < nk) {
#pragma unroll
            for (int i = 0; i < 4; ++i) { ra[i] = *(const u32x4*)(ap[i] + (kt + 1) * 64); rb[i] = *(const u32x4*)(bp[i] + (kt + 1) * 64); }
        }
#pragma unroll
        for (int s = 0; s < 4; ++s) {
            const int co = ((2 * s + h) ^ sw) << 4;
            bf16x8 a[2], bb[2];
            a[0] = *(const bf16x8*)(sA + ra_off + co); a[1] = *(const bf16x8*)(sA + ra_off + 32 * 128 + co);
            bb[0] = *(const bf16x8*)(sB + rb_off + co); bb[1] = *(const bf16x8*)(sB + rb_off + 32 * 128 + co);
#pragma unroll
            for (int mt = 0; mt < 2; ++mt)
#pragma unroll
                for (int nt = 0; nt < 2; ++nt) acc[mt][nt] = __builtin_amdgcn_mfma_f32_32x32x16_bf16(a[mt], bb[nt], acc[mt][nt], 0, 0, 0);
        }
    }
}

DI void phase_qkv(const Params& P, int l, int bid, int nb, char* smem) {
    const int t = threadIdx.x, lane = t & 63, wave = t >> 6, wr = wave >> 1, wc = wave & 1, h = lane >> 5, ln = lane & 31;
    const bf16_t* HX = (const bf16_t*)(P.ws + OFF_HX);
    const bf16_t* Wt = (const bf16_t*)(P.ws + OFF_WIN) + (size_t)l * INC * DM;
    bf16_t* QB = (bf16_t*)(P.ws + OFF_QB); bf16_t* KB = (bf16_t*)(P.ws + OFF_KB); bf16_t* VT = (bf16_t*)(P.ws + OFF_VT);
    const f32x2* ROPE = (const f32x2*)(P.ws + OFF_ROPE);
    constexpr int NMT = NTOK / 128, NNT = INC / 128;
    for (int w = bid; w < NMT * NNT; w += nb) {
        const int mti = w / NNT, nti = w % NNT;
        const int tok0 = mti * 128, b = tok0 / TPB, p0 = tok0 % TPB;
        const bool isctx = p0 < CTXL;
        if (l == 1 && isctx && nti < 8) continue;
        const bf16_t* ap[4]; const bf16_t* bp[4];
#pragma unroll
        for (int i = 0; i < 4; ++i) { const int row = (t >> 3) + 32 * i; ap[i] = HX + (size_t)(tok0 + row) * DM + (t & 7) * 8; bp[i] = Wt + (size_t)(nti * 128 + row) * DM + (t & 7) * 8; }
        f32x16 acc[2][2];
        gemm_core(smem, ap, bp, DM, acc);
        const int cw = nti * 128 + wc * 64;
        int kind, unit;
        bool nrm = false; const float* ng = nullptr;
        if (cw < 1024) { kind = 0; unit = cw >> 6; if (unit >= 8 && unit < 12) { nrm = true; ng = P.q_norm_g + l * 64; } }
        else if (cw < 1536) { kind = 1; unit = (cw - 1024) >> 6; }
        else if (cw < 2048) { kind = 2; unit = cw - 1536; }
        else if (cw < 2176) { kind = 1; unit = 8 + ((cw - 2048) >> 6); nrm = true; ng = P.k_norm_g + l * 64; }
        else if (cw < 2304) { kind = 2; unit = 512 + (cw - 2176); }
        else if (cw < 2432) { kind = 1; unit = 10 + ((cw - 2304) >> 6); }
        else { kind = 2; unit = 640 + (cw - 2432); }
        if (kind == 2) {
#pragma unroll
            for (int mt = 0; mt < 2; ++mt)
#pragma unroll
                for (int nt = 0; nt < 2; ++nt) {
                    bf16_t* dst = VT + ((size_t)b * NVR + unit + nt * 32 + ln) * TPB + p0 + wr * 64 + mt * 32 + 4 * h;
#pragma unroll
                    for (int g = 0; g < 4; ++g) { u32x2 o; o.x = pk2(acc[mt][nt][4 * g], acc[mt][nt][4 * g + 1]); o.y = pk2(acc[mt][nt][4 * g + 2], acc[mt][nt][4 * g + 3]);
                        *(u32x2*)(dst + 8 * g) = o; }
                }
        } else {
            const float g0 = nrm ? ng[ln] : 1.f, g1 = nrm ? ng[32 + ln] : 1.f;
            const float osc = kind == 0 ? QSCALE : 1.f;
            bf16_t* base = (kind == 0 ? QB + ((size_t)b * NQU + unit) * TPB * 64 : KB + ((size_t)b * NKU + unit) * TPB * 64);
#pragma unroll
            for (int mt = 0; mt < 2; ++mt)
#pragma unroll
                for (int i = 0; i < 16; ++i) {
                    float v0 = acc[mt][0][i], v1 = acc[mt][1][i];
                    const int p = p0 + wr * 64 + mt * 32 + crow(i, h);
                    if (nrm) {
                        float ss = v0 * v0 + v1 * v1;
                        ss += __shfl_xor(ss, 1); ss += __shfl_xor(ss, 2); ss += __shfl_xor(ss, 4); ss += __shfl_xor(ss, 8); ss += __shfl_xor(ss, 16);
                        const float r = rsqrtf(ss * (1.f / 64.f) + RMS_EPS);
                        v0 = v0 * r * g0; v1 = v1 * r * g1;
                    }
                    if (!isctx) {
                        const float u0 = __shfl_xor(v0, 16), u1 = __shfl_xor(v1, 16);
                        const f32x2 c0 = ROPE[(size_t)(p - CTXL) * 64 + ln], c1 = ROPE[(size_t)(p - CTXL) * 64 + 32 + ln];
                        v0 = v0 * c0.x + u0 * c0.y; v1 = v1 * c1.x + u1 * c1.y;
                    }
                    base[(size_t)p * 64 + ln] = f2bf(v0 * osc);
                    base[(size_t)p * 64 + 32 + ln] = f2bf(v1 * osc);
                }
        }
    }
}

template <int DV>
DI void naive_attn_acc(const bf16_t* qrow, const bf16_t* Kb, const bf16_t* Vt, int lo0, int hi0, int lo1, int hi1, bool has_sink, float sink2, float coef, float (&acc)[DV]) {
    float q[64];
#pragma unroll
    for (int i = 0; i < 8; ++i) { const u32x4 v = ((const u32x4*)qrow)[i];
        q[8 * i + 0] = __uint_as_float(v.x << 16); q[8 * i + 1] = __uint_as_float(v.x & 0xffff0000u); q[8 * i + 2] = __uint_as_float(v.y << 16); q[8 * i + 3] = __uint_as_float(v.y & 0xffff0000u);
        q[8 * i + 4] = __uint_as_float(v.z << 16); q[8 * i + 5] = __uint_as_float(v.z & 0xffff0000u); q[8 * i + 6] = __uint_as_float(v.w << 16); q[8 * i + 7] = __uint_as_float(v.w & 0xffff0000u); }
    float m = has_sink ? sink2 : -1e30f, lsum = has_sink ? 1.f : 0.f;
    for (int rg = 0; rg < 2; ++rg) {
        const int lo = rg ? lo1 : lo0, hi = rg ? hi1 : hi0;
        for (int key = lo; key < hi; ++key) {
            const u32x4* kr = (const u32x4*)(Kb + (size_t)key * 64);
            float s = 0.f;
#pragma unroll
            for (int i = 0; i < 8; ++i) { const u32x4 v = kr[i];
                s += q[8 * i + 0] * __uint_as_float(v.x << 16) + q[8 * i + 1] * __uint_as_float(v.x & 0xffff0000u) + q[8 * i + 2] * __uint_as_float(v.y << 16) + q[8 * i + 3] * __uint_as_float(v.y & 0xffff0000u)
                   + q[8 * i + 4] * __uint_as_float(v.z << 16) + q[8 * i + 5] * __uint_as_float(v.z & 0xffff0000u) + q[8 * i + 6] * __uint_as_float(v.w << 16) + q[8 * i + 7] * __uint_as_float(v.w & 0xffff0000u); }
            const float mn = fmaxf(m, s);
            lsum = lsum * exp2f(m - mn) + exp2f(s - mn); m = mn;
        }
    }
    const float inv = coef / lsum;
    for (int rg = 0; rg < 2; ++rg) {
        const int lo = rg ? lo1 : lo0, hi = rg ? hi1 : hi0;
        for (int key = lo; key < hi; ++key) {
            const u32x4* kr = (const u32x4*)(Kb + (size_t)key * 64);
            float s = 0.f;
#pragma unroll
            for (int i = 0; i < 8; ++i) { const u32x4 v = kr[i];
                s += q[8 * i + 0] * __uint_as_float(v.x << 16) + q[8 * i + 1] * __uint_as_float(v.x & 0xffff0000u) + q[8 * i + 2] * __uint_as_float(v.y << 16) + q[8 * i + 3] * __uint_as_float(v.y & 0xffff0000u)
                   + q[8 * i + 4] * __uint_as_float(v.z << 16) + q[8 * i + 5] * __uint_as_float(v.z & 0xffff0000u) + q[8 * i + 6] * __uint_as_float(v.w << 16) + q[8 * i + 7] * __uint_as_float(v.w & 0xffff0000u); }
            const float pr = exp2f(s - m) * inv;
#pragma unroll
            for (int d = 0; d < DV; ++d) acc[d] += pr * bf2f(Vt[(size_t)d * TPB + key]);
        }
    }
}

DI void phase_attn_naive(const Params& P, int l, int bid, int nb) {
    const int t = threadIdx.x;
    const bf16_t* QB = (const bf16_t*)(P.ws + OFF_QB); const bf16_t* KB = (const bf16_t*)(P.ws + OFF_KB); const bf16_t* VT = (const bf16_t*)(P.ws + OFF_VT);
    bf16_t* MIX = (bf16_t*)(P.ws + OFF_HX);
    const float lambda_init = l == 0 ? 0.2f : (0.8f - 0.6f * expf(-0.3f));
    float d1 = 0.f, d2 = 0.f;
    for (int i = 0; i < 64; ++i) { d1 += P.lam_q1[l * 64 + i] * P.lam_k1[l * 64 + i]; d2 += P.lam_q2[l * 64 + i] * P.lam_k2[l * 64 + i]; }
    const float lam = expf(d1) - expf(d2) + lambda_init;
    const int nitems = NB * 12 * 9;
    for (int it = bid; it < nitems; it += nb) {
        const int qc = it % 9, ty = (it / 9) % 12, b = it / 108;
        if (qc == 0 && l == 1) continue;
        const int p = qc * 256 + t;
        const bool isctx = qc == 0;
        const int tpos = p - CTXL;
        const int tok = b * TPB + p;
        if (ty < 4) {
            float acc[128];
#pragma unroll
            for (int d = 0; d < 128; ++d) acc[d] = 0.f;
            const bf16_t* V = VT + ((size_t)b * NVR + ty * 128) * TPB;
            const int hi = isctx ? CTXL : TPB;
            naive_attn_acc<128>(QB + (((size_t)b * NQU + 2 * ty + 1) * TPB + p) * 64, KB + ((size_t)b * NKU + 2 * ty + 1) * TPB * 64, V, 0, hi, 0, 0, false, 0.f, -lam, acc);
            naive_attn_acc<128>(QB + (((size_t)b * NQU + 2 * ty) * TPB + p) * 64, KB + ((size_t)b * NKU + 2 * ty) * TPB * 64, V, 0, hi, 0, 0, false, 0.f, 1.f, acc);
            float ss = 0.f;
#pragma unroll
            for (int d = 0; d < 128; ++d) ss += acc[d] * acc[d];
            const float r = rsqrtf(ss * (1.f / 128.f) + RMS_EPS) * (1.f - lambda_init);
            bf16_t* o = MIX + (size_t)tok * DM + ty * 128;
#pragma unroll
            for (int d = 0; d < 128; d += 2) *(unsigned*)(o + d) = pk2(acc[d] * r * P.subln_g[l * 128 + d], acc[d + 1] * r * P.subln_g[l * 128 + d + 1]);
        } else {
            const int j = (ty - 4) & 3; const bool isC = ty >= 8;
            float acc[64];
#pragma unroll
            for (int d = 0; d < 64; ++d) acc[d] = 0.f;
            const int qu = (isC ? 12 : 8) + j, ku = (isC ? 10 : 8) + (j >> 1), vr = (isC ? 640 : 512) + (j >> 1) * 64;
            int lo0 = 0, hi0 = isctx ? CTXL : TPB, lo1 = 0, hi1 = 0;
            if (isC && !isctx) { hi0 = CTXL; lo1 = CTXL + max(0, tpos - 128); hi1 = CTXL + min(SEQ - 1, tpos + 128) + 1; }
            const float sink2 = isC ? P.sink[l * 4 + j] * 1.4426950408889634f : 0.f;
            naive_attn_acc<64>(QB + (((size_t)b * NQU + qu) * TPB + p) * 64, KB + ((size_t)b * NKU + ku) * TPB * 64, VT + ((size_t)b * NVR + vr) * TPB, lo0, hi0, lo1, hi1, isC, sink2, 1.f, acc);
            bf16_t* o = MIX + (size_t)tok * DM + (isC ? 768 : 512) + j * 64;
#pragma unroll
            for (int d = 0; d < 64; d += 2) *(unsigned*)(o + d) = pk2(acc[d], acc[d + 1]);
        }
    }
}

DI void phase_outproj(const Params& P, int l, int bid, int nb, char* smem) {
    const int t = threadIdx.x, lane = t & 63, wave = t >> 6, wr = wave >> 1, wc = wave & 1, h = lane >> 5, ln = lane & 31;
    const bf16_t* MIX = (const bf16_t*)(P.ws + OFF_HX);
    const bf16_t* Wt = (const bf16_t*)(P.ws + OFF_WOUT) + (size_t)l * DM * DM;
    constexpr int NMT = NTOK / 128, NNT = DM / 128;
    for (int w = bid; w < NMT * NNT; w += nb) {
        const int mti = w / NNT, nti = w % NNT;
        const int tok0 = mti * 128, b = tok0 / TPB, p0 = tok0 % TPB;
        const bool isctx = p0 < CTXL;
        if (l == 1 && isctx) continue;
        const bf16_t* ap[4]; const bf16_t* bp[4];
#pragma unroll
        for (int i = 0; i < 4; ++i) { const int row = (t >> 3) + 32 * i; ap[i] = MIX + (size_t)(tok0 + row) * DM + (t & 7) * 8; bp[i] = Wt + (size_t)(nti * 128 + row) * DM + (t & 7) * 8; }
        f32x16 acc[2][2];
        gemm_core(smem, ap, bp, DM, acc);
        const float* g1 = mod_row(P, l, isctx ? 8 : b) + 2048;
#pragma unroll
        for (int nt = 0; nt < 2; ++nt) {
            const int col = nti * 128 + wc * 64 + nt * 32 + ln;
            const float g = g1[col];
#pragma unroll
            for (int mt = 0; mt < 2; ++mt) {
                asm volatile("" ::: "memory");
#pragma unroll
                for (int i = 0; i < 16; ++i) {
                    const int p = p0 + wr * 64 + mt * 32 + crow(i, h);
                    const float xin = (l == 0 ? input_row(P, b, p) : resid_row(P, b, p))[col];
                    resid_row(P, b, p)[col] = xin + g * acc[mt][nt][i];
                }
            }
        }
    }
}

DI void phase_norm2_route(const Params& P, int l, int bid, int nb, char* smem) {
    const int t = threadIdx.x, lane = t & 63, wave = t >> 6;
    __syncthreads();
    for (int idx = t; idx < 1024 * 4; idx += NTHREADS) {
        const int k = idx >> 2, q = idx & 3;
        const int row = ((k >> 8) * 4 + (k & 3)) * 64 + ((k >> 2) & 63);
        *(f32x4*)(smem + row * 64 + ((q ^ ((row >> 2) & 3)) << 4)) = *(const f32x4*)(P.w_router + k * 16 + q * 4);
    }
    __syncthreads();
    bf16_t* HX = (bf16_t*)(P.ws + OFF_HX);
    int* cnt = (int*)(P.ws + OFF_CTL) + l * 16;
    int* list = (int*)(P.ws + OFF_LIST);
    float* tokw = (float*)(P.ws + OFF_TOKW);
    for (int tok = bid * 4 + wave; tok < NTOK; tok += nb * 4) {
        const int b = tok / TPB, p = tok % TPB, mr = p < CTXL ? 8 : b;
        if (l == 1 && p < CTXL) continue;
        const f32x4* xr = (const f32x4*)resid_row(P, b, p) + lane;
        f32x4 v[4]; float ss = 0.f;
#pragma unroll
        for (int j = 0; j < 4; ++j) { v[j] = xr[64 * j]; ss += (v[j].x * v[j].x + v[j].y * v[j].y) + (v[j].z * v[j].z + v[j].w * v[j].w); }
        const float r = rsqrtf(wave_sum(ss) * (1.f / DM) + RMS_EPS);
        const float* md = mod_row(P, l, mr);
        const f32x4* gn = (const f32x4*)(P.norm2_g + l * DM) + lane;
        const f32x4* sh = (const f32x4*)(md + 3072) + lane;
        const f32x4* sc = (const f32x4*)(md + 4096) + lane;
        u32x2* o = (u32x2*)(HX + (size_t)tok * DM) + lane;
        float lg[16];
#pragma unroll
        for (int e = 0; e < 16; ++e) lg[e] = 0.f;
#pragma unroll
        for (int j = 0; j < 4; ++j) {
            const f32x4 g = gn[64 * j], s1 = sc[64 * j], h1 = sh[64 * j];
            float y[4];
            y[0] = v[j].x * r * g.x * (1.f + s1.x) + h1.x; y[1] = v[j].y * r * g.y * (1.f + s1.y) + h1.y;
            y[2] = v[j].z * r * g.z * (1.f + s1.z) + h1.z; y[3] = v[j].w * r * g.w * (1.f + s1.w) + h1.w;
            u32x2 w; w.x = pk2(y[0], y[1]); w.y = pk2(y[2], y[3]);
            o[64 * j] = w;
            asm volatile("" ::: "memory");
#pragma unroll
            for (int cc = 0; cc < 4; ++cc) {
                const int row = (j * 4 + cc) * 64 + lane;
#pragma unroll
                for (int q = 0; q < 4; ++q) {
                    const f32x4 wv = *(const f32x4*)(smem + row * 64 + ((q ^ ((row >> 2) & 3)) << 4));
                    lg[4 * q + 0] += y[cc] * wv.x; lg[4 * q + 1] += y[cc] * wv.y; lg[4 * q + 2] += y[cc] * wv.z; lg[4 * q + 3] += y[cc] * wv.w;
                }
            }
        }
#pragma unroll
        for (int e = 0; e < 16; ++e) lg[e] = wave_sum(lg[e]);
        if (lane == 0) {
            float scv[16], sel[16];
#pragma unroll
            for (int e = 0; e < 16; ++e) { scv[e] = 1.f / (1.f + expf(-lg[e])); sel[e] = scv[e] + P.router_bias[e]; }
            float bestg = -1e30f; int be1 = 0, be2 = 1; float bw1 = 0.f, bw2 = 0.f;
#pragma unroll
            for (int g = 0; g < 4; ++g) {
                int i1 = 0; float v1 = sel[4 * g], w1 = scv[4 * g];
#pragma unroll
                for (int j = 1; j < 4; ++j) if (sel[4 * g + j] > v1) { v1 = sel[4 * g + j]; w1 = scv[4 * g + j]; i1 = j; }
                int i2 = -1; float v2 = -1e30f, w2 = 0.f;
#pragma unroll
                for (int j = 0; j < 4; ++j) if (j != i1 && sel[4 * g + j] > v2) { v2 = sel[4 * g + j]; w2 = scv[4 * g + j]; i2 = j; }
                const float gs = v1 + v2;
                if (gs > bestg) { bestg = gs; be1 = 4 * g + i1; be2 = 4 * g + i2; bw1 = w1; bw2 = w2; }
            }
            const float inv = 1.f / (bw1 + bw2);
            const int p1 = atomicAdd(&cnt[be1], 1), p2 = atomicAdd(&cnt[be2], 1);
            list[be1 * NTOK + p1] = 2 * tok; list[be2 * NTOK + p2] = 2 * tok + 1;
            tokw[2 * tok] = bw1 * inv; tokw[2 * tok + 1] = bw2 * inv;
        }
    }
}

DI bool expert_tile(const int* cnt, int rt, int& e, int& ti, int& hbase, int& n) {
    int acc = 0;
#pragma unroll 1
    for (int i = 0; i < NEXP; ++i) { const int c = cnt[i], nt = (c + 127) >> 7; if (rt < acc + nt) { e = i; ti = rt - acc; hbase = (acc + ti) * 128; n = c; return true; } acc += nt; }
    return false;
}

DI void phase_gateup(const Params& P, int l, int bid, int nb, char* smem) {
    const int t = threadIdx.x, lane = t & 63, wave = t >> 6, wr = wave >> 1, wc = wave & 1, h = lane >> 5, ln = lane & 31;
    const bf16_t* HX = (const bf16_t*)(P.ws + OFF_HX);
    const int* cnt = (const int*)(P.ws + OFF_CTL) + l * 16;
    const int* list = (const int*)(P.ws + OFF_LIST);
    bf16_t* HB = (bf16_t*)(P.ws + OFF_HB);
    for (int w = bid;; w += nb) {
        const int rt = w >> 2, ct = w & 3;
        int e, ti, hbase, n;
        if (!expert_tile(cnt, rt, e, ti, hbase, n)) break;
        const bf16_t* Wt = (const bf16_t*)(P.ws + OFF_WGU) + (size_t)(l * 16 + e) * 512 * DM;
        const bf16_t* ap[4]; const bf16_t* bp[4];
#pragma unroll
        for (int i = 0; i < 4; ++i) { const int row = (t >> 3) + 32 * i; const int li = ti * 128 + row;
            const int slot = li < n ? list[e * NTOK + li] : 0;
            ap[i] = HX + (size_t)(slot >> 1) * DM + (t & 7) * 8; bp[i] = Wt + (size_t)(ct * 128 + row) * DM + (t & 7) * 8; }
        f32x16 acc[2][2];
        gemm_core(smem, ap, bp, DM, acc);
        const int hc = (ct * 128 + wc * 64) / 2 + ln;
#pragma unroll
        for (int mt = 0; mt < 2; ++mt)
#pragma unroll
            for (int i = 0; i < 16; ++i) {
                const float g = acc[mt][0][i], u = acc[mt][1][i];
                const int row = wr * 64 + mt * 32 + crow(i, h);
                HB[(size_t)(hbase + row) * DEXP + hc] = f2bf(g / (1.f + expf(-g)) * u);
            }
    }
}

DI void phase_down(const Params& P, int l, int bid, int nb, char* smem) {
    const int t = threadIdx.x, lane = t & 63, wave = t >> 6, wr = wave >> 1, wc = wave & 1, h = lane >> 5, ln = lane & 31;
    const int* cnt = (const int*)(P.ws + OFF_CTL) + l * 16;
    const int* list = (const int*)(P.ws + OFF_LIST);
    const float* tokw = (const float*)(P.ws + OFF_TOKW);
    const bf16_t* HB = (const bf16_t*)(P.ws + OFF_HB);
    bf16_t* Y = (bf16_t*)(P.ws + OFF_Y);
    for (int w = bid;; w += nb) {
        const int rt = w >> 3, ct = w & 7;
        int e, ti, hbase, n;
        if (!expert_tile(cnt, rt, e, ti, hbase, n)) break;
        const bf16_t* Wt = (const bf16_t*)(P.ws + OFF_WD) + (size_t)(l * 16 + e) * DM * DEXP;
        const bf16_t* ap[4]; const bf16_t* bp[4];
#pragma unroll
        for (int i = 0; i < 4; ++i) { const int row = (t >> 3) + 32 * i; ap[i] = HB + (size_t)(hbase + row) * DEXP + (t & 7) * 8; bp[i] = Wt + (size_t)(ct * 128 + row) * DEXP + (t & 7) * 8; }
        f32x16 acc[2][2];
        gemm_core(smem, ap, bp, DEXP, acc);
#pragma unroll
        for (int mt = 0; mt < 2; ++mt)
#pragma unroll
            for (int i = 0; i < 16; ++i) {
                const int li = ti * 128 + wr * 64 + mt * 32 + crow(i, h);
                if (li < n) {
                    const int slot = list[e * NTOK + li]; const float wg = tokw[slot];
                    bf16_t* yr = Y + (size_t)slot * DM + ct * 128 + wc * 64 + ln;
                    yr[0] = f2bf(wg * acc[mt][0][i]); yr[32] = f2bf(wg * acc[mt][1][i]);
                }
            }
    }
}

constexpr int NPHASES = 16;
__global__ void __launch_bounds__(NTHREADS, 2) mk_fwd(Params P, int ph_lo, int ph_hi) {
    __shared__ __attribute__((aligned(16))) char smem[65536];
    cg::grid_group grid = cg::this_grid();
    const int bid = blockIdx.x, nb = gridDim.x;
#define RUN(k, call) if (ph_lo <= (k) && (k) < ph_hi) { call; if ((k) + 1 < ph_hi) grid.sync(); }
    RUN(0, phase_prologue(P, bid, nb, smem))
    RUN(1, phase_norm1(P, 0, bid, nb))
    RUN(2, phase_qkv(P, 0, bid, nb, smem))
    RUN(3, (void)0)
    RUN(4, phase_outproj(P, 0, bid, nb, smem))
    RUN(5, phase_norm2_route(P, 0, bid, nb, smem))
    RUN(6, phase_gateup(P, 0, bid, nb, smem))
    RUN(7, phase_down(P, 0, bid, nb, smem))
    RUN(8, phase_norm1(P, 1, bid, nb))
    RUN(9, phase_qkv(P, 1, bid, nb, smem))
    RUN(10, (void)0)
    RUN(11, phase_outproj(P, 1, bid, nb, smem))
    RUN(12, phase_norm2_route(P, 1, bid, nb, smem))
    RUN(13, phase_gateup(P, 1, bid, nb, smem))
    RUN(14, phase_down(P, 1, bid, nb, smem))
    RUN(15, phase_final(P, bid, nb))
#undef RUN
}

__global__ void __launch_bounds__(NTHREADS) k_attn_naive(Params P, int l) { phase_attn_naive(P, l, blockIdx.x, gridDim.x); }

extern "C" void kernel_launch(void* const* d_in, const int* in_sizes, int n_in, void* d_out, int out_size, void* d_ws, size_t ws_size, hipStream_t stream) {
    Params p{};
    const float** f = (const float**)&p;
    for (int i = 0; i < 24; ++i) f[i] = (const float*)d_in[i];
    p.out = (float*)d_out; p.ws = (unsigned char*)d_ws;
    if (ws_size < WS_END) { fprintf(stderr, "workspace too small: %zu < %zu\n", ws_size, (size_t)WS_END); return; }
    for (int ph = 0; ph < NPHASES; ++ph) {
        if (ph >= 1 && ph < 15 && (ph - 1) % 7 == 2) hipLaunchKernelGGL(k_attn_naive, dim3(864), dim3(NTHREADS), 0, stream, p, (ph - 1) / 7);
        else hipLaunchKernelGGL(mk_fwd, dim3(512), dim3(NTHREADS), 0, stream, p, ph, ph + 1);
    }
}
```

```cpp
#include <hip/hip_runtime.h>
#include <hip/hip_cooperative_groups.h>
#include <stdint.h>
#include <stdio.h>

namespace cg = cooperative_groups;

#define DI __device__ __forceinline__
typedef unsigned short bf16_t;
typedef short bf16x8 __attribute__((ext_vector_type(8)));
typedef float f32x16 __attribute__((ext_vector_type(16)));
typedef float f32x4 __attribute__((ext_vector_type(4)));
typedef float f32x2 __attribute__((ext_vector_type(2)));
typedef unsigned u32x4 __attribute__((ext_vector_type(4)));
typedef unsigned u32x2 __attribute__((ext_vector_type(2)));

constexpr int NB = 8, SEQ = 2048, CTXL = 256, TPB = SEQ + CTXL  , NTOK = NB * TPB  ;
constexpr int DM = 1024, INC = 2560, NEXP = 16, DEXP = 256;
constexpr int NQU = 16, NKU = 12, NVR = 768;
constexpr int NTHREADS = 256;
constexpr float RMS_EPS = 1e-6f;
constexpr float QSCALE = 0.125f * 1.4426950408889634f;

constexpr size_t OFF_CTL  = 0;
constexpr size_t OFF_MOD  = 4096;
constexpr size_t OFF_ROPE = OFF_MOD + (size_t)2 * 9 * 6144 * 4;
constexpr size_t OFF_WIN  = OFF_ROPE + (size_t)2048 * 64 * 8;
constexpr size_t OFF_WOUT = OFF_WIN + (size_t)2 * 2560 * 1024 * 2;
constexpr size_t OFF_WGU  = OFF_WOUT + (size_t)2 * 1024 * 1024 * 2;
constexpr size_t OFF_WD   = OFF_WGU + (size_t)2 * 16 * 512 * 1024 * 2;
constexpr size_t OFF_HX   = OFF_WD + (size_t)2 * 16 * 1024 * 256 * 2;
constexpr size_t OFF_QB   = OFF_HX + (size_t)NTOK * DM * 2;
constexpr size_t OFF_KB   = OFF_QB + (size_t)NB * NQU * TPB * 64 * 2;
constexpr size_t OFF_VT   = OFF_KB + (size_t)NB * NKU * TPB * 64 * 2;
constexpr size_t OFF_Y    = OFF_QB;
constexpr size_t OFF_XC   = OFF_VT + (size_t)NB * NVR * TPB * 2;
constexpr size_t HB_ROWS  = 2 * NTOK + NEXP * 128;
constexpr size_t OFF_HB   = OFF_XC + (size_t)NB * CTXL * DM * 4;
constexpr size_t OFF_LIST = OFF_HB + HB_ROWS * DEXP * 2;
constexpr size_t OFF_TOKW = OFF_LIST + (size_t)NEXP * NTOK * 4;
constexpr size_t WS_END   = OFF_TOKW + (size_t)2 * NTOK * 4;
static_assert(WS_END <= (size_t)256 * 1024 * 1024, "workspace");
static_assert((size_t)2 * NTOK * DM * 2 <= OFF_XC - OFF_QB, "Y alias");

struct Params {
    const float *x, *c, *ctx, *c_ctx, *w_ada, *b_ada, *norm1_g, *norm2_g, *w_in, *w_out, *lam_q1, *lam_k1, *lam_q2, *lam_k2,
        *subln_g, *q_norm_g, *k_norm_g, *sink, *w_router, *router_bias, *w_gate, *w_up, *w_down, *final_g;
    float* out;
    unsigned char* ws;
};

DI float bf2f(bf16_t b) { return __uint_as_float(((unsigned)b) << 16); }
typedef __bf16 bf2_t __attribute__((ext_vector_type(2)));
DI bf16_t f2bf(float f) { return __builtin_bit_cast(bf16_t, (__bf16)f); }
DI unsigned pk2(float lo, float hi) { bf2_t v = {(__bf16)lo, (__bf16)hi}; return __builtin_bit_cast(unsigned, v); }
DI int crow(int reg, int h) { return (reg & 3) + 8 * (reg >> 2) + 4 * h; }
DI float wave_sum(float v) {
#pragma unroll
    for (int o = 1; o < 64; o <<= 1) v += __shfl_xor(v, o);
    return v;
}
DI float silu(float v) { return v / (1.f + expf(-v)); }
DI float* resid_row(const Params& P, int b, int p) {
    return p < CTXL ? (float*)(P.ws + OFF_XC) + (size_t)(b * CTXL + p) * DM : P.out + (size_t)(b * SEQ + p - CTXL) * DM;
}
DI const float* input_row(const Params& P, int b, int p) {
    return p < CTXL ? P.ctx + (size_t)(b * CTXL + p) * DM : P.x + (size_t)(b * SEQ + p - CTXL) * DM;
}
DI const float* mod_row(const Params& P, int l, int mr) { return (const float*)(P.ws + OFF_MOD) + (size_t)(l * 9 + mr) * 6144; }

template <class RowFn>
DI void transpose_item(float* s  , const float* W, int N, int k0, int n0, bf16_t* dst, int ldd, RowFn drow) {
    const int t = threadIdx.x;
    __syncthreads();
#pragma unroll
    for (int i = 0; i < 16; ++i) { const int r = (t >> 6) + 4 * i, cc = t & 63; s[r * 65 + cc] = W[(size_t)(k0 + r) * N + n0 + cc]; }
    __syncthreads();
    const int n = t >> 2, kc = (t & 3) * 16;
    u32x4 o0, o1;
    o0.x = pk2(s[(kc + 0) * 65 + n], s[(kc + 1) * 65 + n]);   o0.y = pk2(s[(kc + 2) * 65 + n], s[(kc + 3) * 65 + n]);
    o0.z = pk2(s[(kc + 4) * 65 + n], s[(kc + 5) * 65 + n]);   o0.w = pk2(s[(kc + 6) * 65 + n], s[(kc + 7) * 65 + n]);
    o1.x = pk2(s[(kc + 8) * 65 + n], s[(kc + 9) * 65 + n]);   o1.y = pk2(s[(kc + 10) * 65 + n], s[(kc + 11) * 65 + n]);
    o1.z = pk2(s[(kc + 12) * 65 + n], s[(kc + 13) * 65 + n]); o1.w = pk2(s[(kc + 14) * 65 + n], s[(kc + 15) * 65 + n]);
    bf16_t* d = dst + (size_t)drow(n0 + n) * ldd + k0 + kc;
    *(u32x4*)d = o0; *(u32x4*)(d + 8) = o1;
}

DI void phase_prologue(const Params& P, int bid, int nb, char* smem) {
    const int t = threadIdx.x;
    float* s = (float*)smem;
    constexpr int I_IN = 2 * 16 * 40, I_OUT = 2 * 16 * 16, I_G = 32 * 16 * 4, I_U = I_G, I_D = 32 * 4 * 16;
    constexpr int I_MOD = 2 * 384, I_ROPE = 512;
    constexpr int NITEMS = I_IN + I_OUT + I_G + I_U + I_D + I_MOD + I_ROPE + 1;
    for (int it = bid; it < NITEMS; it += nb) {
        int r = it;
        if (r < I_IN) { const int l = r / 640, q = r % 640, kb = q / 40, nbk = q % 40;
            transpose_item(s, P.w_in + (size_t)l * DM * INC, INC, kb * 64, nbk * 64, (bf16_t*)(P.ws + OFF_WIN) + (size_t)l * INC * DM, DM, [](int n) { return n; });
            continue; }
        r -= I_IN;
        if (r < I_OUT) { const int l = r / 256, q = r % 256, kb = q / 16, nbk = q % 16;
            transpose_item(s, P.w_out + (size_t)l * DM * DM, DM, kb * 64, nbk * 64, (bf16_t*)(P.ws + OFF_WOUT) + (size_t)l * DM * DM, DM, [](int n) { return n; });
            continue; }
        r -= I_OUT;
        if (r < I_G) { const int le = r / 64, q = r % 64, kb = q / 4, nbk = q % 4;
            transpose_item(s, P.w_gate + (size_t)le * DM * DEXP, DEXP, kb * 64, nbk * 64, (bf16_t*)(P.ws + OFF_WGU) + (size_t)le * 512 * DM, DM, [](int n) { return (n >> 5) * 64 + (n & 31); });
            continue; }
        r -= I_G;
        if (r < I_U) { const int le = r / 64, q = r % 64, kb = q / 4, nbk = q % 4;
            transpose_item(s, P.w_up + (size_t)le * DM * DEXP, DEXP, kb * 64, nbk * 64, (bf16_t*)(P.ws + OFF_WGU) + (size_t)le * 512 * DM, DM, [](int n) { return (n >> 5) * 64 + 32 + (n & 31); });
            continue; }
        r -= I_U;
        if (r < I_D) { const int le = r / 64, q = r % 64, kb = q / 16, nbk = q % 16;
            transpose_item(s, P.w_down + (size_t)le * DEXP * DM, DM, kb * 64, nbk * 64, (bf16_t*)(P.ws + OFF_WD) + (size_t)le * DM * DEXP, DEXP, [](int n) { return n; });
            continue; }
        r -= I_D;
        if (r < I_MOD) {
            const int l = r / 384, col0 = (r % 384) * 16;
            const int cc = t & 15, kg = t >> 4;
            float acc[9];
#pragma unroll
            for (int i = 0; i < 9; ++i) acc[i] = 0.f;
            const float* W = P.w_ada + (size_t)l * DM * 6144 + col0 + cc;
            for (int kk = 0; kk < 64; ++kk) {
                const int k = kg * 64 + kk;
                const float w = W[(size_t)k * 6144];
#pragma unroll
                for (int i = 0; i < 8; ++i) acc[i] += silu(P.c[i * DM + k]) * w;
                acc[8] += silu(P.c_ctx[k]) * w;
            }
            __syncthreads();
#pragma unroll
            for (int i = 0; i < 9; ++i) s[(i * 16 + kg) * 16 + cc] = acc[i];
            __syncthreads();
            if (t < 144) { const int i = t >> 4, c2 = t & 15; float a = P.b_ada[l * 6144 + col0 + c2];
                for (int g = 0; g < 16; ++g) a += s[(i * 16 + g) * 16 + c2];
                ((float*)(P.ws + OFF_MOD))[(size_t)(l * 9 + i) * 6144 + col0 + c2] = a; }
            continue; }
        r -= I_MOD;
        if (r < I_ROPE) {
            const int idx = r * 256 + t, tt = idx >> 6, d = idx & 63;
            const int pos = d < 32 ? (tt >> 6) : (tt & 63), j = d & 15;
            const float invf = powf(10000.f, -(float)j / 16.f);
            const float ang = (float)pos * invf;
            float sn, cs; sincosf(ang, &sn, &cs);
            f32x2 o; o.x = cs; o.y = (d & 16) ? sn : -sn;
            ((f32x2*)(P.ws + OFF_ROPE))[idx] = o;
            continue; }
        if (t < 64) ((int*)(P.ws + OFF_CTL))[t] = 0;
    }
}

DI void phase_norm1(const Params& P, int l, int bid, int nb) {
    const int lane = threadIdx.x & 63, wave = threadIdx.x >> 6;
    const bf16_t* Y = (const bf16_t*)(P.ws + OFF_Y);
    bf16_t* HX = (bf16_t*)(P.ws + OFF_HX);
    for (int tok = bid * 4 + wave; tok < NTOK; tok += nb * 4) {
        const int b = tok / TPB, p = tok % TPB, mr = p < CTXL ? 8 : b;
        f32x4 v[4];
        if (l == 0) {
            const f32x4* src = (const f32x4*)input_row(P, b, p) + lane;
#pragma unroll
            for (int j = 0; j < 4; ++j) v[j] = src[64 * j];
        } else {
            f32x4* xr = (f32x4*)resid_row(P, b, p) + lane;
            const u32x2* y0 = (const u32x2*)(Y + (size_t)(2 * tok) * DM) + lane;
            const u32x2* y1 = (const u32x2*)(Y + (size_t)(2 * tok + 1) * DM) + lane;
            const f32x4* g2 = (const f32x4*)(mod_row(P, l - 1, mr) + 5120) + lane;
#pragma unroll
            for (int j = 0; j < 4; ++j) {
                const f32x4 xv = xr[64 * j], g = g2[64 * j]; const u32x2 a = y0[64 * j], c2 = y1[64 * j];
                f32x4 yv;
                yv.x = __uint_as_float(a.x << 16) + __uint_as_float(c2.x << 16);
                yv.y = __uint_as_float(a.x & 0xffff0000u) + __uint_as_float(c2.x & 0xffff0000u);
                yv.z = __uint_as_float(a.y << 16) + __uint_as_float(c2.y << 16);
                yv.w = __uint_as_float(a.y & 0xffff0000u) + __uint_as_float(c2.y & 0xffff0000u);
                v[j] = xv + g * yv;
                xr[64 * j] = v[j];
            }
        }
        float ss = 0.f;
#pragma unroll
        for (int j = 0; j < 4; ++j) ss += (v[j].x * v[j].x + v[j].y * v[j].y) + (v[j].z * v[j].z + v[j].w * v[j].w);
        const float r = rsqrtf(wave_sum(ss) * (1.f / DM) + RMS_EPS);
        const float* md = mod_row(P, l, mr);
        const f32x4* gn = (const f32x4*)(P.norm1_g + l * DM) + lane;
        const f32x4* sh = (const f32x4*)(md) + lane;
        const f32x4* sc = (const f32x4*)(md + 1024) + lane;
        u32x2* o = (u32x2*)(HX + (size_t)tok * DM) + lane;
#pragma unroll
        for (int j = 0; j < 4; ++j) {
            const f32x4 g = gn[64 * j], s1 = sc[64 * j], h1 = sh[64 * j];
            f32x4 y;
            y.x = v[j].x * r * g.x * (1.f + s1.x) + h1.x; y.y = v[j].y * r * g.y * (1.f + s1.y) + h1.y;
            y.z = v[j].z * r * g.z * (1.f + s1.z) + h1.z; y.w = v[j].w * r * g.w * (1.f + s1.w) + h1.w;
            u32x2 w; w.x = pk2(y.x, y.y); w.y = pk2(y.z, y.w);
            o[64 * j] = w;
        }
    }
}

DI void phase_final(const Params& P, int bid, int nb) {
    const int lane = threadIdx.x & 63, wave = threadIdx.x >> 6;
    const bf16_t* Y = (const bf16_t*)(P.ws + OFF_Y);
    for (int r = bid * 4 + wave; r < NB * SEQ; r += nb * 4) {
        const int b = r / SEQ, p = CTXL + r % SEQ, tok = b * TPB + p;
        f32x4* xr = (f32x4*)resid_row(P, b, p) + lane;
        const u32x2* y0 = (const u32x2*)(Y + (size_t)(2 * tok) * DM) + lane;
        const u32x2* y1 = (const u32x2*)(Y + (size_t)(2 * tok + 1) * DM) + lane;
        const f32x4* g2 = (const f32x4*)(mod_row(P, 1, b) + 5120) + lane;
        f32x4 v[4]; float ss = 0.f;
#pragma unroll
        for (int j = 0; j < 4; ++j) {
            const f32x4 xv = xr[64 * j], g = g2[64 * j]; const u32x2 a = y0[64 * j], c2 = y1[64 * j];
            f32x4 yv;
            yv.x = __uint_as_float(a.x << 16) + __uint_as_float(c2.x << 16);
            yv.y = __uint_as_float(a.x & 0xffff0000u) + __uint_as_float(c2.x & 0xffff0000u);
            yv.z = __uint_as_float(a.y << 16) + __uint_as_float(c2.y << 16);
            yv.w = __uint_as_float(a.y & 0xffff0000u) + __uint_as_float(c2.y & 0xffff0000u);
            v[j] = xv + g * yv;
            ss += (v[j].x * v[j].x + v[j].y * v[j].y) + (v[j].z * v[j].z + v[j].w * v[j].w);
        }
        const float rr = rsqrtf(wave_sum(ss) * (1.f / DM) + RMS_EPS);
        const f32x4* fg = (const f32x4*)P.final_g + lane;
#pragma unroll
        for (int j = 0; j < 4; ++j) { const f32x4 g = fg[64 * j]; xr[64 * j] = v[j] * rr * g; }
    }
}

DI void gemm_core(char* smem, const bf16_t* const (&ap)[4], const bf16_t* const (&bp)[4], int K, f32x16 (&acc)[2][2]) {
    const int t = threadIdx.x, lane = t & 63, wave = t >> 6, wr = wave >> 1, wc = wave & 1, h = lane >> 5;
    char* sA = smem; char* sB = smem + 16384;
    const int c = t & 7, row0 = t >> 3;
    const int woff = row0 * 128 + ((c ^ ((row0 >> 1) & 7)) << 4);
    const int sw = (lane >> 1) & 7;
    const int ra_off = (wr * 64 + (lane & 31)) * 128, rb_off = (wc * 64 + (lane & 31)) * 128;
    u32x4 ra[4], rb[4];
#pragma unroll
    for (int i = 0; i < 4; ++i) { ra[i] = *(const u32x4*)(ap[i]); rb[i] = *(const u32x4*)(bp[i]); }
#pragma unroll
    for (int mt = 0; mt < 2; ++mt)
#pragma unroll
        for (int nt = 0; nt < 2; ++nt)
#pragma unroll
            for (int i = 0; i < 16; ++i) acc[mt][nt][i] = 0.f;
    const int nk = K >> 6;
    for (int kt = 0; kt < nk; ++kt) {
        __syncthreads();
#pragma unroll
        for (int i = 0; i < 4; ++i) { *(u32x4*)(sA + woff + i * 4096) = ra[i]; *(u32x4*)(sB + woff + i * 4096) = rb[i]; }
        __syncthreads();
        if (kt + 1 < nk) {
#pragma unroll
            for (int i = 0; i < 4; ++i) { ra[i] = *(const u32x4*)(ap[i] + (kt + 1) * 64); rb[i] = *(const u32x4*)(bp[i] + (kt + 1) * 64); }
        }
#pragma unroll
        for (int s = 0; s < 4; ++s) {
            const int co = ((2 * s + h) ^ sw) << 4;
            bf16x8 a[2], bb[2];
            a[0] = *(const bf16x8*)(sA + ra_off + co); a[1] = *(const bf16x8*)(sA + ra_off + 32 * 128 + co);
            bb[0] = *(const bf16x8*)(sB + rb_off + co); bb[1] = *(const bf16x8*)(sB + rb_off + 32 * 128 + co);
#pragma unroll
            for (int mt = 0; mt < 2; ++mt)
#pragma unroll
                for (int nt = 0; nt < 2; ++nt) acc[mt][nt] = __builtin_amdgcn_mfma_f32_32x32x16_bf16(a[mt], bb[nt], acc[mt][nt], 0, 0, 0);
        }
    }
}

DI void phase_qkv(const Params& P, int l, int bid, int nb, char* smem) {
    const int t = threadIdx.x, lane = t & 63, wave = t >> 6, wr = wave >> 1, wc = wave & 1, h = lane >> 5, ln = lane & 31;
    const bf16_t* HX = (const bf16_t*)(P.ws + OFF_HX);
    const bf16_t* Wt = (const bf16_t*)(P.ws + OFF_WIN) + (size_t)l * INC * DM;
    bf16_t* QB = (bf16_t*)(P.ws + OFF_QB); bf16_t* KB = (bf16_t*)(P.ws + OFF_KB); bf16_t* VT = (bf16_t*)(P.ws + OFF_VT);
    const f32x2* ROPE = (const f32x2*)(P.ws + OFF_ROPE);
    constexpr int NMT = NTOK / 128, NNT = INC / 128;
    for (int w = bid; w < NMT * NNT; w += nb) {
        const int mti = w / NNT, nti = w % NNT;
        const int tok0 = mti * 128, b = tok0 / TPB, p0 = tok0 % TPB;
        const bool isctx = p0 < CTXL;
        if (l == 1 && isctx && nti < 8) continue;
        const bf16_t* ap[4]; const bf16_t* bp[4];
#pragma unroll
        for (int i = 0; i < 4; ++i) { const int row = (t >> 3) + 32 * i; ap[i] = HX + (size_t)(tok0 + row) * DM + (t & 7) * 8; bp[i] = Wt + (size_t)(nti * 128 + row) * DM + (t & 7) * 8; }
        f32x16 acc[2][2];
        gemm_core(smem, ap, bp, DM, acc);
        const int cw = nti * 128 + wc * 64;
        int kind, unit;
        bool nrm = false; const float* ng = nullptr;
        if (cw < 1024) { kind = 0; unit = cw >> 6; if (unit >= 8 && unit < 12) { nrm = true; ng = P.q_norm_g + l * 64; } }
        else if (cw < 1536) { kind = 1; unit = (cw - 1024) >> 6; }
        else if (cw < 2048) { kind = 2; unit = cw - 1536; }
        else if (cw < 2176) { kind = 1; unit = 8 + ((cw - 2048) >> 6); nrm = true; ng = P.k_norm_g + l * 64; }
        else if (cw < 2304) { kind = 2; unit = 512 + (cw - 2176); }
        else if (cw < 2432) { kind = 1; unit = 10 + ((cw - 2304) >> 6); }
        else { kind = 2; unit = 640 + (cw - 2432); }
        if (kind == 2) {
#pragma unroll
            for (int mt = 0; mt < 2; ++mt)
#pragma unroll
                for (int nt = 0; nt < 2; ++nt) {
                    bf16_t* dst = VT + ((size_t)b * NVR + unit + nt * 32 + ln) * TPB + p0 + wr * 64 + mt * 32 + 4 * h;
#pragma unroll
                    for (int g = 0; g < 4; ++g) { u32x2 o; o.x = pk2(acc[mt][nt][4 * g], acc[mt][nt][4 * g + 1]); o.y = pk2(acc[mt][nt][4 * g + 2], acc[mt][nt][4 * g + 3]);
                        *(u32x2*)(dst + 8 * g) = o; }
                }
        } else {
            const float g0 = nrm ? ng[ln] : 1.f, g1 = nrm ? ng[32 + ln] : 1.f;
            const float osc = kind == 0 ? QSCALE : 1.f;
            bf16_t* base = (kind == 0 ? QB + ((size_t)b * NQU + unit) * TPB * 64 : KB + ((size_t)b * NKU + unit) * TPB * 64);
#pragma unroll
            for (int mt = 0; mt < 2; ++mt)
#pragma unroll
                for (int i = 0; i < 16; ++i) {
                    float v0 = acc[mt][0][i], v1 = acc[mt][1][i];
                    const int p = p0 + wr * 64 + mt * 32 + crow(i, h);
                    if (nrm) {
                        float ss = v0 * v0 + v1 * v1;
                        ss += __shfl_xor(ss, 1); ss += __shfl_xor(ss, 2); ss += __shfl_xor(ss, 4); ss += __shfl_xor(ss, 8); ss += __shfl_xor(ss, 16);
                        const float r = rsqrtf(ss * (1.f / 64.f) + RMS_EPS);
                        v0 = v0 * r * g0; v1 = v1 * r * g1;
                    }
                    if (!isctx) {
                        const float u0 = __shfl_xor(v0, 16), u1 = __shfl_xor(v1, 16);
                        const f32x2 c0 = ROPE[(size_t)(p - CTXL) * 64 + ln], c1 = ROPE[(size_t)(p - CTXL) * 64 + 32 + ln];
                        v0 = v0 * c0.x + u0 * c0.y; v1 = v1 * c1.x + u1 * c1.y;
                    }
                    base[(size_t)p * 64 + ln] = f2bf(v0 * osc);
                    base[(size_t)p * 64 + 32 + ln] = f2bf(v1 * osc);
                }
        }
    }
}

template <int DV>
DI void naive_attn_acc(const bf16_t* qrow, const bf16_t* Kb, const bf16_t* Vt, int lo0, int hi0, int lo1, int hi1, bool has_sink, float sink2, float coef, float (&acc)[DV]) {
    float q[64];
#pragma unroll
    for (int i = 0; i < 8; ++i) { const u32x4 v = ((const u32x4*)qrow)[i];
        q[8 * i + 0] = __uint_as_float(v.x << 16); q[8 * i + 1] = __uint_as_float(v.x & 0xffff0000u); q[8 * i + 2] = __uint_as_float(v.y << 16); q[8 * i + 3] = __uint_as_float(v.y & 0xffff0000u);
        q[8 * i + 4] = __uint_as_float(v.z << 16); q[8 * i + 5] = __uint_as_float(v.z & 0xffff0000u); q[8 * i + 6] = __uint_as_float(v.w << 16); q[8 * i + 7] = __uint_as_float(v.w & 0xffff0000u); }
    float m = has_sink ? sink2 : -1e30f, lsum = has_sink ? 1.f : 0.f;
    for (int rg = 0; rg < 2; ++rg) {
        const int lo = rg ? lo1 : lo0, hi = rg ? hi1 : hi0;
        for (int key = lo; key < hi; ++key) {
            const u32x4* kr = (const u32x4*)(Kb + (size_t)key * 64);
            float s = 0.f;
#pragma unroll
            for (int i = 0; i < 8; ++i) { const u32x4 v = kr[i];
                s += q[8 * i + 0] * __uint_as_float(v.x << 16) + q[8 * i + 1] * __uint_as_float(v.x & 0xffff0000u) + q[8 * i + 2] * __uint_as_float(v.y << 16) + q[8 * i + 3] * __uint_as_float(v.y & 0xffff0000u)
                   + q[8 * i + 4] * __uint_as_float(v.z << 16) + q[8 * i + 5] * __uint_as_float(v.z & 0xffff0000u) + q[8 * i + 6] * __uint_as_float(v.w << 16) + q[8 * i + 7] * __uint_as_float(v.w & 0xffff0000u); }
            const float mn = fmaxf(m, s);
            lsum = lsum * exp2f(m - mn) + exp2f(s - mn); m = mn;
        }
    }
    const float inv = coef / lsum;
    for (int rg = 0; rg < 2; ++rg) {
        const int lo = rg ? lo1 : lo0, hi = rg ? hi1 : hi0;
        for (int key = lo; key < hi; ++key) {
            const u32x4* kr = (const u32x4*)(Kb + (size_t)key * 64);
            float s = 0.f;
#pragma unroll
            for (int i = 0; i < 8; ++i) { const u32x4 v = kr[i];
                s += q[8 * i + 0] * __uint_as_float(v.x << 16) + q[8 * i + 1] * __uint_as_float(v.x & 0xffff0000u) + q[8 * i + 2] * __uint_as_float(v.y << 16) + q[8 * i + 3] * __uint_as_float(v.y & 0xffff0000u)
                   + q[8 * i + 4] * __uint_as_float(v.z << 16) + q[8 * i + 5] * __uint_as_float(v.z & 0xffff0000u) + q[8 * i + 6] * __uint_as_float(v.w << 16) + q[8 * i + 7] * __uint_as_float(v.w & 0xffff0000u); }
            const float pr = exp2f(s - m) * inv;
#pragma unroll
            for (int d = 0; d < DV; ++d) acc[d] += pr * bf2f(Vt[(size_t)d * TPB + key]);
        }
    }
}

DI void phase_attn_naive(const Params& P, int l, int bid, int nb) {
    const int t = threadIdx.x;
    const bf16_t* QB = (const bf16_t*)(P.ws + OFF_QB); const bf16_t* KB = (const bf16_t*)(P.ws + OFF_KB); const bf16_t* VT = (const bf16_t*)(P.ws + OFF_VT);
    bf16_t* MIX = (bf16_t*)(P.ws + OFF_HX);
    const float lambda_init = l == 0 ? 0.2f : (0.8f - 0.6f * expf(-0.3f));
    float d1 = 0.f, d2 = 0.f;
    for (int i = 0; i < 64; ++i) { d1 += P.lam_q1[l * 64 + i] * P.lam_k1[l * 64 + i]; d2 += P.lam_q2[l * 64 + i] * P.lam_k2[l * 64 + i]; }
    const float lam = expf(d1) - expf(d2) + lambda_init;
    const int nitems = NB * 12 * 9;
    for (int it = bid; it < nitems; it += nb) {
        const int qc = it % 9, ty = (it / 9) % 12, b = it / 108;
        if (qc == 0 && l == 1) continue;
        const int p = qc * 256 + t;
        const bool isctx = qc == 0;
        const int tpos = p - CTXL;
        const int tok = b * TPB + p;
        if (ty < 4) {
            float acc[128];
#pragma unroll
            for (int d = 0; d < 128; ++d) acc[d] = 0.f;
            const bf16_t* V = VT + ((size_t)b * NVR + ty * 128) * TPB;
            const int hi = isctx ? CTXL : TPB;
            naive_attn_acc<128>(QB + (((size_t)b * NQU + 2 * ty + 1) * TPB + p) * 64, KB + ((size_t)b * NKU + 2 * ty + 1) * TPB * 64, V, 0, hi, 0, 0, false, 0.f, -lam, acc);
            naive_attn_acc<128>(QB + (((size_t)b * NQU + 2 * ty) * TPB + p) * 64, KB + ((size_t)b * NKU + 2 * ty) * TPB * 64, V, 0, hi, 0, 0, false, 0.f, 1.f, acc);
            float ss = 0.f;
#pragma unroll
            for (int d = 0; d < 128; ++d) ss += acc[d] * acc[d];
            const float r = rsqrtf(ss * (1.f / 128.f) + RMS_EPS) * (1.f - lambda_init);
            bf16_t* o = MIX + (size_t)tok * DM + ty * 128;
#pragma unroll
            for (int d = 0; d < 128; d += 2) *(unsigned*)(o + d) = pk2(acc[d] * r * P.subln_g[l * 128 + d], acc[d + 1] * r * P.subln_g[l * 128 + d + 1]);
        } else {
            const int j = (ty - 4) & 3; const bool isC = ty >= 8;
            float acc[64];
#pragma unroll
            for (int d = 0; d < 64; ++d) acc[d] = 0.f;
            const int qu = (isC ? 12 : 8) + j, ku = (isC ? 10 : 8) + (j >> 1), vr = (isC ? 640 : 512) + (j >> 1) * 64;
            int lo0 = 0, hi0 = isctx ? CTXL : TPB, lo1 = 0, hi1 = 0;
            if (isC && !isctx) { hi0 = CTXL; lo1 = CTXL + max(0, tpos - 128); hi1 = CTXL + min(SEQ - 1, tpos + 128) + 1; }
            const float sink2 = isC ? P.sink[l * 4 + j] * 1.4426950408889634f : 0.f;
            naive_attn_acc<64>(QB + (((size_t)b * NQU + qu) * TPB + p) * 64, KB + ((size_t)b * NKU + ku) * TPB * 64, VT + ((size_t)b * NVR + vr) * TPB, lo0, hi0, lo1, hi1, isC, sink2, 1.f, acc);
            bf16_t* o = MIX + (size_t)tok * DM + (isC ? 768 : 512) + j * 64;
#pragma unroll
            for (int d = 0; d < 64; d += 2) *(unsigned*)(o + d) = pk2(acc[d], acc[d + 1]);
        }
    }
}


#define MFMA32(a, b, c) __builtin_amdgcn_mfma_f32_32x32x16_bf16((a), (b), (c), 0, 0, 0)
template <int DV>
DI void flash_run(char* smem, const bf16_t* qrow, const bf16_t* Kb, const bf16_t* Vt, int n1, int base2, int n2, int tq, float m0, float l0,
                  f32x16 (&O)[DV / 32], float& lout) {
    constexpr int NT = DV / 32, KBYTES = 8192, STAGE = KBYTES + DV * 136;
    const int t = threadIdx.x, lane = t & 63, h = lane >> 5, ln = lane & 31, sw = (ln >> 1) & 7;
    bf16x8 qf[4];
#pragma unroll
    for (int s = 0; s < 4; ++s) qf[s] = *(const bf16x8*)(qrow + 16 * s + 8 * h);
#pragma unroll
    for (int tt = 0; tt < NT; ++tt)
#pragma unroll
        for (int i = 0; i < 16; ++i) O[tt][i] = 0.f;
    float m = m0, l = l0;
    const int ntile = n1 + n2;
    const int srow = t >> 3, sc = t & 7;
    const int kwoff = srow * 128 + ((sc ^ ((srow >> 1) & 7)) << 4);
    const int vwoff = KBYTES + srow * 136 + sc * 16;
    u32x4 kr[2], vr[NT];
    {
        const int p0 = n1 > 0 ? 0 : base2;
#pragma unroll
        for (int i = 0; i < 2; ++i) kr[i] = *(const u32x4*)(Kb + (size_t)(p0 + srow + 32 * i) * 64 + sc * 8);
#pragma unroll
        for (int i = 0; i < NT; ++i) vr[i] = *(const u32x4*)(Vt + (size_t)(srow + 32 * i) * TPB + p0 + sc * 8);
#pragma unroll
        for (int i = 0; i < 2; ++i) *(u32x4*)(smem + kwoff + i * 4096) = kr[i];
#pragma unroll
        for (int i = 0; i < NT; ++i) { u32x2 a, b2; a.x = vr[i].x; a.y = vr[i].y; b2.x = vr[i].z; b2.y = vr[i].w;
            *(u32x2*)(smem + vwoff + i * 32 * 136) = a; *(u32x2*)(smem + vwoff + i * 32 * 136 + 8) = b2; }
    }
    __syncthreads();
    for (int it = 0; it < ntile; ++it) {
        const int p0 = it < n1 ? 64 * it : base2 + 64 * (it - n1);
        const bool more = it + 1 < ntile;
        if (more) {
            const int pn = (it + 1) < n1 ? 64 * (it + 1) : base2 + 64 * (it + 1 - n1);
#pragma unroll
            for (int i = 0; i < 2; ++i) kr[i] = *(const u32x4*)(Kb + (size_t)(pn + srow + 32 * i) * 64 + sc * 8);
#pragma unroll
            for (int i = 0; i < NT; ++i) vr[i] = *(const u32x4*)(Vt + (size_t)(srow + 32 * i) * TPB + pn + sc * 8);
        }
        const char* kb = smem + (it & 1) * STAGE;
        const char* vb = kb + KBYTES;
        f32x16 s0, s1;
#pragma unroll
        for (int i = 0; i < 16; ++i) { s0[i] = 0.f; s1[i] = 0.f; }
#pragma unroll
        for (int s = 0; s < 4; ++s) {
            const int co = ((2 * s + h) ^ sw) << 4;
            const bf16x8 k0 = *(const bf16x8*)(kb + ln * 128 + co);
            const bf16x8 k1 = *(const bf16x8*)(kb + (32 + ln) * 128 + co);
            s0 = MFMA32(k0, qf[s], s0); s1 = MFMA32(k1, qf[s], s1);
        }
        if (it >= n1) {
            const int d0 = (p0 - CTXL) - tq + 4 * h + 128;
#pragma unroll
            for (int i = 0; i < 16; ++i) {
                const int dd = d0 + (i & 3) + 8 * (i >> 2);
                s0[i] = ((unsigned)dd <= 256u) ? s0[i] : -1e30f;
                s1[i] = ((unsigned)(dd + 32) <= 256u) ? s1[i] : -1e30f;
            }
        }
        float mx = fmaxf(s0[0], s1[0]);
#pragma unroll
        for (int i = 1; i < 16; ++i) mx = fmaxf(mx, fmaxf(s0[i], s1[i]));
        mx = fmaxf(mx, __shfl_xor(mx, 32));
        const float mn = fmaxf(m, mx);
        const float alpha = __builtin_amdgcn_exp2f(m - mn);
        m = mn;
        float ps = 0.f;
        bf16x8 pf[2][2];
        {
            unsigned w[16];
#pragma unroll
            for (int i = 0; i < 16; i += 2) {
                const float a0 = __builtin_amdgcn_exp2f(s0[i] - mn), a1 = __builtin_amdgcn_exp2f(s0[i + 1] - mn);
                const float b0 = __builtin_amdgcn_exp2f(s1[i] - mn), b1 = __builtin_amdgcn_exp2f(s1[i + 1] - mn);
                ps += (a0 + a1) + (b0 + b1);
                w[i >> 1] = pk2(a0, a1); w[8 + (i >> 1)] = pk2(b0, b1);
            }
#pragma unroll
            for (int x = 0; x < 2; ++x)
#pragma unroll
                for (int y = 0; y < 2; ++y) { u32x4 q; q.x = w[8 * x + 4 * y]; q.y = w[8 * x + 4 * y + 1]; q.z = w[8 * x + 4 * y + 2]; q.w = w[8 * x + 4 * y + 3];
                    pf[x][y] = __builtin_bit_cast(bf16x8, q); }
        }
        l = l * alpha + ps;
#pragma unroll
        for (int tt = 0; tt < NT; ++tt)
#pragma unroll
            for (int i = 0; i < 16; ++i) O[tt][i] *= alpha;
#pragma unroll
        for (int tt = 0; tt < NT; ++tt)
#pragma unroll
            for (int x = 0; x < 2; ++x)
#pragma unroll
                for (int y = 0; y < 2; ++y) {
                    const char* va = vb + (32 * tt + ln) * 136 + (32 * x + 16 * y + 4 * h) * 2;
                    const u32x2 lo = *(const u32x2*)va, hi = *(const u32x2*)(va + 16);
                    u32x4 q; q.x = lo.x; q.y = lo.y; q.z = hi.x; q.w = hi.y;
                    O[tt] = MFMA32(__builtin_bit_cast(bf16x8, q), pf[x][y], O[tt]);
                }
        if (more) {
            char* nbuf = smem + ((it + 1) & 1) * STAGE;
#pragma unroll
            for (int i = 0; i < 2; ++i) *(u32x4*)(nbuf + kwoff + i * 4096) = kr[i];
#pragma unroll
            for (int i = 0; i < NT; ++i) { u32x2 a, b2; a.x = vr[i].x; a.y = vr[i].y; b2.x = vr[i].z; b2.y = vr[i].w;
                *(u32x2*)(nbuf + vwoff + i * 32 * 136) = a; *(u32x2*)(nbuf + vwoff + i * 32 * 136 + 8) = b2; }
        }
        __syncthreads();
    }
    lout = l + __shfl_xor(l, 32);
}

DI void phase_attn(const Params& P, int l, int bid, int nb, char* smem) {
    const int t = threadIdx.x, lane = t & 63, wave = t >> 6, h = lane >> 5, ln = lane & 31;
    const bf16_t* QB = (const bf16_t*)(P.ws + OFF_QB); const bf16_t* KB = (const bf16_t*)(P.ws + OFF_KB); const bf16_t* VT = (const bf16_t*)(P.ws + OFF_VT);
    bf16_t* MIX = (bf16_t*)(P.ws + OFF_HX);
    const float lambda_init = l == 0 ? 0.2f : (0.8f - 0.6f * expf(-0.3f));
    float d1 = P.lam_q1[l * 64 + lane] * P.lam_k1[l * 64 + lane], d2 = P.lam_q2[l * 64 + lane] * P.lam_k2[l * 64 + lane];
    d1 = wave_sum(d1); d2 = wave_sum(d2);
    const float lam = expf(d1) - expf(d2) + lambda_init;
    const int nitems = l == 0 ? 1536 + 192 : 1536;
    for (int it = bid; it < nitems; it += nb) {
        int ty, b, hd, p0q, ncx;
        bool isctx;
        if (it < 1536) {
            ty = it >> 9; const int idx = it & 511, xcd = idx & 7, r = idx >> 3, stream = xcd * 4 + (r >> 4);
            b = stream >> 2; hd = stream & 3; p0q = CTXL + (r & 15) * 128; isctx = false; ncx = TPB / 64;
        } else {
            const int i2 = it - 1536, rem = i2 % 24, t12 = rem % 12;
            b = i2 / 24; p0q = (rem / 12) * 128; ty = t12 >> 2; hd = t12 & 3; isctx = true; ncx = CTXL / 64;
        }
        const int p = p0q + wave * 32 + ln, tok = b * TPB + p, tq = p - CTXL;
        if (ty == 0) {
            f32x16 O[4]; float lt;
            const bf16_t* V = VT + ((size_t)b * NVR + hd * 128) * TPB;
            bf16_t* orow = MIX + (size_t)tok * DM + hd * 128 + 4 * h;
            flash_run<128>(smem, QB + (((size_t)b * NQU + 2 * hd + 1) * TPB + p) * 64, KB + ((size_t)b * NKU + 2 * hd + 1) * TPB * 64, V, ncx, 0, 0, tq, -1e30f, 0.f, O, lt);
            {
                const float f = -lam / lt;
#pragma unroll
                for (int tt = 0; tt < 4; ++tt)
#pragma unroll
                    for (int g = 0; g < 4; ++g) { u32x2 o; o.x = pk2(O[tt][4 * g] * f, O[tt][4 * g + 1] * f); o.y = pk2(O[tt][4 * g + 2] * f, O[tt][4 * g + 3] * f);
                        *(u32x2*)(orow + 32 * tt + 8 * g) = o; }
            }
            flash_run<128>(smem, QB + (((size_t)b * NQU + 2 * hd) * TPB + p) * 64, KB + ((size_t)b * NKU + 2 * hd) * TPB * 64, V, ncx, 0, 0, tq, -1e30f, 0.f, O, lt);
            {
                const float f = 1.f / lt; float ss = 0.f;
#pragma unroll
                for (int tt = 0; tt < 4; ++tt)
#pragma unroll
                    for (int g = 0; g < 4; ++g) {
                        const u32x2 st = *(const u32x2*)(orow + 32 * tt + 8 * g);
                        O[tt][4 * g + 0] = O[tt][4 * g + 0] * f + __uint_as_float(st.x << 16);
                        O[tt][4 * g + 1] = O[tt][4 * g + 1] * f + __uint_as_float(st.x & 0xffff0000u);
                        O[tt][4 * g + 2] = O[tt][4 * g + 2] * f + __uint_as_float(st.y << 16);
                        O[tt][4 * g + 3] = O[tt][4 * g + 3] * f + __uint_as_float(st.y & 0xffff0000u);
                        ss += (O[tt][4 * g] * O[tt][4 * g] + O[tt][4 * g + 1] * O[tt][4 * g + 1]) + (O[tt][4 * g + 2] * O[tt][4 * g + 2] + O[tt][4 * g + 3] * O[tt][4 * g + 3]);
                    }
                ss += __shfl_xor(ss, 32);
                const float r = rsqrtf(ss * (1.f / 128.f) + RMS_EPS) * (1.f - lambda_init);
                const float* sg = P.subln_g + l * 128 + 4 * h;
#pragma unroll
                for (int tt = 0; tt < 4; ++tt)
#pragma unroll
                    for (int g = 0; g < 4; ++g) { const f32x4 gg = *(const f32x4*)(sg + 32 * tt + 8 * g);
                        u32x2 o; o.x = pk2(O[tt][4 * g] * r * gg.x, O[tt][4 * g + 1] * r * gg.y); o.y = pk2(O[tt][4 * g + 2] * r * gg.z, O[tt][4 * g + 3] * r * gg.w);
                        *(u32x2*)(orow + 32 * tt + 8 * g) = o; }
            }
        } else {
            const bool isC = ty == 2;
            f32x16 O[2]; float lt;
            const int qu = (isC ? 12 : 8) + hd, ku = (isC ? 10 : 8) + (hd >> 1), vr = (isC ? 640 : 512) + (hd >> 1) * 64;
            int n1 = ncx, base2 = 0, n2 = 0;
            float m0 = -1e30f, l0 = 0.f;
            if (isC) {
                m0 = P.sink[l * 4 + hd] * 1.4426950408889634f; l0 = h == 0 ? 1.f : 0.f;
                if (!isctx) { const int n = (p0q - CTXL) >> 7; n1 = CTXL / 64; const int jlo = n == 0 ? 2 : 0, jhi = n == 15 ? 4 : 6;
                    base2 = CTXL + 128 * (n - 1) + 64 * jlo; n2 = jhi - jlo; }
            }
            flash_run<64>(smem, QB + (((size_t)b * NQU + qu) * TPB + p) * 64, KB + ((size_t)b * NKU + ku) * TPB * 64, VT + ((size_t)b * NVR + vr) * TPB, n1, base2, n2, tq, m0, l0, O, lt);
            const float f = 1.f / lt;
            bf16_t* orow = MIX + (size_t)tok * DM + (isC ? 768 : 512) + hd * 64 + 4 * h;
#pragma unroll
            for (int tt = 0; tt < 2; ++tt)
#pragma unroll
                for (int g = 0; g < 4; ++g) { u32x2 o; o.x = pk2(O[tt][4 * g] * f, O[tt][4 * g + 1] * f); o.y = pk2(O[tt][4 * g + 2] * f, O[tt][4 * g + 3] * f);
                    *(u32x2*)(orow + 32 * tt + 8 * g) = o; }
        }
    }
}

DI void phase_outproj(const Params& P, int l, int bid, int nb, char* smem) {
    const int t = threadIdx.x, lane = t & 63, wave = t >> 6, wr = wave >> 1, wc = wave & 1, h = lane >> 5, ln = lane & 31;
    const bf16_t* MIX = (const bf16_t*)(P.ws + OFF_HX);
    const bf16_t* Wt = (const bf16_t*)(P.ws + OFF_WOUT) + (size_t)l * DM * DM;
    constexpr int NMT = NTOK / 128, NNT = DM / 128;
    for (int w = bid; w < NMT * NNT; w += nb) {
        const int mti = w / NNT, nti = w % NNT;
        const int tok0 = mti * 128, b = tok0 / TPB, p0 = tok0 % TPB;
        const bool isctx = p0 < CTXL;
        if (l == 1 && isctx) continue;
        const bf16_t* ap[4]; const bf16_t* bp[4];
#pragma unroll
        for (int i = 0; i < 4; ++i) { const int row = (t >> 3) + 32 * i; ap[i] = MIX + (size_t)(tok0 + row) * DM + (t & 7) * 8; bp[i] = Wt + (size_t)(nti * 128 + row) * DM + (t & 7) * 8; }
        f32x16 acc[2][2];
        gemm_core(smem, ap, bp, DM, acc);
        const float* g1 = mod_row(P, l, isctx ? 8 : b) + 2048;
#pragma unroll
        for (int nt = 0; nt < 2; ++nt) {
            const int col = nti * 128 + wc * 64 + nt * 32 + ln;
            const float g = g1[col];
#pragma unroll
            for (int mt = 0; mt < 2; ++mt) {
                asm volatile("" ::: "memory");
#pragma unroll
                for (int i = 0; i < 16; ++i) {
                    const int p = p0 + wr * 64 + mt * 32 + crow(i, h);
                    const float xin = (l == 0 ? input_row(P, b, p) : resid_row(P, b, p))[col];
                    resid_row(P, b, p)[col] = xin + g * acc[mt][nt][i];
                }
            }
        }
    }
}

DI void phase_norm2_route(const Params& P, int l, int bid, int nb, char* smem) {
    const int t = threadIdx.x, lane = t & 63, wave = t >> 6;
    __syncthreads();
    for (int idx = t; idx < 1024 * 4; idx += NTHREADS) {
        const int k = idx >> 2, q = idx & 3;
        const int row = ((k >> 8) * 4 + (k & 3)) * 64 + ((k >> 2) & 63);
        *(f32x4*)(smem + row * 64 + ((q ^ ((row >> 2) & 3)) << 4)) = *(const f32x4*)(P.w_router + k * 16 + q * 4);
    }
    __syncthreads();
    bf16_t* HX = (bf16_t*)(P.ws + OFF_HX);
    int* cnt = (int*)(P.ws + OFF_CTL) + l * 16;
    int* list = (int*)(P.ws + OFF_LIST);
    float* tokw = (float*)(P.ws + OFF_TOKW);
    for (int tok = bid * 4 + wave; tok < NTOK; tok += nb * 4) {
        const int b = tok / TPB, p = tok % TPB, mr = p < CTXL ? 8 : b;
        if (l == 1 && p < CTXL) continue;
        const f32x4* xr = (const f32x4*)resid_row(P, b, p) + lane;
        f32x4 v[4]; float ss = 0.f;
#pragma unroll
        for (int j = 0; j < 4; ++j) { v[j] = xr[64 * j]; ss += (v[j].x * v[j].x + v[j].y * v[j].y) + (v[j].z * v[j].z + v[j].w * v[j].w); }
        const float r = rsqrtf(wave_sum(ss) * (1.f / DM) + RMS_EPS);
        const float* md = mod_row(P, l, mr);
        const f32x4* gn = (const f32x4*)(P.norm2_g + l * DM) + lane;
        const f32x4* sh = (const f32x4*)(md + 3072) + lane;
        const f32x4* sc = (const f32x4*)(md + 4096) + lane;
        u32x2* o = (u32x2*)(HX + (size_t)tok * DM) + lane;
        float lg[16];
#pragma unroll
        for (int e = 0; e < 16; ++e) lg[e] = 0.f;
#pragma unroll
        for (int j = 0; j < 4; ++j) {
            const f32x4 g = gn[64 * j], s1 = sc[64 * j], h1 = sh[64 * j];
            float y[4];
            y[0] = v[j].x * r * g.x * (1.f + s1.x) + h1.x; y[1] = v[j].y * r * g.y * (1.f + s1.y) + h1.y;
            y[2] = v[j].z * r * g.z * (1.f + s1.z) + h1.z; y[3] = v[j].w * r * g.w * (1.f + s1.w) + h1.w;
            u32x2 w; w.x = pk2(y[0], y[1]); w.y = pk2(y[2], y[3]);
            o[64 * j] = w;
            asm volatile("" ::: "memory");
#pragma unroll
            for (int cc = 0; cc < 4; ++cc) {
                const int row = (j * 4 + cc) * 64 + lane;
#pragma unroll
                for (int q = 0; q < 4; ++q) {
                    const f32x4 wv = *(const f32x4*)(smem + row * 64 + ((q ^ ((row >> 2) & 3)) << 4));
                    lg[4 * q + 0] += y[cc] * wv.x; lg[4 * q + 1] += y[cc] * wv.y; lg[4 * q + 2] += y[cc] * wv.z; lg[4 * q + 3] += y[cc] * wv.w;
                }
            }
        }
#pragma unroll
        for (int e = 0; e < 16; ++e) lg[e] = wave_sum(lg[e]);
        if (lane == 0) {
            float scv[16], sel[16];
#pragma unroll
            for (int e = 0; e < 16; ++e) { scv[e] = 1.f / (1.f + expf(-lg[e])); sel[e] = scv[e] + P.router_bias[e]; }
            float bestg = -1e30f; int be1 = 0, be2 = 1; float bw1 = 0.f, bw2 = 0.f;
#pragma unroll
            for (int g = 0; g < 4; ++g) {
                int i1 = 0; float v1 = sel[4 * g], w1 = scv[4 * g];
#pragma unroll
                for (int j = 1; j < 4; ++j) if (sel[4 * g + j] > v1) { v1 = sel[4 * g + j]; w1 = scv[4 * g + j]; i1 = j; }
                int i2 = -1; float v2 = -1e30f, w2 = 0.f;
#pragma unroll
                for (int j = 0; j < 4; ++j) if (j != i1 && sel[4 * g + j] > v2) { v2 = sel[4 * g + j]; w2 = scv[4 * g + j]; i2 = j; }
                const float gs = v1 + v2;
                if (gs > bestg) { bestg = gs; be1 = 4 * g + i1; be2 = 4 * g + i2; bw1 = w1; bw2 = w2; }
            }
            const float inv = 1.f / (bw1 + bw2);
            const int p1 = atomicAdd(&cnt[be1], 1), p2 = atomicAdd(&cnt[be2], 1);
            list[be1 * NTOK + p1] = 2 * tok; list[be2 * NTOK + p2] = 2 * tok + 1;
            tokw[2 * tok] = bw1 * inv; tokw[2 * tok + 1] = bw2 * inv;
        }
    }
}

DI bool expert_tile(const int* cnt, int rt, int& e, int& ti, int& hbase, int& n) {
    int acc = 0;
#pragma unroll 1
    for (int i = 0; i < NEXP; ++i) { const int c = cnt[i], nt = (c + 127) >> 7; if (rt < acc + nt) { e = i; ti = rt - acc; hbase = (acc + ti) * 128; n = c; return true; } acc += nt; }
    return false;
}

DI void phase_gateup(const Params& P, int l, int bid, int nb, char* smem) {
    const int t = threadIdx.x, lane = t & 63, wave = t >> 6, wr = wave >> 1, wc = wave & 1, h = lane >> 5, ln = lane & 31;
    const bf16_t* HX = (const bf16_t*)(P.ws + OFF_HX);
    const int* cnt = (const int*)(P.ws + OFF_CTL) + l * 16;
    const int* list = (const int*)(P.ws + OFF_LIST);
    bf16_t* HB = (bf16_t*)(P.ws + OFF_HB);
    for (int w = bid;; w += nb) {
        const int rt = w >> 2, ct = w & 3;
        int e, ti, hbase, n;
        if (!expert_tile(cnt, rt, e, ti, hbase, n)) break;
        const bf16_t* Wt = (const bf16_t*)(P.ws + OFF_WGU) + (size_t)(l * 16 + e) * 512 * DM;
        const bf16_t* ap[4]; const bf16_t* bp[4];
#pragma unroll
        for (int i = 0; i < 4; ++i) { const int row = (t >> 3) + 32 * i; const int li = ti * 128 + row;
            const int slot = li < n ? list[e * NTOK + li] : 0;
            ap[i] = HX + (size_t)(slot >> 1) * DM + (t & 7) * 8; bp[i] = Wt + (size_t)(ct * 128 + row) * DM + (t & 7) * 8; }
        f32x16 acc[2][2];
        gemm_core(smem, ap, bp, DM, acc);
        const int hc = (ct * 128 + wc * 64) / 2 + ln;
#pragma unroll
        for (int mt = 0; mt < 2; ++mt)
#pragma unroll
            for (int i = 0; i < 16; ++i) {
                const float g = acc[mt][0][i], u = acc[mt][1][i];
                const int row = wr * 64 + mt * 32 + crow(i, h);
                HB[(size_t)(hbase + row) * DEXP + hc] = f2bf(g / (1.f + expf(-g)) * u);
            }
    }
}

DI void phase_down(const Params& P, int l, int bid, int nb, char* smem) {
    const int t = threadIdx.x, lane = t & 63, wave = t >> 6, wr = wave >> 1, wc = wave & 1, h = lane >> 5, ln = lane & 31;
    const int* cnt = (const int*)(P.ws + OFF_CTL) + l * 16;
    const int* list = (const int*)(P.ws + OFF_LIST);
    const float* tokw = (const float*)(P.ws + OFF_TOKW);
    const bf16_t* HB = (const bf16_t*)(P.ws + OFF_HB);
    bf16_t* Y = (bf16_t*)(P.ws + OFF_Y);
    for (int w = bid;; w += nb) {
        const int rt = w >> 3, ct = w & 7;
        int e, ti, hbase, n;
        if (!expert_tile(cnt, rt, e, ti, hbase, n)) break;
        const bf16_t* Wt = (const bf16_t*)(P.ws + OFF_WD) + (size_t)(l * 16 + e) * DM * DEXP;
        const bf16_t* ap[4]; const bf16_t* bp[4];
#pragma unroll
        for (int i = 0; i < 4; ++i) { const int row = (t >> 3) + 32 * i; ap[i] = HB + (size_t)(hbase + row) * DEXP + (t & 7) * 8; bp[i] = Wt + (size_t)(ct * 128 + row) * DEXP + (t & 7) * 8; }
        f32x16 acc[2][2];
        gemm_core(smem, ap, bp, DEXP, acc);
#pragma unroll
        for (int mt = 0; mt < 2; ++mt)
#pragma unroll
            for (int i = 0; i < 16; ++i) {
                const int li = ti * 128 + wr * 64 + mt * 32 + crow(i, h);
                if (li < n) {
                    const int slot = list[e * NTOK + li]; const float wg = tokw[slot];
                    bf16_t* yr = Y + (size_t)slot * DM + ct * 128 + wc * 64 + ln;
                    yr[0] = f2bf(wg * acc[mt][0][i]); yr[32] = f2bf(wg * acc[mt][1][i]);
                }
            }
    }
}

constexpr int NPHASES = 16;
__global__ void __launch_bounds__(NTHREADS, 2) mk_fwd(Params P, int ph_lo, int ph_hi) {
    __shared__ __attribute__((aligned(16))) char smem[65536];
    cg::grid_group grid = cg::this_grid();
    const int bid = blockIdx.x, nb = gridDim.x;
#define RUN(k, call) if (ph_lo <= (k) && (k) < ph_hi) { call; if ((k) + 1 < ph_hi) grid.sync(); }
    RUN(0, phase_prologue(P, bid, nb, smem))
    RUN(1, phase_norm1(P, 0, bid, nb))
    RUN(2, phase_qkv(P, 0, bid, nb, smem))
    RUN(3, phase_attn(P, 0, bid, nb, smem))
    RUN(4, phase_outproj(P, 0, bid, nb, smem))
    RUN(5, phase_norm2_route(P, 0, bid, nb, smem))
    RUN(6, phase_gateup(P, 0, bid, nb, smem))
    RUN(7, phase_down(P, 0, bid, nb, smem))
    RUN(8, phase_norm1(P, 1, bid, nb))
    RUN(9, phase_qkv(P, 1, bid, nb, smem))
    RUN(10, phase_attn(P, 1, bid, nb, smem))
    RUN(11, phase_outproj(P, 1, bid, nb, smem))
    RUN(12, phase_norm2_route(P, 1, bid, nb, smem))
    RUN(13, phase_gateup(P, 1, bid, nb, smem))
    RUN(14, phase_down(P, 1, bid, nb, smem))
    RUN(15, phase_final(P, bid, nb))
#undef RUN
}

__global__ void __launch_bounds__(NTHREADS) k_attn_naive(Params P, int l) { phase_attn_naive(P, l, blockIdx.x, gridDim.x); }

extern "C" void kernel_launch(void* const* d_in, const int* in_sizes, int n_in, void* d_out, int out_size, void* d_ws, size_t ws_size, hipStream_t stream) {
    Params p{};
    const float** f = (const float**)&p;
    for (int i = 0; i < 24; ++i) f[i] = (const float*)d_in[i];
    p.out = (float*)d_out; p.ws = (unsigned char*)d_ws;
    if (ws_size < WS_END) { fprintf(stderr, "workspace too small: %zu < %zu\n", ws_size, (size_t)WS_END); return; }
    for (int ph = 0; ph < NPHASES; ++ph) {
#ifndef NAIVE_ATTN
#define NAIVE_ATTN 0
#endif
        if (NAIVE_ATTN && ph >= 1 && ph < 15 && (ph - 1) % 7 == 2) hipLaunchKernelGGL(k_attn_naive, dim3(864), dim3(NTHREADS), 0, stream, p, (ph - 1) / 7);
        else hipLaunchKernelGGL(mk_fwd, dim3(512), dim3(NTHREADS), 0, stream, p, ph, ph + 1);
    }
}
```

```cpp
#include <hip/hip_runtime.h>
#include <stdint.h>
#include <stdio.h>


#define DI __device__ __forceinline__
#define LAS __attribute__((address_space(3)))
typedef unsigned short bf16_t;
typedef short bf16x8 __attribute__((ext_vector_type(8)));
typedef float f32x16 __attribute__((ext_vector_type(16)));
typedef float f32x4 __attribute__((ext_vector_type(4)));
typedef float f32x2 __attribute__((ext_vector_type(2)));
typedef unsigned u32x4 __attribute__((ext_vector_type(4)));
typedef unsigned u32x2 __attribute__((ext_vector_type(2)));
typedef short s16x4 __attribute__((ext_vector_type(4)));

constexpr int NB = 8, SEQ = 2048, CTXL = 256, TPB = SEQ + CTXL  , NTOK = NB * TPB  ;
constexpr int DM = 1024, INC = 2560, NEXP = 16, DEXP = 256;
constexpr int NQU = 16, NKU = 12, NVR = 768;
constexpr size_t VS = (size_t)NVR * TPB;
constexpr int NTHREADS = 512, NW = NTHREADS / 64;
constexpr int LDS_MAIN = 131072, LDS_MISC = LDS_MAIN + 64, LDS_BYTES = LDS_MISC + 16384;
constexpr float RMS_EPS = 1e-6f;
constexpr float QSCALE = 0.125f * 1.4426950408889634f;

constexpr size_t OFF_CTL  = 0;
constexpr size_t OFF_CNT  = 14336, OFF_RDYC = OFF_CNT + 8192, CTL_BYTES = 24576;
constexpr size_t OFF_MOD  = CTL_BYTES;
constexpr size_t OFF_ROPE = OFF_MOD + (size_t)2 * 9 * 6144 * 4;
constexpr size_t OFF_WIN  = OFF_ROPE + 16384;
constexpr size_t OFF_WOUT = OFF_WIN + (size_t)2 * 2560 * 1024 * 2;
constexpr size_t OFF_WGU  = OFF_WOUT + (size_t)2 * 1024 * 1024 * 2;
constexpr size_t OFF_WD   = OFF_WGU + (size_t)2 * 16 * 512 * 1024 * 2;
constexpr size_t OFF_HX   = OFF_WD + (size_t)2 * 16 * 1024 * 256 * 2;
constexpr size_t OFF_QB   = OFF_HX + (size_t)NTOK * DM * 2;
constexpr size_t OFF_KB   = OFF_QB + (size_t)NB * NQU * TPB * 64 * 2;
constexpr size_t OFF_VT   = OFF_KB + (size_t)NB * NKU * TPB * 64 * 2;
constexpr size_t OFF_Y    = OFF_QB;
constexpr size_t OFF_XC   = OFF_VT + (size_t)NB * NVR * TPB * 2;
constexpr size_t HB_ROWS  = 2 * NTOK + NEXP * 256;
constexpr size_t OFF_HB   = OFF_XC + (size_t)NB * CTXL * DM * 4;
constexpr size_t OFF_LIST = OFF_HB + HB_ROWS * DEXP * 2;
constexpr size_t OFF_TOKW = OFF_LIST + (size_t)NEXP * NTOK * 4;
constexpr size_t WS_END   = OFF_TOKW + (size_t)2 * NTOK * 4;
static_assert(WS_END <= (size_t)256 * 1024 * 1024, "workspace");
static_assert((size_t)2 * NTOK * DM * 2 <= OFF_XC - OFF_QB, "Y alias");

struct Params {
    const float *x, *c, *ctx, *c_ctx, *w_ada, *b_ada, *norm1_g, *norm2_g, *w_in, *w_out, *lam_q1, *lam_k1, *lam_q2, *lam_k2,
        *subln_g, *q_norm_g, *k_norm_g, *sink, *w_router, *router_bias, *w_gate, *w_up, *w_down, *final_g;
    float* out;
    unsigned char* ws;
};

DI float bf2f(bf16_t b) { return __uint_as_float(((unsigned)b) << 16); }
typedef __bf16 bf2_t __attribute__((ext_vector_type(2)));
DI bf16_t f2bf(float f) { return __builtin_bit_cast(bf16_t, (__bf16)f); }
DI unsigned pk2(float lo, float hi) { bf2_t v = {(__bf16)lo, (__bf16)hi}; return __builtin_bit_cast(unsigned, v); }
DI int crow(int reg, int h) { return (reg & 3) + 8 * (reg >> 2) + 4 * h; }
DI float wave_sum(float v) {
#pragma unroll
    for (int o = 1; o < 64; o <<= 1) v += __shfl_xor(v, o);
    return v;
}
DI float max2f(float a, float b) { return __builtin_amdgcn_fmed3f(a, b, __builtin_inff()); }
DI float silu(float v) { return v / (1.f + expf(-v)); }
DI float* resid_row(const Params& P, int b, int p) {
    return p < CTXL ? (float*)(P.ws + OFF_XC) + (size_t)(b * CTXL + p) * DM : P.out + (size_t)(b * SEQ + p - CTXL) * DM;
}
DI const float* input_row(const Params& P, int b, int p) {
    return p < CTXL ? P.ctx + (size_t)(b * CTXL + p) * DM : P.x + (size_t)(b * SEQ + p - CTXL) * DM;
}
DI const float* mod_row(const Params& P, int l, int mr) { return (const float*)(P.ws + OFF_MOD) + (size_t)(l * 9 + mr) * 6144; }

constexpr int TI_IN = 2 * 16 * 40, TI_OUT = 2 * 16 * 16, TI_G = 32 * 16 * 4, TI_U = TI_G, TI_D = 32 * 4 * 16, TI_ALL = TI_IN + TI_OUT + TI_G + TI_U + TI_D;
DI void titem_decode(const Params& P, int r, const float*& src, int& N, bf16_t*& dst, int& ldd, int& n0, int& kind) {
    kind = 0;
    if (r < TI_IN) { const int l = r / 640, q = r % 640, kb = q / 40, nbk = q % 40; N = INC; ldd = DM; n0 = nbk * 64; kind = 3;
        src = P.w_in + (size_t)l * DM * INC + (size_t)(kb * 64) * INC + n0; dst = (bf16_t*)(P.ws + OFF_WIN) + (size_t)l * INC * DM + kb * 64; return; }
    r -= TI_IN;
    if (r < TI_OUT) { const int l = r / 256, q = r % 256, kb = q / 16, nbk = q % 16; N = DM; ldd = DM; n0 = nbk * 64;
        src = P.w_out + (size_t)l * DM * DM + (size_t)(kb * 64) * DM + n0; dst = (bf16_t*)(P.ws + OFF_WOUT) + (size_t)l * DM * DM + kb * 64; return; }
    r -= TI_OUT;
    if (r < TI_G + TI_U) { const bool up = r >= TI_G; if (up) r -= TI_G; const int le = r / 64, q = r % 64, kb = q / 4, nbk = q % 4; N = DEXP; ldd = DM; n0 = nbk * 64; kind = up ? 2 : 1;
        src = (up ? P.w_up : P.w_gate) + (size_t)le * DM * DEXP + (size_t)(kb * 64) * DEXP + n0; dst = (bf16_t*)(P.ws + OFF_WGU) + (size_t)le * 512 * DM + kb * 64; return; }
    r -= TI_G + TI_U;
    { const int le = r / 64, q = r % 64, kb = q / 16, nbk = q % 16; N = DM; ldd = DEXP; n0 = nbk * 64;
        src = P.w_down + (size_t)le * DEXP * DM + (size_t)(kb * 64) * DM + n0; dst = (bf16_t*)(P.ws + OFF_WD) + (size_t)le * DM * DEXP + kb * 64; }
}

DI void phase_prologue(const Params& P, int bid, int nb, char* smem) {
    const int t = threadIdx.x;
    float* s = (float*)smem;
    {
        constexpr int NLD = 4096 / NTHREADS;
        float v[NLD];
        int it = bid;
        const float* src; bf16_t* dst; int N, ldd, n0, kind;
        if (it < TI_ALL) { titem_decode(P, it, src, N, dst, ldd, n0, kind);
#pragma unroll
            for (int i = 0; i < NLD; ++i) v[i] = src[(size_t)((t >> 6) + NW * i) * N + (t & 63)]; }
        while (it < TI_ALL) {
            __syncthreads();
#pragma unroll
            for (int i = 0; i < NLD; ++i) s[((t >> 6) + NW * i) * 65 + (t & 63)] = v[i];
            __syncthreads();
            bf16_t* cdst = dst; const int cldd = ldd, cn0 = n0, ckind = kind;
            it += nb;
            if (it < TI_ALL) { titem_decode(P, it, src, N, dst, ldd, n0, kind);
#pragma unroll
                for (int i = 0; i < NLD; ++i) v[i] = src[(size_t)((t >> 6) + NW * i) * N + (t & 63)]; }
            constexpr int KPT = 64 * 64 / NTHREADS;
            const int n = t / (64 / KPT), kc = (t % (64 / KPT)) * KPT;
            const int ng = cn0 + n;
            int drow = ng;
            if (ckind == 3) {
                const bool isv = (ng >= 1536 && ng < 2048) || (ng >= 2176 && ng < 2304) || ng >= 2432;
                const int w = (ng >> 6) & 3, d = ng & 63;
                const int bj = isv ? (d >> 3) & 1 : d >> 5, n = isv ? (d >> 2) & 1 : (d >> 4) & 1, fq = isv ? d >> 4 : (d >> 2) & 3, r = d & 3;
                drow = (ng & ~255) + 128 * bj + 32 * w + 16 * n + 4 * fq + r;
            }
            else if (ckind != 0) drow = (ng >> 7) * 256 + (ckind == 2 ? 128 : 0) + (ng & 127);
            bf16_t* d = cdst + (size_t)drow * cldd + kc;
#pragma unroll
            for (int j = 0; j < KPT; j += 8) { u32x4 o;
                o.x = pk2(s[(kc + j + 0) * 65 + n], s[(kc + j + 1) * 65 + n]); o.y = pk2(s[(kc + j + 2) * 65 + n], s[(kc + j + 3) * 65 + n]);
                o.z = pk2(s[(kc + j + 4) * 65 + n], s[(kc + j + 5) * 65 + n]); o.w = pk2(s[(kc + j + 6) * 65 + n], s[(kc + j + 7) * 65 + n]);
                *(u32x4*)(d + j) = o; }
        }
    }
    {
        constexpr int I_MOD = 2 * 384, KG = NTHREADS / 16, KPG = DM / KG;
        bool have_silu = false;
        float* ssl = s;
        float* red = s + 9 * 1024;
        for (int it = bid; it < I_MOD; it += nb) {
            const int l = it / 384, col0 = (it % 384) * 16, cc = t & 15, kg = t >> 4;
            const float* W = P.w_ada + (size_t)l * DM * 6144 + col0 + cc + (size_t)(kg * KPG) * 6144;
            float w[KPG];
#pragma unroll
            for (int kk = 0; kk < KPG; ++kk) w[kk] = W[(size_t)kk * 6144];
            __syncthreads();
            if (!have_silu) { for (int i = t; i < 9 * 1024; i += NTHREADS) { const float cv = i < 8192 ? P.c[i] : P.c_ctx[i - 8192]; ssl[i] = silu(cv); } have_silu = true; }
            __syncthreads();
            float acc[9];
#pragma unroll
            for (int i = 0; i < 9; ++i) acc[i] = 0.f;
#pragma unroll
            for (int kk = 0; kk < KPG; ++kk) {
#pragma unroll
                for (int i = 0; i < 9; ++i) acc[i] += ssl[i * 1024 + kg * KPG + kk] * w[kk];
            }
#pragma unroll
            for (int i = 0; i < 9; ++i) red[(i * KG + kg) * 16 + cc] = acc[i];
            __syncthreads();
            if (t < 144) { const int i = t >> 4, c2 = t & 15; float a = P.b_ada[l * 6144 + col0 + c2];
                for (int g = 0; g < KG; ++g) a += red[(i * KG + g) * 16 + c2];
                ((float*)(P.ws + OFF_MOD))[(size_t)(l * 9 + i) * 6144 + col0 + c2] = a; }
        }
    }
    for (int idx = bid * NTHREADS + t; idx < 96 * 16; idx += nb * NTHREADS) {
        const int pi = idx >> 4, j = idx & 15, pos = pi < 32 ? pi : pi - 32;
        const float invf = powf(10000.f, -(float)j / 16.f);
        float sn, cs; sincosf((float)pos * invf, &sn, &cs);
        ((float*)(P.ws + OFF_ROPE))[idx] = cs; ((float*)(P.ws + OFF_ROPE))[96 * 16 + idx] = sn;
    }
}

struct RowIn { f32x4 x[4]; u32x2 y0[4], y1[4]; };
template <bool COMBINE>
DI void row_load(const Params& P, int l, int tok, int lane, RowIn& r) {
    const int b = tok / TPB, p = tok % TPB;
    const f32x4* src = (const f32x4*)((l == 0 && !COMBINE) ? input_row(P, b, p) : (const float*)resid_row(P, b, p)) + lane;
#pragma unroll
    for (int j = 0; j < 4; ++j) r.x[j] = src[64 * j];
    if (COMBINE) {
        const bf16_t* Y = (const bf16_t*)(P.ws + OFF_Y);
        const u32x2* y0 = (const u32x2*)(Y + (size_t)(2 * tok) * DM) + lane;
        const u32x2* y1 = (const u32x2*)(Y + (size_t)(2 * tok + 1) * DM) + lane;
#pragma unroll
        for (int j = 0; j < 4; ++j) { r.y0[j] = y0[64 * j]; r.y1[j] = y1[64 * j]; }
    }
}
DI f32x4 row_combine(const f32x4 xv, const f32x4 g, const u32x2 a, const u32x2 c2) {
    f32x4 yv;
    yv.x = __uint_as_float(a.x << 16) + __uint_as_float(c2.x << 16);
    yv.y = __uint_as_float(a.x & 0xffff0000u) + __uint_as_float(c2.x & 0xffff0000u);
    yv.z = __uint_as_float(a.y << 16) + __uint_as_float(c2.y << 16);
    yv.w = __uint_as_float(a.y & 0xffff0000u) + __uint_as_float(c2.y & 0xffff0000u);
    return xv + g * yv;
}
template <bool COMBINE>
DI void norm1_body(const Params& P, int l, int bid, int nb) {
    const int lane = threadIdx.x & 63, wave = threadIdx.x >> 6;
    bf16_t* HX = (bf16_t*)(P.ws + OFF_HX);
    const int per = (NTOK + nb - 1) / nb, tk0 = bid * per, ntk = min(NTOK, tk0 + per) - tk0;
    RowIn cur, nxt;
    f32x4 gs[4], hs[4], g2[4];
    int cur_mr = -1;
    if (wave < ntk) row_load<COMBINE>(P, l, tk0 + wave, lane, nxt);
    for (int i = wave; i < ntk; i += NW) {
        const int tok = tk0 + i, b = tok / TPB, p = tok % TPB, mr = p < CTXL ? 8 : b;
        cur = nxt;
        if (i + NW < ntk) row_load<COMBINE>(P, l, tok + NW, lane, nxt);
        if (mr != cur_mr) {
            const float* md = mod_row(P, l, mr);
            const f32x4* gn = (const f32x4*)(P.norm1_g + l * DM) + lane;
            const f32x4* sh = (const f32x4*)(md) + lane;
            const f32x4* sc = (const f32x4*)(md + 1024) + lane;
#pragma unroll
            for (int j = 0; j < 4; ++j) { gs[j] = gn[64 * j] * (1.f + sc[64 * j]); hs[j] = sh[64 * j]; }
            if (COMBINE) { const f32x4* gp = (const f32x4*)(mod_row(P, l - 1, mr) + 5120) + lane;
#pragma unroll
                for (int j = 0; j < 4; ++j) g2[j] = gp[64 * j]; }
            cur_mr = mr;
        }
        f32x4 v[4]; float ss = 0.f;
        f32x4* xr = (f32x4*)resid_row(P, b, p) + lane;
#pragma unroll
        for (int j = 0; j < 4; ++j) {
            v[j] = COMBINE ? row_combine(cur.x[j], g2[j], cur.y0[j], cur.y1[j]) : cur.x[j];
            if (COMBINE) xr[64 * j] = v[j];
            ss += (v[j].x * v[j].x + v[j].y * v[j].y) + (v[j].z * v[j].z + v[j].w * v[j].w);
        }
        const float r = rsqrtf(wave_sum(ss) * (1.f / DM) + RMS_EPS);
        u32x2* o = (u32x2*)(HX + (size_t)tok * DM) + lane;
#pragma unroll
        for (int j = 0; j < 4; ++j) {
            const f32x4 y = v[j] * r * gs[j] + hs[j];
            u32x2 w; w.x = pk2(y.x, y.y); w.y = pk2(y.z, y.w);
            o[64 * j] = w;
        }
    }
}
DI void phase_norm1(const Params& P, int l, int bid, int nb) { if (l == 0) norm1_body<false>(P, 0, bid, nb); else norm1_body<true>(P, l, bid, nb); }

DI void phase_final(const Params& P, int bid, int nb) {
    const int lane = threadIdx.x & 63, wave = threadIdx.x >> 6;
    const int per = (NB * SEQ + nb - 1) / nb, r0 = bid * per, nr = min(NB * SEQ, r0 + per) - r0;
    RowIn cur, nxt;
    f32x4 fg[4], g2[4];
    const f32x4* fgp = (const f32x4*)P.final_g + lane;
#pragma unroll
    for (int j = 0; j < 4; ++j) fg[j] = fgp[64 * j];
    int cur_b = -1;
    if (wave < nr) { const int r = r0 + wave; row_load<true>(P, 1, (r / SEQ) * TPB + CTXL + r % SEQ, lane, nxt); }
    for (int i = wave; i < nr; i += NW) {
        const int r = r0 + i, b = r / SEQ, p = CTXL + r % SEQ;
        cur = nxt;
        if (i + NW < nr) { const int r2 = r + NW; row_load<true>(P, 1, (r2 / SEQ) * TPB + CTXL + r2 % SEQ, lane, nxt); }
        if (b != cur_b) { const f32x4* gp = (const f32x4*)(mod_row(P, 1, b) + 5120) + lane;
#pragma unroll
            for (int j = 0; j < 4; ++j) g2[j] = gp[64 * j];
            cur_b = b; }
        f32x4 v[4]; float ss = 0.f;
#pragma unroll
        for (int j = 0; j < 4; ++j) { v[j] = row_combine(cur.x[j], g2[j], cur.y0[j], cur.y1[j]); ss += (v[j].x * v[j].x + v[j].y * v[j].y) + (v[j].z * v[j].z + v[j].w * v[j].w); }
        const float rr = rsqrtf(wave_sum(ss) * (1.f / DM) + RMS_EPS);
        f32x4* xr = (f32x4*)resid_row(P, b, p) + lane;
#pragma unroll
        for (int j = 0; j < 4; ++j) xr[64 * j] = v[j] * rr * fg[j];
    }
}

namespace g8 {
constexpr int BK = 64, HALF = 128, HTB = HALF * BK * 2, STAGE_BYTES = 8 * HTB;
DI int lds_byte(int r, int c) { const int st = (r >> 4) * 2 + (c >> 5), rr = r & 15, cc = c & 31, ob = rr * 64 + cc * 2; return st * 1024 + (ob ^ (((ob >> 9) & 1) << 5)); }
DI void stage_rc(int b, int& R, int& C) { const int st = b / 1024, sb = b % 1024, swz = sb ^ (((sb >> 9) & 1) << 5); R = (st >> 1) * 16 + swz / 64; C = (st & 1) * 32 + (swz % 64) / 2; }
struct Unit { int a, b, c, d; const bf16_t* bt; };

template <class Sched, class Epi>
DI void gemm_phase(char* smem, const bf16_t* Abase, const int K, const Sched& S, const Epi& E) {
    LAS unsigned char* lds = (LAS unsigned char*)smem;
    const int tid = threadIdx.x, wid = __builtin_amdgcn_readfirstlane(tid >> 6), lane = tid & 63, wr = wid >> 2, wc = wid & 3, fr = lane & 15, fq = lane >> 4;
    const int nt = K / BK;
    int R[2], C[2];
    unsigned voffB[2], voffA[2];
#pragma unroll
    for (int i = 0; i < 2; ++i) { stage_rc(tid * 16 + i * 8192, R[i], C[i]); voffB[i] = (unsigned)(R[i] * K + C[i]) * 2u; voffA[i] = voffB[i]; }
    const size_t kstep = (size_t)(BK * 2);
    const size_t hstep = (size_t)HALF * K * 2;
    const unsigned ldsw = (unsigned)wid * 1024u;
    const int aoff = lds_byte(wr * 64 + fr, fq * 8), boff = lds_byte(wc * 32 + fr, fq * 8);
#define G8_SA(b, h) (((b) * 2 + (h)) * HTB)
#define G8_SB(b, h) ((4 + (b) * 2 + (h)) * HTB)
#define G8_STAGE_B(bufoff, gbase) do { _Pragma("unroll") for (int _i = 0; _i < 2; ++_i) \
        __builtin_amdgcn_global_load_lds((const unsigned*)((const char*)(gbase) + voffB[_i]), (LAS unsigned*)(lds + (bufoff) + ldsw + _i * 8192), 16, 0, 0); } while (0)
#define G8_GLDS(src, dstoff) __builtin_amdgcn_global_load_lds((const unsigned*)(src), (LAS unsigned*)(lds + (dstoff)), 16, 0, 0)
#define G8_STAGE_A(bufoff, hh, nx, kb) do { \
        if constexpr (Sched::GATHER) { const unsigned o0_ = (nx) ? avn[hh][0] : avc[hh][0], o1_ = (nx) ? avn[hh][1] : avc[hh][1]; \
            G8_GLDS(Ab + (size_t)o0_ + (kb), (bufoff) + ldsw); G8_GLDS(Ab + (size_t)o1_ + (kb), (bufoff) + ldsw + 8192); } \
        else { const char* ba_ = ((nx) ? nA : cA) + (size_t)(hh) * hstep + (kb); G8_GLDS(ba_ + voffA[0], (bufoff) + ldsw); G8_GLDS(ba_ + voffA[1], (bufoff) + ldsw + 8192); } } while (0)
#define G8_LDA(dst, b, h) do { _Pragma("unroll") for (int m = 0; m < 4; ++m) _Pragma("unroll") for (int k = 0; k < 2; ++k) dst[m][k] = *(const LAS bf16x8*)(lds + G8_SA(b, h) + aoff + m * 2048 + k * 1024); } while (0)
#define G8_LDB(dst, b, h) do { _Pragma("unroll") for (int n = 0; n < 2; ++n) _Pragma("unroll") for (int k = 0; k < 2; ++k) dst[n][k] = *(const LAS bf16x8*)(lds + G8_SB(b, h) + boff + n * 2048 + k * 1024); } while (0)
#define G8_MMA(ai, bj, At, Bt) do { __builtin_amdgcn_s_setprio(1); _Pragma("unroll") for (int m = 0; m < 4; ++m) _Pragma("unroll") for (int n = 0; n < 2; ++n) _Pragma("unroll") for (int k = 0; k < 2; ++k) \
        acc[ai][bj][m][n] = __builtin_amdgcn_mfma_f32_16x16x32_bf16(Bt[n][k], At[m][k], acc[ai][bj][m][n], 0, 0, 0); __builtin_amdgcn_s_setprio(0); } while (0)
#define G8_WAIT_V(n) asm volatile("s_waitcnt vmcnt(" #n ")" ::: "memory")
#define G8_WAIT_L(n) asm volatile("s_waitcnt lgkmcnt(" #n ")" ::: "memory")
#define G8_BAR __builtin_amdgcn_s_barrier()
#define G8_SCHED __builtin_amdgcn_sched_barrier(0)
    Unit cur, nxt; int ui = 0;
    if (!S.next(0, cur)) return;
    f32x4 acc[2][2][4][2];
#pragma unroll
    for (int a = 0; a < 2; ++a)
#pragma unroll
        for (int b = 0; b < 2; ++b)
#pragma unroll
            for (int m = 0; m < 4; ++m)
#pragma unroll
                for (int n = 0; n < 2; ++n) acc[a][b][m][n] = (f32x4){0.f, 0.f, 0.f, 0.f};
    bf16x8 At[4][2], B0[2][2], B1[2][2];
    const char* Ab = (const char*)Abase;
    unsigned avc[2][2], avn[2][2];
    const char *cA = Ab, *nA = Ab;
    S.a_ready(cur);
    if constexpr (Sched::GATHER) S.a_offsets(cur, R, C, avc); else cA = (const char*)S.a_base(cur);
    const char* cB = (const char*)cur.bt;
    G8_STAGE_B(G8_SB(0, 0), cB); G8_STAGE_B(G8_SB(0, 1), cB + hstep); G8_STAGE_A(G8_SA(0, 0), 0, false, 0); G8_STAGE_A(G8_SA(0, 1), 1, false, 0);
    if (wr == 1) G8_BAR;
    G8_WAIT_V(2); G8_BAR;
    G8_STAGE_B(G8_SB(1, 0), cB + kstep); G8_STAGE_A(G8_SA(1, 0), 0, false, kstep); G8_STAGE_B(G8_SB(1, 1), cB + hstep + kstep);
    G8_WAIT_V(6); G8_BAR;
    for (;;) {
        const bool has_next = S.next(ui + 1, nxt);
        if constexpr (Sched::GATHER) {
            if (has_next) S.a_offsets(nxt, R, C, avn);
            else {
#pragma unroll
                for (int hh = 0; hh < 2; ++hh)
#pragma unroll
                    for (int i = 0; i < 2; ++i) avn[hh][i] = avc[hh][i];
            }
        } else nA = has_next ? (const char*)S.a_base(nxt) : cA;
        const char* nB = has_next ? (const char*)nxt.bt : cB;
        for (int t = 0; t < nt; t += 2) {
            const bool last = (t == nt - 2);
            const size_t k1 = (size_t)(t + 1) * kstep;
            const size_t k2 = last ? 0 : (size_t)(t + 2) * kstep, k3 = k2 + kstep;
            const char* b2 = last ? nB : cB + k2; const char* b3 = b2 + kstep;
            G8_LDB(B0, 0, 0); G8_LDB(B1, 0, 1); G8_SCHED; G8_LDA(At, 0, 0); G8_STAGE_A(G8_SA(1, 1), 1, false, k1);
            G8_WAIT_V(8); G8_WAIT_L(0); G8_BAR; G8_MMA(0, 0, At, B0); G8_MMA(0, 1, At, B1); G8_BAR; G8_SCHED;
            G8_LDA(At, 0, 1); G8_STAGE_B(G8_SB(0, 0), b2); G8_STAGE_B(G8_SB(0, 1), b2 + hstep); G8_STAGE_A(G8_SA(0, 0), 0, last, k2);
            G8_WAIT_V(8); G8_WAIT_L(0); G8_BAR; G8_MMA(1, 0, At, B0); G8_MMA(1, 1, At, B1); G8_BAR; G8_SCHED;
            G8_LDB(B0, 1, 0); G8_LDB(B1, 1, 1); G8_SCHED; G8_LDA(At, 1, 0); G8_STAGE_A(G8_SA(0, 1), 1, last, k2);
            G8_WAIT_V(8); G8_WAIT_L(0); G8_BAR; G8_MMA(0, 0, At, B0); G8_MMA(0, 1, At, B1); G8_BAR; G8_SCHED;
            G8_LDA(At, 1, 1); G8_STAGE_B(G8_SB(1, 0), b3); G8_STAGE_B(G8_SB(1, 1), b3 + hstep); G8_STAGE_A(G8_SA(1, 0), 0, last, k3);
            G8_WAIT_V(8); G8_WAIT_L(0); G8_BAR; G8_MMA(1, 0, At, B0); G8_MMA(1, 1, At, B1); G8_BAR; G8_SCHED;
        }
        if (wr == 0) G8_BAR;
        E(acc, cur, wr, wc, fr, fq);
        if (!has_next) break;
#pragma unroll
        for (int a = 0; a < 2; ++a)
#pragma unroll
            for (int b = 0; b < 2; ++b)
#pragma unroll
                for (int m = 0; m < 4; ++m)
#pragma unroll
                    for (int n = 0; n < 2; ++n) acc[a][b][m][n] = (f32x4){0.f, 0.f, 0.f, 0.f};
        cur = nxt; cB = nB; cA = nA; ++ui;
        if constexpr (Sched::GATHER) {
#pragma unroll
            for (int hh = 0; hh < 2; ++hh)
#pragma unroll
                for (int i = 0; i < 2; ++i) avc[hh][i] = avn[hh][i];
        }
        if (wr == 1) G8_BAR;
    }
    G8_WAIT_V(0);
    G8_BAR;
#undef G8_SA
#undef G8_SB
#undef G8_STAGE_A
#undef G8_GLDS
#undef G8_STAGE_B
#undef G8_LDA
#undef G8_LDB
#undef G8_MMA
#undef G8_WAIT_V
#undef G8_WAIT_L
#undef G8_BAR
#undef G8_SCHED
}

DI bool static_unit(int i, int G, int c, int nM, int nN, int& pm, int& pn) {
    const int nwg = nM * nN; const long L = (long)i * G + c; if (L >= nwg) return false;
    int wgid = (int)L; { const int q = nwg / 8, r = nwg % 8, xcd = wgid % 8, off = wgid / 8; wgid = (xcd < r ? xcd * (q + 1) : r * (q + 1) + (xcd - r) * q) + off; }
    const int nig = 8 * nN, gid = wgid / nig, fm = gid * 8, gsz = (nM - fm) < 8 ? (nM - fm) : 8;
    pm = fm + ((wgid % nig) % gsz); pn = (wgid % nig) / gsz; return true;
}
}

struct SchedQKV {
    const bf16_t *A, *Wt; int G, c;
    static constexpr bool GATHER = false;
    DI void a_ready(const g8::Unit&) const {}
    DI bool next(int i, g8::Unit& u) const { int pm, pn; if (!g8::static_unit(i, G, c, NTOK / 256, INC / 256, pm, pn)) return false; u.a = pm; u.b = pn; u.c = 0; u.d = 0; u.bt = Wt + (size_t)pn * 256 * DM; return true; }
    DI const bf16_t* a_base(const g8::Unit& u) const { return A + (size_t)u.a * 256 * DM; }
};
struct EpiQKV {
    bf16_t *QB, *KB, *VT; const float *ropec, *ropes, *qg, *kg;
    DI void operator()(const f32x4 (&acc)[2][2][4][2], const g8::Unit& u, int wr, int wc, int fr, int fq) const {
        const int pm = u.a, pn = u.b, b = pm / 9, p0 = (pm % 9) * 256;
        const bool isctx = p0 == 0;
        const int cw = pn * 256 + wc * 64;
        int kind, unit; const float* ng = nullptr;
        if (cw < 1024) { kind = 0; unit = cw >> 6; if (unit >= 8 && unit < 12) ng = qg; }
        else if (cw < 1536) { kind = 1; unit = (cw - 1024) >> 6; }
        else if (cw < 2048) { kind = 2; unit = cw - 1536; }
        else if (cw < 2176) { kind = 1; unit = 8 + ((cw - 2048) >> 6); ng = kg; }
        else if (cw < 2304) { kind = 2; unit = 512 + (cw - 2176); }
        else if (cw < 2432) { kind = 1; unit = 10 + ((cw - 2304) >> 6); }
        else { kind = 2; unit = 640 + (cw - 2432); }
        if (kind == 2) {
            const int vld = unit < 512 ? 128 : 64;
            const size_t vbase = unit < 512 ? (size_t)(unit >> 7) * TPB * 128 + (unit & 127) : (size_t)4 * TPB * 128 + (size_t)((unit - 512) >> 6) * TPB * 64;
            bf16_t* vb = VT + (size_t)b * VS + vbase + 16 * fq;
#pragma unroll
            for (int ai = 0; ai < 2; ++ai)
#pragma unroll
                for (int m = 0; m < 4; ++m) {
                    const int p = p0 + 128 * ai + 64 * wr + 16 * m + fr;
#pragma unroll
                    for (int bj = 0; bj < 2; ++bj) { const f32x4 v0 = acc[ai][bj][m][0], v1 = acc[ai][bj][m][1];
                        u32x4 o; o.x = pk2(v0.x, v0.y); o.y = pk2(v0.z, v0.w); o.z = pk2(v1.x, v1.y); o.w = pk2(v1.z, v1.w);
                        *(u32x4*)(vb + (size_t)p * vld + 8 * bj) = o; }
                }
            return;
        }
        const bool nrm = ng != nullptr;
        f32x4 g4[2][2];
#pragma unroll
        for (int bj = 0; bj < 2; ++bj)
#pragma unroll
            for (int n = 0; n < 2; ++n) g4[bj][n] = nrm ? *(const f32x4*)(ng + 32 * bj + 16 * n + 4 * fq) : (f32x4){1.f, 1.f, 1.f, 1.f};
        const float osc = kind == 0 ? QSCALE : 1.f;
        bf16_t* base = (kind == 0 ? QB + ((size_t)b * NQU + unit) * TPB * 64 : KB + ((size_t)b * NKU + unit) * TPB * 64) + 4 * fq;
#pragma unroll
        for (int ai = 0; ai < 2; ++ai)
#pragma unroll
            for (int m = 0; m < 4; ++m) {
                const int p = p0 + 128 * ai + 64 * wr + 16 * m + fr;
                f32x4 x[2][2];
#pragma unroll
                for (int bj = 0; bj < 2; ++bj)
#pragma unroll
                    for (int n = 0; n < 2; ++n) x[bj][n] = acc[ai][bj][m][n];
                if (nrm) {
                    float ss = 0.f;
#pragma unroll
                    for (int bj = 0; bj < 2; ++bj)
#pragma unroll
                        for (int n = 0; n < 2; ++n) ss += (x[bj][n].x * x[bj][n].x + x[bj][n].y * x[bj][n].y) + (x[bj][n].z * x[bj][n].z + x[bj][n].w * x[bj][n].w);
                    ss += __shfl_xor(ss, 16); ss += __shfl_xor(ss, 32);
                    const float r = rsqrtf(ss * (1.f / 64.f) + RMS_EPS);
#pragma unroll
                    for (int bj = 0; bj < 2; ++bj)
#pragma unroll
                        for (int n = 0; n < 2; ++n) x[bj][n] = x[bj][n] * r * g4[bj][n];
                }
                if (!isctx) {
                    const int t = p - CTXL;
#pragma unroll
                    for (int bj = 0; bj < 2; ++bj) {
                        const int idx = (bj == 0 ? (t >> 6) : 32 + (t & 63)) * 16 + 4 * fq;
                        const f32x4 c4 = *(const f32x4*)(ropec + idx), s4 = *(const f32x4*)(ropes + idx);
                        const f32x4 y0 = x[bj][0] * c4 - x[bj][1] * s4, y1 = x[bj][0] * s4 + x[bj][1] * c4;
                        x[bj][0] = y0; x[bj][1] = y1;
                    }
                }
#pragma unroll
                for (int bj = 0; bj < 2; ++bj)
#pragma unroll
                    for (int n = 0; n < 2; ++n) { u32x2 o; o.x = pk2(x[bj][n].x * osc, x[bj][n].y * osc); o.y = pk2(x[bj][n].z * osc, x[bj][n].w * osc);
                        *(u32x2*)(base + (size_t)p * 64 + 32 * bj + 16 * n) = o; }
            }
    }
};
DI void phase_qkv(const Params& P, int l, int bid, int nb, char* smem) {
    __syncthreads();
    for (int i = threadIdx.x; i < 2 * 96 * 16 / 4; i += NTHREADS) ((f32x4*)(smem + LDS_MISC))[i] = ((const f32x4*)(P.ws + OFF_ROPE))[i];
    __syncthreads();
    SchedQKV S{(const bf16_t*)(P.ws + OFF_HX), (const bf16_t*)(P.ws + OFF_WIN) + (size_t)l * INC * DM, nb, bid};
    EpiQKV E{(bf16_t*)(P.ws + OFF_QB), (bf16_t*)(P.ws + OFF_KB), (bf16_t*)(P.ws + OFF_VT), (const float*)(smem + LDS_MISC), (const float*)(smem + LDS_MISC) + 96 * 16,
             P.q_norm_g + l * 64, P.k_norm_g + l * 64};
    g8::gemm_phase(smem, (const bf16_t*)(P.ws + OFF_HX), DM, S, E);
}


#ifndef PV_AHEAD
#define PV_AHEAD 8
#endif
#define MFMA32(a, b, c) __builtin_amdgcn_mfma_f32_32x32x16_bf16((a), (b), (c), 0, 0, 0)
template <int DV>
DI void flash_run(char* smem, const bf16_t* qrow, const bf16_t* Kb, const bf16_t* Vr, int n1, int base2, int n2, int tq, float m0, float l0,
                  f32x16 (&O)[DV / 32], float& lout) {
    constexpr int NT = DV / 32, KBYTES = 8192, RB = DV * 2, STAGE = KBYTES + 64 * RB, NVP = DV / 64, KP = 1024 / RB, LPR = RB / 16;
    LAS char* lds = (LAS char*)smem;
    const int t = threadIdx.x, wave = __builtin_amdgcn_readfirstlane(t >> 6);
    int lane = t & 63;
    asm volatile("" : "+v"(lane));
    const int h = lane >> 5, ln = lane & 31, sw = (ln >> 1) & 7;
    constexpr bool QLDS = DV == 128;
    LAS char* qb = lds + 4 * STAGE + wave * 4096 + lane * 16;
    bf16x8 qf[4];
#pragma unroll
    for (int s = 0; s < 4; ++s) qf[s] = *(const bf16x8*)(qrow + 16 * s + 8 * h);
    if (QLDS) {
#pragma unroll
        for (int s = 0; s < 4; ++s) *(LAS bf16x8*)(qb + s * 1024) = qf[s];
    }
#pragma unroll
    for (int tt = 0; tt < NT; ++tt)
#pragma unroll
        for (int i = 0; i < 16; ++i) O[tt][i] = 0.f;
    constexpr float THR = 8.f;
    constexpr int PVA = PV_AHEAD;
    float m = m0 > -1e29f ? m0 : 0.f, l = l0;
    f32x16 negm;
#pragma unroll
    for (int i = 0; i < 16; ++i) negm[i] = -m;
    const int ntile = n1 + n2;
    constexpr int VPM = DV == 128 ? 5 : 9;
    bf16x8 pfp[2][2];
#pragma unroll
    for (int x = 0; x < 2; ++x)
#pragma unroll
        for (int y = 0; y < 2; ++y) pfp[x][y] = (bf16x8){0, 0, 0, 0, 0, 0, 0, 0};
    const int krow = 8 * wave + (lane >> 3);
    const unsigned koff = (unsigned)(krow * 64 + (((lane & 7) ^ ((krow >> 1) & 7)) << 3)) * 2u;
    unsigned voff[NVP];
#pragma unroll
    for (int i = 0; i < NVP; ++i) { const int key = 8 * wave + KP * i + lane / LPR, cpos = lane % LPR, z = DV == 128 ? (key & 3) : ((key >> 1) & 1);
        voff[i] = (unsigned)(key * DV + ((cpos ^ (z << 2)) << 3)) * 2u; }
    const int tq_ = (lane & 15) >> 2, tp_ = lane & 3, gb_ = (lane >> 4) & 1, z_ = DV == 128 ? tq_ : ((tq_ >> 1) & 1);
    const int vlane = (4 * h + tq_) * RB + (2 * gb_ + (tp_ >> 1)) * 16 + (tp_ & 1) * 8;
#define FA_DMA(gsrc, ldsdst) do { unsigned keep_; asm volatile("s_mov_b32 %0, m0\n\ts_mov_b32 m0, %2\n\ts_nop 0\n\tglobal_load_lds_dwordx4 %1, off\n\ts_mov_b32 m0, %0" \
        : "=&s"(keep_) : "v"(gsrc), "s"(ldsdst) : "memory"); } while (0)
#define FA_ISSUE(j) do { const int j_ = (j); const int pj_ = j_ < n1 ? 64 * j_ : base2 + 64 * (j_ - n1); const int bo_ = (j_ & 3) * STAGE; \
        const char* kt_ = (const char*)Kb + (size_t)pj_ * 128; const char* vt_ = (const char*)Vr + (size_t)pj_ * RB; \
        FA_DMA(kt_ + koff, (unsigned)(size_t)(lds + bo_ + wave * 1024)); \
        _Pragma("unroll") for (int i_ = 0; i_ < NVP; ++i_) FA_DMA(vt_ + voff[i_], (unsigned)(size_t)(lds + bo_ + KBYTES + (8 * wave + KP * i_) * RB)); } while (0)
    asm volatile("s_waitcnt vmcnt(0)" ::: "memory");
    FA_ISSUE(0);
    if (ntile > 1) FA_ISSUE(1);
#define FA_PVCORE(VB_) do { \
_Pragma("unroll") \
        for (int tt = 0; tt < NT; ++tt) { \
            const LAS char* vt = (VB_) + ((tt ^ z_) << 6); \
_Pragma("unroll") \
            for (int x = 0; x < 2; ++x) \
_Pragma("unroll") \
                for (int y = 0; y < 2; ++y) { \
                    const s16x4 lo = __builtin_amdgcn_ds_read_tr16_b64_v4i16((LAS s16x4*)(vt + (32 * x + 16 * y) * RB)); \
                    const s16x4 hi = __builtin_amdgcn_ds_read_tr16_b64_v4i16((LAS s16x4*)(vt + (32 * x + 16 * y + 8) * RB)); \
                    const bf16x8 vf = __builtin_shufflevector(lo, hi, 0, 1, 2, 3, 4, 5, 6, 7); \
                    O[tt] = MFMA32(vf, pfp[x][y], O[tt]); \
                } \
        } \
 \
    } while (0)
#define FA_EXPCORE() do { \
_Pragma("unroll") \
        for (int i = 0; i < 16; i += 2) { \
            const float a0 = __builtin_amdgcn_exp2f(s0[i]), a1 = __builtin_amdgcn_exp2f(s0[i + 1]); \
            const float b0 = __builtin_amdgcn_exp2f(s1[i]), b1 = __builtin_amdgcn_exp2f(s1[i + 1]); \
            ps += (a0 + a1) + (b0 + b1); \
            w[i >> 1] = pk2(a0, a1); w[8 + (i >> 1)] = pk2(b0, b1); \
        } \
    } while (0)
    for (int it = 0; it < ntile; ++it) {
        const int p0 = it < n1 ? 64 * it : base2 + 64 * (it - n1);
        if (it + 1 < ntile) { if (NVP == 2) asm volatile("s_waitcnt vmcnt(3)" ::: "memory"); else asm volatile("s_waitcnt vmcnt(2)" ::: "memory"); }
        else asm volatile("s_waitcnt vmcnt(0)" ::: "memory");
        __builtin_amdgcn_s_barrier();
        asm volatile("" ::: "memory");
        if (it + 2 < ntile) FA_ISSUE(it + 2);
        int bo = (it & 3) * STAGE;
        asm volatile("" : "+s"(bo));
        const LAS char* kb = lds + bo;
        const LAS char* vb = kb + KBYTES + vlane;
        f32x16 s0 = negm, s1 = negm;
#pragma unroll
        for (int s = 0; s < 4; ++s) {
            const int co = ((2 * s + h) ^ sw) << 4;
            const bf16x8 k0 = *(const LAS bf16x8*)(kb + ln * 128 + co);
            const bf16x8 k1 = *(const LAS bf16x8*)(kb + (32 + ln) * 128 + co);
            const bf16x8 qs = QLDS ? *(const LAS bf16x8*)(qb + s * 1024) : qf[s];
            s0 = MFMA32(k0, qs, s0); s1 = MFMA32(k1, qs, s1);
        }
        if (it >= n1) {
            const int d0 = (p0 - CTXL) - tq + 4 * h + 128;
#pragma unroll
            for (int i = 0; i < 16; ++i) {
                const int dd = d0 + (i & 3) + 8 * (i >> 2);
                s0[i] = ((unsigned)dd <= 256u) ? s0[i] : -1e30f;
                s1[i] = ((unsigned)(dd + 32) <= 256u) ? s1[i] : -1e30f;
            }
        }
        float ps = 0.f;
        unsigned w[16];
        __builtin_amdgcn_sched_barrier(0);
        if (it > 0) {
            int bp = ((it - 1) & 3) * STAGE;
            asm volatile("" : "+s"(bp));
            const LAS char* vbp = lds + bp + KBYTES + vlane;
            FA_PVCORE(vbp);
            FA_EXPCORE();
            __builtin_amdgcn_sched_group_barrier(0x100, PVA, 0);
#pragma unroll
            for (int g = 0; g < 4 * NT; ++g) { __builtin_amdgcn_sched_group_barrier(0x008, 1, 0); __builtin_amdgcn_sched_group_barrier(0x002, VPM, 0);
                if (g < 4 * NT - PVA / 2) __builtin_amdgcn_sched_group_barrier(0x100, 2, 0); }
        } else {
            FA_EXPCORE();
        }
        __builtin_amdgcn_sched_barrier(0);
        if (__any(!(ps <= 1048576.f))) {
            float mx;
            {
                float t0 = max2f(s0[0], s1[0]), t1 = max2f(s0[1], s1[1]), t2 = max2f(s0[2], s1[2]), t3 = max2f(s0[3], s1[3]);
#pragma unroll
                for (int i = 4; i < 16; i += 4) { t0 = max2f(t0, max2f(s0[i], s1[i])); t1 = max2f(t1, max2f(s0[i + 1], s1[i + 1])); t2 = max2f(t2, max2f(s0[i + 2], s1[i + 2])); t3 = max2f(t3, max2f(s0[i + 3], s1[i + 3])); }
                mx = max2f(max2f(t0, t1), max2f(t2, t3));
            }
            mx = max2f(mx, __shfl_xor(mx, 32));
            const float d = fmaxf(mx, 0.f), alpha = __builtin_amdgcn_exp2f(-d);
            m += d; l *= alpha;
#pragma unroll
            for (int i = 0; i < 16; ++i) negm[i] -= d;
#pragma unroll
            for (int tt = 0; tt < NT; ++tt)
#pragma unroll
                for (int i = 0; i < 16; ++i) O[tt][i] *= alpha;
            ps = 0.f;
#pragma unroll
            for (int i = 0; i < 16; i += 2) {
                const float a0 = __builtin_amdgcn_exp2f(s0[i] - d), a1 = __builtin_amdgcn_exp2f(s0[i + 1] - d);
                const float b0 = __builtin_amdgcn_exp2f(s1[i] - d), b1 = __builtin_amdgcn_exp2f(s1[i + 1] - d);
                ps += (a0 + a1) + (b0 + b1);
                w[i >> 1] = pk2(a0, a1); w[8 + (i >> 1)] = pk2(b0, b1);
            }
        }
#pragma unroll
        for (int x = 0; x < 2; ++x)
#pragma unroll
            for (int y = 0; y < 2; ++y) { u32x4 q; q.x = w[8 * x + 4 * y]; q.y = w[8 * x + 4 * y + 1]; q.z = w[8 * x + 4 * y + 2]; q.w = w[8 * x + 4 * y + 3];
                pfp[x][y] = __builtin_bit_cast(bf16x8, q); }
        l += ps;
    }
    { int bp = ((ntile - 1) & 3) * STAGE; asm volatile("" : "+s"(bp)); const LAS char* vbp = lds + bp + KBYTES + vlane; FA_PVCORE(vbp); }
    __builtin_amdgcn_s_barrier();
#undef FA_ISSUE
#undef FA_PVCORE
#undef FA_EXPCORE
#undef FA_DMA
    lout = l + __shfl_xor(l, 32);
}

constexpr int CTX_EARLY_LO = 96, CTX_EARLY_N = 32;
DI bool ctx_early(int nb) { return nb >= CTX_EARLY_LO + CTX_EARLY_N; }
DI void outproj_run(const Params& P, int l, int mode, int c, int nb, char* smem);
DI void phase_attn(const Params& P, int l, int bid, int nb, char* smem) {
    const int t = threadIdx.x, wave = t >> 6;
    const bf16_t* QB = (const bf16_t*)(P.ws + OFF_QB); const bf16_t* KB = (const bf16_t*)(P.ws + OFF_KB); const bf16_t* VT = (const bf16_t*)(P.ws + OFF_VT);
    bf16_t* MIX = (bf16_t*)(P.ws + OFF_HX);
    const float lambda_init = l == 0 ? 0.2f : (0.8f - 0.6f * expf(-0.3f));
    float d1 = P.lam_q1[l * 64 + (t & 63)] * P.lam_k1[l * 64 + (t & 63)], d2 = P.lam_q2[l * 64 + (t & 63)] * P.lam_k2[l * 64 + (t & 63)];
    d1 = wave_sum(d1); d2 = wave_sum(d2);
    const float lam = expf(d1) - expf(d2) + lambda_init;
    const bool has_ctx = l == 0 && bid < 96;
    const int nmain = (768 - bid + nb - 1) / nb;
    const bool rebal = l == 0 && nb == 256 && ctx_early(nb);
    const bool gives = rebal && (bid < 32 || (bid >= 96 && bid < 128)), takes = rebal && bid >= 128 && bid < 192;
    const int extra_c = bid >= 160 ? 512 + (bid - 160) : 512 + 96 + (bid - 128);
#pragma unroll 1
    for (int kk = 0; kk < nmain + (has_ctx ? 1 : 0) + (takes ? 1 : 0); ++kk) {
        int it = has_ctx ? (kk == 0 ? 768 + bid : bid + (kk - 1) * nb) : bid + kk * nb;
        if (takes && kk == nmain) it = extra_c;
        if (gives && it >= 512 && it < 768) continue;
        int ty, b, hd, p0q, ncx;
        bool isctx;
        if (it < 768) {
            ty = it >> 8; const int idx = it & 255, xcd = idx & 7, r = idx >> 3, stream = xcd * 4 + (r >> 3);
            b = stream >> 2; hd = stream & 3; p0q = CTXL + (r & 7) * 256; isctx = false; ncx = TPB / 64;
        } else {
            const int i2 = it - 768, t12 = i2 % 12;
            b = i2 / 12; p0q = 0; ty = t12 >> 2; hd = t12 & 3; isctx = true; ncx = CTXL / 64;
        }
        int lane = t & 63;
        asm volatile("" : "+v"(lane));
        const int h = lane >> 5, ln = lane & 31;
        const int p = p0q + wave * 32 + ln, tok = b * TPB + p, tq = p - CTXL;
        if (ty == 0) {
            f32x16 O[4]; float lt;
            const bf16_t* V = VT + (size_t)b * VS + (size_t)hd * TPB * 128;
            flash_run<128>(smem, QB + (((size_t)b * NQU + 2 * hd + 1) * TPB + p) * 64, KB + ((size_t)b * NKU + 2 * hd + 1) * TPB * 64, V, ncx, 0, 0, tq, -1e30f, 0.f, O, lt);
            {
                int l2_ = t & 63; asm volatile("" : "+v"(l2_)); const int h2 = l2_ >> 5; bf16_t* orow = MIX + (size_t)(b * TPB + p0q + wave * 32 + (l2_ & 31)) * DM + hd * 128 + 4 * h2;
                const float f = -lam / lt;
#pragma unroll
                for (int tt = 0; tt < 4; ++tt)
#pragma unroll
                    for (int g = 0; g < 4; ++g) { u32x2 o; o.x = pk2(O[tt][4 * g] * f, O[tt][4 * g + 1] * f); o.y = pk2(O[tt][4 * g + 2] * f, O[tt][4 * g + 3] * f);
                        *(u32x2*)(orow + 32 * tt + 8 * g) = o; }
            }
            flash_run<128>(smem, QB + (((size_t)b * NQU + 2 * hd) * TPB + p) * 64, KB + ((size_t)b * NKU + 2 * hd) * TPB * 64, V, ncx, 0, 0, tq, -1e30f, 0.f, O, lt);
            {
                int l2_ = t & 63; asm volatile("" : "+v"(l2_)); const int h2 = l2_ >> 5; bf16_t* orow = MIX + (size_t)(b * TPB + p0q + wave * 32 + (l2_ & 31)) * DM + hd * 128 + 4 * h2;
                const float f = 1.f / lt; float ss = 0.f;
#pragma unroll
                for (int tt = 0; tt < 4; ++tt)
#pragma unroll
                    for (int g = 0; g < 4; ++g) {
                        const u32x2 st = *(const u32x2*)(orow + 32 * tt + 8 * g);
                        O[tt][4 * g + 0] = O[tt][4 * g + 0] * f + __uint_as_float(st.x << 16);
                        O[tt][4 * g + 1] = O[tt][4 * g + 1] * f + __uint_as_float(st.x & 0xffff0000u);
                        O[tt][4 * g + 2] = O[tt][4 * g + 2] * f + __uint_as_float(st.y << 16);
                        O[tt][4 * g + 3] = O[tt][4 * g + 3] * f + __uint_as_float(st.y & 0xffff0000u);
                        ss += (O[tt][4 * g] * O[tt][4 * g] + O[tt][4 * g + 1] * O[tt][4 * g + 1]) + (O[tt][4 * g + 2] * O[tt][4 * g + 2] + O[tt][4 * g + 3] * O[tt][4 * g + 3]);
                    }
                ss += __shfl_xor(ss, 32);
                const float r = rsqrtf(ss * (1.f / 128.f) + RMS_EPS) * (1.f - lambda_init);
                const float* sg = P.subln_g + l * 128 + 4 * h2;
#pragma unroll
                for (int tt = 0; tt < 4; ++tt)
#pragma unroll
                    for (int g = 0; g < 4; ++g) { const f32x4 gg = *(const f32x4*)(sg + 32 * tt + 8 * g);
                        u32x2 o; o.x = pk2(O[tt][4 * g] * r * gg.x, O[tt][4 * g + 1] * r * gg.y); o.y = pk2(O[tt][4 * g + 2] * r * gg.z, O[tt][4 * g + 3] * r * gg.w);
                        *(u32x2*)(orow + 32 * tt + 8 * g) = o; }
            }
        } else {
            const bool isC = ty == 2;
            f32x16 O[2]; float lt;
            const int qu = (isC ? 12 : 8) + hd, ku = (isC ? 10 : 8) + (hd >> 1);
            const bf16_t* V = VT + (size_t)b * VS + (size_t)4 * TPB * 128 + (size_t)((isC ? 2 : 0) + (hd >> 1)) * TPB * 64;
            int n1 = ncx, base2 = 0, n2 = 0;
            float m0 = -1e30f, l0 = 0.f;
            if (isC) {
                m0 = P.sink[l * 4 + hd] * 1.4426950408889634f; l0 = h == 0 ? 1.f : 0.f;
                if (!isctx) { const int n = (p0q - CTXL) >> 8; n1 = CTXL / 64; const int jlo = n == 0 ? 2 : 0, jhi = n == 7 ? 6 : 8;
                    base2 = CTXL + 256 * n - 128 + 64 * jlo; n2 = jhi - jlo; }
            }
            flash_run<64>(smem, QB + (((size_t)b * NQU + qu) * TPB + p) * 64, KB + ((size_t)b * NKU + ku) * TPB * 64, V, n1, base2, n2, tq, m0, l0, O, lt);
            const float f = 1.f / lt;
            int l2_ = t & 63; asm volatile("" : "+v"(l2_)); const int h2 = l2_ >> 5; bf16_t* orow = MIX + (size_t)(b * TPB + p0q + wave * 32 + (l2_ & 31)) * DM + (isC ? 768 : 512) + hd * 64 + 4 * h2;
#pragma unroll
            for (int tt = 0; tt < 2; ++tt)
#pragma unroll
                for (int g = 0; g < 4; ++g) { u32x2 o; o.x = pk2(O[tt][4 * g] * f, O[tt][4 * g + 1] * f); o.y = pk2(O[tt][4 * g + 2] * f, O[tt][4 * g + 3] * f);
                    *(u32x2*)(orow + 32 * tt + 8 * g) = o; }
        }
        if (it >= 768) {
            asm volatile("s_waitcnt vmcnt(0)" ::: "memory");
            __syncthreads();
            if (t == 0) { __builtin_amdgcn_fence(__ATOMIC_RELEASE, "agent"); asm volatile("s_waitcnt vmcnt(0)" ::: "memory");
                __hip_atomic_fetch_add((int*)(P.ws + OFF_RDYC) + ((it - 768) / 12) * 64, 1, __ATOMIC_RELAXED, __HIP_MEMORY_SCOPE_AGENT); }
        }
    }
    if (l == 0 && ctx_early(nb) && bid >= CTX_EARLY_LO && bid < CTX_EARLY_LO + CTX_EARLY_N) outproj_run(P, 0, 2, bid - CTX_EARLY_LO, nb, smem);
}

DI void phase_norm2_route(const Params& P, int l, int bid, int nb, char* smem) {
    const int t = threadIdx.x, lane = t & 63, wave = t >> 6;
    int* lcnt = (int*)(smem + LDS_MISC);
    int* lbase = lcnt + 16;
    int* rec = lcnt + 32;
    int* rec2 = rec + 160;
    __syncthreads();
    {
        int ts = t;
        asm volatile("" : "+v"(ts));
        f32x4 wv[4096 / NTHREADS];
#pragma unroll
        for (int i = 0; i < 4096 / NTHREADS; ++i) { const int idx = ts + NTHREADS * i; wv[i] = *(const f32x4*)(P.w_router + (idx >> 2) * 16 + (idx & 3) * 4); }
#pragma unroll
        for (int i = 0; i < 4096 / NTHREADS; ++i) { const int idx = ts + NTHREADS * i, k = idx >> 2, q = idx & 3;
            const int row = ((k >> 8) * 4 + (k & 3)) * 64 + ((k >> 2) & 63);
            *(f32x4*)(smem + row * 64 + ((q ^ ((row >> 2) & 3)) << 4)) = wv[i]; }
    }
    if (t < 16) lcnt[t] = 0;
    __syncthreads();
    bf16_t* HX = (bf16_t*)(P.ws + OFF_HX);
    int* cnt = (int*)(P.ws + OFF_CNT) + l * 16 * 64;
    int* list = (int*)(P.ws + OFF_LIST);
    float* tokw = (float*)(P.ws + OFF_TOKW);
    const int per = (NTOK + nb - 1) / nb;
    const int tk0 = bid * per, tk1 = min(NTOK, tk0 + per), ntk = tk1 - tk0;
    const int eme = ((lane >> 5) & 1) * 8 + ((lane >> 4) & 1) * 4 + ((lane >> 3) & 1) * 2 + ((lane >> 2) & 1);
    const float mybias = P.router_bias[eme];
    f32x4 v[4], vn[4], gs[4], hs[4];
    int cur_mr = -1;
    if (wave < ntk) { const int tok = tk0 + wave, b = tok / TPB, p = tok % TPB; const f32x4* xr = (const f32x4*)resid_row(P, b, p) + lane;
#pragma unroll
        for (int j = 0; j < 4; ++j) vn[j] = xr[64 * j]; }
    for (int i = wave; i < ntk; i += NW) {
        const int tok = tk0 + i;
        const int b = tok / TPB, p = tok % TPB, mr = p < CTXL ? 8 : b;
#pragma unroll
        for (int j = 0; j < 4; ++j) v[j] = vn[j];
        if (i + NW < ntk) { const int tk2 = tok + NW, b2 = tk2 / TPB, p2 = tk2 % TPB; const f32x4* xr = (const f32x4*)resid_row(P, b2, p2) + lane;
#pragma unroll
            for (int j = 0; j < 4; ++j) vn[j] = xr[64 * j]; }
        if (l == 1 && p < CTXL) { if (lane == 0) rec[i] = -1; continue; }
        float ss = 0.f;
#pragma unroll
        for (int j = 0; j < 4; ++j) ss += (v[j].x * v[j].x + v[j].y * v[j].y) + (v[j].z * v[j].z + v[j].w * v[j].w);
        const float r = rsqrtf(wave_sum(ss) * (1.f / DM) + RMS_EPS);
        if (mr != cur_mr) {
            const float* md = mod_row(P, l, mr);
            const f32x4* gn = (const f32x4*)(P.norm2_g + l * DM) + lane;
            const f32x4* sh = (const f32x4*)(md + 3072) + lane;
            const f32x4* sc = (const f32x4*)(md + 4096) + lane;
#pragma unroll
            for (int j = 0; j < 4; ++j) { const f32x4 g = gn[64 * j], s1 = sc[64 * j]; gs[j] = g * (1.f + s1); hs[j] = sh[64 * j]; }
            cur_mr = mr;
        }
        u32x2* o = (u32x2*)(HX + (size_t)tok * DM) + lane;
        float lg[16];
#pragma unroll
        for (int e = 0; e < 16; ++e) lg[e] = 0.f;
#pragma unroll
        for (int j = 0; j < 4; ++j) {
            float y[4];
            y[0] = v[j].x * r * gs[j].x + hs[j].x; y[1] = v[j].y * r * gs[j].y + hs[j].y;
            y[2] = v[j].z * r * gs[j].z + hs[j].z; y[3] = v[j].w * r * gs[j].w + hs[j].w;
            u32x2 w; w.x = pk2(y[0], y[1]); w.y = pk2(y[2], y[3]);
            o[64 * j] = w;
#pragma unroll
            for (int cc = 0; cc < 4; ++cc) {
                const int row = (j * 4 + cc) * 64 + lane;
#pragma unroll
                for (int q = 0; q < 4; ++q) {
                    const f32x4 wv = *(const f32x4*)(smem + row * 64 + ((q ^ ((row >> 2) & 3)) << 4));
                    lg[4 * q + 0] += y[cc] * wv.x; lg[4 * q + 1] += y[cc] * wv.y; lg[4 * q + 2] += y[cc] * wv.z; lg[4 * q + 3] += y[cc] * wv.w;
                }
            }
        }
        float a8[8], a4[4], a2[2], a1;
        { const bool hi = lane & 32;
#pragma unroll
          for (int j = 0; j < 8; ++j) { const float keep = hi ? lg[8 + j] : lg[j], send = hi ? lg[j] : lg[8 + j]; a8[j] = keep + __shfl_xor(send, 32); } }
        { const bool hi = lane & 16;
#pragma unroll
          for (int j = 0; j < 4; ++j) { const float keep = hi ? a8[4 + j] : a8[j], send = hi ? a8[j] : a8[4 + j]; a4[j] = keep + __shfl_xor(send, 16); } }
        { const bool hi = lane & 8;
#pragma unroll
          for (int j = 0; j < 2; ++j) { const float keep = hi ? a4[2 + j] : a4[j], send = hi ? a4[j] : a4[2 + j]; a2[j] = keep + __shfl_xor(send, 8); } }
        { const bool hi = lane & 4; const float keep = hi ? a2[1] : a2[0], send = hi ? a2[0] : a2[1]; a1 = keep + __shfl_xor(send, 4); }
        a1 += __shfl_xor(a1, 2); a1 += __shfl_xor(a1, 1);
        const float mysc = 1.f / (1.f + expf(-a1)), mysel = mysc + mybias;
        float scv[16], sel[16];
#pragma unroll
        for (int e = 0; e < 16; ++e) { const int src = ((e >> 3) & 1) * 32 + ((e >> 2) & 1) * 16 + ((e >> 1) & 1) * 8 + (e & 1) * 4;
            scv[e] = __int_as_float(__builtin_amdgcn_readlane(__float_as_int(mysc), src)); sel[e] = __int_as_float(__builtin_amdgcn_readlane(__float_as_int(mysel), src)); }
        float bestg = -1e30f; int be1 = 0, be2 = 1; float bw1 = 0.f, bw2 = 0.f;
#pragma unroll
        for (int g = 0; g < 4; ++g) {
            int i1 = 0; float v1 = sel[4 * g], w1 = scv[4 * g];
#pragma unroll
            for (int j = 1; j < 4; ++j) if (sel[4 * g + j] > v1) { v1 = sel[4 * g + j]; w1 = scv[4 * g + j]; i1 = j; }
            int i2 = -1; float v2 = -1e30f, w2 = 0.f;
#pragma unroll
            for (int j = 0; j < 4; ++j) if (j != i1 && sel[4 * g + j] > v2) { v2 = sel[4 * g + j]; w2 = scv[4 * g + j]; i2 = j; }
            const float gs = v1 + v2;
            if (gs > bestg) { bestg = gs; be1 = 4 * g + i1; be2 = 4 * g + i2; bw1 = w1; bw2 = w2; }
        }
        if (lane == 0) {
            const float inv = 1.f / (bw1 + bw2);
            const int r1 = atomicAdd(&lcnt[be1], 1), r2 = atomicAdd(&lcnt[be2], 1);
            rec[i] = be1 | (be2 << 8) | (r1 << 16); rec2[i] = r2;
            tokw[2 * tok] = bw1 * inv; tokw[2 * tok + 1] = bw2 * inv;
        }
    }
    __syncthreads();
    if (t < 16) { const int c = lcnt[t]; lbase[t] = c ? atomicAdd(&cnt[t * 64], c) : 0; }
    __syncthreads();
    for (int i = t; i < ntk; i += NTHREADS) {
        const int rc = rec[i];
        if (rc >= 0) { const int e1 = rc & 255, e2 = (rc >> 8) & 255, r1 = rc >> 16, r2 = rec2[i], tok = tk0 + i;
            list[e1 * NTOK + lbase[e1] + r1] = 2 * tok; list[e2 * NTOK + lbase[e2] + r2] = 2 * tok + 1; }
    }
}

struct SchedOut {
    const bf16_t *A, *Wt; int G, c, mode;
    int* rdyc;
    static constexpr bool GATHER = false;
    DI void a_ready(const g8::Unit& u) const {
        if (mode != 2) return;
        if (__builtin_amdgcn_readfirstlane(threadIdx.x >> 6) == 0) {
            unsigned sp = 0;
            while (__hip_atomic_load(rdyc + (u.a / 9) * 64, __ATOMIC_RELAXED, __HIP_MEMORY_SCOPE_AGENT) < 12) { __builtin_amdgcn_s_sleep(2); if (++sp > (1u << 22)) break; }
            __builtin_amdgcn_fence(__ATOMIC_ACQUIRE, "agent");
            asm volatile("s_waitcnt vmcnt(0)" ::: "memory");
        }
        __builtin_amdgcn_s_barrier();
    }
    DI bool next(int i, g8::Unit& u) const {
        int pm, pn;
        if (mode == 2) { if (i != 0) return false; pm = 9 * (c >> 2); pn = c & 3; }
        else { if (!g8::static_unit(i, G, c, mode == 0 ? 72 : 64, 4, pm, pn)) return false; if (mode == 1) pm = 9 * (pm >> 3) + 1 + (pm & 7); }
        u.a = pm; u.b = pn; u.c = 0; u.d = 0; u.bt = Wt + (size_t)pn * 256 * DM; return true; }
    DI const bf16_t* a_base(const g8::Unit& u) const { return A + (size_t)u.a * 256 * DM; }
};
struct EpiOut {
    const float *x, *ctx; float *out, *xc; const float* mod; int l;
    DI void operator()(const f32x4 (&acc)[2][2][4][2], const g8::Unit& u, int wr, int wc, int fr, int fq) const {
        const int tok0 = u.a * 256, b = tok0 / TPB, p0 = tok0 % TPB;
        const bool isctx = p0 == 0;
        const float* g1 = mod + (size_t)(l * 9 + (isctx ? 8 : b)) * 6144 + 2048 + u.b * 256 + 32 * wc + 4 * fq;
        f32x4 g4[2][2];
#pragma unroll
        for (int bj = 0; bj < 2; ++bj)
#pragma unroll
            for (int n = 0; n < 2; ++n) g4[bj][n] = *(const f32x4*)(g1 + 128 * bj + 16 * n);
        const int cb = u.b * 256 + 32 * wc + 4 * fq;
#pragma unroll
        for (int ai = 0; ai < 2; ++ai)
#pragma unroll
            for (int m = 0; m < 4; ++m) {
                const int r = 128 * ai + 64 * wr + 16 * m + fr;
                const size_t ro = isctx ? (size_t)(b * CTXL + r) * DM : (size_t)(b * SEQ + p0 - CTXL + r) * DM;
                const float* xin = (l == 0 ? (isctx ? ctx : x) : (isctx ? xc : out)) + ro + cb;
                float* xo = (isctx ? xc : out) + ro + cb;
#pragma unroll
                for (int bj = 0; bj < 2; ++bj)
#pragma unroll
                    for (int n = 0; n < 2; ++n) { const f32x4 xv = *(const f32x4*)(xin + 128 * bj + 16 * n); *(f32x4*)(xo + 128 * bj + 16 * n) = xv + g4[bj][n] * acc[ai][bj][m][n]; }
                if (m & 1) asm volatile("" ::: "memory");
            }
    }
};
DI void outproj_run(const Params& P, int l, int mode, int c, int nb, char* smem) {
    SchedOut S{(const bf16_t*)(P.ws + OFF_HX), (const bf16_t*)(P.ws + OFF_WOUT) + (size_t)l * DM * DM, nb, c, mode, (int*)(P.ws + OFF_RDYC)};
    EpiOut E{P.x, P.ctx, P.out, (float*)(P.ws + OFF_XC), (const float*)(P.ws + OFF_MOD), l};
    g8::gemm_phase(smem, (const bf16_t*)(P.ws + OFF_HX), DM, S, E);
}
DI void phase_outproj(const Params& P, int l, int bid, int nb, char* smem) {
    outproj_run(P, l, (l == 1 || ctx_early(nb)) ? 1 : 0, bid, nb, smem);
}

constexpr int MAX_RT = 2 * NTOK / 256 + NEXP;
DI void build_tile_table(const int* cnt, char* smem) {
    int* cl = (int*)(smem + LDS_MISC);
    int* tab = cl + 16;
    const int t = threadIdx.x;
    __syncthreads();
    if (t < NEXP) cl[t] = cnt[t * 64];
    __syncthreads();
    if (t < MAX_RT) {
        int acc = 0, e = 0, ti = 0, n = 0, ok = 0;
#pragma unroll
        for (int i = 0; i < NEXP; ++i) { const int c = cl[i], nt = (c + 255) >> 8; const bool hit = !ok && t < acc + nt;
            e = hit ? i : e; ti = hit ? t - acc : ti; n = hit ? c : n; ok = hit ? 1 : ok; acc += nt; }
        tab[4 * t] = e; tab[4 * t + 1] = ti; tab[4 * t + 2] = n; tab[4 * t + 3] = ok;
    }
    __syncthreads();
}
DI bool expert_tile(const char* smem, int rt, int& e, int& ti, int& hbase, int& n) {
    if (rt >= MAX_RT) return false;
    const int* tab = (const int*)(smem + LDS_MISC) + 16 + 4 * rt;
    e = __builtin_amdgcn_readfirstlane(tab[0]); ti = __builtin_amdgcn_readfirstlane(tab[1]); n = __builtin_amdgcn_readfirstlane(tab[2]); hbase = rt * 256;
    return __builtin_amdgcn_readfirstlane(tab[3]) != 0;
}

struct SchedGU {
    const bf16_t* W; const char* tabs; const int* list; int G, c;
    static constexpr bool GATHER = true;
    DI void a_ready(const g8::Unit&) const {}
    DI bool next(int i, g8::Unit& u) const { const int w = i * G + c, rt = w >> 1, ct = w & 1; int e, ti, hb, n; if (!expert_tile(tabs, rt, e, ti, hb, n)) return false;
        u.a = e; u.b = ti | (ct << 16); u.c = hb; u.d = n; u.bt = W + ((size_t)e * 512 + ct * 256) * DM; return true; }
    DI void a_offsets(const g8::Unit& u, const int (&R)[2], const int (&C)[2], unsigned (&av)[2][2]) const {
        const int ti = u.b & 0xffff;
#pragma unroll
        for (int hh = 0; hh < 2; ++hh)
#pragma unroll
            for (int i = 0; i < 2; ++i) { const int li = ti * 256 + 128 * hh + R[i]; const int slot = li < u.d ? list[u.a * NTOK + li] : 0;
                av[hh][i] = (unsigned)((slot >> 1) * DM + C[i]) * 2u; }
    }
};
struct EpiGU {
    bf16_t* HB;
    DI void operator()(const f32x4 (&acc)[2][2][4][2], const g8::Unit& u, int wr, int wc, int fr, int fq) const {
        const int ct = u.b >> 16;
        bf16_t* hb = HB + (size_t)(u.c + 64 * wr + fr) * DEXP + 128 * ct + 32 * wc + 4 * fq;
#pragma unroll
        for (int ai = 0; ai < 2; ++ai)
#pragma unroll
            for (int m = 0; m < 4; ++m)
#pragma unroll
                for (int n = 0; n < 2; ++n) {
                    const f32x4 g = acc[ai][0][m][n], uu = acc[ai][1][m][n];
                    f32x4 hv;
                    hv.x = g.x / (1.f + __expf(-g.x)) * uu.x; hv.y = g.y / (1.f + __expf(-g.y)) * uu.y; hv.z = g.z / (1.f + __expf(-g.z)) * uu.z; hv.w = g.w / (1.f + __expf(-g.w)) * uu.w;
                    u32x2 o; o.x = pk2(hv.x, hv.y); o.y = pk2(hv.z, hv.w);
                    *(u32x2*)(hb + (size_t)(128 * ai + 16 * m) * DEXP + 16 * n) = o;
                }
    }
};
DI void phase_gateup(const Params& P, int l, int bid, int nb, char* smem) {
    build_tile_table((const int*)(P.ws + OFF_CNT) + l * 16 * 64, smem);
    SchedGU S{(const bf16_t*)(P.ws + OFF_WGU) + (size_t)l * 16 * 512 * DM, smem, (const int*)(P.ws + OFF_LIST), nb, bid};
    EpiGU E{(bf16_t*)(P.ws + OFF_HB)};
    g8::gemm_phase(smem, (const bf16_t*)(P.ws + OFF_HX), DM, S, E);
}

struct SchedDown {
    const bf16_t *A, *W; const char* tabs; int G, c;
    static constexpr bool GATHER = false;
    DI void a_ready(const g8::Unit&) const {}
    DI bool next(int i, g8::Unit& u) const { const int w = i * G + c, rt = w >> 2, ct = w & 3; int e, ti, hb, n; if (!expert_tile(tabs, rt, e, ti, hb, n)) return false;
        u.a = e; u.b = ti | (ct << 16); u.c = hb; u.d = n; u.bt = W + ((size_t)e * DM + ct * 256) * DEXP; return true; }
    DI const bf16_t* a_base(const g8::Unit& u) const { return A + (size_t)u.c * DEXP; }
};
struct EpiDown {
    bf16_t* Y; const int* list; const float* tokw;
    DI void operator()(const f32x4 (&acc)[2][2][4][2], const g8::Unit& u, int wr, int wc, int fr, int fq) const {
        const int ti = u.b & 0xffff, ct = u.b >> 16;
#pragma unroll
        for (int ai = 0; ai < 2; ++ai)
#pragma unroll
            for (int m = 0; m < 4; ++m) {
                const int li = ti * 256 + 128 * ai + 64 * wr + 16 * m + fr;
                if (li < u.d) {
                    const int slot = list[u.a * NTOK + li]; const float wg = tokw[slot];
                    bf16_t* yr = Y + (size_t)slot * DM + 256 * ct + 32 * wc + 4 * fq;
#pragma unroll
                    for (int bj = 0; bj < 2; ++bj)
#pragma unroll
                        for (int n = 0; n < 2; ++n) { const f32x4 v = acc[ai][bj][m][n]; u32x2 o; o.x = pk2(wg * v.x, wg * v.y); o.y = pk2(wg * v.z, wg * v.w);
                            *(u32x2*)(yr + 128 * bj + 16 * n) = o; }
                }
            }
    }
};
DI void phase_down(const Params& P, int l, int bid, int nb, char* smem) {
    build_tile_table((const int*)(P.ws + OFF_CNT) + l * 16 * 64, smem);
    SchedDown S{(const bf16_t*)(P.ws + OFF_HB), (const bf16_t*)(P.ws + OFF_WD) + (size_t)l * 16 * DM * DEXP, smem, nb, bid};
    EpiDown E{(bf16_t*)(P.ws + OFF_Y), (const int*)(P.ws + OFF_LIST), (const float*)(P.ws + OFF_TOKW)};
    g8::gemm_phase(smem, (const bf16_t*)(P.ws + OFF_HB), DEXP, S, E);
}

#define XB_TMO      128
#define XB_XCNT(j)  (256  + 64 * (j))
#define XB_XSUB(j)  (1280 + 64 * (j))
#define XB_XGEN(j)  (2304 + 64 * (j))
#define XB_TOP      3328
#define XB_TOPGEN   3392
#define XCD_BAR_WORDS 3456
#define XB_SPIN_CAP (1u << 20)
DI unsigned xb_ld(unsigned* p)              { return __hip_atomic_load(p, __ATOMIC_RELAXED, __HIP_MEMORY_SCOPE_AGENT); }
DI unsigned xb_add(unsigned* p, unsigned v) { return __hip_atomic_fetch_add(p, v, __ATOMIC_RELAXED, __HIP_MEMORY_SCOPE_AGENT); }
DI unsigned xb_xcc_id() { return (unsigned)__builtin_amdgcn_s_getreg((3 << 11) | 20) & 0xFu; }
#define XB_SPIN(cond, bar) do { unsigned _sp = 0; while (cond) { __builtin_amdgcn_s_sleep(1); \
    if ((++_sp & 255u) == 0u) { if (xb_ld(&(bar)[XB_TMO])) break; if (_sp > XB_SPIN_CAP) { atomicAdd(&(bar)[XB_TMO], 1u); break; } } } } while (0)
struct XcdBarrier { unsigned* bar; unsigned x; volatile LAS unsigned* st; };
DI XcdBarrier xcd_barrier_post(unsigned* bar, volatile LAS unsigned* st) {
    XcdBarrier b; b.bar = bar; b.x = xb_xcc_id(); b.st = st;
    if (threadIdx.x == 0) (void)xb_add(&bar[XB_XCNT(b.x)], 1u);
    return b;
}
DI void xcd_barrier_complete(unsigned* bar, unsigned x, unsigned& nloc, unsigned& nx) {
    const unsigned G = gridDim.x * gridDim.y * gridDim.z;
    unsigned sum, cnt, mine, sp = 0u;
    for (;;) {
        sum = 0u; cnt = 0u; mine = 0u;
#pragma unroll
        for (unsigned j = 0; j < 16; ++j) { const unsigned c = xb_ld(&bar[XB_XCNT(j)]); sum += c; cnt += (c > 0u) ? 1u : 0u; mine = (j == x) ? c : mine; }
        if (sum == G) break;
        __builtin_amdgcn_s_sleep(1);
        if ((++sp & 255u) == 0u) { if (xb_ld(&bar[XB_TMO])) break; if (sp > XB_SPIN_CAP) { atomicAdd(&bar[XB_TMO], 1u); break; } }
    }
    nloc = mine > 0u ? mine : 1u; nx = cnt > 0u ? cnt : 1u;
}
DI void xcd_barrier(const XcdBarrier& b) {
    asm volatile("s_waitcnt vmcnt(0)" ::: "memory");
    __syncthreads();
    if (threadIdx.x == 0) {
        unsigned* bar = b.bar;
        __builtin_amdgcn_s_waitcnt(0);
        unsigned nloc = b.st[0], nx = b.st[1];
        if (nloc == 0u) { xcd_barrier_complete(bar, b.x, nloc, nx); b.st[0] = nloc; b.st[1] = nx; }
        const unsigned old = xb_add(&bar[XB_XSUB(b.x)], 1u);
        const unsigned gen = old / nloc;
        if (old + 1u == (gen + 1u) * nloc) {
            __builtin_amdgcn_fence(__ATOMIC_RELEASE, "agent");
            asm volatile("s_waitcnt vmcnt(0)" ::: "memory");
            const unsigned og = xb_add(&bar[XB_TOP], 1u);
            const unsigned tg = og / nx;
            if (og + 1u == (tg + 1u) * nx) xb_add(&bar[XB_TOPGEN], 1u);
            else XB_SPIN(xb_ld(&bar[XB_TOPGEN]) == tg, bar);
            __builtin_amdgcn_fence(__ATOMIC_ACQUIRE, "agent");
            xb_add(&bar[XB_XGEN(b.x)], 1u);
            asm volatile("s_waitcnt vmcnt(0)" ::: "memory");
        } else {
            XB_SPIN(xb_ld(&bar[XB_XGEN(b.x)]) == gen, bar);
            __builtin_amdgcn_fence(__ATOMIC_ACQUIRE, "agent");
            asm volatile("s_waitcnt vmcnt(0)" ::: "memory");
        }
    }
    __syncthreads();
}

constexpr int NPHASES = 16;
__global__ void __launch_bounds__(NTHREADS, 2) mk_fwd(Params P, int ph_lo, int ph_hi) {
    extern __shared__ __attribute__((aligned(16))) char smem[];
    const int bid = blockIdx.x, nb = gridDim.x;
    volatile LAS unsigned* xst = (volatile LAS unsigned*)(LAS char*)(smem + LDS_MAIN);
    if (threadIdx.x == 0) { xst[0] = 0u; xst[1] = 0u; }
    __syncthreads();
    XcdBarrier gbar; gbar.bar = (unsigned*)(P.ws + OFF_CTL); gbar.x = 0; gbar.st = xst;
    if (ph_hi - ph_lo > 1) gbar = xcd_barrier_post((unsigned*)(P.ws + OFF_CTL), xst);
#ifndef REPEAT_K
#define REPEAT_K -1
#endif
#ifndef REPEAT_N
#define REPEAT_N 1
#endif
#ifndef EXTRA_SYNCS
#define EXTRA_SYNCS 0
#endif
#define RUN(k, call) if (ph_lo <= (k) && (k) < ph_hi) { if ((k) == REPEAT_K) { for (int rep_ = 0; rep_ < REPEAT_N; ++rep_) { call; xcd_barrier(gbar); } } call; if ((k) + 1 < ph_hi) xcd_barrier(gbar); }
    for (int es_ = 0; es_ < EXTRA_SYNCS; ++es_) xcd_barrier(gbar);
    RUN(0, phase_prologue(P, bid, nb, smem))
    RUN(1, phase_norm1(P, 0, bid, nb))
    RUN(2, phase_qkv(P, 0, bid, nb, smem))
    RUN(3, phase_attn(P, 0, bid, nb, smem))
    RUN(4, phase_outproj(P, 0, bid, nb, smem))
    RUN(5, phase_norm2_route(P, 0, bid, nb, smem))
    RUN(6, phase_gateup(P, 0, bid, nb, smem))
    RUN(7, phase_down(P, 0, bid, nb, smem))
    RUN(8, phase_norm1(P, 1, bid, nb))
    RUN(9, phase_qkv(P, 1, bid, nb, smem))
    RUN(10, phase_attn(P, 1, bid, nb, smem))
    RUN(11, phase_outproj(P, 1, bid, nb, smem))
    RUN(12, phase_norm2_route(P, 1, bid, nb, smem))
    RUN(13, phase_gateup(P, 1, bid, nb, smem))
    RUN(14, phase_down(P, 1, bid, nb, smem))
    RUN(15, phase_final(P, bid, nb))
#undef RUN
}

extern "C" void kernel_launch(void* const* d_in, const int* in_sizes, int n_in, void* d_out, int out_size, void* d_ws, size_t ws_size, hipStream_t stream) {
    Params p{};
    const float** f = (const float**)&p;
    for (int i = 0; i < 24; ++i) f[i] = (const float*)d_in[i];
    p.out = (float*)d_out; p.ws = (unsigned char*)d_ws;
    if (ws_size < WS_END) { fprintf(stderr, "workspace too small: %zu < %zu\n", ws_size, (size_t)WS_END); return; }
#ifndef MULTI_LAUNCH
#define MULTI_LAUNCH 0
#endif
#if MULTI_LAUNCH
    (void)hipFuncSetAttribute((const void*)mk_fwd, hipFuncAttributeMaxDynamicSharedMemorySize, LDS_BYTES);
    (void)hipMemsetAsync((char*)d_ws + OFF_CTL, 0, CTL_BYTES, stream);
    for (int ph = 0; ph < NPHASES; ++ph) hipLaunchKernelGGL(mk_fwd, dim3(256), dim3(NTHREADS), LDS_BYTES, stream, p, ph, ph + 1);
#else
    static int grid_blocks = 0;
    if (!grid_blocks) {
        int dev = 0, cus = 0, per_cu = 0;
        (void)hipGetDevice(&dev);
        (void)hipDeviceGetAttribute(&cus, hipDeviceAttributeMultiprocessorCount, dev);
        (void)hipFuncSetAttribute((const void*)mk_fwd, hipFuncAttributeMaxDynamicSharedMemorySize, LDS_BYTES);
        (void)hipOccupancyMaxActiveBlocksPerMultiprocessor(&per_cu, mk_fwd, NTHREADS, LDS_BYTES);
        if (per_cu > 1) per_cu = 1;
        grid_blocks = cus * per_cu;
        if (grid_blocks <= 0) { fprintf(stderr, "occupancy query failed (%d x %d)\n", cus, per_cu); grid_blocks = 0; return; }
    }
    (void)hipMemsetAsync((char*)d_ws + OFF_CTL, 0, CTL_BYTES, stream);
    hipLaunchKernelGGL(mk_fwd, dim3(grid_blocks), dim3(NTHREADS), LDS_BYTES, stream, p, 0, NPHASES);
    hipError_t e = hipPeekAtLastError();
    if (e != hipSuccess) fprintf(stderr, "launch failed: %s (grid %d)\n", hipGetErrorString(e), grid_blocks);
#endif
}
```

```cpp
#include <hip/hip_runtime.h>
#include <stdint.h>
#include <stdio.h>


#define DI __device__ __forceinline__
#define LAS __attribute__((address_space(3)))
typedef unsigned short bf16_t;
typedef short bf16x8 __attribute__((ext_vector_type(8)));
typedef float f32x16 __attribute__((ext_vector_type(16)));
typedef float f32x4 __attribute__((ext_vector_type(4)));
typedef float f32x2 __attribute__((ext_vector_type(2)));
typedef unsigned u32x4 __attribute__((ext_vector_type(4)));
typedef unsigned u32x2 __attribute__((ext_vector_type(2)));
typedef short s16x4 __attribute__((ext_vector_type(4)));

constexpr int NB = 8, SEQ = 2048, CTXL = 256, TPB = SEQ + CTXL  , NTOK = NB * TPB  ;
constexpr int DM = 1024, INC = 2560, NEXP = 16, DEXP = 256;
constexpr int NQU = 16, NKU = 12, NVR = 768;
constexpr size_t VS = (size_t)NVR * TPB;
constexpr int NTHREADS = 512, NW = NTHREADS / 64;
constexpr int LDS_MAIN = 131072, LDS_MISC = LDS_MAIN + 64, LDS_BYTES = LDS_MISC + 16384;
constexpr float RMS_EPS = 1e-6f;
constexpr float QSCALE = 0.125f * 1.4426950408889634f;

constexpr size_t OFF_CTL  = 0;
constexpr size_t OFF_CNT  = 14336, OFF_RDYC = OFF_CNT + 8192, OFF_XCNT = 24576, CTL_BYTES = OFF_XCNT + 2 * 72 * 256;
constexpr size_t OFF_MOD  = CTL_BYTES;
constexpr size_t OFF_ROPE = OFF_MOD + (size_t)2 * 9 * 6144 * 4;
constexpr size_t OFF_WIN  = OFF_ROPE + 16384;
constexpr size_t OFF_WOUT = OFF_WIN + (size_t)2 * 2560 * 1024 * 2;
constexpr size_t OFF_WGU  = OFF_WOUT + (size_t)2 * 1024 * 1024 * 2;
constexpr size_t OFF_WD   = OFF_WGU + (size_t)2 * 16 * 512 * 1024 * 2;
constexpr size_t OFF_HX   = OFF_WD + (size_t)2 * 16 * 1024 * 256 * 2;
constexpr size_t OFF_QB   = OFF_HX + (size_t)NTOK * DM * 2;
constexpr size_t OFF_KB   = OFF_QB + (size_t)NB * NQU * TPB * 64 * 2;
constexpr size_t OFF_VT   = OFF_KB + (size_t)NB * NKU * TPB * 64 * 2;
constexpr size_t OFF_Y    = OFF_QB;
constexpr size_t OFF_XC   = OFF_VT + (size_t)NB * NVR * TPB * 2;
constexpr size_t HB_ROWS  = 2 * NTOK + NEXP * 256;
constexpr size_t OFF_HB   = OFF_XC + (size_t)NB * CTXL * DM * 4;
constexpr size_t OFF_LIST = OFF_HB + HB_ROWS * DEXP * 2;
constexpr size_t OFF_TOKW = OFF_LIST + (size_t)NEXP * NTOK * 4;
constexpr size_t OFF_XCH  = OFF_TOKW + (size_t)2 * NTOK * 4;
constexpr size_t OFF_QE   = OFF_ROPE + 12288;
constexpr size_t WS_END   = OFF_XCH + (size_t)72 * 4 * 256 * 17 * 4;
static_assert(WS_END <= (size_t)256 * 1024 * 1024, "workspace");
static_assert((size_t)2 * NTOK * DM * 2 <= OFF_XC - OFF_QB, "Y alias");

struct Params {
    const float *x, *c, *ctx, *c_ctx, *w_ada, *b_ada, *norm1_g, *norm2_g, *w_in, *w_out, *lam_q1, *lam_k1, *lam_q2, *lam_k2,
        *subln_g, *q_norm_g, *k_norm_g, *sink, *w_router, *router_bias, *w_gate, *w_up, *w_down, *final_g;
    float* out;
    unsigned char* ws;
};

DI float bf2f(bf16_t b) { return __uint_as_float(((unsigned)b) << 16); }
typedef __bf16 bf2_t __attribute__((ext_vector_type(2)));
DI bf16_t f2bf(float f) { return __builtin_bit_cast(bf16_t, (__bf16)f); }
DI unsigned pk2(float lo, float hi) { bf2_t v = {(__bf16)lo, (__bf16)hi}; return __builtin_bit_cast(unsigned, v); }
DI int crow(int reg, int h) { return (reg & 3) + 8 * (reg >> 2) + 4 * h; }
DI float wave_sum(float v) {
#pragma unroll
    for (int o = 1; o < 64; o <<= 1) v += __shfl_xor(v, o);
    return v;
}
DI float max2f(float a, float b) { return __builtin_amdgcn_fmed3f(a, b, __builtin_inff()); }
DI float silu(float v) { return v / (1.f + expf(-v)); }
DI float* resid_row(const Params& P, int b, int p) {
    return p < CTXL ? (float*)(P.ws + OFF_XC) + (size_t)(b * CTXL + p) * DM : P.out + (size_t)(b * SEQ + p - CTXL) * DM;
}
DI const float* input_row(const Params& P, int b, int p) {
    return p < CTXL ? P.ctx + (size_t)(b * CTXL + p) * DM : P.x + (size_t)(b * SEQ + p - CTXL) * DM;
}
DI const float* mod_row(const Params& P, int l, int mr) { return (const float*)(P.ws + OFF_MOD) + (size_t)(l * 9 + mr) * 6144; }

constexpr int TI_IN = 2 * 16 * 40, TI_OUT = 2 * 16 * 16, TI_G = 32 * 16 * 4, TI_U = TI_G, TI_D = 32 * 4 * 16, TI_ALL = TI_IN + TI_OUT + TI_G + TI_U + TI_D;
DI void titem_decode(const Params& P, int r, const float*& src, int& N, bf16_t*& dst, int& ldd, int& n0, int& kind) {
    kind = 0;
    if (r < TI_IN) { const int l = r / 640, q = r % 640, kb = q / 40, nbk = q % 40; N = INC; ldd = DM; n0 = nbk * 64; kind = 3;
        src = P.w_in + (size_t)l * DM * INC + (size_t)(kb * 64) * INC + n0; dst = (bf16_t*)(P.ws + OFF_WIN) + (size_t)l * INC * DM + kb * 64; return; }
    r -= TI_IN;
    if (r < TI_OUT) { const int l = r / 256, q = r % 256, kb = q / 16, nbk = q % 16; N = DM; ldd = DM; n0 = nbk * 64;
        src = P.w_out + (size_t)l * DM * DM + (size_t)(kb * 64) * DM + n0; dst = (bf16_t*)(P.ws + OFF_WOUT) + (size_t)l * DM * DM + kb * 64; return; }
    r -= TI_OUT;
    if (r < TI_G + TI_U) { const bool up = r >= TI_G; if (up) r -= TI_G; const int le = r / 64, q = r % 64, kb = q / 4, nbk = q % 4; N = DEXP; ldd = DM; n0 = nbk * 64; kind = up ? 2 : 1;
        src = (up ? P.w_up : P.w_gate) + (size_t)le * DM * DEXP + (size_t)(kb * 64) * DEXP + n0; dst = (bf16_t*)(P.ws + OFF_WGU) + (size_t)le * 512 * DM + kb * 64; return; }
    r -= TI_G + TI_U;
    { const int le = r / 64, q = r % 64, kb = q / 16, nbk = q % 16; N = DM; ldd = DEXP; n0 = nbk * 64;
        src = P.w_down + (size_t)le * DEXP * DM + (size_t)(kb * 64) * DM + n0; dst = (bf16_t*)(P.ws + OFF_WD) + (size_t)le * DM * DEXP + kb * 64; }
}

DI void phase_prologue(const Params& P, int bid, int nb, char* smem) {
    const int t = threadIdx.x;
    float* s = (float*)smem;
    {
        constexpr int NLD = 4096 / NTHREADS;
        float v[NLD];
        int it = bid;
        const float* src; bf16_t* dst; int N, ldd, n0, kind;
        if (it < TI_ALL) { titem_decode(P, it, src, N, dst, ldd, n0, kind);
#pragma unroll
            for (int i = 0; i < NLD; ++i) v[i] = src[(size_t)((t >> 6) + NW * i) * N + (t & 63)]; }
        while (it < TI_ALL) {
            __syncthreads();
#pragma unroll
            for (int i = 0; i < NLD; ++i) s[((t >> 6) + NW * i) * 65 + (t & 63)] = v[i];
            __syncthreads();
            bf16_t* cdst = dst; const int cldd = ldd, cn0 = n0, ckind = kind;
            it += nb;
            if (it < TI_ALL) { titem_decode(P, it, src, N, dst, ldd, n0, kind);
#pragma unroll
                for (int i = 0; i < NLD; ++i) v[i] = src[(size_t)((t >> 6) + NW * i) * N + (t & 63)]; }
            constexpr int KPT = 64 * 64 / NTHREADS;
            const int n = t / (64 / KPT), kc = (t % (64 / KPT)) * KPT;
            const int ng = cn0 + n;
            int drow = ng;
            if (ckind == 3) {
                const bool isv = (ng >= 1536 && ng < 2048) || (ng >= 2176 && ng < 2304) || ng >= 2432;
                const int w = (ng >> 6) & 3, d = ng & 63;
                const int bj = isv ? (d >> 3) & 1 : d >> 5, n = isv ? (d >> 2) & 1 : (d >> 4) & 1, fq = isv ? d >> 4 : (d >> 2) & 3, r = d & 3;
                drow = (ng & ~255) + 128 * bj + 32 * w + 16 * n + 4 * fq + r;
            }
            else if (ckind != 0) drow = (ng >> 7) * 256 + (ckind == 2 ? 128 : 0) + (ng & 127);
            bf16_t* d = cdst + (size_t)drow * cldd + kc;
#pragma unroll
            for (int j = 0; j < KPT; j += 8) { u32x4 o;
                o.x = pk2(s[(kc + j + 0) * 65 + n], s[(kc + j + 1) * 65 + n]); o.y = pk2(s[(kc + j + 2) * 65 + n], s[(kc + j + 3) * 65 + n]);
                o.z = pk2(s[(kc + j + 4) * 65 + n], s[(kc + j + 5) * 65 + n]); o.w = pk2(s[(kc + j + 6) * 65 + n], s[(kc + j + 7) * 65 + n]);
                *(u32x4*)(d + j) = o; }
        }
    }
    {
        constexpr int I_MOD = 2 * 384, KG = NTHREADS / 16, KPG = DM / KG;
        bool have_silu = false;
        float* ssl = s;
        float* red = s + 9 * 1024;
        for (int it = bid; it < I_MOD; it += nb) {
            const int l = it / 384, col0 = (it % 384) * 16, cc = t & 15, kg = t >> 4;
            const float* W = P.w_ada + (size_t)l * DM * 6144 + col0 + cc + (size_t)(kg * KPG) * 6144;
            float w[KPG];
#pragma unroll
            for (int kk = 0; kk < KPG; ++kk) w[kk] = W[(size_t)kk * 6144];
            __syncthreads();
            if (!have_silu) { for (int i = t; i < 9 * 1024; i += NTHREADS) { const float cv = i < 8192 ? P.c[i] : P.c_ctx[i - 8192]; ssl[i] = silu(cv); } have_silu = true; }
            __syncthreads();
            float acc[9];
#pragma unroll
            for (int i = 0; i < 9; ++i) acc[i] = 0.f;
#pragma unroll
            for (int kk = 0; kk < KPG; ++kk) {
#pragma unroll
                for (int i = 0; i < 9; ++i) acc[i] += ssl[i * 1024 + kg * KPG + kk] * w[kk];
            }
#pragma unroll
            for (int i = 0; i < 9; ++i) red[(i * KG + kg) * 16 + cc] = acc[i];
            __syncthreads();
            if (t < 144) { const int i = t >> 4, c2 = t & 15; float a = P.b_ada[l * 6144 + col0 + c2];
                for (int g = 0; g < KG; ++g) a += red[(i * KG + g) * 16 + c2];
                ((float*)(P.ws + OFF_MOD))[(size_t)(l * 9 + i) * 6144 + col0 + c2] = a; }
        }
    }
    for (int idx = bid * NTHREADS + t; idx < 96 * 16; idx += nb * NTHREADS) {
        const int pi = idx >> 4, j = idx & 15, pos = pi < 32 ? pi : pi - 32;
        const float invf = powf(10000.f, -(float)j / 16.f);
        float sn, cs; sincosf((float)pos * invf, &sn, &cs);
        ((float*)(P.ws + OFF_ROPE))[idx] = cs; ((float*)(P.ws + OFF_ROPE))[96 * 16 + idx] = sn;
    }
}

struct RowIn { f32x4 x[4]; u32x2 y0[4], y1[4]; };
template <bool COMBINE>
DI void row_load(const Params& P, int l, int tok, int lane, RowIn& r) {
    const int b = tok / TPB, p = tok % TPB;
    const f32x4* src = (const f32x4*)((l == 0 && !COMBINE) ? input_row(P, b, p) : (const float*)resid_row(P, b, p)) + lane;
#pragma unroll
    for (int j = 0; j < 4; ++j) r.x[j] = src[64 * j];
    if (COMBINE) {
        const bf16_t* Y = (const bf16_t*)(P.ws + OFF_Y);
        const u32x2* y0 = (const u32x2*)(Y + (size_t)(2 * tok) * DM) + lane;
        const u32x2* y1 = (const u32x2*)(Y + (size_t)(2 * tok + 1) * DM) + lane;
#pragma unroll
        for (int j = 0; j < 4; ++j) { r.y0[j] = y0[64 * j]; r.y1[j] = y1[64 * j]; }
    }
}
DI f32x4 row_combine(const f32x4 xv, const f32x4 g, const u32x2 a, const u32x2 c2) {
    f32x4 yv;
    yv.x = __uint_as_float(a.x << 16) + __uint_as_float(c2.x << 16);
    yv.y = __uint_as_float(a.x & 0xffff0000u) + __uint_as_float(c2.x & 0xffff0000u);
    yv.z = __uint_as_float(a.y << 16) + __uint_as_float(c2.y << 16);
    yv.w = __uint_as_float(a.y & 0xffff0000u) + __uint_as_float(c2.y & 0xffff0000u);
    return xv + g * yv;
}
template <bool COMBINE>
DI void norm1_body(const Params& P, int l, int bid, int nb) {
    const int lane = threadIdx.x & 63, wave = threadIdx.x >> 6;
    bf16_t* HX = (bf16_t*)(P.ws + OFF_HX);
    const int per = (NTOK + nb - 1) / nb, tk0 = bid * per, ntk = min(NTOK, tk0 + per) - tk0;
    RowIn cur, nxt;
    f32x4 gs[4], hs[4], g2[4];
    int cur_mr = -1;
    if (wave < ntk) row_load<COMBINE>(P, l, tk0 + wave, lane, nxt);
    for (int i = wave; i < ntk; i += NW) {
        const int tok = tk0 + i, b = tok / TPB, p = tok % TPB, mr = p < CTXL ? 8 : b;
        cur = nxt;
        if (i + NW < ntk) row_load<COMBINE>(P, l, tok + NW, lane, nxt);
        if (mr != cur_mr) {
            const float* md = mod_row(P, l, mr);
            const f32x4* gn = (const f32x4*)(P.norm1_g + l * DM) + lane;
            const f32x4* sh = (const f32x4*)(md) + lane;
            const f32x4* sc = (const f32x4*)(md + 1024) + lane;
#pragma unroll
            for (int j = 0; j < 4; ++j) { gs[j] = gn[64 * j] * (1.f + sc[64 * j]); hs[j] = sh[64 * j]; }
            if (COMBINE) { const f32x4* gp = (const f32x4*)(mod_row(P, l - 1, mr) + 5120) + lane;
#pragma unroll
                for (int j = 0; j < 4; ++j) g2[j] = gp[64 * j]; }
            cur_mr = mr;
        }
        f32x4 v[4]; float ss = 0.f;
        f32x4* xr = (f32x4*)resid_row(P, b, p) + lane;
#pragma unroll
        for (int j = 0; j < 4; ++j) {
            v[j] = COMBINE ? row_combine(cur.x[j], g2[j], cur.y0[j], cur.y1[j]) : cur.x[j];
            if (COMBINE) xr[64 * j] = v[j];
            ss += (v[j].x * v[j].x + v[j].y * v[j].y) + (v[j].z * v[j].z + v[j].w * v[j].w);
        }
        const float r = rsqrtf(wave_sum(ss) * (1.f / DM) + RMS_EPS);
        u32x2* o = (u32x2*)(HX + (size_t)tok * DM) + lane;
#pragma unroll
        for (int j = 0; j < 4; ++j) {
            const f32x4 y = v[j] * r * gs[j] + hs[j];
            u32x2 w; w.x = pk2(y.x, y.y); w.y = pk2(y.z, y.w);
            o[64 * j] = w;
        }
    }
}
DI void router_shift_consts(const Params& P, int l, int bid) {
    if (bid >= 9 || (threadIdx.x >> 6) != NW - 1) return;
    const int lane = threadIdx.x & 63;
    const float* sh = mod_row(P, l, bid) + 3072;
    float a[16];
#pragma unroll
    for (int e = 0; e < 16; ++e) a[e] = 0.f;
    for (int i = 0; i < 16; ++i) { const int k = lane + 64 * i; const float h = sh[k];
#pragma unroll
        for (int q = 0; q < 4; ++q) { const f32x4 w = *(const f32x4*)(P.w_router + k * 16 + 4 * q); a[4 * q] += h * w.x; a[4 * q + 1] += h * w.y; a[4 * q + 2] += h * w.z; a[4 * q + 3] += h * w.w; } }
#pragma unroll
    for (int e = 0; e < 16; ++e) a[e] = wave_sum(a[e]);
    if (lane == 0) { float* qe = (float*)(P.ws + OFF_QE) + (l * 9 + bid) * 16;
#pragma unroll
        for (int e = 0; e < 16; ++e) qe[e] = a[e]; }
}
DI void phase_norm1(const Params& P, int l, int bid, int nb) { router_shift_consts(P, l, bid); if (l == 0) norm1_body<false>(P, 0, bid, nb); else norm1_body<true>(P, l, bid, nb); }

DI void phase_final(const Params& P, int bid, int nb) {
    const int lane = threadIdx.x & 63, wave = threadIdx.x >> 6;
    const int per = (NB * SEQ + nb - 1) / nb, r0 = bid * per, nr = min(NB * SEQ, r0 + per) - r0;
    RowIn cur, nxt;
    f32x4 fg[4], g2[4];
    const f32x4* fgp = (const f32x4*)P.final_g + lane;
#pragma unroll
    for (int j = 0; j < 4; ++j) fg[j] = fgp[64 * j];
    int cur_b = -1;
    if (wave < nr) { const int r = r0 + wave; row_load<true>(P, 1, (r / SEQ) * TPB + CTXL + r % SEQ, lane, nxt); }
    for (int i = wave; i < nr; i += NW) {
        const int r = r0 + i, b = r / SEQ, p = CTXL + r % SEQ;
        cur = nxt;
        if (i + NW < nr) { const int r2 = r + NW; row_load<true>(P, 1, (r2 / SEQ) * TPB + CTXL + r2 % SEQ, lane, nxt); }
        if (b != cur_b) { const f32x4* gp = (const f32x4*)(mod_row(P, 1, b) + 5120) + lane;
#pragma unroll
            for (int j = 0; j < 4; ++j) g2[j] = gp[64 * j];
            cur_b = b; }
        f32x4 v[4]; float ss = 0.f;
#pragma unroll
        for (int j = 0; j < 4; ++j) { v[j] = row_combine(cur.x[j], g2[j], cur.y0[j], cur.y1[j]); ss += (v[j].x * v[j].x + v[j].y * v[j].y) + (v[j].z * v[j].z + v[j].w * v[j].w); }
        const float rr = rsqrtf(wave_sum(ss) * (1.f / DM) + RMS_EPS);
        f32x4* xr = (f32x4*)resid_row(P, b, p) + lane;
#pragma unroll
        for (int j = 0; j < 4; ++j) xr[64 * j] = v[j] * rr * fg[j];
    }
}

namespace g8 {
constexpr int BK = 64, HALF = 128, HTB = HALF * BK * 2, STAGE_BYTES = 8 * HTB;
DI int lds_byte(int r, int c) { const int st = (r >> 4) * 2 + (c >> 5), rr = r & 15, cc = c & 31, ob = rr * 64 + cc * 2; return st * 1024 + (ob ^ (((ob >> 9) & 1) << 5)); }
DI void stage_rc(int b, int& R, int& C) { const int st = b / 1024, sb = b % 1024, swz = sb ^ (((sb >> 9) & 1) << 5); R = (st >> 1) * 16 + swz / 64; C = (st & 1) * 32 + (swz % 64) / 2; }
struct Unit { int a, b, c, d; const bf16_t* bt; };

template <class Sched, class Epi>
DI void gemm_phase(char* smem, const bf16_t* Abase, const int K, const Sched& S, const Epi& E) {
    LAS unsigned char* lds = (LAS unsigned char*)smem;
    const int tid = threadIdx.x, wid = __builtin_amdgcn_readfirstlane(tid >> 6), lane = tid & 63, wr = wid >> 2, wc = wid & 3, fr = lane & 15, fq = lane >> 4;
    const int nt = K / BK;
    int R[2], C[2];
    unsigned voffB[2], voffA[2];
#pragma unroll
    for (int i = 0; i < 2; ++i) { stage_rc(tid * 16 + i * 8192, R[i], C[i]); voffB[i] = (unsigned)(R[i] * K + C[i]) * 2u; voffA[i] = voffB[i]; }
    const size_t kstep = (size_t)(BK * 2);
    const size_t hstep = (size_t)HALF * K * 2;
    const unsigned ldsw = (unsigned)wid * 1024u;
    const int aoff = lds_byte(wr * 64 + fr, fq * 8), boff = lds_byte(wc * 32 + fr, fq * 8);
#define G8_SA(b, h) (((b) * 2 + (h)) * HTB)
#define G8_SB(b, h) ((4 + (b) * 2 + (h)) * HTB)
#define G8_STAGE_B(bufoff, gbase) do { _Pragma("unroll") for (int _i = 0; _i < 2; ++_i) \
        __builtin_amdgcn_global_load_lds((const unsigned*)((const char*)(gbase) + voffB[_i]), (LAS unsigned*)(lds + (bufoff) + ldsw + _i * 8192), 16, 0, 0); } while (0)
#define G8_GLDS(src, dstoff) __builtin_amdgcn_global_load_lds((const unsigned*)(src), (LAS unsigned*)(lds + (dstoff)), 16, 0, 0)
#define G8_STAGE_A(bufoff, hh, nx, kb) do { \
        if constexpr (Sched::GATHER) { const unsigned o0_ = (nx) ? avn[hh][0] : avc[hh][0], o1_ = (nx) ? avn[hh][1] : avc[hh][1]; \
            G8_GLDS(Ab + (size_t)o0_ + (kb), (bufoff) + ldsw); G8_GLDS(Ab + (size_t)o1_ + (kb), (bufoff) + ldsw + 8192); } \
        else { const char* ba_ = ((nx) ? nA : cA) + (size_t)(hh) * hstep + (kb); G8_GLDS(ba_ + voffA[0], (bufoff) + ldsw); G8_GLDS(ba_ + voffA[1], (bufoff) + ldsw + 8192); } } while (0)
#define G8_LDA(dst, b, h) do { _Pragma("unroll") for (int m = 0; m < 4; ++m) _Pragma("unroll") for (int k = 0; k < 2; ++k) dst[m][k] = *(const LAS bf16x8*)(lds + G8_SA(b, h) + aoff + m * 2048 + k * 1024); } while (0)
#define G8_LDB(dst, b, h) do { _Pragma("unroll") for (int n = 0; n < 2; ++n) _Pragma("unroll") for (int k = 0; k < 2; ++k) dst[n][k] = *(const LAS bf16x8*)(lds + G8_SB(b, h) + boff + n * 2048 + k * 1024); } while (0)
#define G8_MMA(ai, bj, At, Bt) do { __builtin_amdgcn_s_setprio(1); _Pragma("unroll") for (int m = 0; m < 4; ++m) _Pragma("unroll") for (int n = 0; n < 2; ++n) _Pragma("unroll") for (int k = 0; k < 2; ++k) \
        acc[ai][bj][m][n] = __builtin_amdgcn_mfma_f32_16x16x32_bf16(Bt[n][k], At[m][k], acc[ai][bj][m][n], 0, 0, 0); __builtin_amdgcn_s_setprio(0); } while (0)
#define G8_WAIT_V(n) asm volatile("s_waitcnt vmcnt(" #n ")" ::: "memory")
#define G8_WAIT_L(n) asm volatile("s_waitcnt lgkmcnt(" #n ")" ::: "memory")
#define G8_BAR __builtin_amdgcn_s_barrier()
#define G8_SCHED __builtin_amdgcn_sched_barrier(0)
    Unit cur, nxt; int ui = 0;
    if (!S.next(0, cur)) return;
    f32x4 acc[2][2][4][2];
#pragma unroll
    for (int a = 0; a < 2; ++a)
#pragma unroll
        for (int b = 0; b < 2; ++b)
#pragma unroll
            for (int m = 0; m < 4; ++m)
#pragma unroll
                for (int n = 0; n < 2; ++n) acc[a][b][m][n] = (f32x4){0.f, 0.f, 0.f, 0.f};
    bf16x8 At[4][2], B0[2][2], B1[2][2];
    const char* Ab = (const char*)Abase;
    unsigned avc[2][2], avn[2][2];
    const char *cA = Ab, *nA = Ab;
    S.a_ready(cur);
    if constexpr (Sched::GATHER) S.a_offsets(cur, R, C, avc); else cA = (const char*)S.a_base(cur);
    const char* cB = (const char*)cur.bt;
    G8_STAGE_B(G8_SB(0, 0), cB); G8_STAGE_B(G8_SB(0, 1), cB + hstep); G8_STAGE_A(G8_SA(0, 0), 0, false, 0); G8_STAGE_A(G8_SA(0, 1), 1, false, 0);
    if (wr == 1) G8_BAR;
    G8_WAIT_V(2); G8_BAR;
    G8_STAGE_B(G8_SB(1, 0), cB + kstep); G8_STAGE_A(G8_SA(1, 0), 0, false, kstep); G8_STAGE_B(G8_SB(1, 1), cB + hstep + kstep);
    G8_WAIT_V(6); G8_BAR;
    for (;;) {
        const bool has_next = S.next(ui + 1, nxt);
        if constexpr (Sched::GATHER) {
            if (has_next) S.a_offsets(nxt, R, C, avn);
            else {
#pragma unroll
                for (int hh = 0; hh < 2; ++hh)
#pragma unroll
                    for (int i = 0; i < 2; ++i) avn[hh][i] = avc[hh][i];
            }
        } else nA = has_next ? (const char*)S.a_base(nxt) : cA;
        const char* nB = has_next ? (const char*)nxt.bt : cB;
        for (int t = 0; t < nt; t += 2) {
            const bool last = (t == nt - 2);
            const size_t k1 = (size_t)(t + 1) * kstep;
            const size_t k2 = last ? 0 : (size_t)(t + 2) * kstep, k3 = k2 + kstep;
            const char* b2 = last ? nB : cB + k2; const char* b3 = b2 + kstep;
            G8_LDB(B0, 0, 0); G8_LDB(B1, 0, 1); G8_SCHED; G8_LDA(At, 0, 0); G8_STAGE_A(G8_SA(1, 1), 1, false, k1);
            G8_WAIT_V(8); G8_WAIT_L(0); G8_BAR; G8_MMA(0, 0, At, B0); G8_MMA(0, 1, At, B1); G8_BAR; G8_SCHED;
            G8_LDA(At, 0, 1); G8_STAGE_B(G8_SB(0, 0), b2); G8_STAGE_B(G8_SB(0, 1), b2 + hstep); G8_STAGE_A(G8_SA(0, 0), 0, last, k2);
            G8_WAIT_V(8); G8_WAIT_L(0); G8_BAR; G8_MMA(1, 0, At, B0); G8_MMA(1, 1, At, B1); G8_BAR; G8_SCHED;
            G8_LDB(B0, 1, 0); G8_LDB(B1, 1, 1); G8_SCHED; G8_LDA(At, 1, 0); G8_STAGE_A(G8_SA(0, 1), 1, last, k2);
            G8_WAIT_V(8); G8_WAIT_L(0); G8_BAR; G8_MMA(0, 0, At, B0); G8_MMA(0, 1, At, B1); G8_BAR; G8_SCHED;
            G8_LDA(At, 1, 1); G8_STAGE_B(G8_SB(1, 0), b3); G8_STAGE_B(G8_SB(1, 1), b3 + hstep); G8_STAGE_A(G8_SA(1, 0), 0, last, k3);
            G8_WAIT_V(8); G8_WAIT_L(0); G8_BAR; G8_MMA(1, 0, At, B0); G8_MMA(1, 1, At, B1); G8_BAR; G8_SCHED;
        }
        if (wr == 0) G8_BAR;
        if constexpr (!Epi::AFTER_DRAIN) E(acc, cur, wr, wc, fr, fq);
        if (!has_next) break;
#pragma unroll
        for (int a = 0; a < 2; ++a)
#pragma unroll
            for (int b = 0; b < 2; ++b)
#pragma unroll
                for (int m = 0; m < 4; ++m)
#pragma unroll
                    for (int n = 0; n < 2; ++n) acc[a][b][m][n] = (f32x4){0.f, 0.f, 0.f, 0.f};
        cur = nxt; cB = nB; cA = nA; ++ui;
        if constexpr (Sched::GATHER) {
#pragma unroll
            for (int hh = 0; hh < 2; ++hh)
#pragma unroll
                for (int i = 0; i < 2; ++i) avc[hh][i] = avn[hh][i];
        }
        if (wr == 1) G8_BAR;
    }
    G8_WAIT_V(0);
    G8_BAR;
    if constexpr (Epi::AFTER_DRAIN) E.fused(acc, cur, wr, wc, fr, fq, smem);
#undef G8_SA
#undef G8_SB
#undef G8_STAGE_A
#undef G8_GLDS
#undef G8_STAGE_B
#undef G8_LDA
#undef G8_LDB
#undef G8_MMA
#undef G8_WAIT_V
#undef G8_WAIT_L
#undef G8_BAR
#undef G8_SCHED
}

DI bool static_unit(int i, int G, int c, int nM, int nN, int& pm, int& pn) {
    const int nwg = nM * nN; const long L = (long)i * G + c; if (L >= nwg) return false;
    int wgid = (int)L; { const int q = nwg / 8, r = nwg % 8, xcd = wgid % 8, off = wgid / 8; wgid = (xcd < r ? xcd * (q + 1) : r * (q + 1) + (xcd - r) * q) + off; }
    const int nig = 8 * nN, gid = wgid / nig, fm = gid * 8, gsz = (nM - fm) < 8 ? (nM - fm) : 8;
    pm = fm + ((wgid % nig) % gsz); pn = (wgid % nig) / gsz; return true;
}
}

struct SchedQKV {
    const bf16_t *A, *Wt; int G, c;
    static constexpr bool GATHER = false;
    DI void a_ready(const g8::Unit&) const {}
    DI bool next(int i, g8::Unit& u) const { int pm, pn; if (!g8::static_unit(i, G, c, NTOK / 256, INC / 256, pm, pn)) return false; u.a = pm; u.b = pn; u.c = 0; u.d = 0; u.bt = Wt + (size_t)pn * 256 * DM; return true; }
    DI const bf16_t* a_base(const g8::Unit& u) const { return A + (size_t)u.a * 256 * DM; }
};
struct EpiQKV {
    static constexpr bool AFTER_DRAIN = false;
    bf16_t *QB, *KB, *VT; const float *ropec, *ropes, *qg, *kg;
    DI void operator()(const f32x4 (&acc)[2][2][4][2], const g8::Unit& u, int wr, int wc, int fr, int fq) const {
        const int pm = u.a, pn = u.b, b = pm / 9, p0 = (pm % 9) * 256;
        const bool isctx = p0 == 0;
        const int cw = pn * 256 + wc * 64;
        int kind, unit; const float* ng = nullptr;
        if (cw < 1024) { kind = 0; unit = cw >> 6; if (unit >= 8 && unit < 12) ng = qg; }
        else if (cw < 1536) { kind = 1; unit = (cw - 1024) >> 6; }
        else if (cw < 2048) { kind = 2; unit = cw - 1536; }
        else if (cw < 2176) { kind = 1; unit = 8 + ((cw - 2048) >> 6); ng = kg; }
        else if (cw < 2304) { kind = 2; unit = 512 + (cw - 2176); }
        else if (cw < 2432) { kind = 1; unit = 10 + ((cw - 2304) >> 6); }
        else { kind = 2; unit = 640 + (cw - 2432); }
        if (kind == 2) {
            const int vld = unit < 512 ? 128 : 64;
            const size_t vbase = unit < 512 ? (size_t)(unit >> 7) * TPB * 128 + (unit & 127) : (size_t)4 * TPB * 128 + (size_t)((unit - 512) >> 6) * TPB * 64;
            bf16_t* vb = VT + (size_t)b * VS + vbase + 16 * fq;
#pragma unroll
            for (int ai = 0; ai < 2; ++ai)
#pragma unroll
                for (int m = 0; m < 4; ++m) {
                    const int p = p0 + 128 * ai + 64 * wr + 16 * m + fr;
#pragma unroll
                    for (int bj = 0; bj < 2; ++bj) { const f32x4 v0 = acc[ai][bj][m][0], v1 = acc[ai][bj][m][1];
                        u32x4 o; o.x = pk2(v0.x, v0.y); o.y = pk2(v0.z, v0.w); o.z = pk2(v1.x, v1.y); o.w = pk2(v1.z, v1.w);
                        *(u32x4*)(vb + (size_t)p * vld + 8 * bj) = o; }
                }
            return;
        }
        const bool nrm = ng != nullptr;
        f32x4 g4[2][2];
#pragma unroll
        for (int bj = 0; bj < 2; ++bj)
#pragma unroll
            for (int n = 0; n < 2; ++n) g4[bj][n] = nrm ? *(const f32x4*)(ng + 32 * bj + 16 * n + 4 * fq) : (f32x4){1.f, 1.f, 1.f, 1.f};
        const float osc = kind == 0 ? QSCALE : 1.f;
        bf16_t* base = (kind == 0 ? QB + ((size_t)b * NQU + unit) * TPB * 64 : KB + ((size_t)b * NKU + unit) * TPB * 64) + 4 * fq;
#pragma unroll
        for (int ai = 0; ai < 2; ++ai)
#pragma unroll
            for (int m = 0; m < 4; ++m) {
                const int p = p0 + 128 * ai + 64 * wr + 16 * m + fr;
                f32x4 x[2][2];
#pragma unroll
                for (int bj = 0; bj < 2; ++bj)
#pragma unroll
                    for (int n = 0; n < 2; ++n) x[bj][n] = acc[ai][bj][m][n];
                if (nrm) {
                    float ss = 0.f;
#pragma unroll
                    for (int bj = 0; bj < 2; ++bj)
#pragma unroll
                        for (int n = 0; n < 2; ++n) ss += (x[bj][n].x * x[bj][n].x + x[bj][n].y * x[bj][n].y) + (x[bj][n].z * x[bj][n].z + x[bj][n].w * x[bj][n].w);
                    ss += __shfl_xor(ss, 16); ss += __shfl_xor(ss, 32);
                    const float r = rsqrtf(ss * (1.f / 64.f) + RMS_EPS);
#pragma unroll
                    for (int bj = 0; bj < 2; ++bj)
#pragma unroll
                        for (int n = 0; n < 2; ++n) x[bj][n] = x[bj][n] * r * g4[bj][n];
                }
                if (!isctx) {
                    const int t = p - CTXL;
#pragma unroll
                    for (int bj = 0; bj < 2; ++bj) {
                        const int idx = (bj == 0 ? (t >> 6) : 32 + (t & 63)) * 16 + 4 * fq;
                        const f32x4 c4 = *(const f32x4*)(ropec + idx), s4 = *(const f32x4*)(ropes + idx);
                        const f32x4 y0 = x[bj][0] * c4 - x[bj][1] * s4, y1 = x[bj][0] * s4 + x[bj][1] * c4;
                        x[bj][0] = y0; x[bj][1] = y1;
                    }
                }
#pragma unroll
                for (int bj = 0; bj < 2; ++bj)
#pragma unroll
                    for (int n = 0; n < 2; ++n) { u32x2 o; o.x = pk2(x[bj][n].x * osc, x[bj][n].y * osc); o.y = pk2(x[bj][n].z * osc, x[bj][n].w * osc);
                        *(u32x2*)(base + (size_t)p * 64 + 32 * bj + 16 * n) = o; }
            }
    }
};
DI void phase_qkv(const Params& P, int l, int bid, int nb, char* smem) {
    __syncthreads();
    for (int i = threadIdx.x; i < 2 * 96 * 16 / 4; i += NTHREADS) ((f32x4*)(smem + LDS_MISC))[i] = ((const f32x4*)(P.ws + OFF_ROPE))[i];
    __syncthreads();
    SchedQKV S{(const bf16_t*)(P.ws + OFF_HX), (const bf16_t*)(P.ws + OFF_WIN) + (size_t)l * INC * DM, nb, bid};
    EpiQKV E{(bf16_t*)(P.ws + OFF_QB), (bf16_t*)(P.ws + OFF_KB), (bf16_t*)(P.ws + OFF_VT), (const float*)(smem + LDS_MISC), (const float*)(smem + LDS_MISC) + 96 * 16,
             P.q_norm_g + l * 64, P.k_norm_g + l * 64};
    g8::gemm_phase(smem, (const bf16_t*)(P.ws + OFF_HX), DM, S, E);
}


#ifndef PV_AHEAD
#define PV_AHEAD 8
#endif
#define MFMA32(a, b, c) __builtin_amdgcn_mfma_f32_32x32x16_bf16((a), (b), (c), 0, 0, 0)
template <int DV>
DI void flash_run(char* smem, const bf16_t* qrow, const bf16_t* Kb, const bf16_t* Vr, int n1, int base2, int n2, int tq, float m0, float l0,
                  f32x16 (&O)[DV / 32], float& lout) {
    constexpr int NT = DV / 32, KBYTES = 8192, RB = DV * 2, STAGE = KBYTES + 64 * RB, NVP = DV / 64, KP = 1024 / RB, LPR = RB / 16;
    LAS char* lds = (LAS char*)smem;
    const int t = threadIdx.x, wave = __builtin_amdgcn_readfirstlane(t >> 6);
    int lane = t & 63;
    asm volatile("" : "+v"(lane));
    const int h = lane >> 5, ln = lane & 31, sw = (ln >> 1) & 7;
    constexpr bool QLDS = DV == 128;
    LAS char* qb = lds + 4 * STAGE + wave * 4096 + lane * 16;
    bf16x8 qf[4];
#pragma unroll
    for (int s = 0; s < 4; ++s) qf[s] = *(const bf16x8*)(qrow + 16 * s + 8 * h);
    if (QLDS) {
#pragma unroll
        for (int s = 0; s < 4; ++s) *(LAS bf16x8*)(qb + s * 1024) = qf[s];
    }
#pragma unroll
    for (int tt = 0; tt < NT; ++tt)
#pragma unroll
        for (int i = 0; i < 16; ++i) O[tt][i] = 0.f;
    constexpr float THR = 8.f;
    constexpr int PVA = PV_AHEAD;
    float m = m0 > -1e29f ? m0 : 0.f, l = l0;
    f32x16 negm;
#pragma unroll
    for (int i = 0; i < 16; ++i) negm[i] = -m;
    const int ntile = n1 + n2;
    constexpr int VPM = DV == 128 ? 5 : 9;
    bf16x8 pfp[2][2];
#pragma unroll
    for (int x = 0; x < 2; ++x)
#pragma unroll
        for (int y = 0; y < 2; ++y) pfp[x][y] = (bf16x8){0, 0, 0, 0, 0, 0, 0, 0};
    const int krow = 8 * wave + (lane >> 3);
    const unsigned koff = (unsigned)(krow * 64 + (((lane & 7) ^ ((krow >> 1) & 7)) << 3)) * 2u;
    unsigned voff[NVP];
#pragma unroll
    for (int i = 0; i < NVP; ++i) { const int key = 8 * wave + KP * i + lane / LPR, cpos = lane % LPR, z = DV == 128 ? (key & 3) : ((key >> 1) & 1);
        voff[i] = (unsigned)(key * DV + ((cpos ^ (z << 2)) << 3)) * 2u; }
    const int tq_ = (lane & 15) >> 2, tp_ = lane & 3, gb_ = (lane >> 4) & 1, z_ = DV == 128 ? tq_ : ((tq_ >> 1) & 1);
    const int vlane = (4 * h + tq_) * RB + (2 * gb_ + (tp_ >> 1)) * 16 + (tp_ & 1) * 8;
#define FA_DMA(gsrc, ldsdst) do { unsigned keep_; asm volatile("s_mov_b32 %0, m0\n\ts_mov_b32 m0, %2\n\ts_nop 0\n\tglobal_load_lds_dwordx4 %1, off\n\ts_mov_b32 m0, %0" \
        : "=&s"(keep_) : "v"(gsrc), "s"(ldsdst) : "memory"); } while (0)
#define FA_ISSUE(j) do { const int j_ = (j); const int pj_ = j_ < n1 ? 64 * j_ : base2 + 64 * (j_ - n1); const int bo_ = (j_ & 3) * STAGE; \
        const char* kt_ = (const char*)Kb + (size_t)pj_ * 128; const char* vt_ = (const char*)Vr + (size_t)pj_ * RB; \
        FA_DMA(kt_ + koff, (unsigned)(size_t)(lds + bo_ + wave * 1024)); \
        _Pragma("unroll") for (int i_ = 0; i_ < NVP; ++i_) FA_DMA(vt_ + voff[i_], (unsigned)(size_t)(lds + bo_ + KBYTES + (8 * wave + KP * i_) * RB)); } while (0)
    asm volatile("s_waitcnt vmcnt(0)" ::: "memory");
    FA_ISSUE(0);
    if (ntile > 1) FA_ISSUE(1);
#define FA_PVCORE(VB_) do { \
_Pragma("unroll") \
        for (int tt = 0; tt < NT; ++tt) { \
            const LAS char* vt = (VB_) + ((tt ^ z_) << 6); \
_Pragma("unroll") \
            for (int x = 0; x < 2; ++x) \
_Pragma("unroll") \
                for (int y = 0; y < 2; ++y) { \
                    const s16x4 lo = __builtin_amdgcn_ds_read_tr16_b64_v4i16((LAS s16x4*)(vt + (32 * x + 16 * y) * RB)); \
                    const s16x4 hi = __builtin_amdgcn_ds_read_tr16_b64_v4i16((LAS s16x4*)(vt + (32 * x + 16 * y + 8) * RB)); \
                    const bf16x8 vf = __builtin_shufflevector(lo, hi, 0, 1, 2, 3, 4, 5, 6, 7); \
                    O[tt] = MFMA32(vf, pfp[x][y], O[tt]); \
                } \
        } \
 \
    } while (0)
#define FA_EXPCORE() do { \
_Pragma("unroll") \
        for (int i = 0; i < 16; i += 2) { \
            const float a0 = __builtin_amdgcn_exp2f(s0[i]), a1 = __builtin_amdgcn_exp2f(s0[i + 1]); \
            const float b0 = __builtin_amdgcn_exp2f(s1[i]), b1 = __builtin_amdgcn_exp2f(s1[i + 1]); \
            ps += (a0 + a1) + (b0 + b1); \
            w[i >> 1] = pk2(a0, a1); w[8 + (i >> 1)] = pk2(b0, b1); \
        } \
    } while (0)
    for (int it = 0; it < ntile; ++it) {
        const int p0 = it < n1 ? 64 * it : base2 + 64 * (it - n1);
        if (it + 1 < ntile) { if (NVP == 2) asm volatile("s_waitcnt vmcnt(3)" ::: "memory"); else asm volatile("s_waitcnt vmcnt(2)" ::: "memory"); }
        else asm volatile("s_waitcnt vmcnt(0)" ::: "memory");
        __builtin_amdgcn_s_barrier();
        asm volatile("" ::: "memory");
        if (it + 2 < ntile) FA_ISSUE(it + 2);
        int bo = (it & 3) * STAGE;
        asm volatile("" : "+s"(bo));
        const LAS char* kb = lds + bo;
        const LAS char* vb = kb + KBYTES + vlane;
        f32x16 s0 = negm, s1 = negm;
#pragma unroll
        for (int s = 0; s < 4; ++s) {
            const int co = ((2 * s + h) ^ sw) << 4;
            const bf16x8 k0 = *(const LAS bf16x8*)(kb + ln * 128 + co);
            const bf16x8 k1 = *(const LAS bf16x8*)(kb + (32 + ln) * 128 + co);
            const bf16x8 qs = QLDS ? *(const LAS bf16x8*)(qb + s * 1024) : qf[s];
            s0 = MFMA32(k0, qs, s0); s1 = MFMA32(k1, qs, s1);
        }
        if (it >= n1) {
            const int d0 = (p0 - CTXL) - tq + 4 * h + 128;
#pragma unroll
            for (int i = 0; i < 16; ++i) {
                const int dd = d0 + (i & 3) + 8 * (i >> 2);
                s0[i] = ((unsigned)dd <= 256u) ? s0[i] : -1e30f;
                s1[i] = ((unsigned)(dd + 32) <= 256u) ? s1[i] : -1e30f;
            }
        }
        float ps = 0.f;
        unsigned w[16];
        __builtin_amdgcn_sched_barrier(0);
        if (it > 0) {
            int bp = ((it - 1) & 3) * STAGE;
            asm volatile("" : "+s"(bp));
            const LAS char* vbp = lds + bp + KBYTES + vlane;
            FA_PVCORE(vbp);
            FA_EXPCORE();
            __builtin_amdgcn_sched_group_barrier(0x100, PVA, 0);
#pragma unroll
            for (int g = 0; g < 4 * NT; ++g) { __builtin_amdgcn_sched_group_barrier(0x008, 1, 0); __builtin_amdgcn_sched_group_barrier(0x002, VPM, 0);
                if (g < 4 * NT - PVA / 2) __builtin_amdgcn_sched_group_barrier(0x100, 2, 0); }
        } else {
            FA_EXPCORE();
        }
        __builtin_amdgcn_sched_barrier(0);
        if (__any(!(ps <= 1048576.f))) {
            float mx;
            {
                float t0 = max2f(s0[0], s1[0]), t1 = max2f(s0[1], s1[1]), t2 = max2f(s0[2], s1[2]), t3 = max2f(s0[3], s1[3]);
#pragma unroll
                for (int i = 4; i < 16; i += 4) { t0 = max2f(t0, max2f(s0[i], s1[i])); t1 = max2f(t1, max2f(s0[i + 1], s1[i + 1])); t2 = max2f(t2, max2f(s0[i + 2], s1[i + 2])); t3 = max2f(t3, max2f(s0[i + 3], s1[i + 3])); }
                mx = max2f(max2f(t0, t1), max2f(t2, t3));
            }
            mx = max2f(mx, __shfl_xor(mx, 32));
            const float d = fmaxf(mx, 0.f), alpha = __builtin_amdgcn_exp2f(-d);
            m += d; l *= alpha;
#pragma unroll
            for (int i = 0; i < 16; ++i) negm[i] -= d;
#pragma unroll
            for (int tt = 0; tt < NT; ++tt)
#pragma unroll
                for (int i = 0; i < 16; ++i) O[tt][i] *= alpha;
            ps = 0.f;
#pragma unroll
            for (int i = 0; i < 16; i += 2) {
                const float a0 = __builtin_amdgcn_exp2f(s0[i] - d), a1 = __builtin_amdgcn_exp2f(s0[i + 1] - d);
                const float b0 = __builtin_amdgcn_exp2f(s1[i] - d), b1 = __builtin_amdgcn_exp2f(s1[i + 1] - d);
                ps += (a0 + a1) + (b0 + b1);
                w[i >> 1] = pk2(a0, a1); w[8 + (i >> 1)] = pk2(b0, b1);
            }
        }
#pragma unroll
        for (int x = 0; x < 2; ++x)
#pragma unroll
            for (int y = 0; y < 2; ++y) { u32x4 q; q.x = w[8 * x + 4 * y]; q.y = w[8 * x + 4 * y + 1]; q.z = w[8 * x + 4 * y + 2]; q.w = w[8 * x + 4 * y + 3];
                pfp[x][y] = __builtin_bit_cast(bf16x8, q); }
        l += ps;
    }
    { int bp = ((ntile - 1) & 3) * STAGE; asm volatile("" : "+s"(bp)); const LAS char* vbp = lds + bp + KBYTES + vlane; FA_PVCORE(vbp); }
    __builtin_amdgcn_s_barrier();
#undef FA_ISSUE
#undef FA_PVCORE
#undef FA_EXPCORE
#undef FA_DMA
    lout = l + __shfl_xor(l, 32);
}

constexpr int CTX_EARLY_LO = 96, CTX_EARLY_N = 32;
DI bool ctx_early(int nb) { return nb >= CTX_EARLY_LO + CTX_EARLY_N; }
DI void outproj_run(const Params& P, int l, int mode, int c, int nb, char* smem);
DI void phase_attn(const Params& P, int l, int bid, int nb, char* smem) {
    const int t = threadIdx.x, wave = t >> 6;
    const bf16_t* QB = (const bf16_t*)(P.ws + OFF_QB); const bf16_t* KB = (const bf16_t*)(P.ws + OFF_KB); const bf16_t* VT = (const bf16_t*)(P.ws + OFF_VT);
    bf16_t* MIX = (bf16_t*)(P.ws + OFF_HX);
    const float lambda_init = l == 0 ? 0.2f : (0.8f - 0.6f * expf(-0.3f));
    float d1 = P.lam_q1[l * 64 + (t & 63)] * P.lam_k1[l * 64 + (t & 63)], d2 = P.lam_q2[l * 64 + (t & 63)] * P.lam_k2[l * 64 + (t & 63)];
    d1 = wave_sum(d1); d2 = wave_sum(d2);
    const float lam = expf(d1) - expf(d2) + lambda_init;
    const bool has_ctx = l == 0 && bid < 96;
    const int nmain = (768 - bid + nb - 1) / nb;
#pragma unroll 1
    for (int kk = 0; kk < nmain + (has_ctx ? 1 : 0); ++kk) {
        const int it = has_ctx ? (kk == 0 ? 768 + bid : bid + (kk - 1) * nb) : bid + kk * nb;
        int ty, b, hd, p0q, ncx;
        bool isctx;
        if (it < 768) {
            ty = it >> 8; const int idx = it & 255, xcd = idx & 7, r = idx >> 3, stream = xcd * 4 + (r >> 3);
            b = stream >> 2; hd = stream & 3; p0q = CTXL + (r & 7) * 256; isctx = false; ncx = TPB / 64;
        } else {
            const int i2 = it - 768, t12 = i2 % 12;
            b = i2 / 12; p0q = 0; ty = t12 >> 2; hd = t12 & 3; isctx = true; ncx = CTXL / 64;
        }
        int lane = t & 63;
        asm volatile("" : "+v"(lane));
        const int h = lane >> 5, ln = lane & 31;
        const int p = p0q + wave * 32 + ln, tok = b * TPB + p, tq = p - CTXL;
        if (ty == 0) {
            f32x16 O[4]; float lt;
            const bf16_t* V = VT + (size_t)b * VS + (size_t)hd * TPB * 128;
            flash_run<128>(smem, QB + (((size_t)b * NQU + 2 * hd + 1) * TPB + p) * 64, KB + ((size_t)b * NKU + 2 * hd + 1) * TPB * 64, V, ncx, 0, 0, tq, -1e30f, 0.f, O, lt);
            {
                int l2_ = t & 63; asm volatile("" : "+v"(l2_)); const int h2 = l2_ >> 5; bf16_t* orow = MIX + (size_t)(b * TPB + p0q + wave * 32 + (l2_ & 31)) * DM + hd * 128 + 4 * h2;
                const float f = -lam / lt;
#pragma unroll
                for (int tt = 0; tt < 4; ++tt)
#pragma unroll
                    for (int g = 0; g < 4; ++g) { u32x2 o; o.x = pk2(O[tt][4 * g] * f, O[tt][4 * g + 1] * f); o.y = pk2(O[tt][4 * g + 2] * f, O[tt][4 * g + 3] * f);
                        *(u32x2*)(orow + 32 * tt + 8 * g) = o; }
            }
            flash_run<128>(smem, QB + (((size_t)b * NQU + 2 * hd) * TPB + p) * 64, KB + ((size_t)b * NKU + 2 * hd) * TPB * 64, V, ncx, 0, 0, tq, -1e30f, 0.f, O, lt);
            {
                int l2_ = t & 63; asm volatile("" : "+v"(l2_)); const int h2 = l2_ >> 5; bf16_t* orow = MIX + (size_t)(b * TPB + p0q + wave * 32 + (l2_ & 31)) * DM + hd * 128 + 4 * h2;
                const float f = 1.f / lt; float ss = 0.f;
#pragma unroll
                for (int tt = 0; tt < 4; ++tt)
#pragma unroll
                    for (int g = 0; g < 4; ++g) {
                        const u32x2 st = *(const u32x2*)(orow + 32 * tt + 8 * g);
                        O[tt][4 * g + 0] = O[tt][4 * g + 0] * f + __uint_as_float(st.x << 16);
                        O[tt][4 * g + 1] = O[tt][4 * g + 1] * f + __uint_as_float(st.x & 0xffff0000u);
                        O[tt][4 * g + 2] = O[tt][4 * g + 2] * f + __uint_as_float(st.y << 16);
                        O[tt][4 * g + 3] = O[tt][4 * g + 3] * f + __uint_as_float(st.y & 0xffff0000u);
                        ss += (O[tt][4 * g] * O[tt][4 * g] + O[tt][4 * g + 1] * O[tt][4 * g + 1]) + (O[tt][4 * g + 2] * O[tt][4 * g + 2] + O[tt][4 * g + 3] * O[tt][4 * g + 3]);
                    }
                ss += __shfl_xor(ss, 32);
                const float r = rsqrtf(ss * (1.f / 128.f) + RMS_EPS) * (1.f - lambda_init);
                const float* sg = P.subln_g + l * 128 + 4 * h2;
#pragma unroll
                for (int tt = 0; tt < 4; ++tt)
#pragma unroll
                    for (int g = 0; g < 4; ++g) { const f32x4 gg = *(const f32x4*)(sg + 32 * tt + 8 * g);
                        u32x2 o; o.x = pk2(O[tt][4 * g] * r * gg.x, O[tt][4 * g + 1] * r * gg.y); o.y = pk2(O[tt][4 * g + 2] * r * gg.z, O[tt][4 * g + 3] * r * gg.w);
                        *(u32x2*)(orow + 32 * tt + 8 * g) = o; }
            }
        } else {
            const bool isC = ty == 2;
            f32x16 O[2]; float lt;
            const int qu = (isC ? 12 : 8) + hd, ku = (isC ? 10 : 8) + (hd >> 1);
            const bf16_t* V = VT + (size_t)b * VS + (size_t)4 * TPB * 128 + (size_t)((isC ? 2 : 0) + (hd >> 1)) * TPB * 64;
            int n1 = ncx, base2 = 0, n2 = 0;
            float m0 = -1e30f, l0 = 0.f;
            if (isC) {
                m0 = P.sink[l * 4 + hd] * 1.4426950408889634f; l0 = h == 0 ? 1.f : 0.f;
                if (!isctx) { const int n = (p0q - CTXL) >> 8; n1 = CTXL / 64; const int jlo = n == 0 ? 2 : 0, jhi = n == 7 ? 6 : 8;
                    base2 = CTXL + 256 * n - 128 + 64 * jlo; n2 = jhi - jlo; }
            }
            flash_run<64>(smem, QB + (((size_t)b * NQU + qu) * TPB + p) * 64, KB + ((size_t)b * NKU + ku) * TPB * 64, V, n1, base2, n2, tq, m0, l0, O, lt);
            const float f = 1.f / lt;
            int l2_ = t & 63; asm volatile("" : "+v"(l2_)); const int h2 = l2_ >> 5; bf16_t* orow = MIX + (size_t)(b * TPB + p0q + wave * 32 + (l2_ & 31)) * DM + (isC ? 768 : 512) + hd * 64 + 4 * h2;
#pragma unroll
            for (int tt = 0; tt < 2; ++tt)
#pragma unroll
                for (int g = 0; g < 4; ++g) { u32x2 o; o.x = pk2(O[tt][4 * g] * f, O[tt][4 * g + 1] * f); o.y = pk2(O[tt][4 * g + 2] * f, O[tt][4 * g + 3] * f);
                    *(u32x2*)(orow + 32 * tt + 8 * g) = o; }
        }
        if (it >= 768) {
            asm volatile("s_waitcnt vmcnt(0)" ::: "memory");
            __syncthreads();
            if (t == 0) { __builtin_amdgcn_fence(__ATOMIC_RELEASE, "agent"); asm volatile("s_waitcnt vmcnt(0)" ::: "memory");
                __hip_atomic_fetch_add((int*)(P.ws + OFF_RDYC) + ((it - 768) / 12) * 64, 1, __ATOMIC_RELAXED, __HIP_MEMORY_SCOPE_AGENT); }
        }
    }
    if (l == 0 && ctx_early(nb) && bid >= CTX_EARLY_LO && bid < CTX_EARLY_LO + CTX_EARLY_N) outproj_run(P, 0, 2, bid - CTX_EARLY_LO, nb, smem);
}

DI void phase_norm2_route(const Params& P, int l, int bid, int nb, char* smem) {
    const int t = threadIdx.x, lane = t & 63, wave = t >> 6;
    int* lcnt = (int*)(smem + LDS_MISC);
    int* lbase = lcnt + 16;
    int* rec = lcnt + 32;
    int* rec2 = rec + 160;
    __syncthreads();
    {
        int ts = t;
        asm volatile("" : "+v"(ts));
        f32x4 wv[4096 / NTHREADS];
#pragma unroll
        for (int i = 0; i < 4096 / NTHREADS; ++i) { const int idx = ts + NTHREADS * i; wv[i] = *(const f32x4*)(P.w_router + (idx >> 2) * 16 + (idx & 3) * 4); }
#pragma unroll
        for (int i = 0; i < 4096 / NTHREADS; ++i) { const int idx = ts + NTHREADS * i, k = idx >> 2, q = idx & 3;
            const int row = ((k >> 8) * 4 + (k & 3)) * 64 + ((k >> 2) & 63);
            *(f32x4*)(smem + row * 64 + ((q ^ ((row >> 2) & 3)) << 4)) = wv[i]; }
    }
    if (t < 16) lcnt[t] = 0;
    __syncthreads();
    bf16_t* HX = (bf16_t*)(P.ws + OFF_HX);
    int* cnt = (int*)(P.ws + OFF_CNT) + l * 16 * 64;
    int* list = (int*)(P.ws + OFF_LIST);
    float* tokw = (float*)(P.ws + OFF_TOKW);
    const int per = (NTOK + nb - 1) / nb;
    const int tk0 = bid * per, tk1 = min(NTOK, tk0 + per), ntk = tk1 - tk0;
    const int eme = ((lane >> 5) & 1) * 8 + ((lane >> 4) & 1) * 4 + ((lane >> 3) & 1) * 2 + ((lane >> 2) & 1);
    const float mybias = P.router_bias[eme];
    f32x4 v[4], vn[4], gs[4], hs[4];
    int cur_mr = -1;
    if (wave < ntk) { const int tok = tk0 + wave, b = tok / TPB, p = tok % TPB; const f32x4* xr = (const f32x4*)resid_row(P, b, p) + lane;
#pragma unroll
        for (int j = 0; j < 4; ++j) vn[j] = xr[64 * j]; }
    for (int i = wave; i < ntk; i += NW) {
        const int tok = tk0 + i;
        const int b = tok / TPB, p = tok % TPB, mr = p < CTXL ? 8 : b;
#pragma unroll
        for (int j = 0; j < 4; ++j) v[j] = vn[j];
        if (i + NW < ntk) { const int tk2 = tok + NW, b2 = tk2 / TPB, p2 = tk2 % TPB; const f32x4* xr = (const f32x4*)resid_row(P, b2, p2) + lane;
#pragma unroll
            for (int j = 0; j < 4; ++j) vn[j] = xr[64 * j]; }
        if (l == 1 && p < CTXL) { if (lane == 0) rec[i] = -1; continue; }
        float ss = 0.f;
#pragma unroll
        for (int j = 0; j < 4; ++j) ss += (v[j].x * v[j].x + v[j].y * v[j].y) + (v[j].z * v[j].z + v[j].w * v[j].w);
        const float r = rsqrtf(wave_sum(ss) * (1.f / DM) + RMS_EPS);
        if (mr != cur_mr) {
            const float* md = mod_row(P, l, mr);
            const f32x4* gn = (const f32x4*)(P.norm2_g + l * DM) + lane;
            const f32x4* sh = (const f32x4*)(md + 3072) + lane;
            const f32x4* sc = (const f32x4*)(md + 4096) + lane;
#pragma unroll
            for (int j = 0; j < 4; ++j) { const f32x4 g = gn[64 * j], s1 = sc[64 * j]; gs[j] = g * (1.f + s1); hs[j] = sh[64 * j]; }
            cur_mr = mr;
        }
        u32x2* o = (u32x2*)(HX + (size_t)tok * DM) + lane;
        float lg[16];
#pragma unroll
        for (int e = 0; e < 16; ++e) lg[e] = 0.f;
#pragma unroll
        for (int j = 0; j < 4; ++j) {
            float y[4];
            y[0] = v[j].x * r * gs[j].x + hs[j].x; y[1] = v[j].y * r * gs[j].y + hs[j].y;
            y[2] = v[j].z * r * gs[j].z + hs[j].z; y[3] = v[j].w * r * gs[j].w + hs[j].w;
            u32x2 w; w.x = pk2(y[0], y[1]); w.y = pk2(y[2], y[3]);
            o[64 * j] = w;
#pragma unroll
            for (int cc = 0; cc < 4; ++cc) {
                const int row = (j * 4 + cc) * 64 + lane;
#pragma unroll
                for (int q = 0; q < 4; ++q) {
                    const f32x4 wv = *(const f32x4*)(smem + row * 64 + ((q ^ ((row >> 2) & 3)) << 4));
                    lg[4 * q + 0] += y[cc] * wv.x; lg[4 * q + 1] += y[cc] * wv.y; lg[4 * q + 2] += y[cc] * wv.z; lg[4 * q + 3] += y[cc] * wv.w;
                }
            }
        }
        float a8[8], a4[4], a2[2], a1;
        { const bool hi = lane & 32;
#pragma unroll
          for (int j = 0; j < 8; ++j) { const float keep = hi ? lg[8 + j] : lg[j], send = hi ? lg[j] : lg[8 + j]; a8[j] = keep + __shfl_xor(send, 32); } }
        { const bool hi = lane & 16;
#pragma unroll
          for (int j = 0; j < 4; ++j) { const float keep = hi ? a8[4 + j] : a8[j], send = hi ? a8[j] : a8[4 + j]; a4[j] = keep + __shfl_xor(send, 16); } }
        { const bool hi = lane & 8;
#pragma unroll
          for (int j = 0; j < 2; ++j) { const float keep = hi ? a4[2 + j] : a4[j], send = hi ? a4[j] : a4[2 + j]; a2[j] = keep + __shfl_xor(send, 8); } }
        { const bool hi = lane & 4; const float keep = hi ? a2[1] : a2[0], send = hi ? a2[0] : a2[1]; a1 = keep + __shfl_xor(send, 4); }
        a1 += __shfl_xor(a1, 2); a1 += __shfl_xor(a1, 1);
        const float mysc = 1.f / (1.f + expf(-a1)), mysel = mysc + mybias;
        float scv[16], sel[16];
#pragma unroll
        for (int e = 0; e < 16; ++e) { const int src = ((e >> 3) & 1) * 32 + ((e >> 2) & 1) * 16 + ((e >> 1) & 1) * 8 + (e & 1) * 4;
            scv[e] = __int_as_float(__builtin_amdgcn_readlane(__float_as_int(mysc), src)); sel[e] = __int_as_float(__builtin_amdgcn_readlane(__float_as_int(mysel), src)); }
        float bestg = -1e30f; int be1 = 0, be2 = 1; float bw1 = 0.f, bw2 = 0.f;
#pragma unroll
        for (int g = 0; g < 4; ++g) {
            int i1 = 0; float v1 = sel[4 * g], w1 = scv[4 * g];
#pragma unroll
            for (int j = 1; j < 4; ++j) if (sel[4 * g + j] > v1) { v1 = sel[4 * g + j]; w1 = scv[4 * g + j]; i1 = j; }
            int i2 = -1; float v2 = -1e30f, w2 = 0.f;
#pragma unroll
            for (int j = 0; j < 4; ++j) if (j != i1 && sel[4 * g + j] > v2) { v2 = sel[4 * g + j]; w2 = scv[4 * g + j]; i2 = j; }
            const float gs = v1 + v2;
            if (gs > bestg) { bestg = gs; be1 = 4 * g + i1; be2 = 4 * g + i2; bw1 = w1; bw2 = w2; }
        }
        if (lane == 0) {
            const float inv = 1.f / (bw1 + bw2);
            const int r1 = atomicAdd(&lcnt[be1], 1), r2 = atomicAdd(&lcnt[be2], 1);
            rec[i] = be1 | (be2 << 8) | (r1 << 16); rec2[i] = r2;
            tokw[2 * tok] = bw1 * inv; tokw[2 * tok + 1] = bw2 * inv;
        }
    }
    __syncthreads();
    if (t < 16) { const int c = lcnt[t]; lbase[t] = c ? atomicAdd(&cnt[t * 64], c) : 0; }
    __syncthreads();
    for (int i = t; i < ntk; i += NTHREADS) {
        const int rc = rec[i];
        if (rc >= 0) { const int e1 = rc & 255, e2 = (rc >> 8) & 255, r1 = rc >> 16, r2 = rec2[i], tok = tk0 + i;
            list[e1 * NTOK + lbase[e1] + r1] = 2 * tok; list[e2 * NTOK + lbase[e2] + r2] = 2 * tok + 1; }
    }
}

struct SchedOut {
    const bf16_t *A, *Wt; int G, c, mode;
    int* rdyc;
    static constexpr bool GATHER = false;
    DI void a_ready(const g8::Unit& u) const {
        if (mode != 2) return;
        if (__builtin_amdgcn_readfirstlane(threadIdx.x >> 6) == 0) {
            unsigned sp = 0;
            while (__hip_atomic_load(rdyc + (u.a / 9) * 64, __ATOMIC_RELAXED, __HIP_MEMORY_SCOPE_AGENT) < 12) { __builtin_amdgcn_s_sleep(2); if (++sp > (1u << 22)) break; }
            __builtin_amdgcn_fence(__ATOMIC_ACQUIRE, "agent");
            asm volatile("s_waitcnt vmcnt(0)" ::: "memory");
        }
        __builtin_amdgcn_s_barrier();
    }
    DI bool next(int i, g8::Unit& u) const {
        int pm, pn;
        if (mode == 2) { if (i != 0) return false; pm = 9 * (c >> 2); pn = c & 3; }
        else { if (!g8::static_unit(i, G, c, mode == 0 ? 72 : 64, 4, pm, pn)) return false; if (mode == 1) pm = 9 * (pm >> 3) + 1 + (pm & 7); }
        u.a = pm; u.b = pn; u.c = 0; u.d = 0; u.bt = Wt + (size_t)pn * 256 * DM; return true; }
    DI const bf16_t* a_base(const g8::Unit& u) const { return A + (size_t)u.a * 256 * DM; }
};
struct EpiOut {
    static constexpr bool AFTER_DRAIN = false;
    const float *x, *ctx; float *out, *xc; const float* mod; int l;
    DI void operator()(const f32x4 (&acc)[2][2][4][2], const g8::Unit& u, int wr, int wc, int fr, int fq) const {
        const int tok0 = u.a * 256, b = tok0 / TPB, p0 = tok0 % TPB;
        const bool isctx = p0 == 0;
        const float* g1 = mod + (size_t)(l * 9 + (isctx ? 8 : b)) * 6144 + 2048 + u.b * 256 + 32 * wc + 4 * fq;
        f32x4 g4[2][2];
#pragma unroll
        for (int bj = 0; bj < 2; ++bj)
#pragma unroll
            for (int n = 0; n < 2; ++n) g4[bj][n] = *(const f32x4*)(g1 + 128 * bj + 16 * n);
        const int cb = u.b * 256 + 32 * wc + 4 * fq;
#pragma unroll
        for (int ai = 0; ai < 2; ++ai)
#pragma unroll
            for (int m = 0; m < 4; ++m) {
                const int r = 128 * ai + 64 * wr + 16 * m + fr;
                const size_t ro = isctx ? (size_t)(b * CTXL + r) * DM : (size_t)(b * SEQ + p0 - CTXL + r) * DM;
                const float* xin = (l == 0 ? (isctx ? ctx : x) : (isctx ? xc : out)) + ro + cb;
                float* xo = (isctx ? xc : out) + ro + cb;
#pragma unroll
                for (int bj = 0; bj < 2; ++bj)
#pragma unroll
                    for (int n = 0; n < 2; ++n) { const f32x4 xv = *(const f32x4*)(xin + 128 * bj + 16 * n); *(f32x4*)(xo + 128 * bj + 16 * n) = xv + g4[bj][n] * acc[ai][bj][m][n]; }
                if (m & 1) asm volatile("" ::: "memory");
            }
    }
};
struct EpiOutF {
    static constexpr bool AFTER_DRAIN = true;
    const Params& P; int l;
    DI void operator()(const f32x4 (&)[2][2][4][2], const g8::Unit&, int, int, int, int) const {}
    DI void fused(f32x4 (&acc)[2][2][4][2], const g8::Unit& u, int wr, int wc, int fr, int fq, char* smem) const {
        const int tid = threadIdx.x;
        const int tok0 = u.a * 256, b = tok0 / TPB, p0 = tok0 % TPB, pn = u.b;
        const bool isctx = p0 == 0;
        const int mr = isctx ? 8 : b;
        const float* md = mod_row(P, l, mr);
        const int cb = pn * 256 + 32 * wc + 4 * fq;
        float* part = (float*)smem;
        float* rt = part + 256 * 4 * 17;
        int* lcnt = (int*)(rt + 256);
        int* lbase = lcnt + 16;
        const float* wtab = (const float*)(smem + LDS_MISC);
        float* xc = (float*)(P.ws + OFF_XC);
        {
            f32x4 g4[2][2];
#pragma unroll
            for (int bj = 0; bj < 2; ++bj)
#pragma unroll
                for (int n = 0; n < 2; ++n) g4[bj][n] = *(const f32x4*)(md + 2048 + cb + 128 * bj + 16 * n);
#pragma unroll
            for (int ai = 0; ai < 2; ++ai)
#pragma unroll
                for (int m = 0; m < 4; ++m) {
                    const int r = 128 * ai + 64 * wr + 16 * m + fr;
                    const size_t ro = isctx ? (size_t)(b * CTXL + r) * DM : (size_t)(b * SEQ + p0 - CTXL + r) * DM;
                    const float* xin = (l == 0 ? (isctx ? P.ctx : P.x) : (isctx ? xc : P.out)) + ro + cb;
                    float* xo = (isctx ? xc : P.out) + ro + cb;
#pragma unroll
                    for (int bj = 0; bj < 2; ++bj)
#pragma unroll
                        for (int n = 0; n < 2; ++n) { const f32x4 xv = *(const f32x4*)(xin + 128 * bj + 16 * n); acc[ai][bj][m][n] = xv + g4[bj][n] * acc[ai][bj][m][n]; *(f32x4*)(xo + 128 * bj + 16 * n) = acc[ai][bj][m][n]; }
                    if (m & 1) asm volatile("" ::: "memory");
                }
        }
        {
            float wb[2][2][4];
#pragma unroll
            for (int bj = 0; bj < 2; ++bj)
#pragma unroll
                for (int n = 0; n < 2; ++n)
#pragma unroll
                    for (int r = 0; r < 4; ++r) wb[bj][n][r] = wtab[(128 * bj + 32 * wc + 16 * n + 4 * fq + r) * 16 + fr];
#pragma unroll
            for (int ai = 0; ai < 2; ++ai)
#pragma unroll
                for (int m = 0; m < 4; ++m) {
                    f32x4 d = {0.f, 0.f, 0.f, 0.f}; float ss = 0.f;
#pragma unroll
                    for (int bj = 0; bj < 2; ++bj)
#pragma unroll
                        for (int n = 0; n < 2; ++n) { const f32x4 v = acc[ai][bj][m][n];
                            ss += (v.x * v.x + v.y * v.y) + (v.z * v.z + v.w * v.w);
                            d = __builtin_amdgcn_mfma_f32_16x16x4f32(v.x, wb[bj][n][0], d, 0, 0, 0);
                            d = __builtin_amdgcn_mfma_f32_16x16x4f32(v.y, wb[bj][n][1], d, 0, 0, 0);
                            d = __builtin_amdgcn_mfma_f32_16x16x4f32(v.z, wb[bj][n][2], d, 0, 0, 0);
                            d = __builtin_amdgcn_mfma_f32_16x16x4f32(v.w, wb[bj][n][3], d, 0, 0, 0); }
                    ss += __shfl_xor(ss, 16); ss += __shfl_xor(ss, 32);
                    const int rowb = 128 * ai + 64 * wr + 16 * m;
                    part[((rowb + 4 * fq + 0) * 4 + wc) * 17 + fr] = d.x;
                    part[((rowb + 4 * fq + 1) * 4 + wc) * 17 + fr] = d.y;
                    part[((rowb + 4 * fq + 2) * 4 + wc) * 17 + fr] = d.z;
                    part[((rowb + 4 * fq + 3) * 4 + wc) * 17 + fr] = d.w;
                    if (fq == 0) part[((rowb + fr) * 4 + wc) * 17 + 16] = ss;
                }
        }
        __syncthreads();
        float* xch = (float*)(P.ws + OFF_XCH) + (size_t)u.a * 4 * 256 * 17;
        { float* dst = xch + (size_t)pn * 256 * 17;
          for (int i = tid; i < 256 * 17; i += NTHREADS) { const int row = i / 17, e = i - row * 17; const float* pp = part + row * 68 + e; __hip_atomic_store(dst + i, (pp[0] + pp[17]) + (pp[34] + pp[51]), __ATOMIC_RELAXED, __HIP_MEMORY_SCOPE_AGENT); } }
        asm volatile("s_waitcnt vmcnt(0)" ::: "memory");
        __syncthreads();
        if (tid == 0) {
            int* xcn = (int*)(P.ws + OFF_XCNT) + (l * 72 + u.a) * 64;
            __hip_atomic_fetch_add(xcn, 1, __ATOMIC_RELAXED, __HIP_MEMORY_SCOPE_AGENT);
            unsigned sp = 0;
            while (__hip_atomic_load(xcn, __ATOMIC_RELAXED, __HIP_MEMORY_SCOPE_AGENT) < 4) { __builtin_amdgcn_s_sleep(1); if (++sp > (1u << 22)) break; }
            __builtin_amdgcn_fence(__ATOMIC_ACQUIRE, "agent");
            asm volatile("s_waitcnt vmcnt(0)" ::: "memory");
        }
        if (tid >= 64 && tid < 80) lcnt[tid - 64] = 0;
        __syncthreads();
        if (tid < 256) { float sq = 0.f;
#pragma unroll
            for (int q = 0; q < 4; ++q) sq += xch[(size_t)(q * 256 + tid) * 17 + 16];
            rt[tid] = rsqrtf(sq * (1.f / DM) + RMS_EPS); }
        __syncthreads();
        {
            f32x4 gs[2][2], hs[2][2];
#pragma unroll
            for (int bj = 0; bj < 2; ++bj)
#pragma unroll
                for (int n = 0; n < 2; ++n) { const int c = cb + 128 * bj + 16 * n;
                    const f32x4 g = *(const f32x4*)(P.norm2_g + l * DM + c), s1 = *(const f32x4*)(md + 4096 + c);
                    gs[bj][n] = g * (1.f + s1); hs[bj][n] = *(const f32x4*)(md + 3072 + c); }
            bf16_t* HX = (bf16_t*)(P.ws + OFF_HX);
#pragma unroll
            for (int ai = 0; ai < 2; ++ai)
#pragma unroll
                for (int m = 0; m < 4; ++m) {
                    const int row = 128 * ai + 64 * wr + 16 * m + fr;
                    const float r = rt[row];
                    bf16_t* o = HX + (size_t)(tok0 + row) * DM + cb;
#pragma unroll
                    for (int bj = 0; bj < 2; ++bj)
#pragma unroll
                        for (int n = 0; n < 2; ++n) { const f32x4 v = acc[ai][bj][m][n], g = gs[bj][n], h = hs[bj][n];
                            u32x2 w; w.x = pk2(v.x * r * g.x + h.x, v.y * r * g.y + h.y); w.y = pk2(v.z * r * g.z + h.z, v.w * r * g.w + h.w);
                            *(u32x2*)(o + 128 * bj + 16 * n) = w; }
                }
        }
        int be1 = 0, be2 = 1, r1 = 0, r2 = 0;
        const int rrow = 64 * pn + tid, rtok = tok0 + rrow;
        if (tid < 64) {
            const float r = rt[rrow];
            float lg[16];
#pragma unroll
            for (int e = 0; e < 16; ++e) lg[e] = 0.f;
#pragma unroll
            for (int q = 0; q < 4; ++q) { const float* sp = xch + (size_t)(q * 256 + rrow) * 17;
#pragma unroll
                for (int e = 0; e < 16; ++e) lg[e] += sp[e]; }
            const float* qe = (const float*)(P.ws + OFF_QE) + (l * 9 + mr) * 16;
            float scv[16], sel[16];
#pragma unroll
            for (int e = 0; e < 16; ++e) { const float a = lg[e] * r + qe[e]; scv[e] = 1.f / (1.f + expf(-a)); sel[e] = scv[e] + P.router_bias[e]; }
            float bestg = -1e30f; float bw1 = 0.f, bw2 = 0.f;
#pragma unroll
            for (int g = 0; g < 4; ++g) {
                int i1 = 0; float v1 = sel[4 * g], w1 = scv[4 * g];
#pragma unroll
                for (int j = 1; j < 4; ++j) if (sel[4 * g + j] > v1) { v1 = sel[4 * g + j]; w1 = scv[4 * g + j]; i1 = j; }
                int i2 = -1; float v2 = -1e30f, w2 = 0.f;
#pragma unroll
                for (int j = 0; j < 4; ++j) if (j != i1 && sel[4 * g + j] > v2) { v2 = sel[4 * g + j]; w2 = scv[4 * g + j]; i2 = j; }
                const float gsum = v1 + v2;
                if (gsum > bestg) { bestg = gsum; be1 = 4 * g + i1; be2 = 4 * g + i2; bw1 = w1; bw2 = w2; }
            }
            const float inv = 1.f / (bw1 + bw2);
            r1 = atomicAdd(&lcnt[be1], 1); r2 = atomicAdd(&lcnt[be2], 1);
            float* tokw = (float*)(P.ws + OFF_TOKW);
            tokw[2 * rtok] = bw1 * inv; tokw[2 * rtok + 1] = bw2 * inv;
        }
        __syncthreads();
        if (tid < 16) { const int c = lcnt[tid]; int* cnt = (int*)(P.ws + OFF_CNT) + l * 16 * 64; lbase[tid] = c ? atomicAdd(&cnt[tid * 64], c) : 0; }
        __syncthreads();
        if (tid < 64) { int* list = (int*)(P.ws + OFF_LIST);
            list[be1 * NTOK + lbase[be1] + r1] = 2 * rtok; list[be2 * NTOK + lbase[be2] + r2] = 2 * rtok + 1; }
        __syncthreads();
    }
};
DI bool route_fused(int nb) { return nb == 256; }
DI void outproj_run(const Params& P, int l, int mode, int c, int nb, char* smem) {
    SchedOut S{(const bf16_t*)(P.ws + OFF_HX), (const bf16_t*)(P.ws + OFF_WOUT) + (size_t)l * DM * DM, nb, c, mode, (int*)(P.ws + OFF_RDYC)};
    if (route_fused(nb) && mode != 0) {
        g8::Unit u;
        if (S.next(0, u)) {
            const int tok0 = u.a * 256, mr = (tok0 % TPB == 0) ? 8 : tok0 / TPB;
            const float* md = mod_row(P, l, mr);
            float* wtab = (float*)(smem + LDS_MISC);
#pragma unroll
            for (int i = 0; i < 2; ++i) { const int idx = threadIdx.x + NTHREADS * i, cc = idx >> 2, q = idx & 3, col = u.b * 256 + cc;
                const float g = P.norm2_g[l * DM + col] * (1.f + md[4096 + col]);
                *(f32x4*)(wtab + cc * 16 + 4 * q) = g * *(const f32x4*)(P.w_router + col * 16 + 4 * q); }
        }
        EpiOutF E{P, l};
        g8::gemm_phase(smem, (const bf16_t*)(P.ws + OFF_HX), DM, S, E);
        return;
    }
    EpiOut E{P.x, P.ctx, P.out, (float*)(P.ws + OFF_XC), (const float*)(P.ws + OFF_MOD), l};
    g8::gemm_phase(smem, (const bf16_t*)(P.ws + OFF_HX), DM, S, E);
}
DI void phase_outproj(const Params& P, int l, int bid, int nb, char* smem) {
    outproj_run(P, l, (l == 1 || ctx_early(nb)) ? 1 : 0, bid, nb, smem);
}

constexpr int MAX_RT = 2 * NTOK / 256 + NEXP;
DI void build_tile_table(const int* cnt, char* smem) {
    int* cl = (int*)(smem + LDS_MISC);
    int* tab = cl + 16;
    const int t = threadIdx.x;
    __syncthreads();
    if (t < NEXP) cl[t] = cnt[t * 64];
    __syncthreads();
    if (t < MAX_RT) {
        int acc = 0, e = 0, ti = 0, n = 0, ok = 0;
#pragma unroll
        for (int i = 0; i < NEXP; ++i) { const int c = cl[i], nt = (c + 255) >> 8; const bool hit = !ok && t < acc + nt;
            e = hit ? i : e; ti = hit ? t - acc : ti; n = hit ? c : n; ok = hit ? 1 : ok; acc += nt; }
        tab[4 * t] = e; tab[4 * t + 1] = ti; tab[4 * t + 2] = n; tab[4 * t + 3] = ok;
    }
    __syncthreads();
}
DI bool expert_tile(const char* smem, int rt, int& e, int& ti, int& hbase, int& n) {
    if (rt >= MAX_RT) return false;
    const int* tab = (const int*)(smem + LDS_MISC) + 16 + 4 * rt;
    e = __builtin_amdgcn_readfirstlane(tab[0]); ti = __builtin_amdgcn_readfirstlane(tab[1]); n = __builtin_amdgcn_readfirstlane(tab[2]); hbase = rt * 256;
    return __builtin_amdgcn_readfirstlane(tab[3]) != 0;
}

struct SchedGU {
    const bf16_t* W; const char* tabs; const int* list; int G, c;
    static constexpr bool GATHER = true;
    DI void a_ready(const g8::Unit&) const {}
    DI bool next(int i, g8::Unit& u) const { const int w = i * G + c, rt = w >> 1, ct = w & 1; int e, ti, hb, n; if (!expert_tile(tabs, rt, e, ti, hb, n)) return false;
        u.a = e; u.b = ti | (ct << 16); u.c = hb; u.d = n; u.bt = W + ((size_t)e * 512 + ct * 256) * DM; return true; }
    DI void a_offsets(const g8::Unit& u, const int (&R)[2], const int (&C)[2], unsigned (&av)[2][2]) const {
        const int ti = u.b & 0xffff;
#pragma unroll
        for (int hh = 0; hh < 2; ++hh)
#pragma unroll
            for (int i = 0; i < 2; ++i) { const int li = ti * 256 + 128 * hh + R[i]; const int slot = li < u.d ? list[u.a * NTOK + li] : 0;
                av[hh][i] = (unsigned)((slot >> 1) * DM + C[i]) * 2u; }
    }
};
struct EpiGU {
    static constexpr bool AFTER_DRAIN = false;
    bf16_t* HB;
    DI void operator()(const f32x4 (&acc)[2][2][4][2], const g8::Unit& u, int wr, int wc, int fr, int fq) const {
        const int ct = u.b >> 16;
        bf16_t* hb = HB + (size_t)(u.c + 64 * wr + fr) * DEXP + 128 * ct + 32 * wc + 4 * fq;
#pragma unroll
        for (int ai = 0; ai < 2; ++ai)
#pragma unroll
            for (int m = 0; m < 4; ++m)
#pragma unroll
                for (int n = 0; n < 2; ++n) {
                    const f32x4 g = acc[ai][0][m][n], uu = acc[ai][1][m][n];
                    f32x4 hv;
                    hv.x = g.x / (1.f + __expf(-g.x)) * uu.x; hv.y = g.y / (1.f + __expf(-g.y)) * uu.y; hv.z = g.z / (1.f + __expf(-g.z)) * uu.z; hv.w = g.w / (1.f + __expf(-g.w)) * uu.w;
                    u32x2 o; o.x = pk2(hv.x, hv.y); o.y = pk2(hv.z, hv.w);
                    *(u32x2*)(hb + (size_t)(128 * ai + 16 * m) * DEXP + 16 * n) = o;
                }
    }
};
DI void phase_gateup(const Params& P, int l, int bid, int nb, char* smem) {
    build_tile_table((const int*)(P.ws + OFF_CNT) + l * 16 * 64, smem);
    SchedGU S{(const bf16_t*)(P.ws + OFF_WGU) + (size_t)l * 16 * 512 * DM, smem, (const int*)(P.ws + OFF_LIST), nb, bid};
    EpiGU E{(bf16_t*)(P.ws + OFF_HB)};
    g8::gemm_phase(smem, (const bf16_t*)(P.ws + OFF_HX), DM, S, E);
}

struct SchedDown {
    const bf16_t *A, *W; const char* tabs; int G, c;
    static constexpr bool GATHER = false;
    DI void a_ready(const g8::Unit&) const {}
    DI bool next(int i, g8::Unit& u) const { const int w = i * G + c, rt = w >> 2, ct = w & 3; int e, ti, hb, n; if (!expert_tile(tabs, rt, e, ti, hb, n)) return false;
        u.a = e; u.b = ti | (ct << 16); u.c = hb; u.d = n; u.bt = W + ((size_t)e * DM + ct * 256) * DEXP; return true; }
    DI const bf16_t* a_base(const g8::Unit& u) const { return A + (size_t)u.c * DEXP; }
};
struct EpiDown {
    static constexpr bool AFTER_DRAIN = false;
    bf16_t* Y; const int* list; const float* tokw;
    DI void operator()(const f32x4 (&acc)[2][2][4][2], const g8::Unit& u, int wr, int wc, int fr, int fq) const {
        const int ti = u.b & 0xffff, ct = u.b >> 16;
#pragma unroll
        for (int ai = 0; ai < 2; ++ai)
#pragma unroll
            for (int m = 0; m < 4; ++m) {
                const int li = ti * 256 + 128 * ai + 64 * wr + 16 * m + fr;
                if (li < u.d) {
                    const int slot = list[u.a * NTOK + li]; const float wg = tokw[slot];
                    bf16_t* yr = Y + (size_t)slot * DM + 256 * ct + 32 * wc + 4 * fq;
#pragma unroll
                    for (int bj = 0; bj < 2; ++bj)
#pragma unroll
                        for (int n = 0; n < 2; ++n) { const f32x4 v = acc[ai][bj][m][n]; u32x2 o; o.x = pk2(wg * v.x, wg * v.y); o.y = pk2(wg * v.z, wg * v.w);
                            *(u32x2*)(yr + 128 * bj + 16 * n) = o; }
                }
            }
    }
};
DI void phase_down(const Params& P, int l, int bid, int nb, char* smem) {
    build_tile_table((const int*)(P.ws + OFF_CNT) + l * 16 * 64, smem);
    SchedDown S{(const bf16_t*)(P.ws + OFF_HB), (const bf16_t*)(P.ws + OFF_WD) + (size_t)l * 16 * DM * DEXP, smem, nb, bid};
    EpiDown E{(bf16_t*)(P.ws + OFF_Y), (const int*)(P.ws + OFF_LIST), (const float*)(P.ws + OFF_TOKW)};
    g8::gemm_phase(smem, (const bf16_t*)(P.ws + OFF_HB), DEXP, S, E);
}

#define XB_TMO      128
#define XB_XCNT(j)  (256  + 64 * (j))
#define XB_XSUB(j)  (1280 + 64 * (j))
#define XB_XGEN(j)  (2304 + 64 * (j))
#define XB_TOP      3328
#define XB_TOPGEN   3392
#define XCD_BAR_WORDS 3456
#define XB_SPIN_CAP (1u << 20)
DI unsigned xb_ld(unsigned* p)              { return __hip_atomic_load(p, __ATOMIC_RELAXED, __HIP_MEMORY_SCOPE_AGENT); }
DI unsigned xb_add(unsigned* p, unsigned v) { return __hip_atomic_fetch_add(p, v, __ATOMIC_RELAXED, __HIP_MEMORY_SCOPE_AGENT); }
DI unsigned xb_xcc_id() { return (unsigned)__builtin_amdgcn_s_getreg((3 << 11) | 20) & 0xFu; }
#define XB_SPIN(cond, bar) do { unsigned _sp = 0; while (cond) { __builtin_amdgcn_s_sleep(1); \
    if ((++_sp & 255u) == 0u) { if (xb_ld(&(bar)[XB_TMO])) break; if (_sp > XB_SPIN_CAP) { atomicAdd(&(bar)[XB_TMO], 1u); break; } } } } while (0)
struct XcdBarrier { unsigned* bar; unsigned x; volatile LAS unsigned* st; };
DI XcdBarrier xcd_barrier_post(unsigned* bar, volatile LAS unsigned* st) {
    XcdBarrier b; b.bar = bar; b.x = xb_xcc_id(); b.st = st;
    if (threadIdx.x == 0) (void)xb_add(&bar[XB_XCNT(b.x)], 1u);
    return b;
}
DI void xcd_barrier_complete(unsigned* bar, unsigned x, unsigned& nloc, unsigned& nx) {
    const unsigned G = gridDim.x * gridDim.y * gridDim.z;
    unsigned sum, cnt, mine, sp = 0u;
    for (;;) {
        sum = 0u; cnt = 0u; mine = 0u;
#pragma unroll
        for (unsigned j = 0; j < 16; ++j) { const unsigned c = xb_ld(&bar[XB_XCNT(j)]); sum += c; cnt += (c > 0u) ? 1u : 0u; mine = (j == x) ? c : mine; }
        if (sum == G) break;
        __builtin_amdgcn_s_sleep(1);
        if ((++sp & 255u) == 0u) { if (xb_ld(&bar[XB_TMO])) break; if (sp > XB_SPIN_CAP) { atomicAdd(&bar[XB_TMO], 1u); break; } }
    }
    nloc = mine > 0u ? mine : 1u; nx = cnt > 0u ? cnt : 1u;
}
DI void xcd_barrier(const XcdBarrier& b) {
    asm volatile("s_waitcnt vmcnt(0)" ::: "memory");
    __syncthreads();
    if (threadIdx.x == 0) {
        unsigned* bar = b.bar;
        __builtin_amdgcn_s_waitcnt(0);
        unsigned nloc = b.st[0], nx = b.st[1];
        if (nloc == 0u) { xcd_barrier_complete(bar, b.x, nloc, nx); b.st[0] = nloc; b.st[1] = nx; }
        const unsigned old = xb_add(&bar[XB_XSUB(b.x)], 1u);
        const unsigned gen = old / nloc;
        if (old + 1u == (gen + 1u) * nloc) {
            __builtin_amdgcn_fence(__ATOMIC_RELEASE, "agent");
            asm volatile("s_waitcnt vmcnt(0)" ::: "memory");
            const unsigned og = xb_add(&bar[XB_TOP], 1u);
            const unsigned tg = og / nx;
            if (og + 1u == (tg + 1u) * nx) xb_add(&bar[XB_TOPGEN], 1u);
            else XB_SPIN(xb_ld(&bar[XB_TOPGEN]) == tg, bar);
            __builtin_amdgcn_fence(__ATOMIC_ACQUIRE, "agent");
            xb_add(&bar[XB_XGEN(b.x)], 1u);
            asm volatile("s_waitcnt vmcnt(0)" ::: "memory");
        } else {
            XB_SPIN(xb_ld(&bar[XB_XGEN(b.x)]) == gen, bar);
            __builtin_amdgcn_fence(__ATOMIC_ACQUIRE, "agent");
            asm volatile("s_waitcnt vmcnt(0)" ::: "memory");
        }
    }
    __syncthreads();
}

constexpr int NPHASES = 16;
__global__ void __launch_bounds__(NTHREADS, 2) mk_fwd(Params P, int ph_lo, int ph_hi) {
    extern __shared__ __attribute__((aligned(16))) char smem[];
    const int bid = blockIdx.x, nb = gridDim.x;
    volatile LAS unsigned* xst = (volatile LAS unsigned*)(LAS char*)(smem + LDS_MAIN);
    if (threadIdx.x == 0) { xst[0] = 0u; xst[1] = 0u; }
    __syncthreads();
    XcdBarrier gbar; gbar.bar = (unsigned*)(P.ws + OFF_CTL); gbar.x = 0; gbar.st = xst;
    if (ph_hi - ph_lo > 1) gbar = xcd_barrier_post((unsigned*)(P.ws + OFF_CTL), xst);
#ifndef REPEAT_K
#define REPEAT_K -1
#endif
#ifndef REPEAT_N
#define REPEAT_N 1
#endif
#ifndef EXTRA_SYNCS
#define EXTRA_SYNCS 0
#endif
#define RUN(k, call) if (ph_lo <= (k) && (k) < ph_hi) { if ((k) == REPEAT_K) { for (int rep_ = 0; rep_ < REPEAT_N; ++rep_) { call; xcd_barrier(gbar); } } call; if ((k) + 1 < ph_hi) xcd_barrier(gbar); }
    for (int es_ = 0; es_ < EXTRA_SYNCS; ++es_) xcd_barrier(gbar);
    RUN(0, phase_prologue(P, bid, nb, smem))
    RUN(1, phase_norm1(P, 0, bid, nb))
    RUN(2, phase_qkv(P, 0, bid, nb, smem))
    RUN(3, phase_attn(P, 0, bid, nb, smem))
    RUN(4, phase_outproj(P, 0, bid, nb, smem))
    if (!route_fused(nb)) { RUN(5, phase_norm2_route(P, 0, bid, nb, smem)) }
    RUN(6, phase_gateup(P, 0, bid, nb, smem))
    RUN(7, phase_down(P, 0, bid, nb, smem))
    RUN(8, phase_norm1(P, 1, bid, nb))
    RUN(9, phase_qkv(P, 1, bid, nb, smem))
    RUN(10, phase_attn(P, 1, bid, nb, smem))
    RUN(11, phase_outproj(P, 1, bid, nb, smem))
    if (!route_fused(nb)) { RUN(12, phase_norm2_route(P, 1, bid, nb, smem)) }
    RUN(13, phase_gateup(P, 1, bid, nb, smem))
    RUN(14, phase_down(P, 1, bid, nb, smem))
    RUN(15, phase_final(P, bid, nb))
#undef RUN
}

extern "C" void kernel_launch(void* const* d_in, const int* in_sizes, int n_in, void* d_out, int out_size, void* d_ws, size_t ws_size, hipStream_t stream) {
    Params p{};
    const float** f = (const float**)&p;
    for (int i = 0; i < 24; ++i) f[i] = (const float*)d_in[i];
    p.out = (float*)d_out; p.ws = (unsigned char*)d_ws;
    if (ws_size < WS_END) { fprintf(stderr, "workspace too small: %zu < %zu\n", ws_size, (size_t)WS_END); return; }
#ifndef MULTI_LAUNCH
#define MULTI_LAUNCH 0
#endif
#if MULTI_LAUNCH
    (void)hipFuncSetAttribute((const void*)mk_fwd, hipFuncAttributeMaxDynamicSharedMemorySize, LDS_BYTES);
    (void)hipMemsetAsync((char*)d_ws + OFF_CTL, 0, CTL_BYTES, stream);
    for (int ph = 0; ph < NPHASES; ++ph) hipLaunchKernelGGL(mk_fwd, dim3(256), dim3(NTHREADS), LDS_BYTES, stream, p, ph, ph + 1);
#else
    static int grid_blocks = 0;
    if (!grid_blocks) {
        int dev = 0, cus = 0, per_cu = 0;
        (void)hipGetDevice(&dev);
        (void)hipDeviceGetAttribute(&cus, hipDeviceAttributeMultiprocessorCount, dev);
        (void)hipFuncSetAttribute((const void*)mk_fwd, hipFuncAttributeMaxDynamicSharedMemorySize, LDS_BYTES);
        (void)hipOccupancyMaxActiveBlocksPerMultiprocessor(&per_cu, mk_fwd, NTHREADS, LDS_BYTES);
        if (per_cu > 1) per_cu = 1;
        grid_blocks = cus * per_cu;
        if (grid_blocks <= 0) { fprintf(stderr, "occupancy query failed (%d x %d)\n", cus, per_cu); grid_blocks = 0; return; }
    }
    (void)hipMemsetAsync((char*)d_ws + OFF_CTL, 0, CTL_BYTES, stream);
    hipLaunchKernelGGL(mk_fwd, dim3(grid_blocks), dim3(NTHREADS), LDS_BYTES, stream, p, 0, NPHASES);
    hipError_t e = hipPeekAtLastError();
    if (e != hipSuccess) fprintf(stderr, "launch failed: %s (grid %d)\n", hipGetErrorString(e), grid_blocks);
#endif
}
```

```cpp
#include <hip/hip_runtime.h>
#include <stdint.h>
#include <stdio.h>


#define DI __device__ __forceinline__
#define LAS __attribute__((address_space(3)))
typedef unsigned short bf16_t;
typedef short bf16x8 __attribute__((ext_vector_type(8)));
typedef float f32x16 __attribute__((ext_vector_type(16)));
typedef float f32x4 __attribute__((ext_vector_type(4)));
typedef float f32x2 __attribute__((ext_vector_type(2)));
typedef unsigned u32x4 __attribute__((ext_vector_type(4)));
typedef unsigned u32x2 __attribute__((ext_vector_type(2)));
typedef short s16x4 __attribute__((ext_vector_type(4)));

constexpr int NB = 8, SEQ = 2048, CTXL = 256, TPB = SEQ + CTXL  , NTOK = NB * TPB  ;
constexpr int DM = 1024, INC = 2560, NEXP = 16, DEXP = 256;
constexpr int NQU = 16, NKU = 12, NVR = 768;
constexpr size_t VS = (size_t)NVR * TPB;
constexpr int NTHREADS = 512, NW = NTHREADS / 64;
constexpr int LDS_MAIN = 131072, LDS_MISC = LDS_MAIN + 64, LDS_BYTES = LDS_MISC + 16384;
constexpr float RMS_EPS = 1e-6f;
constexpr float QSCALE = 0.125f * 1.4426950408889634f;

constexpr size_t OFF_CTL  = 0;
constexpr size_t OFF_CNT  = 14336, OFF_RDYC = OFF_CNT + 8192, OFF_XCNT = 24576, CTL_BYTES = OFF_XCNT + 2 * 72 * 256;
constexpr size_t OFF_MOD  = CTL_BYTES;
constexpr size_t OFF_ROPE = OFF_MOD + (size_t)2 * 9 * 6144 * 4;
constexpr size_t OFF_WIN  = OFF_ROPE + 16384;
constexpr size_t OFF_WOUT = OFF_WIN + (size_t)2 * 2560 * 1024 * 2;
constexpr size_t OFF_WGU  = OFF_WOUT + (size_t)2 * 1024 * 1024 * 2;
constexpr size_t OFF_WD   = OFF_WGU + (size_t)2 * 16 * 512 * 1024 * 2;
constexpr size_t OFF_HX   = OFF_WD + (size_t)2 * 16 * 1024 * 256 * 2;
constexpr size_t OFF_QB   = OFF_HX + (size_t)NTOK * DM * 2;
constexpr size_t OFF_KB   = OFF_QB + (size_t)NB * NQU * TPB * 64 * 2;
constexpr size_t OFF_VT   = OFF_KB + (size_t)NB * NKU * TPB * 64 * 2;
constexpr size_t OFF_Y    = OFF_QB;
constexpr size_t OFF_XC   = OFF_VT + (size_t)NB * NVR * TPB * 2;
constexpr size_t HB_ROWS  = 2 * NTOK + NEXP * 256;
constexpr size_t OFF_HB   = OFF_XC + (size_t)NB * CTXL * DM * 4;
constexpr size_t OFF_LIST = OFF_HB + HB_ROWS * DEXP * 2;
constexpr size_t OFF_TOKW = OFF_LIST + (size_t)NEXP * NTOK * 4;
constexpr size_t OFF_XCH  = OFF_TOKW + (size_t)2 * NTOK * 4;
constexpr size_t OFF_QE   = OFF_ROPE + 12288;
constexpr size_t WS_END   = OFF_XCH + (size_t)72 * 4 * 256 * 17 * 4;
static_assert(WS_END <= (size_t)256 * 1024 * 1024, "workspace");
static_assert((size_t)2 * NTOK * DM * 2 <= OFF_XC - OFF_QB, "Y alias");

struct Params {
    const float *x, *c, *ctx, *c_ctx, *w_ada, *b_ada, *norm1_g, *norm2_g, *w_in, *w_out, *lam_q1, *lam_k1, *lam_q2, *lam_k2,
        *subln_g, *q_norm_g, *k_norm_g, *sink, *w_router, *router_bias, *w_gate, *w_up, *w_down, *final_g;
    float* out;
    unsigned char* ws;
};

DI float bf2f(bf16_t b) { return __uint_as_float(((unsigned)b) << 16); }
typedef __bf16 bf2_t __attribute__((ext_vector_type(2)));
DI bf16_t f2bf(float f) { return __builtin_bit_cast(bf16_t, (__bf16)f); }
DI unsigned pk2(float lo, float hi) { bf2_t v = {(__bf16)lo, (__bf16)hi}; return __builtin_bit_cast(unsigned, v); }
DI int crow(int reg, int h) { return (reg & 3) + 8 * (reg >> 2) + 4 * h; }
DI float wave_sum(float v) {
#pragma unroll
    for (int o = 1; o < 64; o <<= 1) v += __shfl_xor(v, o);
    return v;
}
DI float max2f(float a, float b) { return __builtin_amdgcn_fmed3f(a, b, __builtin_inff()); }
DI float silu(float v) { return v / (1.f + expf(-v)); }
DI bf16_t* resid_row(const Params& P, int b, int p) {
    return p < CTXL ? (bf16_t*)(P.ws + OFF_XC) + (size_t)(b * CTXL + p) * DM : (bf16_t*)(P.out + (size_t)(b * SEQ + p - CTXL) * DM);
}
DI f32x4 bf4_to_f32(const u32x2 a) { f32x4 v; v.x = __uint_as_float(a.x << 16); v.y = __uint_as_float(a.x & 0xffff0000u); v.z = __uint_as_float(a.y << 16); v.w = __uint_as_float(a.y & 0xffff0000u); return v; }
DI u32x2 f32_to_bf4(const f32x4 v) { u32x2 w; w.x = pk2(v.x, v.y); w.y = pk2(v.z, v.w); return w; }
DI const float* input_row(const Params& P, int b, int p) {
    return p < CTXL ? P.ctx + (size_t)(b * CTXL + p) * DM : P.x + (size_t)(b * SEQ + p - CTXL) * DM;
}
DI const float* mod_row(const Params& P, int l, int mr) { return (const float*)(P.ws + OFF_MOD) + (size_t)(l * 9 + mr) * 6144; }

constexpr int TI_IN = 2 * 16 * 40, TI_OUT = 2 * 16 * 16, TI_G = 32 * 16 * 4, TI_U = TI_G, TI_D = 32 * 4 * 16, TI_ALL = TI_IN + TI_OUT + TI_G + TI_U + TI_D;
DI void titem_decode(const Params& P, int r, const float*& src, int& N, bf16_t*& dst, int& ldd, int& n0, int& kind) {
    kind = 0;
    if (r < TI_IN) { const int l = r / 640, q = r % 640, kb = q / 40, nbk = q % 40; N = INC; ldd = DM; n0 = nbk * 64; kind = 3;
        src = P.w_in + (size_t)l * DM * INC + (size_t)(kb * 64) * INC + n0; dst = (bf16_t*)(P.ws + OFF_WIN) + (size_t)l * INC * DM + kb * 64; return; }
    r -= TI_IN;
    if (r < TI_OUT) { const int l = r / 256, q = r % 256, kb = q / 16, nbk = q % 16; N = DM; ldd = DM; n0 = nbk * 64;
        src = P.w_out + (size_t)l * DM * DM + (size_t)(kb * 64) * DM + n0; dst = (bf16_t*)(P.ws + OFF_WOUT) + (size_t)l * DM * DM + kb * 64; return; }
    r -= TI_OUT;
    if (r < TI_G + TI_U) { const bool up = r >= TI_G; if (up) r -= TI_G; const int le = r / 64, q = r % 64, kb = q / 4, nbk = q % 4; N = DEXP; ldd = DM; n0 = nbk * 64; kind = up ? 2 : 1;
        src = (up ? P.w_up : P.w_gate) + (size_t)le * DM * DEXP + (size_t)(kb * 64) * DEXP + n0; dst = (bf16_t*)(P.ws + OFF_WGU) + (size_t)le * 512 * DM + kb * 64; return; }
    r -= TI_G + TI_U;
    { const int le = r / 64, q = r % 64, kb = q / 16, nbk = q % 16; N = DM; ldd = DEXP; n0 = nbk * 64;
        src = P.w_down + (size_t)le * DEXP * DM + (size_t)(kb * 64) * DM + n0; dst = (bf16_t*)(P.ws + OFF_WD) + (size_t)le * DM * DEXP + kb * 64; }
}

DI void phase_prologue(const Params& P, int bid, int nb, char* smem) {
    const int t = threadIdx.x;
    float* s = (float*)smem;
    {
        constexpr int NLD = 4096 / NTHREADS;
        float v[NLD];
        int it = bid;
        const float* src; bf16_t* dst; int N, ldd, n0, kind;
        if (it < TI_ALL) { titem_decode(P, it, src, N, dst, ldd, n0, kind);
#pragma unroll
            for (int i = 0; i < NLD; ++i) v[i] = src[(size_t)((t >> 6) + NW * i) * N + (t & 63)]; }
        while (it < TI_ALL) {
            __syncthreads();
#pragma unroll
            for (int i = 0; i < NLD; ++i) s[((t >> 6) + NW * i) * 65 + (t & 63)] = v[i];
            __syncthreads();
            bf16_t* cdst = dst; const int cldd = ldd, cn0 = n0, ckind = kind;
            it += nb;
            if (it < TI_ALL) { titem_decode(P, it, src, N, dst, ldd, n0, kind);
#pragma unroll
                for (int i = 0; i < NLD; ++i) v[i] = src[(size_t)((t >> 6) + NW * i) * N + (t & 63)]; }
            constexpr int KPT = 64 * 64 / NTHREADS;
            const int n = t / (64 / KPT), kc = (t % (64 / KPT)) * KPT;
            const int ng = cn0 + n;
            int drow = ng;
            if (ckind == 3) {
                const bool isv = (ng >= 1536 && ng < 2048) || (ng >= 2176 && ng < 2304) || ng >= 2432;
                const int w = (ng >> 6) & 3, d = ng & 63;
                const int bj = isv ? (d >> 3) & 1 : d >> 5, n = isv ? (d >> 2) & 1 : (d >> 4) & 1, fq = isv ? d >> 4 : (d >> 2) & 3, r = d & 3;
                drow = (ng & ~255) + 128 * bj + 32 * w + 16 * n + 4 * fq + r;
            }
            else if (ckind != 0) drow = (ng >> 7) * 256 + (ckind == 2 ? 128 : 0) + (ng & 127);
            bf16_t* d = cdst + (size_t)drow * cldd + kc;
#pragma unroll
            for (int j = 0; j < KPT; j += 8) { u32x4 o;
                o.x = pk2(s[(kc + j + 0) * 65 + n], s[(kc + j + 1) * 65 + n]); o.y = pk2(s[(kc + j + 2) * 65 + n], s[(kc + j + 3) * 65 + n]);
                o.z = pk2(s[(kc + j + 4) * 65 + n], s[(kc + j + 5) * 65 + n]); o.w = pk2(s[(kc + j + 6) * 65 + n], s[(kc + j + 7) * 65 + n]);
                *(u32x4*)(d + j) = o; }
        }
    }
    {
        constexpr int I_MOD = 2 * 384, KG = NTHREADS / 16, KPG = DM / KG;
        bool have_silu = false;
        float* ssl = s;
        float* red = s + 9 * 1024;
        for (int it = bid; it < I_MOD; it += nb) {
            const int l = it / 384, col0 = (it % 384) * 16, cc = t & 15, kg = t >> 4;
            const float* W = P.w_ada + (size_t)l * DM * 6144 + col0 + cc + (size_t)(kg * KPG) * 6144;
            float w[KPG];
#pragma unroll
            for (int kk = 0; kk < KPG; ++kk) w[kk] = W[(size_t)kk * 6144];
            __syncthreads();
            if (!have_silu) { for (int i = t; i < 9 * 1024; i += NTHREADS) { const float cv = i < 8192 ? P.c[i] : P.c_ctx[i - 8192]; ssl[i] = silu(cv); } have_silu = true; }
            __syncthreads();
            float acc[9];
#pragma unroll
            for (int i = 0; i < 9; ++i) acc[i] = 0.f;
#pragma unroll
            for (int kk = 0; kk < KPG; ++kk) {
#pragma unroll
                for (int i = 0; i < 9; ++i) acc[i] += ssl[i * 1024 + kg * KPG + kk] * w[kk];
            }
#pragma unroll
            for (int i = 0; i < 9; ++i) red[(i * KG + kg) * 16 + cc] = acc[i];
            __syncthreads();
            if (t < 144) { const int i = t >> 4, c2 = t & 15; float a = P.b_ada[l * 6144 + col0 + c2];
                for (int g = 0; g < KG; ++g) a += red[(i * KG + g) * 16 + c2];
                ((float*)(P.ws + OFF_MOD))[(size_t)(l * 9 + i) * 6144 + col0 + c2] = a; }
        }
    }
    for (int idx = bid * NTHREADS + t; idx < 96 * 16; idx += nb * NTHREADS) {
        const int pi = idx >> 4, j = idx & 15, pos = pi < 32 ? pi : pi - 32;
        const float invf = powf(10000.f, -(float)j / 16.f);
        float sn, cs; sincosf((float)pos * invf, &sn, &cs);
        ((float*)(P.ws + OFF_ROPE))[idx] = cs; ((float*)(P.ws + OFF_ROPE))[96 * 16 + idx] = sn;
    }
}

struct RowIn { f32x4 x[4]; u32x2 xb[4], y0[4], y1[4]; };
template <bool COMBINE>
DI void row_load(const Params& P, int l, int tok, int lane, RowIn& r) {
    const int b = tok / TPB, p = tok % TPB;
    if (l == 0 && !COMBINE) { const f32x4* src = (const f32x4*)input_row(P, b, p) + lane;
#pragma unroll
        for (int j = 0; j < 4; ++j) r.x[j] = src[64 * j]; }
    else { const u32x2* src = (const u32x2*)resid_row(P, b, p) + lane;
#pragma unroll
        for (int j = 0; j < 4; ++j) r.xb[j] = src[64 * j]; }
    if (COMBINE) {
        const bf16_t* Y = (const bf16_t*)(P.ws + OFF_Y);
        const u32x2* y0 = (const u32x2*)(Y + (size_t)(2 * tok) * DM) + lane;
        const u32x2* y1 = (const u32x2*)(Y + (size_t)(2 * tok + 1) * DM) + lane;
#pragma unroll
        for (int j = 0; j < 4; ++j) { r.y0[j] = y0[64 * j]; r.y1[j] = y1[64 * j]; }
    }
}
DI f32x4 row_combine(const f32x4 xv, const f32x4 g, const u32x2 a, const u32x2 c2) {
    f32x4 yv;
    yv.x = __uint_as_float(a.x << 16) + __uint_as_float(c2.x << 16);
    yv.y = __uint_as_float(a.x & 0xffff0000u) + __uint_as_float(c2.x & 0xffff0000u);
    yv.z = __uint_as_float(a.y << 16) + __uint_as_float(c2.y << 16);
    yv.w = __uint_as_float(a.y & 0xffff0000u) + __uint_as_float(c2.y & 0xffff0000u);
    return xv + g * yv;
}
template <bool COMBINE>
DI void norm1_body(const Params& P, int l, int bid, int nb) {
    const int lane = threadIdx.x & 63, wave = threadIdx.x >> 6;
    bf16_t* HX = (bf16_t*)(P.ws + OFF_HX);
    const int per = (NTOK + nb - 1) / nb, tk0 = bid * per, ntk = min(NTOK, tk0 + per) - tk0;
    RowIn cur, nxt;
    f32x4 gs[4], hs[4], g2[4];
    int cur_mr = -1;
    if (wave < ntk) row_load<COMBINE>(P, l, tk0 + wave, lane, nxt);
    for (int i = wave; i < ntk; i += NW) {
        const int tok = tk0 + i, b = tok / TPB, p = tok % TPB, mr = p < CTXL ? 8 : b;
        cur = nxt;
        if (i + NW < ntk) row_load<COMBINE>(P, l, tok + NW, lane, nxt);
        if (mr != cur_mr) {
            const float* md = mod_row(P, l, mr);
            const f32x4* gn = (const f32x4*)(P.norm1_g + l * DM) + lane;
            const f32x4* sh = (const f32x4*)(md) + lane;
            const f32x4* sc = (const f32x4*)(md + 1024) + lane;
#pragma unroll
            for (int j = 0; j < 4; ++j) { gs[j] = gn[64 * j] * (1.f + sc[64 * j]); hs[j] = sh[64 * j]; }
            if (COMBINE) { const f32x4* gp = (const f32x4*)(mod_row(P, l - 1, mr) + 5120) + lane;
#pragma unroll
                for (int j = 0; j < 4; ++j) g2[j] = gp[64 * j]; }
            cur_mr = mr;
        }
        f32x4 v[4]; float ss = 0.f;
        u32x2* xr = (u32x2*)resid_row(P, b, p) + lane;
#pragma unroll
        for (int j = 0; j < 4; ++j) {
            v[j] = COMBINE ? row_combine(bf4_to_f32(cur.xb[j]), g2[j], cur.y0[j], cur.y1[j]) : cur.x[j];
            if (COMBINE) xr[64 * j] = f32_to_bf4(v[j]);
            ss += (v[j].x * v[j].x + v[j].y * v[j].y) + (v[j].z * v[j].z + v[j].w * v[j].w);
        }
        const float r = rsqrtf(wave_sum(ss) * (1.f / DM) + RMS_EPS);
        u32x2* o = (u32x2*)(HX + (size_t)tok * DM) + lane;
#pragma unroll
        for (int j = 0; j < 4; ++j) {
            const f32x4 y = v[j] * r * gs[j] + hs[j];
            u32x2 w; w.x = pk2(y.x, y.y); w.y = pk2(y.z, y.w);
            o[64 * j] = w;
        }
    }
}
DI void router_shift_consts(const Params& P, int l, int bid) {
    if (bid >= 9 || (threadIdx.x >> 6) != NW - 1) return;
    const int lane = threadIdx.x & 63;
    const float* sh = mod_row(P, l, bid) + 3072;
    float a[16];
#pragma unroll
    for (int e = 0; e < 16; ++e) a[e] = 0.f;
    for (int i = 0; i < 16; ++i) { const int k = lane + 64 * i; const float h = sh[k];
#pragma unroll
        for (int q = 0; q < 4; ++q) { const f32x4 w = *(const f32x4*)(P.w_router + k * 16 + 4 * q); a[4 * q] += h * w.x; a[4 * q + 1] += h * w.y; a[4 * q + 2] += h * w.z; a[4 * q + 3] += h * w.w; } }
#pragma unroll
    for (int e = 0; e < 16; ++e) a[e] = wave_sum(a[e]);
    if (lane == 0) { float* qe = (float*)(P.ws + OFF_QE) + (l * 9 + bid) * 16;
#pragma unroll
        for (int e = 0; e < 16; ++e) qe[e] = a[e]; }
}
DI void phase_norm1(const Params& P, int l, int bid, int nb) { router_shift_consts(P, l, bid); if (l == 0) norm1_body<false>(P, 0, bid, nb); else norm1_body<true>(P, l, bid, nb); }

DI void phase_final(const Params& P, int bid, int nb) {
    const int lane = threadIdx.x & 63, wave = threadIdx.x >> 6;
    const int per = (NB * SEQ + nb - 1) / nb, r0 = bid * per, nr = min(NB * SEQ, r0 + per) - r0;
    RowIn cur, nxt;
    f32x4 fg[4], g2[4];
    const f32x4* fgp = (const f32x4*)P.final_g + lane;
#pragma unroll
    for (int j = 0; j < 4; ++j) fg[j] = fgp[64 * j];
    int cur_b = -1;
    if (wave < nr) { const int r = r0 + wave; row_load<true>(P, 1, (r / SEQ) * TPB + CTXL + r % SEQ, lane, nxt); }
    for (int i = wave; i < nr; i += NW) {
        const int r = r0 + i, b = r / SEQ, p = CTXL + r % SEQ;
        cur = nxt;
        if (i + NW < nr) { const int r2 = r + NW; row_load<true>(P, 1, (r2 / SEQ) * TPB + CTXL + r2 % SEQ, lane, nxt); }
        if (b != cur_b) { const f32x4* gp = (const f32x4*)(mod_row(P, 1, b) + 5120) + lane;
#pragma unroll
            for (int j = 0; j < 4; ++j) g2[j] = gp[64 * j];
            cur_b = b; }
        f32x4 v[4]; float ss = 0.f;
#pragma unroll
        for (int j = 0; j < 4; ++j) { v[j] = row_combine(bf4_to_f32(cur.xb[j]), g2[j], cur.y0[j], cur.y1[j]); ss += (v[j].x * v[j].x + v[j].y * v[j].y) + (v[j].z * v[j].z + v[j].w * v[j].w); }
        const float rr = rsqrtf(wave_sum(ss) * (1.f / DM) + RMS_EPS);
        f32x4* xr = (f32x4*)(P.out + (size_t)r * DM) + lane;
#pragma unroll
        for (int j = 0; j < 4; ++j) xr[64 * j] = v[j] * rr * fg[j];
    }
}

namespace g8 {
constexpr int BK = 64, HALF = 128, HTB = HALF * BK * 2, STAGE_BYTES = 8 * HTB;
DI int lds_byte(int r, int c) { const int st = (r >> 4) * 2 + (c >> 5), rr = r & 15, cc = c & 31, ob = rr * 64 + cc * 2; return st * 1024 + (ob ^ (((ob >> 9) & 1) << 5)); }
DI void stage_rc(int b, int& R, int& C) { const int st = b / 1024, sb = b % 1024, swz = sb ^ (((sb >> 9) & 1) << 5); R = (st >> 1) * 16 + swz / 64; C = (st & 1) * 32 + (swz % 64) / 2; }
struct Unit { int a, b, c, d; const bf16_t* bt; };

template <class Sched, class Epi>
DI void gemm_phase(char* smem, const bf16_t* Abase, const int K, const Sched& S, const Epi& E) {
    LAS unsigned char* lds = (LAS unsigned char*)smem;
    const int tid = threadIdx.x, wid = __builtin_amdgcn_readfirstlane(tid >> 6), lane = tid & 63, wr = wid >> 2, wc = wid & 3, fr = lane & 15, fq = lane >> 4;
    const int nt = K / BK;
    int R[2], C[2];
    unsigned voffB[2], voffA[2];
#pragma unroll
    for (int i = 0; i < 2; ++i) { stage_rc(tid * 16 + i * 8192, R[i], C[i]); voffB[i] = (unsigned)(R[i] * K + C[i]) * 2u; voffA[i] = voffB[i]; }
    const size_t kstep = (size_t)(BK * 2);
    const size_t hstep = (size_t)HALF * K * 2;
    const unsigned ldsw = (unsigned)wid * 1024u;
    const int aoff = lds_byte(wr * 64 + fr, fq * 8), boff = lds_byte(wc * 32 + fr, fq * 8);
#define G8_SA(b, h) (((b) * 2 + (h)) * HTB)
#define G8_SB(b, h) ((4 + (b) * 2 + (h)) * HTB)
#define G8_STAGE_B(bufoff, gbase) do { _Pragma("unroll") for (int _i = 0; _i < 2; ++_i) \
        __builtin_amdgcn_global_load_lds((const unsigned*)((const char*)(gbase) + voffB[_i]), (LAS unsigned*)(lds + (bufoff) + ldsw + _i * 8192), 16, 0, 0); } while (0)
#define G8_GLDS(src, dstoff) __builtin_amdgcn_global_load_lds((const unsigned*)(src), (LAS unsigned*)(lds + (dstoff)), 16, 0, 0)
#define G8_STAGE_A(bufoff, hh, nx, kb) do { \
        if constexpr (Sched::GATHER) { const unsigned o0_ = (nx) ? avn[hh][0] : avc[hh][0], o1_ = (nx) ? avn[hh][1] : avc[hh][1]; \
            G8_GLDS(Ab + (size_t)o0_ + (kb), (bufoff) + ldsw); G8_GLDS(Ab + (size_t)o1_ + (kb), (bufoff) + ldsw + 8192); } \
        else { const char* ba_ = ((nx) ? nA : cA) + (size_t)(hh) * hstep + (kb); G8_GLDS(ba_ + voffA[0], (bufoff) + ldsw); G8_GLDS(ba_ + voffA[1], (bufoff) + ldsw + 8192); } } while (0)
#define G8_LDA(dst, b, h) do { _Pragma("unroll") for (int m = 0; m < 4; ++m) _Pragma("unroll") for (int k = 0; k < 2; ++k) dst[m][k] = *(const LAS bf16x8*)(lds + G8_SA(b, h) + aoff + m * 2048 + k * 1024); } while (0)
#define G8_LDB(dst, b, h) do { _Pragma("unroll") for (int n = 0; n < 2; ++n) _Pragma("unroll") for (int k = 0; k < 2; ++k) dst[n][k] = *(const LAS bf16x8*)(lds + G8_SB(b, h) + boff + n * 2048 + k * 1024); } while (0)
#define G8_MMA(ai, bj, At, Bt) do { __builtin_amdgcn_s_setprio(1); _Pragma("unroll") for (int m = 0; m < 4; ++m) _Pragma("unroll") for (int n = 0; n < 2; ++n) _Pragma("unroll") for (int k = 0; k < 2; ++k) \
        acc[ai][bj][m][n] = __builtin_amdgcn_mfma_f32_16x16x32_bf16(Bt[n][k], At[m][k], acc[ai][bj][m][n], 0, 0, 0); __builtin_amdgcn_s_setprio(0); } while (0)
#define G8_WAIT_V(n) asm volatile("s_waitcnt vmcnt(" #n ")" ::: "memory")
#define G8_WAIT_L(n) asm volatile("s_waitcnt lgkmcnt(" #n ")" ::: "memory")
#define G8_BAR __builtin_amdgcn_s_barrier()
#define G8_SCHED __builtin_amdgcn_sched_barrier(0)
    Unit cur, nxt; int ui = 0;
    if (!S.next(0, cur)) return;
    f32x4 acc[2][2][4][2];
#pragma unroll
    for (int a = 0; a < 2; ++a)
#pragma unroll
        for (int b = 0; b < 2; ++b)
#pragma unroll
            for (int m = 0; m < 4; ++m)
#pragma unroll
                for (int n = 0; n < 2; ++n) acc[a][b][m][n] = (f32x4){0.f, 0.f, 0.f, 0.f};
    bf16x8 At[4][2], B0[2][2], B1[2][2];
    const char* Ab = (const char*)Abase;
    unsigned avc[2][2], avn[2][2];
    const char *cA = Ab, *nA = Ab;
    S.a_ready(cur);
    if constexpr (Sched::GATHER) S.a_offsets(cur, R, C, avc); else cA = (const char*)S.a_base(cur);
    const char* cB = (const char*)cur.bt;
    G8_STAGE_B(G8_SB(0, 0), cB); G8_STAGE_B(G8_SB(0, 1), cB + hstep); G8_STAGE_A(G8_SA(0, 0), 0, false, 0); G8_STAGE_A(G8_SA(0, 1), 1, false, 0);
    if (wr == 1) G8_BAR;
    G8_WAIT_V(2); G8_BAR;
    G8_STAGE_B(G8_SB(1, 0), cB + kstep); G8_STAGE_A(G8_SA(1, 0), 0, false, kstep); G8_STAGE_B(G8_SB(1, 1), cB + hstep + kstep);
    G8_WAIT_V(6); G8_BAR;
    for (;;) {
        const bool has_next = S.next(ui + 1, nxt);
        if constexpr (Sched::GATHER) {
            if (has_next) S.a_offsets(nxt, R, C, avn);
            else {
#pragma unroll
                for (int hh = 0; hh < 2; ++hh)
#pragma unroll
                    for (int i = 0; i < 2; ++i) avn[hh][i] = avc[hh][i];
            }
        } else nA = has_next ? (const char*)S.a_base(nxt) : cA;
        const char* nB = has_next ? (const char*)nxt.bt : cB;
        for (int t = 0; t < nt; t += 2) {
            const bool last = (t == nt - 2);
            const size_t k1 = (size_t)(t + 1) * kstep;
            const size_t k2 = last ? 0 : (size_t)(t + 2) * kstep, k3 = k2 + kstep;
            const char* b2 = last ? nB : cB + k2; const char* b3 = b2 + kstep;
            G8_LDB(B0, 0, 0); G8_LDB(B1, 0, 1); G8_SCHED; G8_LDA(At, 0, 0); G8_STAGE_A(G8_SA(1, 1), 1, false, k1);
            G8_WAIT_V(8); G8_WAIT_L(0); G8_BAR; G8_MMA(0, 0, At, B0); G8_MMA(0, 1, At, B1); G8_BAR; G8_SCHED;
            G8_LDA(At, 0, 1); G8_STAGE_B(G8_SB(0, 0), b2); G8_STAGE_B(G8_SB(0, 1), b2 + hstep); G8_STAGE_A(G8_SA(0, 0), 0, last, k2);
            G8_WAIT_V(8); G8_WAIT_L(0); G8_BAR; G8_MMA(1, 0, At, B0); G8_MMA(1, 1, At, B1); G8_BAR; G8_SCHED;
            G8_LDB(B0, 1, 0); G8_LDB(B1, 1, 1); G8_SCHED; G8_LDA(At, 1, 0); G8_STAGE_A(G8_SA(0, 1), 1, last, k2);
            G8_WAIT_V(8); G8_WAIT_L(0); G8_BAR; G8_MMA(0, 0, At, B0); G8_MMA(0, 1, At, B1); G8_BAR; G8_SCHED;
            G8_LDA(At, 1, 1); G8_STAGE_B(G8_SB(1, 0), b3); G8_STAGE_B(G8_SB(1, 1), b3 + hstep); G8_STAGE_A(G8_SA(1, 0), 0, last, k3);
            G8_WAIT_V(8); G8_WAIT_L(0); G8_BAR; G8_MMA(1, 0, At, B0); G8_MMA(1, 1, At, B1); G8_BAR; G8_SCHED;
        }
        if (wr == 0) G8_BAR;
        if constexpr (!Epi::AFTER_DRAIN) E(acc, cur, wr, wc, fr, fq);
        if (!has_next) break;
#pragma unroll
        for (int a = 0; a < 2; ++a)
#pragma unroll
            for (int b = 0; b < 2; ++b)
#pragma unroll
                for (int m = 0; m < 4; ++m)
#pragma unroll
                    for (int n = 0; n < 2; ++n) acc[a][b][m][n] = (f32x4){0.f, 0.f, 0.f, 0.f};
        cur = nxt; cB = nB; cA = nA; ++ui;
        if constexpr (Sched::GATHER) {
#pragma unroll
            for (int hh = 0; hh < 2; ++hh)
#pragma unroll
                for (int i = 0; i < 2; ++i) avc[hh][i] = avn[hh][i];
        }
        if (wr == 1) G8_BAR;
    }
    G8_WAIT_V(0);
    G8_BAR;
    if constexpr (Epi::AFTER_DRAIN) E.fused(acc, cur, wr, wc, fr, fq, smem);
#undef G8_SA
#undef G8_SB
#undef G8_STAGE_A
#undef G8_GLDS
#undef G8_STAGE_B
#undef G8_LDA
#undef G8_LDB
#undef G8_MMA
#undef G8_WAIT_V
#undef G8_WAIT_L
#undef G8_BAR
#undef G8_SCHED
}

DI bool static_unit(int i, int G, int c, int nM, int nN, int& pm, int& pn) {
    const int nwg = nM * nN; const long L = (long)i * G + c; if (L >= nwg) return false;
    int wgid = (int)L; { const int q = nwg / 8, r = nwg % 8, xcd = wgid % 8, off = wgid / 8; wgid = (xcd < r ? xcd * (q + 1) : r * (q + 1) + (xcd - r) * q) + off; }
    const int nig = 8 * nN, gid = wgid / nig, fm = gid * 8, gsz = (nM - fm) < 8 ? (nM - fm) : 8;
    pm = fm + ((wgid % nig) % gsz); pn = (wgid % nig) / gsz; return true;
}
}

struct SchedQKV {
    const bf16_t *A, *Wt; int G, c;
    static constexpr bool GATHER = false;
    DI void a_ready(const g8::Unit&) const {}
    DI bool next(int i, g8::Unit& u) const { int pm, pn; if (!g8::static_unit(i, G, c, NTOK / 256, INC / 256, pm, pn)) return false; u.a = pm; u.b = pn; u.c = 0; u.d = 0; u.bt = Wt + (size_t)pn * 256 * DM; return true; }
    DI const bf16_t* a_base(const g8::Unit& u) const { return A + (size_t)u.a * 256 * DM; }
};
struct EpiQKV {
    static constexpr bool AFTER_DRAIN = false;
    bf16_t *QB, *KB, *VT; const float *ropec, *ropes, *qg, *kg;
    DI void operator()(const f32x4 (&acc)[2][2][4][2], const g8::Unit& u, int wr, int wc, int fr, int fq) const {
        const int pm = u.a, pn = u.b, b = pm / 9, p0 = (pm % 9) * 256;
        const bool isctx = p0 == 0;
        const int cw = pn * 256 + wc * 64;
        int kind, unit; const float* ng = nullptr;
        if (cw < 1024) { kind = 0; unit = cw >> 6; if (unit >= 8 && unit < 12) ng = qg; }
        else if (cw < 1536) { kind = 1; unit = (cw - 1024) >> 6; }
        else if (cw < 2048) { kind = 2; unit = cw - 1536; }
        else if (cw < 2176) { kind = 1; unit = 8 + ((cw - 2048) >> 6); ng = kg; }
        else if (cw < 2304) { kind = 2; unit = 512 + (cw - 2176); }
        else if (cw < 2432) { kind = 1; unit = 10 + ((cw - 2304) >> 6); }
        else { kind = 2; unit = 640 + (cw - 2432); }
        if (kind == 2) {
            const int vld = unit < 512 ? 128 : 64;
            const size_t vbase = unit < 512 ? (size_t)(unit >> 7) * TPB * 128 + (unit & 127) : (size_t)4 * TPB * 128 + (size_t)((unit - 512) >> 6) * TPB * 64;
            bf16_t* vb = VT + (size_t)b * VS + vbase + 16 * fq;
#pragma unroll
            for (int ai = 0; ai < 2; ++ai)
#pragma unroll
                for (int m = 0; m < 4; ++m) {
                    const int p = p0 + 128 * ai + 64 * wr + 16 * m + fr;
#pragma unroll
                    for (int bj = 0; bj < 2; ++bj) { const f32x4 v0 = acc[ai][bj][m][0], v1 = acc[ai][bj][m][1];
                        u32x4 o; o.x = pk2(v0.x, v0.y); o.y = pk2(v0.z, v0.w); o.z = pk2(v1.x, v1.y); o.w = pk2(v1.z, v1.w);
                        *(u32x4*)(vb + (size_t)p * vld + 8 * bj) = o; }
                }
            return;
        }
        const bool nrm = ng != nullptr;
        f32x4 g4[2][2];
#pragma unroll
        for (int bj = 0; bj < 2; ++bj)
#pragma unroll
            for (int n = 0; n < 2; ++n) g4[bj][n] = nrm ? *(const f32x4*)(ng + 32 * bj + 16 * n + 4 * fq) : (f32x4){1.f, 1.f, 1.f, 1.f};
        const float osc = kind == 0 ? QSCALE : 1.f;
        bf16_t* base = (kind == 0 ? QB + ((size_t)b * NQU + unit) * TPB * 64 : KB + ((size_t)b * NKU + unit) * TPB * 64) + 4 * fq;
#pragma unroll
        for (int ai = 0; ai < 2; ++ai)
#pragma unroll
            for (int m = 0; m < 4; ++m) {
                const int p = p0 + 128 * ai + 64 * wr + 16 * m + fr;
                f32x4 x[2][2];
#pragma unroll
                for (int bj = 0; bj < 2; ++bj)
#pragma unroll
                    for (int n = 0; n < 2; ++n) x[bj][n] = acc[ai][bj][m][n];
                if (nrm) {
                    float ss = 0.f;
#pragma unroll
                    for (int bj = 0; bj < 2; ++bj)
#pragma unroll
                        for (int n = 0; n < 2; ++n) ss += (x[bj][n].x * x[bj][n].x + x[bj][n].y * x[bj][n].y) + (x[bj][n].z * x[bj][n].z + x[bj][n].w * x[bj][n].w);
                    ss += __shfl_xor(ss, 16); ss += __shfl_xor(ss, 32);
                    const float r = rsqrtf(ss * (1.f / 64.f) + RMS_EPS);
#pragma unroll
                    for (int bj = 0; bj < 2; ++bj)
#pragma unroll
                        for (int n = 0; n < 2; ++n) x[bj][n] = x[bj][n] * r * g4[bj][n];
                }
                if (!isctx) {
                    const int t = p - CTXL;
#pragma unroll
                    for (int bj = 0; bj < 2; ++bj) {
                        const int idx = (bj == 0 ? (t >> 6) : 32 + (t & 63)) * 16 + 4 * fq;
                        const f32x4 c4 = *(const f32x4*)(ropec + idx), s4 = *(const f32x4*)(ropes + idx);
                        const f32x4 y0 = x[bj][0] * c4 - x[bj][1] * s4, y1 = x[bj][0] * s4 + x[bj][1] * c4;
                        x[bj][0] = y0; x[bj][1] = y1;
                    }
                }
#pragma unroll
                for (int bj = 0; bj < 2; ++bj)
#pragma unroll
                    for (int n = 0; n < 2; ++n) { u32x2 o; o.x = pk2(x[bj][n].x * osc, x[bj][n].y * osc); o.y = pk2(x[bj][n].z * osc, x[bj][n].w * osc);
                        *(u32x2*)(base + (size_t)p * 64 + 32 * bj + 16 * n) = o; }
            }
    }
};
DI void phase_qkv(const Params& P, int l, int bid, int nb, char* smem) {
    __syncthreads();
    for (int i = threadIdx.x; i < 2 * 96 * 16 / 4; i += NTHREADS) ((f32x4*)(smem + LDS_MISC))[i] = ((const f32x4*)(P.ws + OFF_ROPE))[i];
    __syncthreads();
    SchedQKV S{(const bf16_t*)(P.ws + OFF_HX), (const bf16_t*)(P.ws + OFF_WIN) + (size_t)l * INC * DM, nb, bid};
    EpiQKV E{(bf16_t*)(P.ws + OFF_QB), (bf16_t*)(P.ws + OFF_KB), (bf16_t*)(P.ws + OFF_VT), (const float*)(smem + LDS_MISC), (const float*)(smem + LDS_MISC) + 96 * 16,
             P.q_norm_g + l * 64, P.k_norm_g + l * 64};
    g8::gemm_phase(smem, (const bf16_t*)(P.ws + OFF_HX), DM, S, E);
}


#ifndef PV_AHEAD
#define PV_AHEAD 8
#endif
#define MFMA32(a, b, c) __builtin_amdgcn_mfma_f32_32x32x16_bf16((a), (b), (c), 0, 0, 0)
template <int DV>
DI void flash_run(char* smem, const bf16_t* qrow, const bf16_t* Kb, const bf16_t* Vr, int n1, int base2, int n2, int tq, float m0, float l0,
                  f32x16 (&O)[DV / 32], float& lout) {
    constexpr int NT = DV / 32, KBYTES = 8192, RB = DV * 2, STAGE = KBYTES + 64 * RB, NVP = DV / 64, KP = 1024 / RB, LPR = RB / 16;
    LAS char* lds = (LAS char*)smem;
    const int t = threadIdx.x, wave = __builtin_amdgcn_readfirstlane(t >> 6);
    int lane = t & 63;
    asm volatile("" : "+v"(lane));
    const int h = lane >> 5, ln = lane & 31, sw = (ln >> 1) & 7;
    constexpr bool QLDS = DV == 128;
    LAS char* qb = lds + 4 * STAGE + wave * 4096 + lane * 16;
    bf16x8 qf[4];
#pragma unroll
    for (int s = 0; s < 4; ++s) qf[s] = *(const bf16x8*)(qrow + 16 * s + 8 * h);
    if (QLDS) {
#pragma unroll
        for (int s = 0; s < 4; ++s) *(LAS bf16x8*)(qb + s * 1024) = qf[s];
    }
#pragma unroll
    for (int tt = 0; tt < NT; ++tt)
#pragma unroll
        for (int i = 0; i < 16; ++i) O[tt][i] = 0.f;
    constexpr float THR = 8.f;
    constexpr int PVA = PV_AHEAD;
    float m = m0 > -1e29f ? m0 : 0.f, l = l0;
    f32x16 negm;
#pragma unroll
    for (int i = 0; i < 16; ++i) negm[i] = -m;
    const int ntile = n1 + n2;
    constexpr int VPM = DV == 128 ? 5 : 9;
    bf16x8 pfp[2][2];
#pragma unroll
    for (int x = 0; x < 2; ++x)
#pragma unroll
        for (int y = 0; y < 2; ++y) pfp[x][y] = (bf16x8){0, 0, 0, 0, 0, 0, 0, 0};
    const int krow = 8 * wave + (lane >> 3);
    const unsigned koff = (unsigned)(krow * 64 + (((lane & 7) ^ ((krow >> 1) & 7)) << 3)) * 2u;
    unsigned voff[NVP];
#pragma unroll
    for (int i = 0; i < NVP; ++i) { const int key = 8 * wave + KP * i + lane / LPR, cpos = lane % LPR, z = DV == 128 ? (key & 3) : ((key >> 1) & 1);
        voff[i] = (unsigned)(key * DV + ((cpos ^ (z << 2)) << 3)) * 2u; }
    const int tq_ = (lane & 15) >> 2, tp_ = lane & 3, gb_ = (lane >> 4) & 1, z_ = DV == 128 ? tq_ : ((tq_ >> 1) & 1);
    const int vlane = (4 * h + tq_) * RB + (2 * gb_ + (tp_ >> 1)) * 16 + (tp_ & 1) * 8;
#define FA_DMA(gsrc, ldsdst) do { unsigned keep_; asm volatile("s_mov_b32 %0, m0\n\ts_mov_b32 m0, %2\n\ts_nop 0\n\tglobal_load_lds_dwordx4 %1, off\n\ts_mov_b32 m0, %0" \
        : "=&s"(keep_) : "v"(gsrc), "s"(ldsdst) : "memory"); } while (0)
#define FA_ISSUE(j) do { const int j_ = (j); const int pj_ = j_ < n1 ? 64 * j_ : base2 + 64 * (j_ - n1); const int bo_ = (j_ & 3) * STAGE; \
        const char* kt_ = (const char*)Kb + (size_t)pj_ * 128; const char* vt_ = (const char*)Vr + (size_t)pj_ * RB; \
        FA_DMA(kt_ + koff, (unsigned)(size_t)(lds + bo_ + wave * 1024)); \
        _Pragma("unroll") for (int i_ = 0; i_ < NVP; ++i_) FA_DMA(vt_ + voff[i_], (unsigned)(size_t)(lds + bo_ + KBYTES + (8 * wave + KP * i_) * RB)); } while (0)
    asm volatile("s_waitcnt vmcnt(0)" ::: "memory");
    FA_ISSUE(0);
    if (ntile > 1) FA_ISSUE(1);
#define FA_PVCORE(VB_) do { \
_Pragma("unroll") \
        for (int tt = 0; tt < NT; ++tt) { \
            const LAS char* vt = (VB_) + ((tt ^ z_) << 6); \
_Pragma("unroll") \
            for (int x = 0; x < 2; ++x) \
_Pragma("unroll") \
                for (int y = 0; y < 2; ++y) { \
                    const s16x4 lo = __builtin_amdgcn_ds_read_tr16_b64_v4i16((LAS s16x4*)(vt + (32 * x + 16 * y) * RB)); \
                    const s16x4 hi = __builtin_amdgcn_ds_read_tr16_b64_v4i16((LAS s16x4*)(vt + (32 * x + 16 * y + 8) * RB)); \
                    const bf16x8 vf = __builtin_shufflevector(lo, hi, 0, 1, 2, 3, 4, 5, 6, 7); \
                    O[tt] = MFMA32(vf, pfp[x][y], O[tt]); \
                } \
        } \
 \
    } while (0)
#define FA_EXPCORE() do { \
_Pragma("unroll") \
        for (int i = 0; i < 16; i += 2) { \
            const float a0 = __builtin_amdgcn_exp2f(s0[i]), a1 = __builtin_amdgcn_exp2f(s0[i + 1]); \
            const float b0 = __builtin_amdgcn_exp2f(s1[i]), b1 = __builtin_amdgcn_exp2f(s1[i + 1]); \
            ps += (a0 + a1) + (b0 + b1); \
            w[i >> 1] = pk2(a0, a1); w[8 + (i >> 1)] = pk2(b0, b1); \
        } \
    } while (0)
    for (int it = 0; it < ntile; ++it) {
        const int p0 = it < n1 ? 64 * it : base2 + 64 * (it - n1);
        if (it + 1 < ntile) { if (NVP == 2) asm volatile("s_waitcnt vmcnt(3)" ::: "memory"); else asm volatile("s_waitcnt vmcnt(2)" ::: "memory"); }
        else asm volatile("s_waitcnt vmcnt(0)" ::: "memory");
        __builtin_amdgcn_s_barrier();
        asm volatile("" ::: "memory");
        if (it + 2 < ntile) FA_ISSUE(it + 2);
        int bo = (it & 3) * STAGE;
        asm volatile("" : "+s"(bo));
        const LAS char* kb = lds + bo;
        const LAS char* vb = kb + KBYTES + vlane;
        f32x16 s0 = negm, s1 = negm;
#pragma unroll
        for (int s = 0; s < 4; ++s) {
            const int co = ((2 * s + h) ^ sw) << 4;
            const bf16x8 k0 = *(const LAS bf16x8*)(kb + ln * 128 + co);
            const bf16x8 k1 = *(const LAS bf16x8*)(kb + (32 + ln) * 128 + co);
            const bf16x8 qs = QLDS ? *(const LAS bf16x8*)(qb + s * 1024) : qf[s];
            s0 = MFMA32(k0, qs, s0); s1 = MFMA32(k1, qs, s1);
        }
        if (it >= n1) {
            const int d0 = (p0 - CTXL) - tq + 4 * h + 128;
#pragma unroll
            for (int i = 0; i < 16; ++i) {
                const int dd = d0 + (i & 3) + 8 * (i >> 2);
                s0[i] = ((unsigned)dd <= 256u) ? s0[i] : -1e30f;
                s1[i] = ((unsigned)(dd + 32) <= 256u) ? s1[i] : -1e30f;
            }
        }
        float ps = 0.f;
        unsigned w[16];
        __builtin_amdgcn_sched_barrier(0);
        if (it > 0) {
            int bp = ((it - 1) & 3) * STAGE;
            asm volatile("" : "+s"(bp));
            const LAS char* vbp = lds + bp + KBYTES + vlane;
            FA_PVCORE(vbp);
            FA_EXPCORE();
            __builtin_amdgcn_sched_group_barrier(0x100, PVA, 0);
#pragma unroll
            for (int g = 0; g < 4 * NT; ++g) { __builtin_amdgcn_sched_group_barrier(0x008, 1, 0); __builtin_amdgcn_sched_group_barrier(0x002, VPM, 0);
                if (g < 4 * NT - PVA / 2) __builtin_amdgcn_sched_group_barrier(0x100, 2, 0); }
        } else {
            FA_EXPCORE();
        }
        __builtin_amdgcn_sched_barrier(0);
        if (__any(!(ps <= 1048576.f))) {
            float mx;
            {
                float t0 = max2f(s0[0], s1[0]), t1 = max2f(s0[1], s1[1]), t2 = max2f(s0[2], s1[2]), t3 = max2f(s0[3], s1[3]);
#pragma unroll
                for (int i = 4; i < 16; i += 4) { t0 = max2f(t0, max2f(s0[i], s1[i])); t1 = max2f(t1, max2f(s0[i + 1], s1[i + 1])); t2 = max2f(t2, max2f(s0[i + 2], s1[i + 2])); t3 = max2f(t3, max2f(s0[i + 3], s1[i + 3])); }
                mx = max2f(max2f(t0, t1), max2f(t2, t3));
            }
            mx = max2f(mx, __shfl_xor(mx, 32));
            const float d = fmaxf(mx, 0.f), alpha = __builtin_amdgcn_exp2f(-d);
            m += d; l *= alpha;
#pragma unroll
            for (int i = 0; i < 16; ++i) negm[i] -= d;
#pragma unroll
            for (int tt = 0; tt < NT; ++tt)
#pragma unroll
                for (int i = 0; i < 16; ++i) O[tt][i] *= alpha;
            ps = 0.f;
#pragma unroll
            for (int i = 0; i < 16; i += 2) {
                const float a0 = __builtin_amdgcn_exp2f(s0[i] - d), a1 = __builtin_amdgcn_exp2f(s0[i + 1] - d);
                const float b0 = __builtin_amdgcn_exp2f(s1[i] - d), b1 = __builtin_amdgcn_exp2f(s1[i + 1] - d);
                ps += (a0 + a1) + (b0 + b1);
                w[i >> 1] = pk2(a0, a1); w[8 + (i >> 1)] = pk2(b0, b1);
            }
        }
#pragma unroll
        for (int x = 0; x < 2; ++x)
#pragma unroll
            for (int y = 0; y < 2; ++y) { u32x4 q; q.x = w[8 * x + 4 * y]; q.y = w[8 * x + 4 * y + 1]; q.z = w[8 * x + 4 * y + 2]; q.w = w[8 * x + 4 * y + 3];
                pfp[x][y] = __builtin_bit_cast(bf16x8, q); }
        l += ps;
    }
    { int bp = ((ntile - 1) & 3) * STAGE; asm volatile("" : "+s"(bp)); const LAS char* vbp = lds + bp + KBYTES + vlane; FA_PVCORE(vbp); }
    __builtin_amdgcn_s_barrier();
#undef FA_ISSUE
#undef FA_PVCORE
#undef FA_EXPCORE
#undef FA_DMA
    lout = l + __shfl_xor(l, 32);
}

constexpr int CTX_EARLY_LO = 96, CTX_EARLY_N = 32;
DI bool ctx_early(int nb) { return nb >= CTX_EARLY_LO + CTX_EARLY_N; }
DI void outproj_run(const Params& P, int l, int mode, int c, int nb, char* smem);
DI void phase_attn(const Params& P, int l, int bid, int nb, char* smem) {
    const int t = threadIdx.x, wave = t >> 6;
    const bf16_t* QB = (const bf16_t*)(P.ws + OFF_QB); const bf16_t* KB = (const bf16_t*)(P.ws + OFF_KB); const bf16_t* VT = (const bf16_t*)(P.ws + OFF_VT);
    bf16_t* MIX = (bf16_t*)(P.ws + OFF_HX);
    const float lambda_init = l == 0 ? 0.2f : (0.8f - 0.6f * expf(-0.3f));
    float d1 = P.lam_q1[l * 64 + (t & 63)] * P.lam_k1[l * 64 + (t & 63)], d2 = P.lam_q2[l * 64 + (t & 63)] * P.lam_k2[l * 64 + (t & 63)];
    d1 = wave_sum(d1); d2 = wave_sum(d2);
    const float lam = expf(d1) - expf(d2) + lambda_init;
    const bool has_ctx = l == 0 && bid < 96;
    const int nmain = (768 - bid + nb - 1) / nb;
#pragma unroll 1
    for (int kk = 0; kk < nmain + (has_ctx ? 1 : 0); ++kk) {
        const int it = has_ctx ? (kk == 0 ? 768 + bid : bid + (kk - 1) * nb) : bid + kk * nb;
        int ty, b, hd, p0q, ncx;
        bool isctx;
        if (it < 768) {
            ty = it >> 8; const int idx = it & 255, xcd = idx & 7, r = idx >> 3, stream = xcd * 4 + (r >> 3);
            b = stream >> 2; hd = stream & 3; p0q = CTXL + (r & 7) * 256; isctx = false; ncx = TPB / 64;
        } else {
            const int i2 = it - 768, t12 = i2 % 12;
            b = i2 / 12; p0q = 0; ty = t12 >> 2; hd = t12 & 3; isctx = true; ncx = CTXL / 64;
        }
        int lane = t & 63;
        asm volatile("" : "+v"(lane));
        const int h = lane >> 5, ln = lane & 31;
        const int p = p0q + wave * 32 + ln, tok = b * TPB + p, tq = p - CTXL;
        if (ty == 0) {
            f32x16 O[4]; float lt;
            const bf16_t* V = VT + (size_t)b * VS + (size_t)hd * TPB * 128;
            flash_run<128>(smem, QB + (((size_t)b * NQU + 2 * hd + 1) * TPB + p) * 64, KB + ((size_t)b * NKU + 2 * hd + 1) * TPB * 64, V, ncx, 0, 0, tq, -1e30f, 0.f, O, lt);
            {
                int l2_ = t & 63; asm volatile("" : "+v"(l2_)); const int h2 = l2_ >> 5; bf16_t* orow = MIX + (size_t)(b * TPB + p0q + wave * 32 + (l2_ & 31)) * DM + hd * 128 + 4 * h2;
                const float f = -lam / lt;
#pragma unroll
                for (int tt = 0; tt < 4; ++tt)
#pragma unroll
                    for (int g = 0; g < 4; ++g) { u32x2 o; o.x = pk2(O[tt][4 * g] * f, O[tt][4 * g + 1] * f); o.y = pk2(O[tt][4 * g + 2] * f, O[tt][4 * g + 3] * f);
                        *(u32x2*)(orow + 32 * tt + 8 * g) = o; }
            }
            flash_run<128>(smem, QB + (((size_t)b * NQU + 2 * hd) * TPB + p) * 64, KB + ((size_t)b * NKU + 2 * hd) * TPB * 64, V, ncx, 0, 0, tq, -1e30f, 0.f, O, lt);
            {
                int l2_ = t & 63; asm volatile("" : "+v"(l2_)); const int h2 = l2_ >> 5; bf16_t* orow = MIX + (size_t)(b * TPB + p0q + wave * 32 + (l2_ & 31)) * DM + hd * 128 + 4 * h2;
                const float f = 1.f / lt; float ss = 0.f;
#pragma unroll
                for (int tt = 0; tt < 4; ++tt)
#pragma unroll
                    for (int g = 0; g < 4; ++g) {
                        const u32x2 st = *(const u32x2*)(orow + 32 * tt + 8 * g);
                        O[tt][4 * g + 0] = O[tt][4 * g + 0] * f + __uint_as_float(st.x << 16);
                        O[tt][4 * g + 1] = O[tt][4 * g + 1] * f + __uint_as_float(st.x & 0xffff0000u);
                        O[tt][4 * g + 2] = O[tt][4 * g + 2] * f + __uint_as_float(st.y << 16);
                        O[tt][4 * g + 3] = O[tt][4 * g + 3] * f + __uint_as_float(st.y & 0xffff0000u);
                        ss += (O[tt][4 * g] * O[tt][4 * g] + O[tt][4 * g + 1] * O[tt][4 * g + 1]) + (O[tt][4 * g + 2] * O[tt][4 * g + 2] + O[tt][4 * g + 3] * O[tt][4 * g + 3]);
                    }
                ss += __shfl_xor(ss, 32);
                const float r = rsqrtf(ss * (1.f / 128.f) + RMS_EPS) * (1.f - lambda_init);
                const float* sg = P.subln_g + l * 128 + 4 * h2;
#pragma unroll
                for (int tt = 0; tt < 4; ++tt)
#pragma unroll
                    for (int g = 0; g < 4; ++g) { const f32x4 gg = *(const f32x4*)(sg + 32 * tt + 8 * g);
                        u32x2 o; o.x = pk2(O[tt][4 * g] * r * gg.x, O[tt][4 * g + 1] * r * gg.y); o.y = pk2(O[tt][4 * g + 2] * r * gg.z, O[tt][4 * g + 3] * r * gg.w);
                        *(u32x2*)(orow + 32 * tt + 8 * g) = o; }
            }
        } else {
            const bool isC = ty == 2;
            f32x16 O[2]; float lt;
            const int qu = (isC ? 12 : 8) + hd, ku = (isC ? 10 : 8) + (hd >> 1);
            const bf16_t* V = VT + (size_t)b * VS + (size_t)4 * TPB * 128 + (size_t)((isC ? 2 : 0) + (hd >> 1)) * TPB * 64;
            int n1 = ncx, base2 = 0, n2 = 0;
            float m0 = -1e30f, l0 = 0.f;
            if (isC) {
                m0 = P.sink[l * 4 + hd] * 1.4426950408889634f; l0 = h == 0 ? 1.f : 0.f;
                if (!isctx) { const int n = (p0q - CTXL) >> 8; n1 = CTXL / 64; const int jlo = n == 0 ? 2 : 0, jhi = n == 7 ? 6 : 8;
                    base2 = CTXL + 256 * n - 128 + 64 * jlo; n2 = jhi - jlo; }
            }
            flash_run<64>(smem, QB + (((size_t)b * NQU + qu) * TPB + p) * 64, KB + ((size_t)b * NKU + ku) * TPB * 64, V, n1, base2, n2, tq, m0, l0, O, lt);
            const float f = 1.f / lt;
            int l2_ = t & 63; asm volatile("" : "+v"(l2_)); const int h2 = l2_ >> 5; bf16_t* orow = MIX + (size_t)(b * TPB + p0q + wave * 32 + (l2_ & 31)) * DM + (isC ? 768 : 512) + hd * 64 + 4 * h2;
#pragma unroll
            for (int tt = 0; tt < 2; ++tt)
#pragma unroll
                for (int g = 0; g < 4; ++g) { u32x2 o; o.x = pk2(O[tt][4 * g] * f, O[tt][4 * g + 1] * f); o.y = pk2(O[tt][4 * g + 2] * f, O[tt][4 * g + 3] * f);
                    *(u32x2*)(orow + 32 * tt + 8 * g) = o; }
        }
        if (it >= 768) {
            asm volatile("s_waitcnt vmcnt(0)" ::: "memory");
            __syncthreads();
            if (t == 0) { __builtin_amdgcn_fence(__ATOMIC_RELEASE, "agent"); asm volatile("s_waitcnt vmcnt(0)" ::: "memory");
                __hip_atomic_fetch_add((int*)(P.ws + OFF_RDYC) + ((it - 768) / 12) * 64, 1, __ATOMIC_RELAXED, __HIP_MEMORY_SCOPE_AGENT); }
        }
    }
    if (l == 0 && ctx_early(nb) && bid >= CTX_EARLY_LO && bid < CTX_EARLY_LO + CTX_EARLY_N) outproj_run(P, 0, 2, bid - CTX_EARLY_LO, nb, smem);
}

DI void phase_norm2_route(const Params& P, int l, int bid, int nb, char* smem) {
    const int t = threadIdx.x, lane = t & 63, wave = t >> 6;
    int* lcnt = (int*)(smem + LDS_MISC);
    int* lbase = lcnt + 16;
    int* rec = lcnt + 32;
    int* rec2 = rec + 160;
    __syncthreads();
    {
        int ts = t;
        asm volatile("" : "+v"(ts));
        f32x4 wv[4096 / NTHREADS];
#pragma unroll
        for (int i = 0; i < 4096 / NTHREADS; ++i) { const int idx = ts + NTHREADS * i; wv[i] = *(const f32x4*)(P.w_router + (idx >> 2) * 16 + (idx & 3) * 4); }
#pragma unroll
        for (int i = 0; i < 4096 / NTHREADS; ++i) { const int idx = ts + NTHREADS * i, k = idx >> 2, q = idx & 3;
            const int row = ((k >> 8) * 4 + (k & 3)) * 64 + ((k >> 2) & 63);
            *(f32x4*)(smem + row * 64 + ((q ^ ((row >> 2) & 3)) << 4)) = wv[i]; }
    }
    if (t < 16) lcnt[t] = 0;
    __syncthreads();
    bf16_t* HX = (bf16_t*)(P.ws + OFF_HX);
    int* cnt = (int*)(P.ws + OFF_CNT) + l * 16 * 64;
    int* list = (int*)(P.ws + OFF_LIST);
    float* tokw = (float*)(P.ws + OFF_TOKW);
    const int per = (NTOK + nb - 1) / nb;
    const int tk0 = bid * per, tk1 = min(NTOK, tk0 + per), ntk = tk1 - tk0;
    const int eme = ((lane >> 5) & 1) * 8 + ((lane >> 4) & 1) * 4 + ((lane >> 3) & 1) * 2 + ((lane >> 2) & 1);
    const float mybias = P.router_bias[eme];
    f32x4 v[4], vn[4], gs[4], hs[4];
    int cur_mr = -1;
    if (wave < ntk) { const int tok = tk0 + wave, b = tok / TPB, p = tok % TPB; const u32x2* xr = (const u32x2*)resid_row(P, b, p) + lane;
#pragma unroll
        for (int j = 0; j < 4; ++j) vn[j] = bf4_to_f32(xr[64 * j]); }
    for (int i = wave; i < ntk; i += NW) {
        const int tok = tk0 + i;
        const int b = tok / TPB, p = tok % TPB, mr = p < CTXL ? 8 : b;
#pragma unroll
        for (int j = 0; j < 4; ++j) v[j] = vn[j];
        if (i + NW < ntk) { const int tk2 = tok + NW, b2 = tk2 / TPB, p2 = tk2 % TPB; const u32x2* xr = (const u32x2*)resid_row(P, b2, p2) + lane;
#pragma unroll
            for (int j = 0; j < 4; ++j) vn[j] = bf4_to_f32(xr[64 * j]); }
        if (l == 1 && p < CTXL) { if (lane == 0) rec[i] = -1; continue; }
        float ss = 0.f;
#pragma unroll
        for (int j = 0; j < 4; ++j) ss += (v[j].x * v[j].x + v[j].y * v[j].y) + (v[j].z * v[j].z + v[j].w * v[j].w);
        const float r = rsqrtf(wave_sum(ss) * (1.f / DM) + RMS_EPS);
        if (mr != cur_mr) {
            const float* md = mod_row(P, l, mr);
            const f32x4* gn = (const f32x4*)(P.norm2_g + l * DM) + lane;
            const f32x4* sh = (const f32x4*)(md + 3072) + lane;
            const f32x4* sc = (const f32x4*)(md + 4096) + lane;
#pragma unroll
            for (int j = 0; j < 4; ++j) { const f32x4 g = gn[64 * j], s1 = sc[64 * j]; gs[j] = g * (1.f + s1); hs[j] = sh[64 * j]; }
            cur_mr = mr;
        }
        u32x2* o = (u32x2*)(HX + (size_t)tok * DM) + lane;
        float lg[16];
#pragma unroll
        for (int e = 0; e < 16; ++e) lg[e] = 0.f;
#pragma unroll
        for (int j = 0; j < 4; ++j) {
            float y[4];
            y[0] = v[j].x * r * gs[j].x + hs[j].x; y[1] = v[j].y * r * gs[j].y + hs[j].y;
            y[2] = v[j].z * r * gs[j].z + hs[j].z; y[3] = v[j].w * r * gs[j].w + hs[j].w;
            u32x2 w; w.x = pk2(y[0], y[1]); w.y = pk2(y[2], y[3]);
            o[64 * j] = w;
#pragma unroll
            for (int cc = 0; cc < 4; ++cc) {
                const int row = (j * 4 + cc) * 64 + lane;
#pragma unroll
                for (int q = 0; q < 4; ++q) {
                    const f32x4 wv = *(const f32x4*)(smem + row * 64 + ((q ^ ((row >> 2) & 3)) << 4));
                    lg[4 * q + 0] += y[cc] * wv.x; lg[4 * q + 1] += y[cc] * wv.y; lg[4 * q + 2] += y[cc] * wv.z; lg[4 * q + 3] += y[cc] * wv.w;
                }
            }
        }
        float a8[8], a4[4], a2[2], a1;
        { const bool hi = lane & 32;
#pragma unroll
          for (int j = 0; j < 8; ++j) { const float keep = hi ? lg[8 + j] : lg[j], send = hi ? lg[j] : lg[8 + j]; a8[j] = keep + __shfl_xor(send, 32); } }
        { const bool hi = lane & 16;
#pragma unroll
          for (int j = 0; j < 4; ++j) { const float keep = hi ? a8[4 + j] : a8[j], send = hi ? a8[j] : a8[4 + j]; a4[j] = keep + __shfl_xor(send, 16); } }
        { const bool hi = lane & 8;
#pragma unroll
          for (int j = 0; j < 2; ++j) { const float keep = hi ? a4[2 + j] : a4[j], send = hi ? a4[j] : a4[2 + j]; a2[j] = keep + __shfl_xor(send, 8); } }
        { const bool hi = lane & 4; const float keep = hi ? a2[1] : a2[0], send = hi ? a2[0] : a2[1]; a1 = keep + __shfl_xor(send, 4); }
        a1 += __shfl_xor(a1, 2); a1 += __shfl_xor(a1, 1);
        const float mysc = 1.f / (1.f + expf(-a1)), mysel = mysc + mybias;
        float scv[16], sel[16];
#pragma unroll
        for (int e = 0; e < 16; ++e) { const int src = ((e >> 3) & 1) * 32 + ((e >> 2) & 1) * 16 + ((e >> 1) & 1) * 8 + (e & 1) * 4;
            scv[e] = __int_as_float(__builtin_amdgcn_readlane(__float_as_int(mysc), src)); sel[e] = __int_as_float(__builtin_amdgcn_readlane(__float_as_int(mysel), src)); }
        float bestg = -1e30f; int be1 = 0, be2 = 1; float bw1 = 0.f, bw2 = 0.f;
#pragma unroll
        for (int g = 0; g < 4; ++g) {
            int i1 = 0; float v1 = sel[4 * g], w1 = scv[4 * g];
#pragma unroll
            for (int j = 1; j < 4; ++j) if (sel[4 * g + j] > v1) { v1 = sel[4 * g + j]; w1 = scv[4 * g + j]; i1 = j; }
            int i2 = -1; float v2 = -1e30f, w2 = 0.f;
#pragma unroll
            for (int j = 0; j < 4; ++j) if (j != i1 && sel[4 * g + j] > v2) { v2 = sel[4 * g + j]; w2 = scv[4 * g + j]; i2 = j; }
            const float gs = v1 + v2;
            if (gs > bestg) { bestg = gs; be1 = 4 * g + i1; be2 = 4 * g + i2; bw1 = w1; bw2 = w2; }
        }
        if (lane == 0) {
            const float inv = 1.f / (bw1 + bw2);
            const int r1 = atomicAdd(&lcnt[be1], 1), r2 = atomicAdd(&lcnt[be2], 1);
            rec[i] = be1 | (be2 << 8) | (r1 << 16); rec2[i] = r2;
            tokw[2 * tok] = bw1 * inv; tokw[2 * tok + 1] = bw2 * inv;
        }
    }
    __syncthreads();
    if (t < 16) { const int c = lcnt[t]; lbase[t] = c ? atomicAdd(&cnt[t * 64], c) : 0; }
    __syncthreads();
    for (int i = t; i < ntk; i += NTHREADS) {
        const int rc = rec[i];
        if (rc >= 0) { const int e1 = rc & 255, e2 = (rc >> 8) & 255, r1 = rc >> 16, r2 = rec2[i], tok = tk0 + i;
            list[e1 * NTOK + lbase[e1] + r1] = 2 * tok; list[e2 * NTOK + lbase[e2] + r2] = 2 * tok + 1; }
    }
}

struct SchedOut {
    const bf16_t *A, *Wt; int G, c, mode;
    int* rdyc;
    static constexpr bool GATHER = false;
    DI void a_ready(const g8::Unit& u) const {
        if (mode != 2) return;
        if (__builtin_amdgcn_readfirstlane(threadIdx.x >> 6) == 0) {
            unsigned sp = 0;
            while (__hip_atomic_load(rdyc + (u.a / 9) * 64, __ATOMIC_RELAXED, __HIP_MEMORY_SCOPE_AGENT) < 12) { __builtin_amdgcn_s_sleep(2); if (++sp > (1u << 22)) break; }
            __builtin_amdgcn_fence(__ATOMIC_ACQUIRE, "agent");
            asm volatile("s_waitcnt vmcnt(0)" ::: "memory");
        }
        __builtin_amdgcn_s_barrier();
    }
    DI bool next(int i, g8::Unit& u) const {
        int pm, pn;
        if (mode == 2) { if (i != 0) return false; pm = 9 * (c >> 2); pn = c & 3; }
        else { if (!g8::static_unit(i, G, c, mode == 0 ? 72 : 64, 4, pm, pn)) return false; if (mode == 1) pm = 9 * (pm >> 3) + 1 + (pm & 7); }
        u.a = pm; u.b = pn; u.c = 0; u.d = 0; u.bt = Wt + (size_t)pn * 256 * DM; return true; }
    DI const bf16_t* a_base(const g8::Unit& u) const { return A + (size_t)u.a * 256 * DM; }
};
struct EpiOut {
    static constexpr bool AFTER_DRAIN = false;
    const float *x, *ctx; float *out, *xc; const float* mod; int l;
    DI void operator()(const f32x4 (&acc)[2][2][4][2], const g8::Unit& u, int wr, int wc, int fr, int fq) const {
        const int tok0 = u.a * 256, b = tok0 / TPB, p0 = tok0 % TPB;
        const bool isctx = p0 == 0;
        const float* g1 = mod + (size_t)(l * 9 + (isctx ? 8 : b)) * 6144 + 2048 + u.b * 256 + 32 * wc + 4 * fq;
        f32x4 g4[2][2];
#pragma unroll
        for (int bj = 0; bj < 2; ++bj)
#pragma unroll
            for (int n = 0; n < 2; ++n) g4[bj][n] = *(const f32x4*)(g1 + 128 * bj + 16 * n);
        const int cb = u.b * 256 + 32 * wc + 4 * fq;
#pragma unroll
        for (int ai = 0; ai < 2; ++ai)
#pragma unroll
            for (int m = 0; m < 4; ++m) {
                const int r = 128 * ai + 64 * wr + 16 * m + fr;
                const size_t ro = isctx ? (size_t)(b * CTXL + r) * DM : (size_t)(b * SEQ + p0 - CTXL + r) * DM;
                const float* xin = (isctx ? ctx : x) + ro + cb;
                bf16_t* xo = (isctx ? (bf16_t*)xc + ro : (bf16_t*)(out + ro)) + cb;
#pragma unroll
                for (int bj = 0; bj < 2; ++bj)
#pragma unroll
                    for (int n = 0; n < 2; ++n) { const f32x4 xv = l == 0 ? *(const f32x4*)(xin + 128 * bj + 16 * n) : bf4_to_f32(*(const u32x2*)(xo + 128 * bj + 16 * n));
                        *(u32x2*)(xo + 128 * bj + 16 * n) = f32_to_bf4(xv + g4[bj][n] * acc[ai][bj][m][n]); }
                if (m & 1) asm volatile("" ::: "memory");
            }
    }
};
struct EpiOutF {
    static constexpr bool AFTER_DRAIN = true;
    const Params& P; int l;
    DI void operator()(const f32x4 (&)[2][2][4][2], const g8::Unit&, int, int, int, int) const {}
    DI void fused(f32x4 (&acc)[2][2][4][2], const g8::Unit& u, int wr, int wc, int fr, int fq, char* smem) const {
        const int tid = threadIdx.x;
        const int tok0 = u.a * 256, b = tok0 / TPB, p0 = tok0 % TPB, pn = u.b;
        const bool isctx = p0 == 0;
        const int mr = isctx ? 8 : b;
        const float* md = mod_row(P, l, mr);
        const int cb = pn * 256 + 32 * wc + 4 * fq;
        float* part = (float*)smem;
        float* rt = part + 256 * 4 * 17;
        int* lcnt = (int*)(rt + 256);
        int* lbase = lcnt + 16;
        const float* wtab = (const float*)(smem + LDS_MISC);
        float* xc = (float*)(P.ws + OFF_XC);
        {
            f32x4 g4[2][2];
#pragma unroll
            for (int bj = 0; bj < 2; ++bj)
#pragma unroll
                for (int n = 0; n < 2; ++n) g4[bj][n] = *(const f32x4*)(md + 2048 + cb + 128 * bj + 16 * n);
#pragma unroll
            for (int ai = 0; ai < 2; ++ai)
#pragma unroll
                for (int m = 0; m < 4; ++m) {
                    const int r = 128 * ai + 64 * wr + 16 * m + fr;
                    const size_t ro = isctx ? (size_t)(b * CTXL + r) * DM : (size_t)(b * SEQ + p0 - CTXL + r) * DM;
                    const float* xin = (isctx ? P.ctx : P.x) + ro + cb;
                    bf16_t* xo = (isctx ? (bf16_t*)xc + ro : (bf16_t*)(P.out + ro)) + cb;
#pragma unroll
                    for (int bj = 0; bj < 2; ++bj)
#pragma unroll
                        for (int n = 0; n < 2; ++n) { const f32x4 xv = l == 0 ? *(const f32x4*)(xin + 128 * bj + 16 * n) : bf4_to_f32(*(const u32x2*)(xo + 128 * bj + 16 * n));
                            acc[ai][bj][m][n] = xv + g4[bj][n] * acc[ai][bj][m][n]; *(u32x2*)(xo + 128 * bj + 16 * n) = f32_to_bf4(acc[ai][bj][m][n]); }
                    if (m & 1) asm volatile("" ::: "memory");
                }
        }
        {
            float wb[2][2][4];
#pragma unroll
            for (int bj = 0; bj < 2; ++bj)
#pragma unroll
                for (int n = 0; n < 2; ++n)
#pragma unroll
                    for (int r = 0; r < 4; ++r) wb[bj][n][r] = wtab[(128 * bj + 32 * wc + 16 * n + 4 * fq + r) * 16 + fr];
#pragma unroll
            for (int ai = 0; ai < 2; ++ai)
#pragma unroll
                for (int m = 0; m < 4; ++m) {
                    f32x4 d = {0.f, 0.f, 0.f, 0.f}; float ss = 0.f;
#pragma unroll
                    for (int bj = 0; bj < 2; ++bj)
#pragma unroll
                        for (int n = 0; n < 2; ++n) { const f32x4 v = acc[ai][bj][m][n];
                            ss += (v.x * v.x + v.y * v.y) + (v.z * v.z + v.w * v.w);
                            d = __builtin_amdgcn_mfma_f32_16x16x4f32(v.x, wb[bj][n][0], d, 0, 0, 0);
                            d = __builtin_amdgcn_mfma_f32_16x16x4f32(v.y, wb[bj][n][1], d, 0, 0, 0);
                            d = __builtin_amdgcn_mfma_f32_16x16x4f32(v.z, wb[bj][n][2], d, 0, 0, 0);
                            d = __builtin_amdgcn_mfma_f32_16x16x4f32(v.w, wb[bj][n][3], d, 0, 0, 0); }
                    ss += __shfl_xor(ss, 16); ss += __shfl_xor(ss, 32);
                    const int rowb = 128 * ai + 64 * wr + 16 * m;
                    part[((rowb + 4 * fq + 0) * 4 + wc) * 17 + fr] = d.x;
                    part[((rowb + 4 * fq + 1) * 4 + wc) * 17 + fr] = d.y;
                    part[((rowb + 4 * fq + 2) * 4 + wc) * 17 + fr] = d.z;
                    part[((rowb + 4 * fq + 3) * 4 + wc) * 17 + fr] = d.w;
                    if (fq == 0) part[((rowb + fr) * 4 + wc) * 17 + 16] = ss;
                }
        }
        __syncthreads();
        float* xch = (float*)(P.ws + OFF_XCH) + (size_t)u.a * 4 * 256 * 17;
        { float* dst = xch + (size_t)pn * 256 * 17;
          for (int i = tid; i < 256 * 17; i += NTHREADS) { const int row = i / 17, e = i - row * 17; const float* pp = part + row * 68 + e; __hip_atomic_store(dst + i, (pp[0] + pp[17]) + (pp[34] + pp[51]), __ATOMIC_RELAXED, __HIP_MEMORY_SCOPE_AGENT); } }
        asm volatile("s_waitcnt vmcnt(0)" ::: "memory");
        __syncthreads();
        if (tid == 0) {
            int* xcn = (int*)(P.ws + OFF_XCNT) + (l * 72 + u.a) * 64;
            __hip_atomic_fetch_add(xcn, 1, __ATOMIC_RELAXED, __HIP_MEMORY_SCOPE_AGENT);
            unsigned sp = 0;
            while (__hip_atomic_load(xcn, __ATOMIC_RELAXED, __HIP_MEMORY_SCOPE_AGENT) < 4) { __builtin_amdgcn_s_sleep(1); if (++sp > (1u << 22)) break; }
            __builtin_amdgcn_fence(__ATOMIC_ACQUIRE, "agent");
            asm volatile("s_waitcnt vmcnt(0)" ::: "memory");
        }
        if (tid >= 64 && tid < 80) lcnt[tid - 64] = 0;
        __syncthreads();
        if (tid < 256) { float sq = 0.f;
#pragma unroll
            for (int q = 0; q < 4; ++q) sq += xch[(size_t)(q * 256 + tid) * 17 + 16];
            rt[tid] = rsqrtf(sq * (1.f / DM) + RMS_EPS); }
        __syncthreads();
        {
            f32x4 gs[2][2], hs[2][2];
#pragma unroll
            for (int bj = 0; bj < 2; ++bj)
#pragma unroll
                for (int n = 0; n < 2; ++n) { const int c = cb + 128 * bj + 16 * n;
                    const f32x4 g = *(const f32x4*)(P.norm2_g + l * DM + c), s1 = *(const f32x4*)(md + 4096 + c);
                    gs[bj][n] = g * (1.f + s1); hs[bj][n] = *(const f32x4*)(md + 3072 + c); }
            bf16_t* HX = (bf16_t*)(P.ws + OFF_HX);
#pragma unroll
            for (int ai = 0; ai < 2; ++ai)
#pragma unroll
                for (int m = 0; m < 4; ++m) {
                    const int row = 128 * ai + 64 * wr + 16 * m + fr;
                    const float r = rt[row];
                    bf16_t* o = HX + (size_t)(tok0 + row) * DM + cb;
#pragma unroll
                    for (int bj = 0; bj < 2; ++bj)
#pragma unroll
                        for (int n = 0; n < 2; ++n) { const f32x4 v = acc[ai][bj][m][n], g = gs[bj][n], h = hs[bj][n];
                            u32x2 w; w.x = pk2(v.x * r * g.x + h.x, v.y * r * g.y + h.y); w.y = pk2(v.z * r * g.z + h.z, v.w * r * g.w + h.w);
                            *(u32x2*)(o + 128 * bj + 16 * n) = w; }
                }
        }
        int be1 = 0, be2 = 1, r1 = 0, r2 = 0;
        const int rrow = 64 * pn + tid, rtok = tok0 + rrow;
        if (tid < 64) {
            const float r = rt[rrow];
            float lg[16];
#pragma unroll
            for (int e = 0; e < 16; ++e) lg[e] = 0.f;
#pragma unroll
            for (int q = 0; q < 4; ++q) { const float* sp = xch + (size_t)(q * 256 + rrow) * 17;
#pragma unroll
                for (int e = 0; e < 16; ++e) lg[e] += sp[e]; }
            const float* qe = (const float*)(P.ws + OFF_QE) + (l * 9 + mr) * 16;
            float scv[16], sel[16];
#pragma unroll
            for (int e = 0; e < 16; ++e) { const float a = lg[e] * r + qe[e]; scv[e] = 1.f / (1.f + expf(-a)); sel[e] = scv[e] + P.router_bias[e]; }
            float bestg = -1e30f; float bw1 = 0.f, bw2 = 0.f;
#pragma unroll
            for (int g = 0; g < 4; ++g) {
                int i1 = 0; float v1 = sel[4 * g], w1 = scv[4 * g];
#pragma unroll
                for (int j = 1; j < 4; ++j) if (sel[4 * g + j] > v1) { v1 = sel[4 * g + j]; w1 = scv[4 * g + j]; i1 = j; }
                int i2 = -1; float v2 = -1e30f, w2 = 0.f;
#pragma unroll
                for (int j = 0; j < 4; ++j) if (j != i1 && sel[4 * g + j] > v2) { v2 = sel[4 * g + j]; w2 = scv[4 * g + j]; i2 = j; }
                const float gsum = v1 + v2;
                if (gsum > bestg) { bestg = gsum; be1 = 4 * g + i1; be2 = 4 * g + i2; bw1 = w1; bw2 = w2; }
            }
            const float inv = 1.f / (bw1 + bw2);
            r1 = atomicAdd(&lcnt[be1], 1); r2 = atomicAdd(&lcnt[be2], 1);
            float* tokw = (float*)(P.ws + OFF_TOKW);
            tokw[2 * rtok] = bw1 * inv; tokw[2 * rtok + 1] = bw2 * inv;
        }
        __syncthreads();
        if (tid < 16) { const int c = lcnt[tid]; int* cnt = (int*)(P.ws + OFF_CNT) + l * 16 * 64; lbase[tid] = c ? atomicAdd(&cnt[tid * 64], c) : 0; }
        __syncthreads();
        if (tid < 64) { int* list = (int*)(P.ws + OFF_LIST);
            list[be1 * NTOK + lbase[be1] + r1] = 2 * rtok; list[be2 * NTOK + lbase[be2] + r2] = 2 * rtok + 1; }
        __syncthreads();
    }
};
DI bool route_fused(int nb) { return nb == 256; }
DI void outproj_run(const Params& P, int l, int mode, int c, int nb, char* smem) {
    SchedOut S{(const bf16_t*)(P.ws + OFF_HX), (const bf16_t*)(P.ws + OFF_WOUT) + (size_t)l * DM * DM, nb, c, mode, (int*)(P.ws + OFF_RDYC)};
    if (route_fused(nb) && mode != 0) {
        g8::Unit u;
        if (S.next(0, u)) {
            const int tok0 = u.a * 256, mr = (tok0 % TPB == 0) ? 8 : tok0 / TPB;
            const float* md = mod_row(P, l, mr);
            float* wtab = (float*)(smem + LDS_MISC);
#pragma unroll
            for (int i = 0; i < 2; ++i) { const int idx = threadIdx.x + NTHREADS * i, cc = idx >> 2, q = idx & 3, col = u.b * 256 + cc;
                const float g = P.norm2_g[l * DM + col] * (1.f + md[4096 + col]);
                *(f32x4*)(wtab + cc * 16 + 4 * q) = g * *(const f32x4*)(P.w_router + col * 16 + 4 * q); }
        }
        EpiOutF E{P, l};
        g8::gemm_phase(smem, (const bf16_t*)(P.ws + OFF_HX), DM, S, E);
        return;
    }
    EpiOut E{P.x, P.ctx, P.out, (float*)(P.ws + OFF_XC), (const float*)(P.ws + OFF_MOD), l};
    g8::gemm_phase(smem, (const bf16_t*)(P.ws + OFF_HX), DM, S, E);
}
DI void phase_outproj(const Params& P, int l, int bid, int nb, char* smem) {
    outproj_run(P, l, (l == 1 || ctx_early(nb)) ? 1 : 0, bid, nb, smem);
}

constexpr int MAX_RT = 2 * NTOK / 256 + NEXP;
DI void build_tile_table(const int* cnt, char* smem) {
    int* cl = (int*)(smem + LDS_MISC);
    int* tab = cl + 16;
    const int t = threadIdx.x;
    __syncthreads();
    if (t < NEXP) cl[t] = cnt[t * 64];
    __syncthreads();
    if (t < MAX_RT) {
        int acc = 0, e = 0, ti = 0, n = 0, ok = 0;
#pragma unroll
        for (int i = 0; i < NEXP; ++i) { const int c = cl[i], nt = (c + 255) >> 8; const bool hit = !ok && t < acc + nt;
            e = hit ? i : e; ti = hit ? t - acc : ti; n = hit ? c : n; ok = hit ? 1 : ok; acc += nt; }
        tab[4 * t] = e; tab[4 * t + 1] = ti; tab[4 * t + 2] = n; tab[4 * t + 3] = ok;
    }
    __syncthreads();
}
DI bool expert_tile(const char* smem, int rt, int& e, int& ti, int& hbase, int& n) {
    if (rt >= MAX_RT) return false;
    const int* tab = (const int*)(smem + LDS_MISC) + 16 + 4 * rt;
    e = __builtin_amdgcn_readfirstlane(tab[0]); ti = __builtin_amdgcn_readfirstlane(tab[1]); n = __builtin_amdgcn_readfirstlane(tab[2]); hbase = rt * 256;
    return __builtin_amdgcn_readfirstlane(tab[3]) != 0;
}

struct SchedGU {
    const bf16_t* W; const char* tabs; const int* list; int G, c;
    static constexpr bool GATHER = true;
    DI void a_ready(const g8::Unit&) const {}
    DI bool next(int i, g8::Unit& u) const { const int w = i * G + c, rt = w >> 1, ct = w & 1; int e, ti, hb, n; if (!expert_tile(tabs, rt, e, ti, hb, n)) return false;
        u.a = e; u.b = ti | (ct << 16); u.c = hb; u.d = n; u.bt = W + ((size_t)e * 512 + ct * 256) * DM; return true; }
    DI void a_offsets(const g8::Unit& u, const int (&R)[2], const int (&C)[2], unsigned (&av)[2][2]) const {
        const int ti = u.b & 0xffff;
#pragma unroll
        for (int hh = 0; hh < 2; ++hh)
#pragma unroll
            for (int i = 0; i < 2; ++i) { const int li = ti * 256 + 128 * hh + R[i]; const int slot = li < u.d ? list[u.a * NTOK + li] : 0;
                av[hh][i] = (unsigned)((slot >> 1) * DM + C[i]) * 2u; }
    }
};
struct EpiGU {
    static constexpr bool AFTER_DRAIN = false;
    bf16_t* HB;
    DI void operator()(const f32x4 (&acc)[2][2][4][2], const g8::Unit& u, int wr, int wc, int fr, int fq) const {
        const int ct = u.b >> 16;
        bf16_t* hb = HB + (size_t)(u.c + 64 * wr + fr) * DEXP + 128 * ct + 32 * wc + 4 * fq;
#pragma unroll
        for (int ai = 0; ai < 2; ++ai)
#pragma unroll
            for (int m = 0; m < 4; ++m)
#pragma unroll
                for (int n = 0; n < 2; ++n) {
                    const f32x4 g = acc[ai][0][m][n], uu = acc[ai][1][m][n];
                    f32x4 hv;
                    hv.x = g.x / (1.f + __expf(-g.x)) * uu.x; hv.y = g.y / (1.f + __expf(-g.y)) * uu.y; hv.z = g.z / (1.f + __expf(-g.z)) * uu.z; hv.w = g.w / (1.f + __expf(-g.w)) * uu.w;
                    u32x2 o; o.x = pk2(hv.x, hv.y); o.y = pk2(hv.z, hv.w);
                    *(u32x2*)(hb + (size_t)(128 * ai + 16 * m) * DEXP + 16 * n) = o;
                }
    }
};
DI void phase_gateup(const Params& P, int l, int bid, int nb, char* smem) {
    build_tile_table((const int*)(P.ws + OFF_CNT) + l * 16 * 64, smem);
    SchedGU S{(const bf16_t*)(P.ws + OFF_WGU) + (size_t)l * 16 * 512 * DM, smem, (const int*)(P.ws + OFF_LIST), nb, bid};
    EpiGU E{(bf16_t*)(P.ws + OFF_HB)};
    g8::gemm_phase(smem, (const bf16_t*)(P.ws + OFF_HX), DM, S, E);
}

struct SchedDown {
    const bf16_t *A, *W; const char* tabs; int G, c;
    static constexpr bool GATHER = false;
    DI void a_ready(const g8::Unit&) const {}
    DI bool next(int i, g8::Unit& u) const { const int w = i * G + c, rt = w >> 2, ct = w & 3; int e, ti, hb, n; if (!expert_tile(tabs, rt, e, ti, hb, n)) return false;
        u.a = e; u.b = ti | (ct << 16); u.c = hb; u.d = n; u.bt = W + ((size_t)e * DM + ct * 256) * DEXP; return true; }
    DI const bf16_t* a_base(const g8::Unit& u) const { return A + (size_t)u.c * DEXP; }
};
struct EpiDown {
    static constexpr bool AFTER_DRAIN = false;
    bf16_t* Y; const int* list; const float* tokw;
    DI void operator()(const f32x4 (&acc)[2][2][4][2], const g8::Unit& u, int wr, int wc, int fr, int fq) const {
        const int ti = u.b & 0xffff, ct = u.b >> 16;
#pragma unroll
        for (int ai = 0; ai < 2; ++ai)
#pragma unroll
            for (int m = 0; m < 4; ++m) {
                const int li = ti * 256 + 128 * ai + 64 * wr + 16 * m + fr;
                if (li < u.d) {
                    const int slot = list[u.a * NTOK + li]; const float wg = tokw[slot];
                    bf16_t* yr = Y + (size_t)slot * DM + 256 * ct + 32 * wc + 4 * fq;
#pragma unroll
                    for (int bj = 0; bj < 2; ++bj)
#pragma unroll
                        for (int n = 0; n < 2; ++n) { const f32x4 v = acc[ai][bj][m][n]; u32x2 o; o.x = pk2(wg * v.x, wg * v.y); o.y = pk2(wg * v.z, wg * v.w);
                            *(u32x2*)(yr + 128 * bj + 16 * n) = o; }
                }
            }
    }
};
DI void phase_down(const Params& P, int l, int bid, int nb, char* smem) {
    build_tile_table((const int*)(P.ws + OFF_CNT) + l * 16 * 64, smem);
    SchedDown S{(const bf16_t*)(P.ws + OFF_HB), (const bf16_t*)(P.ws + OFF_WD) + (size_t)l * 16 * DM * DEXP, smem, nb, bid};
    EpiDown E{(bf16_t*)(P.ws + OFF_Y), (const int*)(P.ws + OFF_LIST), (const float*)(P.ws + OFF_TOKW)};
    g8::gemm_phase(smem, (const bf16_t*)(P.ws + OFF_HB), DEXP, S, E);
}

#define XB_TMO      128
#define XB_XCNT(j)  (256  + 64 * (j))
#define XB_XSUB(j)  (1280 + 64 * (j))
#define XB_XGEN(j)  (2304 + 64 * (j))
#define XB_TOP      3328
#define XB_TOPGEN   3392
#define XCD_BAR_WORDS 3456
#define XB_SPIN_CAP (1u << 20)
DI unsigned xb_ld(unsigned* p)              { return __hip_atomic_load(p, __ATOMIC_RELAXED, __HIP_MEMORY_SCOPE_AGENT); }
DI unsigned xb_add(unsigned* p, unsigned v) { return __hip_atomic_fetch_add(p, v, __ATOMIC_RELAXED, __HIP_MEMORY_SCOPE_AGENT); }
DI unsigned xb_xcc_id() { return (unsigned)__builtin_amdgcn_s_getreg((3 << 11) | 20) & 0xFu; }
#define XB_SPIN(cond, bar) do { unsigned _sp = 0; while (cond) { __builtin_amdgcn_s_sleep(1); \
    if ((++_sp & 255u) == 0u) { if (xb_ld(&(bar)[XB_TMO])) break; if (_sp > XB_SPIN_CAP) { atomicAdd(&(bar)[XB_TMO], 1u); break; } } } } while (0)
struct XcdBarrier { unsigned* bar; unsigned x; volatile LAS unsigned* st; };
DI XcdBarrier xcd_barrier_post(unsigned* bar, volatile LAS unsigned* st) {
    XcdBarrier b; b.bar = bar; b.x = xb_xcc_id(); b.st = st;
    if (threadIdx.x == 0) (void)xb_add(&bar[XB_XCNT(b.x)], 1u);
    return b;
}
DI void xcd_barrier_complete(unsigned* bar, unsigned x, unsigned& nloc, unsigned& nx) {
    const unsigned G = gridDim.x * gridDim.y * gridDim.z;
    unsigned sum, cnt, mine, sp = 0u;
    for (;;) {
        sum = 0u; cnt = 0u; mine = 0u;
#pragma unroll
        for (unsigned j = 0; j < 16; ++j) { const unsigned c = xb_ld(&bar[XB_XCNT(j)]); sum += c; cnt += (c > 0u) ? 1u : 0u; mine = (j == x) ? c : mine; }
        if (sum == G) break;
        __builtin_amdgcn_s_sleep(1);
        if ((++sp & 255u) == 0u) { if (xb_ld(&bar[XB_TMO])) break; if (sp > XB_SPIN_CAP) { atomicAdd(&bar[XB_TMO], 1u); break; } }
    }
    nloc = mine > 0u ? mine : 1u; nx = cnt > 0u ? cnt : 1u;
}
DI void xcd_barrier(const XcdBarrier& b) {
    asm volatile("s_waitcnt vmcnt(0)" ::: "memory");
    __syncthreads();
    if (threadIdx.x == 0) {
        unsigned* bar = b.bar;
        __builtin_amdgcn_s_waitcnt(0);
        unsigned nloc = b.st[0], nx = b.st[1];
        if (nloc == 0u) { xcd_barrier_complete(bar, b.x, nloc, nx); b.st[0] = nloc; b.st[1] = nx; }
        const unsigned old = xb_add(&bar[XB_XSUB(b.x)], 1u);
        const unsigned gen = old / nloc;
        if (old + 1u == (gen + 1u) * nloc) {
            __builtin_amdgcn_fence(__ATOMIC_RELEASE, "agent");
            asm volatile("s_waitcnt vmcnt(0)" ::: "memory");
            const unsigned og = xb_add(&bar[XB_TOP], 1u);
            const unsigned tg = og / nx;
            if (og + 1u == (tg + 1u) * nx) xb_add(&bar[XB_TOPGEN], 1u);
            else XB_SPIN(xb_ld(&bar[XB_TOPGEN]) == tg, bar);
            __builtin_amdgcn_fence(__ATOMIC_ACQUIRE, "agent");
            xb_add(&bar[XB_XGEN(b.x)], 1u);
            asm volatile("s_waitcnt vmcnt(0)" ::: "memory");
        } else {
            XB_SPIN(xb_ld(&bar[XB_XGEN(b.x)]) == gen, bar);
            __builtin_amdgcn_fence(__ATOMIC_ACQUIRE, "agent");
            asm volatile("s_waitcnt vmcnt(0)" ::: "memory");
        }
    }
    __syncthreads();
}

constexpr int NPHASES = 16;
__global__ void __launch_bounds__(NTHREADS, 2) mk_fwd(Params P, int ph_lo, int ph_hi) {
    extern __shared__ __attribute__((aligned(16))) char smem[];
    const int bid = blockIdx.x, nb = gridDim.x;
    volatile LAS unsigned* xst = (volatile LAS unsigned*)(LAS char*)(smem + LDS_MAIN);
    if (threadIdx.x == 0) { xst[0] = 0u; xst[1] = 0u; }
    __syncthreads();
    XcdBarrier gbar; gbar.bar = (unsigned*)(P.ws + OFF_CTL); gbar.x = 0; gbar.st = xst;
    if (ph_hi - ph_lo > 1) gbar = xcd_barrier_post((unsigned*)(P.ws + OFF_CTL), xst);
#ifndef REPEAT_K
#define REPEAT_K -1
#endif
#ifndef REPEAT_N
#define REPEAT_N 1
#endif
#ifndef EXTRA_SYNCS
#define EXTRA_SYNCS 0
#endif
#define RUN(k, call) if (ph_lo <= (k) && (k) < ph_hi) { if ((k) == REPEAT_K) { for (int rep_ = 0; rep_ < REPEAT_N; ++rep_) { call; xcd_barrier(gbar); } } call; if ((k) + 1 < ph_hi) xcd_barrier(gbar); }
    for (int es_ = 0; es_ < EXTRA_SYNCS; ++es_) xcd_barrier(gbar);
    RUN(0, phase_prologue(P, bid, nb, smem))
    RUN(1, phase_norm1(P, 0, bid, nb))
    RUN(2, phase_qkv(P, 0, bid, nb, smem))
    RUN(3, phase_attn(P, 0, bid, nb, smem))
    RUN(4, phase_outproj(P, 0, bid, nb, smem))
    if (!route_fused(nb)) { RUN(5, phase_norm2_route(P, 0, bid, nb, smem)) }
    RUN(6, phase_gateup(P, 0, bid, nb, smem))
    RUN(7, phase_down(P, 0, bid, nb, smem))
    RUN(8, phase_norm1(P, 1, bid, nb))
    RUN(9, phase_qkv(P, 1, bid, nb, smem))
    RUN(10, phase_attn(P, 1, bid, nb, smem))
    RUN(11, phase_outproj(P, 1, bid, nb, smem))
    if (!route_fused(nb)) { RUN(12, phase_norm2_route(P, 1, bid, nb, smem)) }
    RUN(13, phase_gateup(P, 1, bid, nb, smem))
    RUN(14, phase_down(P, 1, bid, nb, smem))
    RUN(15, phase_final(P, bid, nb))
#undef RUN
}

extern "C" void kernel_launch(void* const* d_in, const int* in_sizes, int n_in, void* d_out, int out_size, void* d_ws, size_t ws_size, hipStream_t stream) {
    Params p{};
    const float** f = (const float**)&p;
    for (int i = 0; i < 24; ++i) f[i] = (const float*)d_in[i];
    p.out = (float*)d_out; p.ws = (unsigned char*)d_ws;
    if (ws_size < WS_END) { fprintf(stderr, "workspace too small: %zu < %zu\n", ws_size, (size_t)WS_END); return; }
#ifndef MULTI_LAUNCH
#define MULTI_LAUNCH 0
#endif
#if MULTI_LAUNCH
    (void)hipFuncSetAttribute((const void*)mk_fwd, hipFuncAttributeMaxDynamicSharedMemorySize, LDS_BYTES);
    (void)hipMemsetAsync((char*)d_ws + OFF_CTL, 0, CTL_BYTES, stream);
    for (int ph = 0; ph < NPHASES; ++ph) hipLaunchKernelGGL(mk_fwd, dim3(256), dim3(NTHREADS), LDS_BYTES, stream, p, ph, ph + 1);
#else
    static int grid_blocks = 0;
    if (!grid_blocks) {
        int dev = 0, cus = 0, per_cu = 0;
        (void)hipGetDevice(&dev);
        (void)hipDeviceGetAttribute(&cus, hipDeviceAttributeMultiprocessorCount, dev);
        (void)hipFuncSetAttribute((const void*)mk_fwd, hipFuncAttributeMaxDynamicSharedMemorySize, LDS_BYTES);
        (void)hipOccupancyMaxActiveBlocksPerMultiprocessor(&per_cu, mk_fwd, NTHREADS, LDS_BYTES);
        if (per_cu > 1) per_cu = 1;
        grid_blocks = cus * per_cu;
        if (grid_blocks <= 0) { fprintf(stderr, "occupancy query failed (%d x %d)\n", cus, per_cu); grid_blocks = 0; return; }
    }
    (void)hipMemsetAsync((char*)d_ws + OFF_CTL, 0, CTL_BYTES, stream);
    hipLaunchKernelGGL(mk_fwd, dim3(grid_blocks), dim3(NTHREADS), LDS_BYTES, stream, p, 0, NPHASES);
    hipError_t e = hipPeekAtLastError();
    if (e != hipSuccess) fprintf(stderr, "launch failed: %s (grid %d)\n", hipGetErrorString(e), grid_blocks);
#endif
}
```

```cpp
#include <hip/hip_runtime.h>
#include <stdint.h>
#include <stdio.h>


#define DI __device__ __forceinline__
#define LAS __attribute__((address_space(3)))
typedef unsigned short bf16_t;
typedef short bf16x8 __attribute__((ext_vector_type(8)));
typedef float f32x16 __attribute__((ext_vector_type(16)));
typedef float f32x4 __attribute__((ext_vector_type(4)));
typedef float f32x2 __attribute__((ext_vector_type(2)));
typedef unsigned u32x4 __attribute__((ext_vector_type(4)));
typedef unsigned u32x2 __attribute__((ext_vector_type(2)));
typedef short s16x4 __attribute__((ext_vector_type(4)));

constexpr int NB = 8, SEQ = 2048, CTXL = 256, TPB = SEQ + CTXL  , NTOK = NB * TPB  ;
constexpr int DM = 1024, INC = 2560, NEXP = 16, DEXP = 256;
constexpr int NQU = 16, NKU = 12, NVR = 768;
constexpr size_t VS = (size_t)NVR * TPB;
constexpr int NTHREADS = 512, NW = NTHREADS / 64;
constexpr int LDS_MAIN = 131072, LDS_MISC = LDS_MAIN + 64, LDS_BYTES = LDS_MISC + 16384;
constexpr float RMS_EPS = 1e-6f;
constexpr float QSCALE = 0.125f * 1.4426950408889634f;

constexpr size_t OFF_CTL  = 0;
constexpr size_t OFF_CNT  = 14336, OFF_RDYC = OFF_CNT + 8192, OFF_XCNT = 24576, CTL_BYTES = OFF_XCNT + 2 * 72 * 256;
constexpr size_t OFF_MOD  = CTL_BYTES;
constexpr size_t OFF_ROPE = OFF_MOD + (size_t)2 * 9 * 6144 * 4;
constexpr size_t OFF_WIN  = OFF_ROPE + 16384;
constexpr size_t OFF_WOUT = OFF_WIN + (size_t)2 * 2560 * 1024 * 2;
constexpr size_t OFF_WGU  = OFF_WOUT + (size_t)2 * 1024 * 1024 * 2;
constexpr size_t OFF_WD   = OFF_WGU + (size_t)2 * 16 * 512 * 1024 * 2;
constexpr size_t OFF_HX   = OFF_WD + (size_t)2 * 16 * 1024 * 256 * 2;
constexpr size_t OFF_QB   = OFF_HX + (size_t)NTOK * DM * 2;
constexpr size_t OFF_KB   = OFF_QB + (size_t)NB * NQU * TPB * 64 * 2;
constexpr size_t OFF_VT   = OFF_KB + (size_t)NB * NKU * TPB * 64 * 2;
constexpr size_t OFF_Y    = OFF_QB;
constexpr size_t OFF_XC   = OFF_VT + (size_t)NB * NVR * TPB * 2;
constexpr size_t HB_ROWS  = 2 * NTOK + NEXP * 256;
constexpr size_t OFF_HB   = OFF_XC + (size_t)NB * CTXL * DM * 4;
constexpr size_t OFF_LIST = OFF_HB + HB_ROWS * DEXP * 2;
constexpr size_t OFF_TOKW = OFF_LIST + (size_t)NEXP * NTOK * 4;
constexpr size_t OFF_XCH  = OFF_TOKW + (size_t)2 * NTOK * 4;
constexpr size_t OFF_QE   = OFF_ROPE + 12288;
constexpr size_t WS_END   = OFF_XCH + (size_t)72 * 4 * 256 * 17 * 4;
static_assert(WS_END <= (size_t)256 * 1024 * 1024, "workspace");
static_assert((size_t)2 * NTOK * DM * 2 <= OFF_XC - OFF_QB, "Y alias");

struct Params {
    const float *x, *c, *ctx, *c_ctx, *w_ada, *b_ada, *norm1_g, *norm2_g, *w_in, *w_out, *lam_q1, *lam_k1, *lam_q2, *lam_k2,
        *subln_g, *q_norm_g, *k_norm_g, *sink, *w_router, *router_bias, *w_gate, *w_up, *w_down, *final_g;
    float* out;
    unsigned char* ws;
};

DI float bf2f(bf16_t b) { return __uint_as_float(((unsigned)b) << 16); }
typedef __bf16 bf2_t __attribute__((ext_vector_type(2)));
DI bf16_t f2bf(float f) { return __builtin_bit_cast(bf16_t, (__bf16)f); }
DI unsigned pk2(float lo, float hi) { bf2_t v = {(__bf16)lo, (__bf16)hi}; return __builtin_bit_cast(unsigned, v); }
DI int crow(int reg, int h) { return (reg & 3) + 8 * (reg >> 2) + 4 * h; }
DI float wave_sum(float v) {
#pragma unroll
    for (int o = 1; o < 64; o <<= 1) v += __shfl_xor(v, o);
    return v;
}
DI float max2f(float a, float b) { return __builtin_amdgcn_fmed3f(a, b, __builtin_inff()); }
DI float silu(float v) { return v / (1.f + expf(-v)); }
DI bf16_t* resid_row(const Params& P, int b, int p) {
    return p < CTXL ? (bf16_t*)(P.ws + OFF_XC) + (size_t)(b * CTXL + p) * DM : (bf16_t*)(P.out + (size_t)(b * SEQ + p - CTXL) * DM);
}
DI f32x4 bf4_to_f32(const u32x2 a) { f32x4 v; v.x = __uint_as_float(a.x << 16); v.y = __uint_as_float(a.x & 0xffff0000u); v.z = __uint_as_float(a.y << 16); v.w = __uint_as_float(a.y & 0xffff0000u); return v; }
DI u32x2 f32_to_bf4(const f32x4 v) { u32x2 w; w.x = pk2(v.x, v.y); w.y = pk2(v.z, v.w); return w; }
DI const float* input_row(const Params& P, int b, int p) {
    return p < CTXL ? P.ctx + (size_t)(b * CTXL + p) * DM : P.x + (size_t)(b * SEQ + p - CTXL) * DM;
}
DI const float* mod_row(const Params& P, int l, int mr) { return (const float*)(P.ws + OFF_MOD) + (size_t)(l * 9 + mr) * 6144; }

constexpr int TI_IN = 2 * 16 * 40, TI_OUT = 2 * 16 * 16, TI_G = 32 * 16 * 4, TI_U = TI_G, TI_D = 32 * 4 * 16, TI_ALL = TI_IN + TI_OUT + TI_G + TI_U + TI_D;
DI void titem_decode(const Params& P, int r, const float*& src, int& N, bf16_t*& dst, int& ldd, int& n0, int& kind) {
    kind = 0;
    if (r < TI_IN) { const int l = r / 640, q = r % 640, kb = q / 40, nbk = q % 40; N = INC; ldd = DM; n0 = nbk * 64; kind = 3;
        src = P.w_in + (size_t)l * DM * INC + (size_t)(kb * 64) * INC + n0; dst = (bf16_t*)(P.ws + OFF_WIN) + (size_t)l * INC * DM + kb * 64; return; }
    r -= TI_IN;
    if (r < TI_OUT) { const int l = r / 256, q = r % 256, kb = q / 16, nbk = q % 16; N = DM; ldd = DM; n0 = nbk * 64;
        src = P.w_out + (size_t)l * DM * DM + (size_t)(kb * 64) * DM + n0; dst = (bf16_t*)(P.ws + OFF_WOUT) + (size_t)l * DM * DM + kb * 64; return; }
    r -= TI_OUT;
    if (r < TI_G + TI_U) { const bool up = r >= TI_G; if (up) r -= TI_G; const int le = r / 64, q = r % 64, kb = q / 4, nbk = q % 4; N = DEXP; ldd = DM; n0 = nbk * 64; kind = up ? 2 : 1;
        src = (up ? P.w_up : P.w_gate) + (size_t)le * DM * DEXP + (size_t)(kb * 64) * DEXP + n0; dst = (bf16_t*)(P.ws + OFF_WGU) + (size_t)le * 512 * DM + kb * 64; return; }
    r -= TI_G + TI_U;
    { const int le = r / 64, q = r % 64, kb = q / 16, nbk = q % 16; N = DM; ldd = DEXP; n0 = nbk * 64;
        src = P.w_down + (size_t)le * DEXP * DM + (size_t)(kb * 64) * DM + n0; dst = (bf16_t*)(P.ws + OFF_WD) + (size_t)le * DM * DEXP + kb * 64; }
}

DI void phase_prologue(const Params& P, int bid, int nb, char* smem) {
    const int t = threadIdx.x;
    float* s = (float*)smem;
    {
        constexpr int NLD = 4096 / NTHREADS;
        float v[NLD];
        int it = bid;
        const float* src; bf16_t* dst; int N, ldd, n0, kind;
        if (it < TI_ALL) { titem_decode(P, it, src, N, dst, ldd, n0, kind);
#pragma unroll
            for (int i = 0; i < NLD; ++i) v[i] = src[(size_t)((t >> 6) + NW * i) * N + (t & 63)]; }
        while (it < TI_ALL) {
            __syncthreads();
#pragma unroll
            for (int i = 0; i < NLD; ++i) s[((t >> 6) + NW * i) * 65 + (t & 63)] = v[i];
            __syncthreads();
            bf16_t* cdst = dst; const int cldd = ldd, cn0 = n0, ckind = kind;
            it += nb;
            if (it < TI_ALL) { titem_decode(P, it, src, N, dst, ldd, n0, kind);
#pragma unroll
                for (int i = 0; i < NLD; ++i) v[i] = src[(size_t)((t >> 6) + NW * i) * N + (t & 63)]; }
            constexpr int KPT = 64 * 64 / NTHREADS;
            const int n = t / (64 / KPT), kc = (t % (64 / KPT)) * KPT;
            const int ng = cn0 + n;
            int drow = ng;
            if (ckind == 3) {
                const bool isv = (ng >= 1536 && ng < 2048) || (ng >= 2176 && ng < 2304) || ng >= 2432;
                const int w = (ng >> 6) & 3, d = ng & 63;
                const int bj = isv ? (d >> 3) & 1 : d >> 5, n = isv ? (d >> 2) & 1 : (d >> 4) & 1, fq = isv ? d >> 4 : (d >> 2) & 3, r = d & 3;
                drow = (ng & ~255) + 128 * bj + 32 * w + 16 * n + 4 * fq + r;
            }
            else if (ckind != 0) drow = (ng >> 7) * 256 + (ckind == 2 ? 128 : 0) + (ng & 127);
            bf16_t* d = cdst + (size_t)drow * cldd + kc;
#pragma unroll
            for (int j = 0; j < KPT; j += 8) { u32x4 o;
                o.x = pk2(s[(kc + j + 0) * 65 + n], s[(kc + j + 1) * 65 + n]); o.y = pk2(s[(kc + j + 2) * 65 + n], s[(kc + j + 3) * 65 + n]);
                o.z = pk2(s[(kc + j + 4) * 65 + n], s[(kc + j + 5) * 65 + n]); o.w = pk2(s[(kc + j + 6) * 65 + n], s[(kc + j + 7) * 65 + n]);
                *(u32x4*)(d + j) = o; }
        }
    }
    {
        constexpr int I_MOD = 2 * 384, KG = NTHREADS / 16, KPG = DM / KG;
        bool have_silu = false;
        float* ssl = s;
        float* red = s + 9 * 1024;
        for (int it = bid; it < I_MOD; it += nb) {
            const int l = it / 384, col0 = (it % 384) * 16, cc = t & 15, kg = t >> 4;
            const float* W = P.w_ada + (size_t)l * DM * 6144 + col0 + cc + (size_t)(kg * KPG) * 6144;
            float w[KPG];
#pragma unroll
            for (int kk = 0; kk < KPG; ++kk) w[kk] = W[(size_t)kk * 6144];
            __syncthreads();
            if (!have_silu) { for (int i = t; i < 9 * 1024; i += NTHREADS) { const float cv = i < 8192 ? P.c[i] : P.c_ctx[i - 8192]; ssl[i] = silu(cv); } have_silu = true; }
            __syncthreads();
            float acc[9];
#pragma unroll
            for (int i = 0; i < 9; ++i) acc[i] = 0.f;
#pragma unroll
            for (int kk = 0; kk < KPG; ++kk) {
#pragma unroll
                for (int i = 0; i < 9; ++i) acc[i] += ssl[i * 1024 + kg * KPG + kk] * w[kk];
            }
#pragma unroll
            for (int i = 0; i < 9; ++i) red[(i * KG + kg) * 16 + cc] = acc[i];
            __syncthreads();
            if (t < 144) { const int i = t >> 4, c2 = t & 15; float a = P.b_ada[l * 6144 + col0 + c2];
                for (int g = 0; g < KG; ++g) a += red[(i * KG + g) * 16 + c2];
                ((float*)(P.ws + OFF_MOD))[(size_t)(l * 9 + i) * 6144 + col0 + c2] = a; }
        }
    }
    for (int idx = bid * NTHREADS + t; idx < 96 * 16; idx += nb * NTHREADS) {
        const int pi = idx >> 4, j = idx & 15, pos = pi < 32 ? pi : pi - 32;
        const float invf = powf(10000.f, -(float)j / 16.f);
        float sn, cs; sincosf((float)pos * invf, &sn, &cs);
        ((float*)(P.ws + OFF_ROPE))[idx] = cs; ((float*)(P.ws + OFF_ROPE))[96 * 16 + idx] = sn;
    }
}

struct RowIn { f32x4 x[4]; u32x2 xb[4], y0[4], y1[4]; };
template <bool COMBINE>
DI void row_load(const Params& P, int l, int tok, int lane, RowIn& r) {
    const int b = tok / TPB, p = tok % TPB;
    if (l == 0 && !COMBINE) { const f32x4* src = (const f32x4*)input_row(P, b, p) + lane;
#pragma unroll
        for (int j = 0; j < 4; ++j) r.x[j] = src[64 * j]; }
    else { const u32x2* src = (const u32x2*)resid_row(P, b, p) + lane;
#pragma unroll
        for (int j = 0; j < 4; ++j) r.xb[j] = src[64 * j]; }
    if (COMBINE) {
        const bf16_t* Y = (const bf16_t*)(P.ws + OFF_Y);
        const u32x2* y0 = (const u32x2*)(Y + (size_t)(2 * tok) * DM) + lane;
        const u32x2* y1 = (const u32x2*)(Y + (size_t)(2 * tok + 1) * DM) + lane;
#pragma unroll
        for (int j = 0; j < 4; ++j) { r.y0[j] = y0[64 * j]; r.y1[j] = y1[64 * j]; }
    }
}
DI f32x4 row_combine(const f32x4 xv, const f32x4 g, const u32x2 a, const u32x2 c2) {
    f32x4 yv;
    yv.x = __uint_as_float(a.x << 16) + __uint_as_float(c2.x << 16);
    yv.y = __uint_as_float(a.x & 0xffff0000u) + __uint_as_float(c2.x & 0xffff0000u);
    yv.z = __uint_as_float(a.y << 16) + __uint_as_float(c2.y << 16);
    yv.w = __uint_as_float(a.y & 0xffff0000u) + __uint_as_float(c2.y & 0xffff0000u);
    return xv + g * yv;
}
template <bool COMBINE>
DI void norm1_body(const Params& P, int l, int bid, int nb) {
    const int lane = threadIdx.x & 63, wave = threadIdx.x >> 6;
    bf16_t* HX = (bf16_t*)(P.ws + OFF_HX);
    const int per = (NTOK + nb - 1) / nb, tk0 = bid * per, ntk = min(NTOK, tk0 + per) - tk0;
    RowIn cur, nxt;
    f32x4 gs[4], hs[4], g2[4];
    int cur_mr = -1;
    if (wave < ntk) row_load<COMBINE>(P, l, tk0 + wave, lane, nxt);
    for (int i = wave; i < ntk; i += NW) {
        const int tok = tk0 + i, b = tok / TPB, p = tok % TPB, mr = p < CTXL ? 8 : b;
        cur = nxt;
        if (i + NW < ntk) row_load<COMBINE>(P, l, tok + NW, lane, nxt);
        if (mr != cur_mr) {
            const float* md = mod_row(P, l, mr);
            const f32x4* gn = (const f32x4*)(P.norm1_g + l * DM) + lane;
            const f32x4* sh = (const f32x4*)(md) + lane;
            const f32x4* sc = (const f32x4*)(md + 1024) + lane;
#pragma unroll
            for (int j = 0; j < 4; ++j) { gs[j] = gn[64 * j] * (1.f + sc[64 * j]); hs[j] = sh[64 * j]; }
            if (COMBINE) { const f32x4* gp = (const f32x4*)(mod_row(P, l - 1, mr) + 5120) + lane;
#pragma unroll
                for (int j = 0; j < 4; ++j) g2[j] = gp[64 * j]; }
            cur_mr = mr;
        }
        f32x4 v[4]; float ss = 0.f;
        u32x2* xr = (u32x2*)resid_row(P, b, p) + lane;
#pragma unroll
        for (int j = 0; j < 4; ++j) {
            v[j] = COMBINE ? row_combine(bf4_to_f32(cur.xb[j]), g2[j], cur.y0[j], cur.y1[j]) : cur.x[j];
            if (COMBINE) xr[64 * j] = f32_to_bf4(v[j]);
            ss += (v[j].x * v[j].x + v[j].y * v[j].y) + (v[j].z * v[j].z + v[j].w * v[j].w);
        }
        const float r = rsqrtf(wave_sum(ss) * (1.f / DM) + RMS_EPS);
        u32x2* o = (u32x2*)(HX + (size_t)tok * DM) + lane;
#pragma unroll
        for (int j = 0; j < 4; ++j) {
            const f32x4 y = v[j] * r * gs[j] + hs[j];
            u32x2 w; w.x = pk2(y.x, y.y); w.y = pk2(y.z, y.w);
            o[64 * j] = w;
        }
    }
}
DI void router_shift_consts(const Params& P, int l, int bid) {
    if (bid >= 9 || (threadIdx.x >> 6) != NW - 1) return;
    const int lane = threadIdx.x & 63;
    const float* sh = mod_row(P, l, bid) + 3072;
    float a[16];
#pragma unroll
    for (int e = 0; e < 16; ++e) a[e] = 0.f;
    for (int i = 0; i < 16; ++i) { const int k = lane + 64 * i; const float h = sh[k];
#pragma unroll
        for (int q = 0; q < 4; ++q) { const f32x4 w = *(const f32x4*)(P.w_router + k * 16 + 4 * q); a[4 * q] += h * w.x; a[4 * q + 1] += h * w.y; a[4 * q + 2] += h * w.z; a[4 * q + 3] += h * w.w; } }
#pragma unroll
    for (int e = 0; e < 16; ++e) a[e] = wave_sum(a[e]);
    if (lane == 0) { float* qe = (float*)(P.ws + OFF_QE) + (l * 9 + bid) * 16;
#pragma unroll
        for (int e = 0; e < 16; ++e) qe[e] = a[e]; }
}
DI void phase_norm1(const Params& P, int l, int bid, int nb) { router_shift_consts(P, l, bid); if (l == 0) norm1_body<false>(P, 0, bid, nb); else norm1_body<true>(P, l, bid, nb); }

DI void phase_final(const Params& P, int bid, int nb) {
    const int lane = threadIdx.x & 63, wave = threadIdx.x >> 6;
    const int per = (NB * SEQ + nb - 1) / nb, r0 = bid * per, nr = min(NB * SEQ, r0 + per) - r0;
    RowIn cur, nxt;
    f32x4 fg[4], g2[4];
    const f32x4* fgp = (const f32x4*)P.final_g + lane;
#pragma unroll
    for (int j = 0; j < 4; ++j) fg[j] = fgp[64 * j];
    int cur_b = -1;
    if (wave < nr) { const int r = r0 + wave; row_load<true>(P, 1, (r / SEQ) * TPB + CTXL + r % SEQ, lane, nxt); }
    for (int i = wave; i < nr; i += NW) {
        const int r = r0 + i, b = r / SEQ, p = CTXL + r % SEQ;
        cur = nxt;
        if (i + NW < nr) { const int r2 = r + NW; row_load<true>(P, 1, (r2 / SEQ) * TPB + CTXL + r2 % SEQ, lane, nxt); }
        if (b != cur_b) { const f32x4* gp = (const f32x4*)(mod_row(P, 1, b) + 5120) + lane;
#pragma unroll
            for (int j = 0; j < 4; ++j) g2[j] = gp[64 * j];
            cur_b = b; }
        f32x4 v[4]; float ss = 0.f;
#pragma unroll
        for (int j = 0; j < 4; ++j) { v[j] = row_combine(bf4_to_f32(cur.xb[j]), g2[j], cur.y0[j], cur.y1[j]); ss += (v[j].x * v[j].x + v[j].y * v[j].y) + (v[j].z * v[j].z + v[j].w * v[j].w); }
        const float rr = rsqrtf(wave_sum(ss) * (1.f / DM) + RMS_EPS);
        f32x4* xr = (f32x4*)(P.out + (size_t)r * DM) + lane;
#pragma unroll
        for (int j = 0; j < 4; ++j) xr[64 * j] = v[j] * rr * fg[j];
    }
}

namespace g8 {
constexpr int BK = 64, HALF = 128, HTB = HALF * BK * 2, STAGE_BYTES = 8 * HTB;
DI int lds_byte(int r, int c) { const int st = (r >> 4) * 2 + (c >> 5), rr = r & 15, cc = c & 31, ob = rr * 64 + cc * 2; return st * 1024 + (ob ^ (((ob >> 9) & 1) << 5)); }
DI void stage_rc(int b, int& R, int& C) { const int st = b / 1024, sb = b % 1024, swz = sb ^ (((sb >> 9) & 1) << 5); R = (st >> 1) * 16 + swz / 64; C = (st & 1) * 32 + (swz % 64) / 2; }
struct Unit { int a, b, c, d; const bf16_t* bt; };

template <class Sched, class Epi>
DI void gemm_phase(char* smem, const bf16_t* Abase, const int K, const Sched& S, const Epi& E) {
    LAS unsigned char* lds = (LAS unsigned char*)smem;
    const int tid = threadIdx.x, wid = __builtin_amdgcn_readfirstlane(tid >> 6), lane = tid & 63, wr = wid >> 2, wc = wid & 3, fr = lane & 15, fq = lane >> 4;
    const int nt = K / BK;
    int R[2], C[2];
    unsigned voffB[2], voffA[2];
#pragma unroll
    for (int i = 0; i < 2; ++i) { stage_rc(tid * 16 + i * 8192, R[i], C[i]); voffB[i] = (unsigned)(R[i] * K + C[i]) * 2u; voffA[i] = voffB[i]; }
    const size_t kstep = (size_t)(BK * 2);
    const size_t hstep = (size_t)HALF * K * 2;
    const unsigned ldsw = (unsigned)wid * 1024u;
    const int aoff = lds_byte(wr * 64 + fr, fq * 8), boff = lds_byte(wc * 32 + fr, fq * 8);
#define G8_SA(b, h) (((b) * 2 + (h)) * HTB)
#define G8_SB(b, h) ((4 + (b) * 2 + (h)) * HTB)
#define G8_STAGE_B(bufoff, gbase) do { _Pragma("unroll") for (int _i = 0; _i < 2; ++_i) \
        __builtin_amdgcn_global_load_lds((const unsigned*)((const char*)(gbase) + voffB[_i]), (LAS unsigned*)(lds + (bufoff) + ldsw + _i * 8192), 16, 0, 0); } while (0)
#define G8_GLDS(src, dstoff) __builtin_amdgcn_global_load_lds((const unsigned*)(src), (LAS unsigned*)(lds + (dstoff)), 16, 0, 0)
#define G8_STAGE_A(bufoff, hh, nx, kb) do { \
        if constexpr (Sched::GATHER) { const unsigned o0_ = (nx) ? avn[hh][0] : avc[hh][0], o1_ = (nx) ? avn[hh][1] : avc[hh][1]; \
            G8_GLDS(Ab + (size_t)o0_ + (kb), (bufoff) + ldsw); G8_GLDS(Ab + (size_t)o1_ + (kb), (bufoff) + ldsw + 8192); } \
        else { const char* ba_ = ((nx) ? nA : cA) + (size_t)(hh) * hstep + (kb); G8_GLDS(ba_ + voffA[0], (bufoff) + ldsw); G8_GLDS(ba_ + voffA[1], (bufoff) + ldsw + 8192); } } while (0)
#define G8_LDA(dst, b, h) do { _Pragma("unroll") for (int m = 0; m < 4; ++m) _Pragma("unroll") for (int k = 0; k < 2; ++k) dst[m][k] = *(const LAS bf16x8*)(lds + G8_SA(b, h) + aoff + m * 2048 + k * 1024); } while (0)
#define G8_LDB(dst, b, h) do { _Pragma("unroll") for (int n = 0; n < 2; ++n) _Pragma("unroll") for (int k = 0; k < 2; ++k) dst[n][k] = *(const LAS bf16x8*)(lds + G8_SB(b, h) + boff + n * 2048 + k * 1024); } while (0)
#define G8_MMA(ai, bj, At, Bt) do { __builtin_amdgcn_s_setprio(1); _Pragma("unroll") for (int m = 0; m < 4; ++m) _Pragma("unroll") for (int n = 0; n < 2; ++n) _Pragma("unroll") for (int k = 0; k < 2; ++k) \
        acc[ai][bj][m][n] = __builtin_amdgcn_mfma_f32_16x16x32_bf16(Bt[n][k], At[m][k], acc[ai][bj][m][n], 0, 0, 0); __builtin_amdgcn_s_setprio(0); } while (0)
#define G8_WAIT_V(n) asm volatile("s_waitcnt vmcnt(" #n ")" ::: "memory")
#define G8_WAIT_L(n) asm volatile("s_waitcnt lgkmcnt(" #n ")" ::: "memory")
#define G8_BAR __builtin_amdgcn_s_barrier()
#define G8_SCHED __builtin_amdgcn_sched_barrier(0)
    Unit cur, nxt; int ui = 0;
    if (!S.next(0, cur)) return;
    f32x4 acc[2][2][4][2];
#pragma unroll
    for (int a = 0; a < 2; ++a)
#pragma unroll
        for (int b = 0; b < 2; ++b)
#pragma unroll
            for (int m = 0; m < 4; ++m)
#pragma unroll
                for (int n = 0; n < 2; ++n) acc[a][b][m][n] = (f32x4){0.f, 0.f, 0.f, 0.f};
    bf16x8 At[4][2], B0[2][2], B1[2][2];
    const char* Ab = (const char*)Abase;
    unsigned avc[2][2], avn[2][2];
    const char *cA = Ab, *nA = Ab;
    S.a_ready(cur);
    if constexpr (Sched::GATHER) S.a_offsets(cur, R, C, avc); else cA = (const char*)S.a_base(cur);
    const char* cB = (const char*)cur.bt;
    G8_STAGE_B(G8_SB(0, 0), cB); G8_STAGE_B(G8_SB(0, 1), cB + hstep); G8_STAGE_A(G8_SA(0, 0), 0, false, 0); G8_STAGE_A(G8_SA(0, 1), 1, false, 0);
    if (wr == 1) G8_BAR;
    G8_WAIT_V(2); G8_BAR;
    G8_STAGE_B(G8_SB(1, 0), cB + kstep); G8_STAGE_A(G8_SA(1, 0), 0, false, kstep); G8_STAGE_B(G8_SB(1, 1), cB + hstep + kstep);
    G8_WAIT_V(6); G8_BAR;
    for (;;) {
        const bool has_next = S.next(ui + 1, nxt);
        if constexpr (Sched::GATHER) {
            if (has_next) S.a_offsets(nxt, R, C, avn);
            else {
#pragma unroll
                for (int hh = 0; hh < 2; ++hh)
#pragma unroll
                    for (int i = 0; i < 2; ++i) avn[hh][i] = avc[hh][i];
            }
        } else nA = has_next ? (const char*)S.a_base(nxt) : cA;
        const char* nB = has_next ? (const char*)nxt.bt : cB;
        for (int t = 0; t < nt; t += 2) {
            const bool last = (t == nt - 2);
            const size_t k1 = (size_t)(t + 1) * kstep;
            const size_t k2 = last ? 0 : (size_t)(t + 2) * kstep, k3 = k2 + kstep;
            const char* b2 = last ? nB : cB + k2; const char* b3 = b2 + kstep;
            G8_LDB(B0, 0, 0); G8_LDB(B1, 0, 1); G8_SCHED; G8_LDA(At, 0, 0); G8_STAGE_A(G8_SA(1, 1), 1, false, k1);
            G8_WAIT_V(8); G8_WAIT_L(0); G8_BAR; G8_MMA(0, 0, At, B0); G8_MMA(0, 1, At, B1); G8_BAR; G8_SCHED;
            G8_LDA(At, 0, 1); G8_STAGE_B(G8_SB(0, 0), b2); G8_STAGE_B(G8_SB(0, 1), b2 + hstep); G8_STAGE_A(G8_SA(0, 0), 0, last, k2);
            G8_WAIT_V(8); G8_WAIT_L(0); G8_BAR; G8_MMA(1, 0, At, B0); G8_MMA(1, 1, At, B1); G8_BAR; G8_SCHED;
            G8_LDB(B0, 1, 0); G8_LDB(B1, 1, 1); G8_SCHED; G8_LDA(At, 1, 0); G8_STAGE_A(G8_SA(0, 1), 1, last, k2);
            G8_WAIT_V(8); G8_WAIT_L(0); G8_BAR; G8_MMA(0, 0, At, B0); G8_MMA(0, 1, At, B1); G8_BAR; G8_SCHED;
            G8_LDA(At, 1, 1); G8_STAGE_B(G8_SB(1, 0), b3); G8_STAGE_B(G8_SB(1, 1), b3 + hstep); G8_STAGE_A(G8_SA(1, 0), 0, last, k3);
            G8_WAIT_V(8); G8_WAIT_L(0); G8_BAR; G8_MMA(1, 0, At, B0); G8_MMA(1, 1, At, B1); G8_BAR; G8_SCHED;
        }
        if (wr == 0) G8_BAR;
        if constexpr (!Epi::AFTER_DRAIN) E(acc, cur, wr, wc, fr, fq);
        if (!has_next) break;
#pragma unroll
        for (int a = 0; a < 2; ++a)
#pragma unroll
            for (int b = 0; b < 2; ++b)
#pragma unroll
                for (int m = 0; m < 4; ++m)
#pragma unroll
                    for (int n = 0; n < 2; ++n) acc[a][b][m][n] = (f32x4){0.f, 0.f, 0.f, 0.f};
        cur = nxt; cB = nB; cA = nA; ++ui;
        if constexpr (Sched::GATHER) {
#pragma unroll
            for (int hh = 0; hh < 2; ++hh)
#pragma unroll
                for (int i = 0; i < 2; ++i) avc[hh][i] = avn[hh][i];
        }
        if (wr == 1) G8_BAR;
    }
    G8_WAIT_V(0);
    G8_BAR;
    if constexpr (Epi::AFTER_DRAIN) E.fused(acc, cur, wr, wc, fr, fq, smem);
#undef G8_SA
#undef G8_SB
#undef G8_STAGE_A
#undef G8_GLDS
#undef G8_STAGE_B
#undef G8_LDA
#undef G8_LDB
#undef G8_MMA
#undef G8_WAIT_V
#undef G8_WAIT_L
#undef G8_BAR
#undef G8_SCHED
}

DI bool static_unit(int i, int G, int c, int nM, int nN, int& pm, int& pn) {
    const int nwg = nM * nN; const long L = (long)i * G + c; if (L >= nwg) return false;
    int wgid = (int)L; { const int q = nwg / 8, r = nwg % 8, xcd = wgid % 8, off = wgid / 8; wgid = (xcd < r ? xcd * (q + 1) : r * (q + 1) + (xcd - r) * q) + off; }
    const int nig = 8 * nN, gid = wgid / nig, fm = gid * 8, gsz = (nM - fm) < 8 ? (nM - fm) : 8;
    pm = fm + ((wgid % nig) % gsz); pn = (wgid % nig) / gsz; return true;
}
}

struct SchedQKV {
    const bf16_t *A, *Wt; int G, c;
    static constexpr bool GATHER = false;
    DI void a_ready(const g8::Unit&) const {}
    DI bool next(int i, g8::Unit& u) const { int pm, pn; if (!g8::static_unit(i, G, c, NTOK / 256, INC / 256, pm, pn)) return false; u.a = pm; u.b = pn; u.c = 0; u.d = 0; u.bt = Wt + (size_t)pn * 256 * DM; return true; }
    DI const bf16_t* a_base(const g8::Unit& u) const { return A + (size_t)u.a * 256 * DM; }
};
struct EpiQKV {
    static constexpr bool AFTER_DRAIN = false;
    bf16_t *QB, *KB, *VT; const float *ropec, *ropes, *qg, *kg;
    DI void operator()(const f32x4 (&acc)[2][2][4][2], const g8::Unit& u, int wr, int wc, int fr, int fq) const {
        const int pm = u.a, pn = u.b, b = pm / 9, p0 = (pm % 9) * 256;
        const bool isctx = p0 == 0;
        const int cw = pn * 256 + wc * 64;
        int kind, unit; const float* ng = nullptr;
        if (cw < 1024) { kind = 0; unit = cw >> 6; if (unit >= 8 && unit < 12) ng = qg; }
        else if (cw < 1536) { kind = 1; unit = (cw - 1024) >> 6; }
        else if (cw < 2048) { kind = 2; unit = cw - 1536; }
        else if (cw < 2176) { kind = 1; unit = 8 + ((cw - 2048) >> 6); ng = kg; }
        else if (cw < 2304) { kind = 2; unit = 512 + (cw - 2176); }
        else if (cw < 2432) { kind = 1; unit = 10 + ((cw - 2304) >> 6); }
        else { kind = 2; unit = 640 + (cw - 2432); }
        if (kind == 2) {
            const int vld = unit < 512 ? 128 : 64;
            const size_t vbase = unit < 512 ? (size_t)(unit >> 7) * TPB * 128 + (unit & 127) : (size_t)4 * TPB * 128 + (size_t)((unit - 512) >> 6) * TPB * 64;
            bf16_t* vb = VT + (size_t)b * VS + vbase + 16 * fq;
#pragma unroll
            for (int ai = 0; ai < 2; ++ai)
#pragma unroll
                for (int m = 0; m < 4; ++m) {
                    const int p = p0 + 128 * ai + 64 * wr + 16 * m + fr;
#pragma unroll
                    for (int bj = 0; bj < 2; ++bj) { const f32x4 v0 = acc[ai][bj][m][0], v1 = acc[ai][bj][m][1];
                        u32x4 o; o.x = pk2(v0.x, v0.y); o.y = pk2(v0.z, v0.w); o.z = pk2(v1.x, v1.y); o.w = pk2(v1.z, v1.w);
                        *(u32x4*)(vb + (size_t)p * vld + 8 * bj) = o; }
                }
            return;
        }
        const bool nrm = ng != nullptr;
        f32x4 g4[2][2];
#pragma unroll
        for (int bj = 0; bj < 2; ++bj)
#pragma unroll
            for (int n = 0; n < 2; ++n) g4[bj][n] = nrm ? *(const f32x4*)(ng + 32 * bj + 16 * n + 4 * fq) : (f32x4){1.f, 1.f, 1.f, 1.f};
        const float osc = kind == 0 ? QSCALE : 1.f;
        bf16_t* base = (kind == 0 ? QB + ((size_t)b * NQU + unit) * TPB * 64 : KB + ((size_t)b * NKU + unit) * TPB * 64) + 4 * fq;
#pragma unroll
        for (int ai = 0; ai < 2; ++ai)
#pragma unroll
            for (int m = 0; m < 4; ++m) {
                const int p = p0 + 128 * ai + 64 * wr + 16 * m + fr;
                f32x4 x[2][2];
#pragma unroll
                for (int bj = 0; bj < 2; ++bj)
#pragma unroll
                    for (int n = 0; n < 2; ++n) x[bj][n] = acc[ai][bj][m][n];
                if (nrm) {
                    float ss = 0.f;
#pragma unroll
                    for (int bj = 0; bj < 2; ++bj)
#pragma unroll
                        for (int n = 0; n < 2; ++n) ss += (x[bj][n].x * x[bj][n].x + x[bj][n].y * x[bj][n].y) + (x[bj][n].z * x[bj][n].z + x[bj][n].w * x[bj][n].w);
                    ss += __shfl_xor(ss, 16); ss += __shfl_xor(ss, 32);
                    const float r = rsqrtf(ss * (1.f / 64.f) + RMS_EPS);
#pragma unroll
                    for (int bj = 0; bj < 2; ++bj)
#pragma unroll
                        for (int n = 0; n < 2; ++n) x[bj][n] = x[bj][n] * r * g4[bj][n];
                }
                if (!isctx) {
                    const int t = p - CTXL;
#pragma unroll
                    for (int bj = 0; bj < 2; ++bj) {
                        const int idx = (bj == 0 ? (t >> 6) : 32 + (t & 63)) * 16 + 4 * fq;
                        const f32x4 c4 = *(const f32x4*)(ropec + idx), s4 = *(const f32x4*)(ropes + idx);
                        const f32x4 y0 = x[bj][0] * c4 - x[bj][1] * s4, y1 = x[bj][0] * s4 + x[bj][1] * c4;
                        x[bj][0] = y0; x[bj][1] = y1;
                    }
                }
#pragma unroll
                for (int bj = 0; bj < 2; ++bj)
#pragma unroll
                    for (int n = 0; n < 2; ++n) { u32x2 o; o.x = pk2(x[bj][n].x * osc, x[bj][n].y * osc); o.y = pk2(x[bj][n].z * osc, x[bj][n].w * osc);
                        *(u32x2*)(base + (size_t)p * 64 + 32 * bj + 16 * n) = o; }
            }
    }
};
DI void phase_qkv(const Params& P, int l, int bid, int nb, char* smem) {
    __syncthreads();
    for (int i = threadIdx.x; i < 2 * 96 * 16 / 4; i += NTHREADS) ((f32x4*)(smem + LDS_MISC))[i] = ((const f32x4*)(P.ws + OFF_ROPE))[i];
    __syncthreads();
    SchedQKV S{(const bf16_t*)(P.ws + OFF_HX), (const bf16_t*)(P.ws + OFF_WIN) + (size_t)l * INC * DM, nb, bid};
    EpiQKV E{(bf16_t*)(P.ws + OFF_QB), (bf16_t*)(P.ws + OFF_KB), (bf16_t*)(P.ws + OFF_VT), (const float*)(smem + LDS_MISC), (const float*)(smem + LDS_MISC) + 96 * 16,
             P.q_norm_g + l * 64, P.k_norm_g + l * 64};
    g8::gemm_phase(smem, (const bf16_t*)(P.ws + OFF_HX), DM, S, E);
}


#ifndef PV_AHEAD
#define PV_AHEAD 8
#endif
#define MFMA32(a, b, c) __builtin_amdgcn_mfma_f32_32x32x16_bf16((a), (b), (c), 0, 0, 0)
template <int DV>
DI void flash_run(char* smem, const bf16_t* qrow, const bf16_t* Kb, const bf16_t* Vr, int n1, int base2, int n2, int tq, float m0, float l0,
                  f32x16 (&O)[DV / 32], float& lout) {
    constexpr int NT = DV / 32, KBYTES = 8192, RB = DV * 2, STAGE = KBYTES + 64 * RB, NVP = DV / 64, KP = 1024 / RB, LPR = RB / 16;
    LAS char* lds = (LAS char*)smem;
    const int t = threadIdx.x, wave = __builtin_amdgcn_readfirstlane(t >> 6);
    int lane = t & 63;
    asm volatile("" : "+v"(lane));
    const int h = lane >> 5, ln = lane & 31, sw = (ln >> 1) & 7;
    constexpr bool QLDS = DV == 128;
    LAS char* qb = lds + 4 * STAGE + wave * 4096 + lane * 16;
    bf16x8 qf[4];
#pragma unroll
    for (int s = 0; s < 4; ++s) qf[s] = *(const bf16x8*)(qrow + 16 * s + 8 * h);
    if (QLDS) {
#pragma unroll
        for (int s = 0; s < 4; ++s) *(LAS bf16x8*)(qb + s * 1024) = qf[s];
    }
#pragma unroll
    for (int tt = 0; tt < NT; ++tt)
#pragma unroll
        for (int i = 0; i < 16; ++i) O[tt][i] = 0.f;
    constexpr float THR = 8.f;
    constexpr int PVA = PV_AHEAD;
    float m = m0 > -1e29f ? m0 : 0.f, l = l0;
    f32x16 negm;
#pragma unroll
    for (int i = 0; i < 16; ++i) negm[i] = -m;
    const int ntile = n1 + n2;
    constexpr int VPM = DV == 128 ? 5 : 9;
    bf16x8 pfp[2][2];
#pragma unroll
    for (int x = 0; x < 2; ++x)
#pragma unroll
        for (int y = 0; y < 2; ++y) pfp[x][y] = (bf16x8){0, 0, 0, 0, 0, 0, 0, 0};
    const int krow = 8 * wave + (lane >> 3);
    const unsigned koff = (unsigned)(krow * 64 + (((lane & 7) ^ ((krow >> 1) & 7)) << 3)) * 2u;
    unsigned voff[NVP];
#pragma unroll
    for (int i = 0; i < NVP; ++i) { const int key = 8 * wave + KP * i + lane / LPR, cpos = lane % LPR, z = DV == 128 ? (key & 3) : ((key >> 1) & 1);
        voff[i] = (unsigned)(key * DV + ((cpos ^ (z << 2)) << 3)) * 2u; }
    const int tq_ = (lane & 15) >> 2, tp_ = lane & 3, gb_ = (lane >> 4) & 1, z_ = DV == 128 ? tq_ : ((tq_ >> 1) & 1);
    const int vlane = (4 * h + tq_) * RB + (2 * gb_ + (tp_ >> 1)) * 16 + (tp_ & 1) * 8;
#define FA_DMA(gsrc, ldsdst) do { unsigned keep_; asm volatile("s_mov_b32 %0, m0\n\ts_mov_b32 m0, %2\n\ts_nop 0\n\tglobal_load_lds_dwordx4 %1, off\n\ts_mov_b32 m0, %0" \
        : "=&s"(keep_) : "v"(gsrc), "s"(ldsdst) : "memory"); } while (0)
#define FA_ISSUE(j) do { const int j_ = (j); const int pj_ = j_ < n1 ? 64 * j_ : base2 + 64 * (j_ - n1); const int bo_ = (j_ & 3) * STAGE; \
        const char* kt_ = (const char*)Kb + (size_t)pj_ * 128; const char* vt_ = (const char*)Vr + (size_t)pj_ * RB; \
        FA_DMA(kt_ + koff, (unsigned)(size_t)(lds + bo_ + wave * 1024)); \
        _Pragma("unroll") for (int i_ = 0; i_ < NVP; ++i_) FA_DMA(vt_ + voff[i_], (unsigned)(size_t)(lds + bo_ + KBYTES + (8 * wave + KP * i_) * RB)); } while (0)
    asm volatile("s_waitcnt vmcnt(0)" ::: "memory");
    FA_ISSUE(0);
    if (ntile > 1) FA_ISSUE(1);
#define FA_PVCORE(VB_) do { \
_Pragma("unroll") \
        for (int tt = 0; tt < NT; ++tt) { \
            const LAS char* vt = (VB_) + ((tt ^ z_) << 6); \
_Pragma("unroll") \
            for (int x = 0; x < 2; ++x) \
_Pragma("unroll") \
                for (int y = 0; y < 2; ++y) { \
                    const s16x4 lo = __builtin_amdgcn_ds_read_tr16_b64_v4i16((LAS s16x4*)(vt + (32 * x + 16 * y) * RB)); \
                    const s16x4 hi = __builtin_amdgcn_ds_read_tr16_b64_v4i16((LAS s16x4*)(vt + (32 * x + 16 * y + 8) * RB)); \
                    const bf16x8 vf = __builtin_shufflevector(lo, hi, 0, 1, 2, 3, 4, 5, 6, 7); \
                    O[tt] = MFMA32(vf, pfp[x][y], O[tt]); \
                } \
        } \
 \
    } while (0)
#define FA_EXPCORE() do { \
_Pragma("unroll") \
        for (int i = 0; i < 16; i += 2) { \
            const float a0 = __builtin_amdgcn_exp2f(s0[i]), a1 = __builtin_amdgcn_exp2f(s0[i + 1]); \
            const float b0 = __builtin_amdgcn_exp2f(s1[i]), b1 = __builtin_amdgcn_exp2f(s1[i + 1]); \
            ps += (a0 + a1) + (b0 + b1); \
            w[i >> 1] = pk2(a0, a1); w[8 + (i >> 1)] = pk2(b0, b1); \
        } \
    } while (0)
    for (int it = 0; it < ntile; ++it) {
        const int p0 = it < n1 ? 64 * it : base2 + 64 * (it - n1);
        if (it + 1 < ntile) { if (NVP == 2) asm volatile("s_waitcnt vmcnt(3)" ::: "memory"); else asm volatile("s_waitcnt vmcnt(2)" ::: "memory"); }
        else asm volatile("s_waitcnt vmcnt(0)" ::: "memory");
        __builtin_amdgcn_s_barrier();
        asm volatile("" ::: "memory");
        if (it + 2 < ntile) FA_ISSUE(it + 2);
        int bo = (it & 3) * STAGE;
        asm volatile("" : "+s"(bo));
        const LAS char* kb = lds + bo;
        const LAS char* vb = kb + KBYTES + vlane;
        f32x16 s0 = negm, s1 = negm;
#pragma unroll
        for (int s = 0; s < 4; ++s) {
            const int co = ((2 * s + h) ^ sw) << 4;
            const bf16x8 k0 = *(const LAS bf16x8*)(kb + ln * 128 + co);
            const bf16x8 k1 = *(const LAS bf16x8*)(kb + (32 + ln) * 128 + co);
            const bf16x8 qs = QLDS ? *(const LAS bf16x8*)(qb + s * 1024) : qf[s];
            s0 = MFMA32(k0, qs, s0); s1 = MFMA32(k1, qs, s1);
        }
        if (it >= n1) {
            const int d0 = (p0 - CTXL) - tq + 4 * h + 128;
#pragma unroll
            for (int i = 0; i < 16; ++i) {
                const int dd = d0 + (i & 3) + 8 * (i >> 2);
                s0[i] = ((unsigned)dd <= 256u) ? s0[i] : -1e30f;
                s1[i] = ((unsigned)(dd + 32) <= 256u) ? s1[i] : -1e30f;
            }
        }
        float ps = 0.f;
        unsigned w[16];
        __builtin_amdgcn_sched_barrier(0);
        if (it > 0) {
            int bp = ((it - 1) & 3) * STAGE;
            asm volatile("" : "+s"(bp));
            const LAS char* vbp = lds + bp + KBYTES + vlane;
            FA_PVCORE(vbp);
            FA_EXPCORE();
            __builtin_amdgcn_sched_group_barrier(0x100, PVA, 0);
#pragma unroll
            for (int g = 0; g < 4 * NT; ++g) { __builtin_amdgcn_sched_group_barrier(0x008, 1, 0); __builtin_amdgcn_sched_group_barrier(0x002, VPM, 0);
                if (g < 4 * NT - PVA / 2) __builtin_amdgcn_sched_group_barrier(0x100, 2, 0); }
        } else {
            FA_EXPCORE();
        }
        __builtin_amdgcn_sched_barrier(0);
        if (__any(!(ps <= 1048576.f))) {
            float mx;
            {
                float t0 = max2f(s0[0], s1[0]), t1 = max2f(s0[1], s1[1]), t2 = max2f(s0[2], s1[2]), t3 = max2f(s0[3], s1[3]);
#pragma unroll
                for (int i = 4; i < 16; i += 4) { t0 = max2f(t0, max2f(s0[i], s1[i])); t1 = max2f(t1, max2f(s0[i + 1], s1[i + 1])); t2 = max2f(t2, max2f(s0[i + 2], s1[i + 2])); t3 = max2f(t3, max2f(s0[i + 3], s1[i + 3])); }
                mx = max2f(max2f(t0, t1), max2f(t2, t3));
            }
            mx = max2f(mx, __shfl_xor(mx, 32));
            const float d = fmaxf(mx, 0.f), alpha = __builtin_amdgcn_exp2f(-d);
            m += d; l *= alpha;
#pragma unroll
            for (int i = 0; i < 16; ++i) negm[i] -= d;
#pragma unroll
            for (int tt = 0; tt < NT; ++tt)
#pragma unroll
                for (int i = 0; i < 16; ++i) O[tt][i] *= alpha;
            ps = 0.f;
#pragma unroll
            for (int i = 0; i < 16; i += 2) {
                const float a0 = __builtin_amdgcn_exp2f(s0[i] - d), a1 = __builtin_amdgcn_exp2f(s0[i + 1] - d);
                const float b0 = __builtin_amdgcn_exp2f(s1[i] - d), b1 = __builtin_amdgcn_exp2f(s1[i + 1] - d);
                ps += (a0 + a1) + (b0 + b1);
                w[i >> 1] = pk2(a0, a1); w[8 + (i >> 1)] = pk2(b0, b1);
            }
        }
#pragma unroll
        for (int x = 0; x < 2; ++x)
#pragma unroll
            for (int y = 0; y < 2; ++y) { u32x4 q; q.x = w[8 * x + 4 * y]; q.y = w[8 * x + 4 * y + 1]; q.z = w[8 * x + 4 * y + 2]; q.w = w[8 * x + 4 * y + 3];
                pfp[x][y] = __builtin_bit_cast(bf16x8, q); }
        l += ps;
    }
    { int bp = ((ntile - 1) & 3) * STAGE; asm volatile("" : "+s"(bp)); const LAS char* vbp = lds + bp + KBYTES + vlane; FA_PVCORE(vbp); }
    __builtin_amdgcn_s_barrier();
#undef FA_ISSUE
#undef FA_PVCORE
#undef FA_EXPCORE
#undef FA_DMA
    lout = l + __shfl_xor(l, 32);
}

constexpr int CTX_EARLY_LO = 96, CTX_EARLY_N = 32;
DI bool ctx_early(int nb) { return nb >= CTX_EARLY_LO + CTX_EARLY_N; }
DI void outproj_run(const Params& P, int l, int mode, int c, int nb, char* smem);
DI void phase_attn(const Params& P, int l, int bid, int nb, char* smem) {
    const int t = threadIdx.x, wave = t >> 6;
    const bf16_t* QB = (const bf16_t*)(P.ws + OFF_QB); const bf16_t* KB = (const bf16_t*)(P.ws + OFF_KB); const bf16_t* VT = (const bf16_t*)(P.ws + OFF_VT);
    bf16_t* MIX = (bf16_t*)(P.ws + OFF_HX);
    const float lambda_init = l == 0 ? 0.2f : (0.8f - 0.6f * expf(-0.3f));
    float d1 = P.lam_q1[l * 64 + (t & 63)] * P.lam_k1[l * 64 + (t & 63)], d2 = P.lam_q2[l * 64 + (t & 63)] * P.lam_k2[l * 64 + (t & 63)];
    d1 = wave_sum(d1); d2 = wave_sum(d2);
    const float lam = expf(d1) - expf(d2) + lambda_init;
    const bool has_ctx = l == 0 && bid < 96;
    const int nmain = (768 - bid + nb - 1) / nb;
#pragma unroll 1
    for (int kk = 0; kk < nmain + (has_ctx ? 1 : 0); ++kk) {
        const int it = has_ctx ? (kk == 0 ? 768 + bid : bid + (kk - 1) * nb) : bid + kk * nb;
        int ty, b, hd, p0q, ncx;
        bool isctx;
        if (it < 768) {
            ty = it >> 8; const int idx = it & 255, xcd = idx & 7, r = idx >> 3, stream = xcd * 4 + (r >> 3);
            b = stream >> 2; hd = stream & 3; p0q = CTXL + (r & 7) * 256; isctx = false; ncx = TPB / 64;
        } else {
            const int i2 = it - 768, t12 = i2 % 12;
            b = i2 / 12; p0q = 0; ty = t12 >> 2; hd = t12 & 3; isctx = true; ncx = CTXL / 64;
        }
        int lane = t & 63;
        asm volatile("" : "+v"(lane));
        const int h = lane >> 5, ln = lane & 31;
        const int p = p0q + wave * 32 + ln, tok = b * TPB + p, tq = p - CTXL;
        if (ty == 0) {
            f32x16 O[4]; float lt;
            const bf16_t* V = VT + (size_t)b * VS + (size_t)hd * TPB * 128;
            flash_run<128>(smem, QB + (((size_t)b * NQU + 2 * hd + 1) * TPB + p) * 64, KB + ((size_t)b * NKU + 2 * hd + 1) * TPB * 64, V, ncx, 0, 0, tq, -1e30f, 0.f, O, lt);
            {
                int l2_ = t & 63; asm volatile("" : "+v"(l2_)); const int h2 = l2_ >> 5; bf16_t* orow = MIX + (size_t)(b * TPB + p0q + wave * 32 + (l2_ & 31)) * DM + hd * 128 + 4 * h2;
                const float f = -lam / lt;
#pragma unroll
                for (int tt = 0; tt < 4; ++tt)
#pragma unroll
                    for (int g = 0; g < 4; ++g) { u32x2 o; o.x = pk2(O[tt][4 * g] * f, O[tt][4 * g + 1] * f); o.y = pk2(O[tt][4 * g + 2] * f, O[tt][4 * g + 3] * f);
                        *(u32x2*)(orow + 32 * tt + 8 * g) = o; }
            }
            flash_run<128>(smem, QB + (((size_t)b * NQU + 2 * hd) * TPB + p) * 64, KB + ((size_t)b * NKU + 2 * hd) * TPB * 64, V, ncx, 0, 0, tq, -1e30f, 0.f, O, lt);
            {
                int l2_ = t & 63; asm volatile("" : "+v"(l2_)); const int h2 = l2_ >> 5; bf16_t* orow = MIX + (size_t)(b * TPB + p0q + wave * 32 + (l2_ & 31)) * DM + hd * 128 + 4 * h2;
                const float f = 1.f / lt; float ss = 0.f;
#pragma unroll
                for (int tt = 0; tt < 4; ++tt)
#pragma unroll
                    for (int g = 0; g < 4; ++g) {
                        const u32x2 st = *(const u32x2*)(orow + 32 * tt + 8 * g);
                        O[tt][4 * g + 0] = O[tt][4 * g + 0] * f + __uint_as_float(st.x << 16);
                        O[tt][4 * g + 1] = O[tt][4 * g + 1] * f + __uint_as_float(st.x & 0xffff0000u);
                        O[tt][4 * g + 2] = O[tt][4 * g + 2] * f + __uint_as_float(st.y << 16);
                        O[tt][4 * g + 3] = O[tt][4 * g + 3] * f + __uint_as_float(st.y & 0xffff0000u);
                        ss += (O[tt][4 * g] * O[tt][4 * g] + O[tt][4 * g + 1] * O[tt][4 * g + 1]) + (O[tt][4 * g + 2] * O[tt][4 * g + 2] + O[tt][4 * g + 3] * O[tt][4 * g + 3]);
                    }
                ss += __shfl_xor(ss, 32);
                const float r = rsqrtf(ss * (1.f / 128.f) + RMS_EPS) * (1.f - lambda_init);
                const float* sg = P.subln_g + l * 128 + 4 * h2;
#pragma unroll
                for (int tt = 0; tt < 4; ++tt)
#pragma unroll
                    for (int g = 0; g < 4; ++g) { const f32x4 gg = *(const f32x4*)(sg + 32 * tt + 8 * g);
                        u32x2 o; o.x = pk2(O[tt][4 * g] * r * gg.x, O[tt][4 * g + 1] * r * gg.y); o.y = pk2(O[tt][4 * g + 2] * r * gg.z, O[tt][4 * g + 3] * r * gg.w);
                        *(u32x2*)(orow + 32 * tt + 8 * g) = o; }
            }
        } else {
            const bool isC = ty == 2;
            f32x16 O[2]; float lt;
            const int qu = (isC ? 12 : 8) + hd, ku = (isC ? 10 : 8) + (hd >> 1);
            const bf16_t* V = VT + (size_t)b * VS + (size_t)4 * TPB * 128 + (size_t)((isC ? 2 : 0) + (hd >> 1)) * TPB * 64;
            int n1 = ncx, base2 = 0, n2 = 0;
            float m0 = -1e30f, l0 = 0.f;
            if (isC) {
                m0 = P.sink[l * 4 + hd] * 1.4426950408889634f; l0 = h == 0 ? 1.f : 0.f;
                if (!isctx) { const int n = (p0q - CTXL) >> 8; n1 = CTXL / 64; const int jlo = n == 0 ? 2 : 0, jhi = n == 7 ? 6 : 8;
                    base2 = CTXL + 256 * n - 128 + 64 * jlo; n2 = jhi - jlo; }
            }
            flash_run<64>(smem, QB + (((size_t)b * NQU + qu) * TPB + p) * 64, KB + ((size_t)b * NKU + ku) * TPB * 64, V, n1, base2, n2, tq, m0, l0, O, lt);
            const float f = 1.f / lt;
            int l2_ = t & 63; asm volatile("" : "+v"(l2_)); const int h2 = l2_ >> 5; bf16_t* orow = MIX + (size_t)(b * TPB + p0q + wave * 32 + (l2_ & 31)) * DM + (isC ? 768 : 512) + hd * 64 + 4 * h2;
#pragma unroll
            for (int tt = 0; tt < 2; ++tt)
#pragma unroll
                for (int g = 0; g < 4; ++g) { u32x2 o; o.x = pk2(O[tt][4 * g] * f, O[tt][4 * g + 1] * f); o.y = pk2(O[tt][4 * g + 2] * f, O[tt][4 * g + 3] * f);
                    *(u32x2*)(orow + 32 * tt + 8 * g) = o; }
        }
        if (it >= 768) {
            asm volatile("s_waitcnt vmcnt(0)" ::: "memory");
            __syncthreads();
            if (t == 0) { __builtin_amdgcn_fence(__ATOMIC_RELEASE, "agent"); asm volatile("s_waitcnt vmcnt(0)" ::: "memory");
                __hip_atomic_fetch_add((int*)(P.ws + OFF_RDYC) + ((it - 768) / 12) * 64, 1, __ATOMIC_RELAXED, __HIP_MEMORY_SCOPE_AGENT); }
        }
    }
    if (l == 0 && ctx_early(nb) && bid >= CTX_EARLY_LO && bid < CTX_EARLY_LO + CTX_EARLY_N) outproj_run(P, 0, 2, bid - CTX_EARLY_LO, nb, smem);
}

DI void phase_norm2_route(const Params& P, int l, int bid, int nb, char* smem) {
    const int t = threadIdx.x, lane = t & 63, wave = t >> 6;
    int* lcnt = (int*)(smem + LDS_MISC);
    int* lbase = lcnt + 16;
    int* rec = lcnt + 32;
    int* rec2 = rec + 160;
    __syncthreads();
    {
        int ts = t;
        asm volatile("" : "+v"(ts));
        f32x4 wv[4096 / NTHREADS];
#pragma unroll
        for (int i = 0; i < 4096 / NTHREADS; ++i) { const int idx = ts + NTHREADS * i; wv[i] = *(const f32x4*)(P.w_router + (idx >> 2) * 16 + (idx & 3) * 4); }
#pragma unroll
        for (int i = 0; i < 4096 / NTHREADS; ++i) { const int idx = ts + NTHREADS * i, k = idx >> 2, q = idx & 3;
            const int row = ((k >> 8) * 4 + (k & 3)) * 64 + ((k >> 2) & 63);
            *(f32x4*)(smem + row * 64 + ((q ^ ((row >> 2) & 3)) << 4)) = wv[i]; }
    }
    if (t < 16) lcnt[t] = 0;
    __syncthreads();
    bf16_t* HX = (bf16_t*)(P.ws + OFF_HX);
    int* cnt = (int*)(P.ws + OFF_CNT) + l * 16 * 64;
    int* list = (int*)(P.ws + OFF_LIST);
    float* tokw = (float*)(P.ws + OFF_TOKW);
    const int per = (NTOK + nb - 1) / nb;
    const int tk0 = bid * per, tk1 = min(NTOK, tk0 + per), ntk = tk1 - tk0;
    const int eme = ((lane >> 5) & 1) * 8 + ((lane >> 4) & 1) * 4 + ((lane >> 3) & 1) * 2 + ((lane >> 2) & 1);
    const float mybias = P.router_bias[eme];
    f32x4 v[4], vn[4], gs[4], hs[4];
    int cur_mr = -1;
    if (wave < ntk) { const int tok = tk0 + wave, b = tok / TPB, p = tok % TPB; const u32x2* xr = (const u32x2*)resid_row(P, b, p) + lane;
#pragma unroll
        for (int j = 0; j < 4; ++j) vn[j] = bf4_to_f32(xr[64 * j]); }
    for (int i = wave; i < ntk; i += NW) {
        const int tok = tk0 + i;
        const int b = tok / TPB, p = tok % TPB, mr = p < CTXL ? 8 : b;
#pragma unroll
        for (int j = 0; j < 4; ++j) v[j] = vn[j];
        if (i + NW < ntk) { const int tk2 = tok + NW, b2 = tk2 / TPB, p2 = tk2 % TPB; const u32x2* xr = (const u32x2*)resid_row(P, b2, p2) + lane;
#pragma unroll
            for (int j = 0; j < 4; ++j) vn[j] = bf4_to_f32(xr[64 * j]); }
        if (l == 1 && p < CTXL) { if (lane == 0) rec[i] = -1; continue; }
        float ss = 0.f;
#pragma unroll
        for (int j = 0; j < 4; ++j) ss += (v[j].x * v[j].x + v[j].y * v[j].y) + (v[j].z * v[j].z + v[j].w * v[j].w);
        const float r = rsqrtf(wave_sum(ss) * (1.f / DM) + RMS_EPS);
        if (mr != cur_mr) {
            const float* md = mod_row(P, l, mr);
            const f32x4* gn = (const f32x4*)(P.norm2_g + l * DM) + lane;
            const f32x4* sh = (const f32x4*)(md + 3072) + lane;
            const f32x4* sc = (const f32x4*)(md + 4096) + lane;
#pragma unroll
            for (int j = 0; j < 4; ++j) { const f32x4 g = gn[64 * j], s1 = sc[64 * j]; gs[j] = g * (1.f + s1); hs[j] = sh[64 * j]; }
            cur_mr = mr;
        }
        u32x2* o = (u32x2*)(HX + (size_t)tok * DM) + lane;
        float lg[16];
#pragma unroll
        for (int e = 0; e < 16; ++e) lg[e] = 0.f;
#pragma unroll
        for (int j = 0; j < 4; ++j) {
            float y[4];
            y[0] = v[j].x * r * gs[j].x + hs[j].x; y[1] = v[j].y * r * gs[j].y + hs[j].y;
            y[2] = v[j].z * r * gs[j].z + hs[j].z; y[3] = v[j].w * r * gs[j].w + hs[j].w;
            u32x2 w; w.x = pk2(y[0], y[1]); w.y = pk2(y[2], y[3]);
            o[64 * j] = w;
#pragma unroll
            for (int cc = 0; cc < 4; ++cc) {
                const int row = (j * 4 + cc) * 64 + lane;
#pragma unroll
                for (int q = 0; q < 4; ++q) {
                    const f32x4 wv = *(const f32x4*)(smem + row * 64 + ((q ^ ((row >> 2) & 3)) << 4));
                    lg[4 * q + 0] += y[cc] * wv.x; lg[4 * q + 1] += y[cc] * wv.y; lg[4 * q + 2] += y[cc] * wv.z; lg[4 * q + 3] += y[cc] * wv.w;
                }
            }
        }
        float a8[8], a4[4], a2[2], a1;
        { const bool hi = lane & 32;
#pragma unroll
          for (int j = 0; j < 8; ++j) { const float keep = hi ? lg[8 + j] : lg[j], send = hi ? lg[j] : lg[8 + j]; a8[j] = keep + __shfl_xor(send, 32); } }
        { const bool hi = lane & 16;
#pragma unroll
          for (int j = 0; j < 4; ++j) { const float keep = hi ? a8[4 + j] : a8[j], send = hi ? a8[j] : a8[4 + j]; a4[j] = keep + __shfl_xor(send, 16); } }
        { const bool hi = lane & 8;
#pragma unroll
          for (int j = 0; j < 2; ++j) { const float keep = hi ? a4[2 + j] : a4[j], send = hi ? a4[j] : a4[2 + j]; a2[j] = keep + __shfl_xor(send, 8); } }
        { const bool hi = lane & 4; const float keep = hi ? a2[1] : a2[0], send = hi ? a2[0] : a2[1]; a1 = keep + __shfl_xor(send, 4); }
        a1 += __shfl_xor(a1, 2); a1 += __shfl_xor(a1, 1);
        const float mysc = 1.f / (1.f + expf(-a1)), mysel = mysc + mybias;
        float scv[16], sel[16];
#pragma unroll
        for (int e = 0; e < 16; ++e) { const int src = ((e >> 3) & 1) * 32 + ((e >> 2) & 1) * 16 + ((e >> 1) & 1) * 8 + (e & 1) * 4;
            scv[e] = __int_as_float(__builtin_amdgcn_readlane(__float_as_int(mysc), src)); sel[e] = __int_as_float(__builtin_amdgcn_readlane(__float_as_int(mysel), src)); }
        float bestg = -1e30f; int be1 = 0, be2 = 1; float bw1 = 0.f, bw2 = 0.f;
#pragma unroll
        for (int g = 0; g < 4; ++g) {
            int i1 = 0; float v1 = sel[4 * g], w1 = scv[4 * g];
#pragma unroll
            for (int j = 1; j < 4; ++j) if (sel[4 * g + j] > v1) { v1 = sel[4 * g + j]; w1 = scv[4 * g + j]; i1 = j; }
            int i2 = -1; float v2 = -1e30f, w2 = 0.f;
#pragma unroll
            for (int j = 0; j < 4; ++j) if (j != i1 && sel[4 * g + j] > v2) { v2 = sel[4 * g + j]; w2 = scv[4 * g + j]; i2 = j; }
            const float gs = v1 + v2;
            if (gs > bestg) { bestg = gs; be1 = 4 * g + i1; be2 = 4 * g + i2; bw1 = w1; bw2 = w2; }
        }
        if (lane == 0) {
            const float inv = 1.f / (bw1 + bw2);
            const int r1 = atomicAdd(&lcnt[be1], 1), r2 = atomicAdd(&lcnt[be2], 1);
            rec[i] = be1 | (be2 << 8) | (r1 << 16); rec2[i] = r2;
            tokw[2 * tok] = bw1 * inv; tokw[2 * tok + 1] = bw2 * inv;
        }
    }
    __syncthreads();
    if (t < 16) { const int c = lcnt[t]; lbase[t] = c ? atomicAdd(&cnt[t * 64], c) : 0; }
    __syncthreads();
    for (int i = t; i < ntk; i += NTHREADS) {
        const int rc = rec[i];
        if (rc >= 0) { const int e1 = rc & 255, e2 = (rc >> 8) & 255, r1 = rc >> 16, r2 = rec2[i], tok = tk0 + i;
            list[e1 * NTOK + lbase[e1] + r1] = 2 * tok; list[e2 * NTOK + lbase[e2] + r2] = 2 * tok + 1; }
    }
}

struct SchedOut {
    const bf16_t *A, *Wt; int G, c, mode;
    int* rdyc;
    static constexpr bool GATHER = false;
    DI void a_ready(const g8::Unit& u) const {
        if (mode != 2) return;
        if (__builtin_amdgcn_readfirstlane(threadIdx.x >> 6) == 0) {
            unsigned sp = 0;
            while (__hip_atomic_load(rdyc + (u.a / 9) * 64, __ATOMIC_RELAXED, __HIP_MEMORY_SCOPE_AGENT) < 12) { __builtin_amdgcn_s_sleep(2); if (++sp > (1u << 22)) break; }
            __builtin_amdgcn_fence(__ATOMIC_ACQUIRE, "agent");
            asm volatile("s_waitcnt vmcnt(0)" ::: "memory");
        }
        __builtin_amdgcn_s_barrier();
    }
    DI bool next(int i, g8::Unit& u) const {
        int pm, pn;
        if (mode == 2) { if (i != 0) return false; pm = 9 * (c >> 2); pn = c & 3; }
        else { if (!g8::static_unit(i, G, c, mode == 0 ? 72 : 64, 4, pm, pn)) return false; if (mode == 1) pm = 9 * (pm >> 3) + 1 + (pm & 7); }
        u.a = pm; u.b = pn; u.c = 0; u.d = 0; u.bt = Wt + (size_t)pn * 256 * DM; return true; }
    DI const bf16_t* a_base(const g8::Unit& u) const { return A + (size_t)u.a * 256 * DM; }
};
struct EpiOut {
    static constexpr bool AFTER_DRAIN = false;
    const float *x, *ctx; float *out, *xc; const float* mod; int l;
    DI void operator()(const f32x4 (&acc)[2][2][4][2], const g8::Unit& u, int wr, int wc, int fr, int fq) const {
        const int tok0 = u.a * 256, b = tok0 / TPB, p0 = tok0 % TPB;
        const bool isctx = p0 == 0;
        const float* g1 = mod + (size_t)(l * 9 + (isctx ? 8 : b)) * 6144 + 2048 + u.b * 256 + 32 * wc + 4 * fq;
        f32x4 g4[2][2];
#pragma unroll
        for (int bj = 0; bj < 2; ++bj)
#pragma unroll
            for (int n = 0; n < 2; ++n) g4[bj][n] = *(const f32x4*)(g1 + 128 * bj + 16 * n);
        const int cb = u.b * 256 + 32 * wc + 4 * fq;
#pragma unroll
        for (int ai = 0; ai < 2; ++ai)
#pragma unroll
            for (int m = 0; m < 4; ++m) {
                const int r = 128 * ai + 64 * wr + 16 * m + fr;
                const size_t ro = isctx ? (size_t)(b * CTXL + r) * DM : (size_t)(b * SEQ + p0 - CTXL + r) * DM;
                const float* xin = (isctx ? ctx : x) + ro + cb;
                bf16_t* xo = (isctx ? (bf16_t*)xc + ro : (bf16_t*)(out + ro)) + cb;
#pragma unroll
                for (int bj = 0; bj < 2; ++bj)
#pragma unroll
                    for (int n = 0; n < 2; ++n) { const f32x4 xv = l == 0 ? *(const f32x4*)(xin + 128 * bj + 16 * n) : bf4_to_f32(*(const u32x2*)(xo + 128 * bj + 16 * n));
                        *(u32x2*)(xo + 128 * bj + 16 * n) = f32_to_bf4(xv + g4[bj][n] * acc[ai][bj][m][n]); }
                if (m & 1) asm volatile("" ::: "memory");
            }
    }
};
struct EpiOutF {
    static constexpr bool AFTER_DRAIN = true;
    const Params& P; int l;
    DI void operator()(const f32x4 (&)[2][2][4][2], const g8::Unit&, int, int, int, int) const {}
    DI void fused(f32x4 (&acc)[2][2][4][2], const g8::Unit& u, int wr, int wc, int fr, int fq, char* smem) const {
        const int tid = threadIdx.x;
        const int tok0 = u.a * 256, b = tok0 / TPB, p0 = tok0 % TPB, pn = u.b;
        const bool isctx = p0 == 0;
        const int mr = isctx ? 8 : b;
        const float* md = mod_row(P, l, mr);
        const int cb = pn * 256 + 32 * wc + 4 * fq;
        float* part = (float*)smem;
        float* rt = part + 256 * 4 * 17;
        int* lcnt = (int*)(rt + 256);
        int* lbase = lcnt + 16;
        const float* wtab = (const float*)(smem + LDS_MISC);
        float* xc = (float*)(P.ws + OFF_XC);
        {
            f32x4 g4[2][2];
#pragma unroll
            for (int bj = 0; bj < 2; ++bj)
#pragma unroll
                for (int n = 0; n < 2; ++n) g4[bj][n] = *(const f32x4*)(md + 2048 + cb + 128 * bj + 16 * n);
#pragma unroll
            for (int ai = 0; ai < 2; ++ai)
#pragma unroll
                for (int m = 0; m < 4; ++m) {
                    const int r = 128 * ai + 64 * wr + 16 * m + fr;
                    const size_t ro = isctx ? (size_t)(b * CTXL + r) * DM : (size_t)(b * SEQ + p0 - CTXL + r) * DM;
                    const float* xin = (isctx ? P.ctx : P.x) + ro + cb;
                    bf16_t* xo = (isctx ? (bf16_t*)xc + ro : (bf16_t*)(P.out + ro)) + cb;
#pragma unroll
                    for (int bj = 0; bj < 2; ++bj)
#pragma unroll
                        for (int n = 0; n < 2; ++n) { const f32x4 xv = l == 0 ? *(const f32x4*)(xin + 128 * bj + 16 * n) : bf4_to_f32(*(const u32x2*)(xo + 128 * bj + 16 * n));
                            acc[ai][bj][m][n] = xv + g4[bj][n] * acc[ai][bj][m][n]; *(u32x2*)(xo + 128 * bj + 16 * n) = f32_to_bf4(acc[ai][bj][m][n]); }
                    if (m & 1) asm volatile("" ::: "memory");
                }
        }
        {
            float wb[2][2][4];
#pragma unroll
            for (int bj = 0; bj < 2; ++bj)
#pragma unroll
                for (int n = 0; n < 2; ++n)
#pragma unroll
                    for (int r = 0; r < 4; ++r) wb[bj][n][r] = wtab[(128 * bj + 32 * wc + 16 * n + 4 * fq + r) * 16 + fr];
#pragma unroll
            for (int ai = 0; ai < 2; ++ai)
#pragma unroll
                for (int m = 0; m < 4; ++m) {
                    f32x4 d = {0.f, 0.f, 0.f, 0.f}; float ss = 0.f;
#pragma unroll
                    for (int bj = 0; bj < 2; ++bj)
#pragma unroll
                        for (int n = 0; n < 2; ++n) { const f32x4 v = acc[ai][bj][m][n];
                            ss += (v.x * v.x + v.y * v.y) + (v.z * v.z + v.w * v.w);
                            d = __builtin_amdgcn_mfma_f32_16x16x4f32(v.x, wb[bj][n][0], d, 0, 0, 0);
                            d = __builtin_amdgcn_mfma_f32_16x16x4f32(v.y, wb[bj][n][1], d, 0, 0, 0);
                            d = __builtin_amdgcn_mfma_f32_16x16x4f32(v.z, wb[bj][n][2], d, 0, 0, 0);
                            d = __builtin_amdgcn_mfma_f32_16x16x4f32(v.w, wb[bj][n][3], d, 0, 0, 0); }
                    ss += __shfl_xor(ss, 16); ss += __shfl_xor(ss, 32);
                    const int rowb = 128 * ai + 64 * wr + 16 * m;
                    part[((rowb + 4 * fq + 0) * 4 + wc) * 17 + fr] = d.x;
                    part[((rowb + 4 * fq + 1) * 4 + wc) * 17 + fr] = d.y;
                    part[((rowb + 4 * fq + 2) * 4 + wc) * 17 + fr] = d.z;
                    part[((rowb + 4 * fq + 3) * 4 + wc) * 17 + fr] = d.w;
                    if (fq == 0) part[((rowb + fr) * 4 + wc) * 17 + 16] = ss;
                }
        }
        __syncthreads();
        float* xch = (float*)(P.ws + OFF_XCH) + (size_t)u.a * 4 * 256 * 17;
        { float* dst = xch + (size_t)pn * 256 * 17;
          for (int i = tid; i < 256 * 17; i += NTHREADS) { const int row = i / 17, e = i - row * 17; const float* pp = part + row * 68 + e; __hip_atomic_store(dst + i, (pp[0] + pp[17]) + (pp[34] + pp[51]), __ATOMIC_RELAXED, __HIP_MEMORY_SCOPE_AGENT); } }
        asm volatile("s_waitcnt vmcnt(0)" ::: "memory");
        __syncthreads();
        if (tid == 0) {
            int* xcn = (int*)(P.ws + OFF_XCNT) + (l * 72 + u.a) * 64;
            __hip_atomic_fetch_add(xcn, 1, __ATOMIC_RELAXED, __HIP_MEMORY_SCOPE_AGENT);
            unsigned sp = 0;
            while (__hip_atomic_load(xcn, __ATOMIC_RELAXED, __HIP_MEMORY_SCOPE_AGENT) < 4) { __builtin_amdgcn_s_sleep(1); if (++sp > (1u << 22)) break; }
            __builtin_amdgcn_fence(__ATOMIC_ACQUIRE, "agent");
            asm volatile("s_waitcnt vmcnt(0)" ::: "memory");
        }
        if (tid >= 64 && tid < 80) lcnt[tid - 64] = 0;
        __syncthreads();
        if (tid < 256) { float sq = 0.f;
#pragma unroll
            for (int q = 0; q < 4; ++q) sq += xch[(size_t)(q * 256 + tid) * 17 + 16];
            rt[tid] = rsqrtf(sq * (1.f / DM) + RMS_EPS); }
        __syncthreads();
        {
            f32x4 gs[2][2], hs[2][2];
#pragma unroll
            for (int bj = 0; bj < 2; ++bj)
#pragma unroll
                for (int n = 0; n < 2; ++n) { const int c = cb + 128 * bj + 16 * n;
                    const f32x4 g = *(const f32x4*)(P.norm2_g + l * DM + c), s1 = *(const f32x4*)(md + 4096 + c);
                    gs[bj][n] = g * (1.f + s1); hs[bj][n] = *(const f32x4*)(md + 3072 + c); }
            bf16_t* HX = (bf16_t*)(P.ws + OFF_HX);
#pragma unroll
            for (int ai = 0; ai < 2; ++ai)
#pragma unroll
                for (int m = 0; m < 4; ++m) {
                    const int row = 128 * ai + 64 * wr + 16 * m + fr;
                    const float r = rt[row];
                    bf16_t* o = HX + (size_t)(tok0 + row) * DM + cb;
#pragma unroll
                    for (int bj = 0; bj < 2; ++bj)
#pragma unroll
                        for (int n = 0; n < 2; ++n) { const f32x4 v = acc[ai][bj][m][n], g = gs[bj][n], h = hs[bj][n];
                            u32x2 w; w.x = pk2(v.x * r * g.x + h.x, v.y * r * g.y + h.y); w.y = pk2(v.z * r * g.z + h.z, v.w * r * g.w + h.w);
                            *(u32x2*)(o + 128 * bj + 16 * n) = w; }
                }
        }
        int be1 = 0, be2 = 1, r1 = 0, r2 = 0;
        const int rrow = 64 * pn + tid, rtok = tok0 + rrow;
        if (tid < 64) {
            const float r = rt[rrow];
            float lg[16];
#pragma unroll
            for (int e = 0; e < 16; ++e) lg[e] = 0.f;
#pragma unroll
            for (int q = 0; q < 4; ++q) { const float* sp = xch + (size_t)(q * 256 + rrow) * 17;
#pragma unroll
                for (int e = 0; e < 16; ++e) lg[e] += sp[e]; }
            const float* qe = (const float*)(P.ws + OFF_QE) + (l * 9 + mr) * 16;
            float scv[16], sel[16];
#pragma unroll
            for (int e = 0; e < 16; ++e) { const float a = lg[e] * r + qe[e]; scv[e] = 1.f / (1.f + expf(-a)); sel[e] = scv[e] + P.router_bias[e]; }
            float bestg = -1e30f; float bw1 = 0.f, bw2 = 0.f;
#pragma unroll
            for (int g = 0; g < 4; ++g) {
                int i1 = 0; float v1 = sel[4 * g], w1 = scv[4 * g];
#pragma unroll
                for (int j = 1; j < 4; ++j) if (sel[4 * g + j] > v1) { v1 = sel[4 * g + j]; w1 = scv[4 * g + j]; i1 = j; }
                int i2 = -1; float v2 = -1e30f, w2 = 0.f;
#pragma unroll
                for (int j = 0; j < 4; ++j) if (j != i1 && sel[4 * g + j] > v2) { v2 = sel[4 * g + j]; w2 = scv[4 * g + j]; i2 = j; }
                const float gsum = v1 + v2;
                if (gsum > bestg) { bestg = gsum; be1 = 4 * g + i1; be2 = 4 * g + i2; bw1 = w1; bw2 = w2; }
            }
            const float inv = 1.f / (bw1 + bw2);
            r1 = atomicAdd(&lcnt[be1], 1); r2 = atomicAdd(&lcnt[be2], 1);
            float* tokw = (float*)(P.ws + OFF_TOKW);
            tokw[2 * rtok] = bw1 * inv; tokw[2 * rtok + 1] = bw2 * inv;
        }
        __syncthreads();
        if (tid < 16) { const int c = lcnt[tid]; int* cnt = (int*)(P.ws + OFF_CNT) + l * 16 * 64; lbase[tid] = c ? atomicAdd(&cnt[tid * 64], c) : 0; }
        __syncthreads();
        if (tid < 64) { int* list = (int*)(P.ws + OFF_LIST);
            list[be1 * NTOK + lbase[be1] + r1] = 2 * rtok; list[be2 * NTOK + lbase[be2] + r2] = 2 * rtok + 1; }
        __syncthreads();
    }
};
DI bool route_fused(int nb) { return nb == 256; }
DI void outproj_run(const Params& P, int l, int mode, int c, int nb, char* smem) {
    SchedOut S{(const bf16_t*)(P.ws + OFF_HX), (const bf16_t*)(P.ws + OFF_WOUT) + (size_t)l * DM * DM, nb, c, mode, (int*)(P.ws + OFF_RDYC)};
    if (route_fused(nb) && mode != 0) {
        g8::Unit u;
        if (S.next(0, u)) {
            const int tok0 = u.a * 256, mr = (tok0 % TPB == 0) ? 8 : tok0 / TPB;
            const float* md = mod_row(P, l, mr);
            float* wtab = (float*)(smem + LDS_MISC);
#pragma unroll
            for (int i = 0; i < 2; ++i) { const int idx = threadIdx.x + NTHREADS * i, cc = idx >> 2, q = idx & 3, col = u.b * 256 + cc;
                const float g = P.norm2_g[l * DM + col] * (1.f + md[4096 + col]);
                *(f32x4*)(wtab + cc * 16 + 4 * q) = g * *(const f32x4*)(P.w_router + col * 16 + 4 * q); }
        }
        EpiOutF E{P, l};
        g8::gemm_phase(smem, (const bf16_t*)(P.ws + OFF_HX), DM, S, E);
        return;
    }
    EpiOut E{P.x, P.ctx, P.out, (float*)(P.ws + OFF_XC), (const float*)(P.ws + OFF_MOD), l};
    g8::gemm_phase(smem, (const bf16_t*)(P.ws + OFF_HX), DM, S, E);
}
DI void phase_outproj(const Params& P, int l, int bid, int nb, char* smem) {
    outproj_run(P, l, (l == 1 || ctx_early(nb)) ? 1 : 0, bid, nb, smem);
}

constexpr int MAX_RT = 2 * NTOK / 256 + NEXP;
DI void build_tile_table(const int* cnt, char* smem) {
    int* cl = (int*)(smem + LDS_MISC);
    int* tab = cl + 16;
    const int t = threadIdx.x;
    __syncthreads();
    if (t < NEXP) cl[t] = cnt[t * 64];
    __syncthreads();
    if (t < MAX_RT) {
        int acc = 0, e = 0, ti = 0, n = 0, ok = 0;
#pragma unroll
        for (int i = 0; i < NEXP; ++i) { const int c = cl[i], nt = (c + 255) >> 8; const bool hit = !ok && t < acc + nt;
            e = hit ? i : e; ti = hit ? t - acc : ti; n = hit ? c : n; ok = hit ? 1 : ok; acc += nt; }
        tab[4 * t] = e; tab[4 * t + 1] = ti; tab[4 * t + 2] = n; tab[4 * t + 3] = ok;
    }
    __syncthreads();
}
DI bool expert_tile(const char* smem, int rt, int& e, int& ti, int& hbase, int& n) {
    if (rt >= MAX_RT) return false;
    const int* tab = (const int*)(smem + LDS_MISC) + 16 + 4 * rt;
    e = __builtin_amdgcn_readfirstlane(tab[0]); ti = __builtin_amdgcn_readfirstlane(tab[1]); n = __builtin_amdgcn_readfirstlane(tab[2]); hbase = rt * 256;
    return __builtin_amdgcn_readfirstlane(tab[3]) != 0;
}

struct SchedGU {
    const bf16_t* W; const char* tabs; const int* list; int G, c;
    static constexpr bool GATHER = true;
    DI void a_ready(const g8::Unit&) const {}
    DI bool next(int i, g8::Unit& u) const { const int w = i * G + c, rt = w >> 1, ct = w & 1; int e, ti, hb, n; if (!expert_tile(tabs, rt, e, ti, hb, n)) return false;
        u.a = e; u.b = ti | (ct << 16); u.c = hb; u.d = n; u.bt = W + ((size_t)e * 512 + ct * 256) * DM; return true; }
    DI void a_offsets(const g8::Unit& u, const int (&R)[2], const int (&C)[2], unsigned (&av)[2][2]) const {
        const int ti = u.b & 0xffff;
#pragma unroll
        for (int hh = 0; hh < 2; ++hh)
#pragma unroll
            for (int i = 0; i < 2; ++i) { const int li = ti * 256 + 128 * hh + R[i]; const int slot = li < u.d ? list[u.a * NTOK + li] : 0;
                av[hh][i] = (unsigned)((slot >> 1) * DM + C[i]) * 2u; }
    }
};
struct EpiGU {
    static constexpr bool AFTER_DRAIN = false;
    bf16_t* HB;
    DI void operator()(const f32x4 (&acc)[2][2][4][2], const g8::Unit& u, int wr, int wc, int fr, int fq) const {
        const int ct = u.b >> 16;
        bf16_t* hb = HB + (size_t)(u.c + 64 * wr + fr) * DEXP + 128 * ct + 32 * wc + 4 * fq;
#pragma unroll
        for (int ai = 0; ai < 2; ++ai)
#pragma unroll
            for (int m = 0; m < 4; ++m)
#pragma unroll
                for (int n = 0; n < 2; ++n) {
                    const f32x4 g = acc[ai][0][m][n], uu = acc[ai][1][m][n];
                    f32x4 hv;
                    hv.x = g.x / (1.f + __expf(-g.x)) * uu.x; hv.y = g.y / (1.f + __expf(-g.y)) * uu.y; hv.z = g.z / (1.f + __expf(-g.z)) * uu.z; hv.w = g.w / (1.f + __expf(-g.w)) * uu.w;
                    u32x2 o; o.x = pk2(hv.x, hv.y); o.y = pk2(hv.z, hv.w);
                    *(u32x2*)(hb + (size_t)(128 * ai + 16 * m) * DEXP + 16 * n) = o;
                }
    }
};
DI void phase_gateup(const Params& P, int l, int bid, int nb, char* smem) {
    build_tile_table((const int*)(P.ws + OFF_CNT) + l * 16 * 64, smem);
    SchedGU S{(const bf16_t*)(P.ws + OFF_WGU) + (size_t)l * 16 * 512 * DM, smem, (const int*)(P.ws + OFF_LIST), nb, bid};
    EpiGU E{(bf16_t*)(P.ws + OFF_HB)};
    g8::gemm_phase(smem, (const bf16_t*)(P.ws + OFF_HX), DM, S, E);
}

struct SchedDown {
    const bf16_t *A, *W; const char* tabs; int G, c;
    static constexpr bool GATHER = false;
    DI void a_ready(const g8::Unit&) const {}
    DI bool next(int i, g8::Unit& u) const { const int w = i * G + c, rt = w >> 2, ct = w & 3; int e, ti, hb, n; if (!expert_tile(tabs, rt, e, ti, hb, n)) return false;
        u.a = e; u.b = ti | (ct << 16); u.c = hb; u.d = n; u.bt = W + ((size_t)e * DM + ct * 256) * DEXP; return true; }
    DI const bf16_t* a_base(const g8::Unit& u) const { return A + (size_t)u.c * DEXP; }
};
struct EpiDown {
    static constexpr bool AFTER_DRAIN = false;
    bf16_t* Y; const int* list; const float* tokw;
    DI void operator()(const f32x4 (&acc)[2][2][4][2], const g8::Unit& u, int wr, int wc, int fr, int fq) const {
        const int ti = u.b & 0xffff, ct = u.b >> 16;
        int slot[2][4]; float wg[2][4];
        const int* le = list + u.a * NTOK;
        const int li0 = ti * 256 + 64 * wr + fr;
#pragma unroll
        for (int ai = 0; ai < 2; ++ai)
#pragma unroll
            for (int m = 0; m < 4; ++m) slot[ai][m] = le[min(li0 + 128 * ai + 16 * m, u.d - 1)];
#pragma unroll
        for (int ai = 0; ai < 2; ++ai)
#pragma unroll
            for (int m = 0; m < 4; ++m) wg[ai][m] = tokw[slot[ai][m]];
#pragma unroll
        for (int ai = 0; ai < 2; ++ai)
#pragma unroll
            for (int m = 0; m < 4; ++m) {
                if (li0 + 128 * ai + 16 * m < u.d) {
                    const float w1 = wg[ai][m];
                    bf16_t* yr = Y + (size_t)slot[ai][m] * DM + 256 * ct + 32 * wc + 4 * fq;
#pragma unroll
                    for (int bj = 0; bj < 2; ++bj)
#pragma unroll
                        for (int n = 0; n < 2; ++n) { const f32x4 v = acc[ai][bj][m][n]; u32x2 o; o.x = pk2(w1 * v.x, w1 * v.y); o.y = pk2(w1 * v.z, w1 * v.w);
                            *(u32x2*)(yr + 128 * bj + 16 * n) = o; }
                }
            }
    }
};
DI void phase_down(const Params& P, int l, int bid, int nb, char* smem) {
    build_tile_table((const int*)(P.ws + OFF_CNT) + l * 16 * 64, smem);
    SchedDown S{(const bf16_t*)(P.ws + OFF_HB), (const bf16_t*)(P.ws + OFF_WD) + (size_t)l * 16 * DM * DEXP, smem, nb, bid};
    EpiDown E{(bf16_t*)(P.ws + OFF_Y), (const int*)(P.ws + OFF_LIST), (const float*)(P.ws + OFF_TOKW)};
    g8::gemm_phase(smem, (const bf16_t*)(P.ws + OFF_HB), DEXP, S, E);
}

#define XB_TMO      128
#define XB_XCNT(j)  (256  + 64 * (j))
#define XB_XSUB(j)  (1280 + 64 * (j))
#define XB_XGEN(j)  (2304 + 64 * (j))
#define XB_TOP      3328
#define XB_TOPGEN   3392
#define XCD_BAR_WORDS 3456
#define XB_SPIN_CAP (1u << 20)
DI unsigned xb_ld(unsigned* p)              { return __hip_atomic_load(p, __ATOMIC_RELAXED, __HIP_MEMORY_SCOPE_AGENT); }
DI unsigned xb_add(unsigned* p, unsigned v) { return __hip_atomic_fetch_add(p, v, __ATOMIC_RELAXED, __HIP_MEMORY_SCOPE_AGENT); }
DI unsigned xb_xcc_id() { return (unsigned)__builtin_amdgcn_s_getreg((3 << 11) | 20) & 0xFu; }
#define XB_SPIN(cond, bar) do { unsigned _sp = 0; while (cond) { __builtin_amdgcn_s_sleep(1); \
    if ((++_sp & 255u) == 0u) { if (xb_ld(&(bar)[XB_TMO])) break; if (_sp > XB_SPIN_CAP) { atomicAdd(&(bar)[XB_TMO], 1u); break; } } } } while (0)
struct XcdBarrier { unsigned* bar; unsigned x; volatile LAS unsigned* st; };
DI XcdBarrier xcd_barrier_post(unsigned* bar, volatile LAS unsigned* st) {
    XcdBarrier b; b.bar = bar; b.x = xb_xcc_id(); b.st = st;
    if (threadIdx.x == 0) (void)xb_add(&bar[XB_XCNT(b.x)], 1u);
    return b;
}
DI void xcd_barrier_complete(unsigned* bar, unsigned x, unsigned& nloc, unsigned& nx) {
    const unsigned G = gridDim.x * gridDim.y * gridDim.z;
    unsigned sum, cnt, mine, sp = 0u;
    for (;;) {
        sum = 0u; cnt = 0u; mine = 0u;
#pragma unroll
        for (unsigned j = 0; j < 16; ++j) { const unsigned c = xb_ld(&bar[XB_XCNT(j)]); sum += c; cnt += (c > 0u) ? 1u : 0u; mine = (j == x) ? c : mine; }
        if (sum == G) break;
        __builtin_amdgcn_s_sleep(1);
        if ((++sp & 255u) == 0u) { if (xb_ld(&bar[XB_TMO])) break; if (sp > XB_SPIN_CAP) { atomicAdd(&bar[XB_TMO], 1u); break; } }
    }
    nloc = mine > 0u ? mine : 1u; nx = cnt > 0u ? cnt : 1u;
}
DI void xcd_barrier(const XcdBarrier& b) {
    asm volatile("s_waitcnt vmcnt(0)" ::: "memory");
    __syncthreads();
    if (threadIdx.x == 0) {
        unsigned* bar = b.bar;
        __builtin_amdgcn_s_waitcnt(0);
        unsigned nloc = b.st[0], nx = b.st[1];
        if (nloc == 0u) { xcd_barrier_complete(bar, b.x, nloc, nx); b.st[0] = nloc; b.st[1] = nx; }
        const unsigned old = xb_add(&bar[XB_XSUB(b.x)], 1u);
        const unsigned gen = old / nloc;
        if (old + 1u == (gen + 1u) * nloc) {
            __builtin_amdgcn_fence(__ATOMIC_RELEASE, "agent");
            asm volatile("s_waitcnt vmcnt(0)" ::: "memory");
            const unsigned og = xb_add(&bar[XB_TOP], 1u);
            const unsigned tg = og / nx;
            if (og + 1u == (tg + 1u) * nx) xb_add(&bar[XB_TOPGEN], 1u);
            else XB_SPIN(xb_ld(&bar[XB_TOPGEN]) == tg, bar);
            __builtin_amdgcn_fence(__ATOMIC_ACQUIRE, "agent");
            xb_add(&bar[XB_XGEN(b.x)], 1u);
            asm volatile("s_waitcnt vmcnt(0)" ::: "memory");
        } else {
            XB_SPIN(xb_ld(&bar[XB_XGEN(b.x)]) == gen, bar);
            __builtin_amdgcn_fence(__ATOMIC_ACQUIRE, "agent");
            asm volatile("s_waitcnt vmcnt(0)" ::: "memory");
        }
    }
    __syncthreads();
}

constexpr int NPHASES = 16;
__global__ void __launch_bounds__(NTHREADS, 2) mk_fwd(Params P, int ph_lo, int ph_hi) {
    extern __shared__ __attribute__((aligned(16))) char smem[];
    const int bid = blockIdx.x, nb = gridDim.x;
    volatile LAS unsigned* xst = (volatile LAS unsigned*)(LAS char*)(smem + LDS_MAIN);
    if (threadIdx.x == 0) { xst[0] = 0u; xst[1] = 0u; }
    __syncthreads();
    XcdBarrier gbar; gbar.bar = (unsigned*)(P.ws + OFF_CTL); gbar.x = 0; gbar.st = xst;
    if (ph_hi - ph_lo > 1) gbar = xcd_barrier_post((unsigned*)(P.ws + OFF_CTL), xst);
#ifndef REPEAT_K
#define REPEAT_K -1
#endif
#ifndef REPEAT_N
#define REPEAT_N 1
#endif
#ifndef EXTRA_SYNCS
#define EXTRA_SYNCS 0
#endif
#define RUN(k, call) if (ph_lo <= (k) && (k) < ph_hi) { if ((k) == REPEAT_K) { for (int rep_ = 0; rep_ < REPEAT_N; ++rep_) { call; xcd_barrier(gbar); } } call; if ((k) + 1 < ph_hi) xcd_barrier(gbar); }
    for (int es_ = 0; es_ < EXTRA_SYNCS; ++es_) xcd_barrier(gbar);
    RUN(0, phase_prologue(P, bid, nb, smem))
    RUN(1, phase_norm1(P, 0, bid, nb))
    RUN(2, phase_qkv(P, 0, bid, nb, smem))
    RUN(3, phase_attn(P, 0, bid, nb, smem))
    RUN(4, phase_outproj(P, 0, bid, nb, smem))
    if (!route_fused(nb)) { RUN(5, phase_norm2_route(P, 0, bid, nb, smem)) }
    RUN(6, phase_gateup(P, 0, bid, nb, smem))
    RUN(7, phase_down(P, 0, bid, nb, smem))
    RUN(8, phase_norm1(P, 1, bid, nb))
    RUN(9, phase_qkv(P, 1, bid, nb, smem))
    RUN(10, phase_attn(P, 1, bid, nb, smem))
    RUN(11, phase_outproj(P, 1, bid, nb, smem))
    if (!route_fused(nb)) { RUN(12, phase_norm2_route(P, 1, bid, nb, smem)) }
    RUN(13, phase_gateup(P, 1, bid, nb, smem))
    RUN(14, phase_down(P, 1, bid, nb, smem))
    RUN(15, phase_final(P, bid, nb))
#undef RUN
}

extern "C" void kernel_launch(void* const* d_in, const int* in_sizes, int n_in, void* d_out, int out_size, void* d_ws, size_t ws_size, hipStream_t stream) {
    Params p{};
    const float** f = (const float**)&p;
    for (int i = 0; i < 24; ++i) f[i] = (const float*)d_in[i];
    p.out = (float*)d_out; p.ws = (unsigned char*)d_ws;
    if (ws_size < WS_END) { fprintf(stderr, "workspace too small: %zu < %zu\n", ws_size, (size_t)WS_END); return; }
#ifndef MULTI_LAUNCH
#define MULTI_LAUNCH 0
#endif
#if MULTI_LAUNCH
    (void)hipFuncSetAttribute((const void*)mk_fwd, hipFuncAttributeMaxDynamicSharedMemorySize, LDS_BYTES);
    (void)hipMemsetAsync((char*)d_ws + OFF_CTL, 0, CTL_BYTES, stream);
    for (int ph = 0; ph < NPHASES; ++ph) hipLaunchKernelGGL(mk_fwd, dim3(256), dim3(NTHREADS), LDS_BYTES, stream, p, ph, ph + 1);
#else
    static int grid_blocks = 0;
    if (!grid_blocks) {
        int dev = 0, cus = 0, per_cu = 0;
        (void)hipGetDevice(&dev);
        (void)hipDeviceGetAttribute(&cus, hipDeviceAttributeMultiprocessorCount, dev);
        (void)hipFuncSetAttribute((const void*)mk_fwd, hipFuncAttributeMaxDynamicSharedMemorySize, LDS_BYTES);
        (void)hipOccupancyMaxActiveBlocksPerMultiprocessor(&per_cu, mk_fwd, NTHREADS, LDS_BYTES);
        if (per_cu > 1) per_cu = 1;
        grid_blocks = cus * per_cu;
        if (grid_blocks <= 0) { fprintf(stderr, "occupancy query failed (%d x %d)\n", cus, per_cu); grid_blocks = 0; return; }
    }
    (void)hipMemsetAsync((char*)d_ws + OFF_CTL, 0, CTL_BYTES, stream);
    hipLaunchKernelGGL(mk_fwd, dim3(grid_blocks), dim3(NTHREADS), LDS_BYTES, stream, p, 0, NPHASES);
    hipError_t e = hipPeekAtLastError();
    if (e != hipSuccess) fprintf(stderr, "launch failed: %s (grid %d)\n", hipGetErrorString(e), grid_blocks);
#endif
}
```

```cpp
#include <hip/hip_runtime.h>
#include <stdint.h>
#include <stdio.h>


#define DI __device__ __forceinline__
#define LAS __attribute__((address_space(3)))
typedef unsigned short bf16_t;
typedef short bf16x8 __attribute__((ext_vector_type(8)));
typedef float f32x16 __attribute__((ext_vector_type(16)));
typedef float f32x4 __attribute__((ext_vector_type(4)));
typedef float f32x2 __attribute__((ext_vector_type(2)));
typedef unsigned u32x4 __attribute__((ext_vector_type(4)));
typedef unsigned u32x2 __attribute__((ext_vector_type(2)));
typedef short s16x4 __attribute__((ext_vector_type(4)));

constexpr int NB = 8, SEQ = 2048, CTXL = 256, TPB = SEQ + CTXL  , NTOK = NB * TPB  ;
constexpr int DM = 1024, INC = 2560, NEXP = 16, DEXP = 256;
constexpr int NQU = 16, NKU = 12, NVR = 768;
constexpr size_t VS = (size_t)NVR * TPB;
constexpr int NTHREADS = 512, NW = NTHREADS / 64;
constexpr int LDS_MAIN = 131072, LDS_MISC = LDS_MAIN + 64, LDS_BYTES = LDS_MISC + 16384;
constexpr float RMS_EPS = 1e-6f;
constexpr float QSCALE = 0.125f * 1.4426950408889634f;

constexpr size_t OFF_CTL  = 0;
constexpr size_t OFF_CNT  = 14336, OFF_RDYC = OFF_CNT + 8192, OFF_XCNT = 24576, CTL_BYTES = OFF_XCNT + 2 * 72 * 256;
constexpr size_t OFF_MOD  = CTL_BYTES;
constexpr size_t OFF_ROPE = OFF_MOD + (size_t)2 * 9 * 6144 * 4;
constexpr size_t OFF_WIN  = OFF_ROPE + 16384;
constexpr size_t OFF_WOUT = OFF_WIN + (size_t)2 * 2560 * 1024 * 2;
constexpr size_t OFF_WGU  = OFF_WOUT + (size_t)2 * 1024 * 1024 * 2;
constexpr size_t OFF_WD   = OFF_WGU + (size_t)2 * 16 * 512 * 1024 * 2;
constexpr size_t OFF_HX   = OFF_WD + (size_t)2 * 16 * 1024 * 256 * 2;
constexpr size_t OFF_QB   = OFF_HX + (size_t)NTOK * DM * 2;
constexpr size_t OFF_KB   = OFF_QB + (size_t)NB * NQU * TPB * 64 * 2;
constexpr size_t OFF_VT   = OFF_KB + (size_t)NB * NKU * TPB * 64 * 2;
constexpr size_t OFF_Y    = OFF_QB;
constexpr size_t OFF_XC   = OFF_VT + (size_t)NB * NVR * TPB * 2;
constexpr size_t HB_ROWS  = 2 * NTOK + NEXP * 256;
constexpr size_t OFF_HB   = OFF_XC + (size_t)NB * CTXL * DM * 4;
constexpr size_t OFF_LIST = OFF_HB + HB_ROWS * DEXP * 2;
constexpr size_t OFF_TOKW = OFF_LIST + (size_t)NEXP * NTOK * 4;
constexpr size_t OFF_XCH  = OFF_TOKW + (size_t)NEXP * NTOK * 4;
constexpr size_t OFF_QE   = OFF_ROPE + 12288;
constexpr size_t WS_END   = OFF_XCH + (size_t)72 * 4 * 256 * 20 * 4;
static_assert(WS_END <= (size_t)256 * 1024 * 1024, "workspace");
static_assert((size_t)2 * NTOK * DM * 2 <= OFF_XC - OFF_QB, "Y alias");

struct Params {
    const float *x, *c, *ctx, *c_ctx, *w_ada, *b_ada, *norm1_g, *norm2_g, *w_in, *w_out, *lam_q1, *lam_k1, *lam_q2, *lam_k2,
        *subln_g, *q_norm_g, *k_norm_g, *sink, *w_router, *router_bias, *w_gate, *w_up, *w_down, *final_g;
    float* out;
    unsigned char* ws;
};

DI float bf2f(bf16_t b) { return __uint_as_float(((unsigned)b) << 16); }
typedef __bf16 bf2_t __attribute__((ext_vector_type(2)));
DI bf16_t f2bf(float f) { return __builtin_bit_cast(bf16_t, (__bf16)f); }
DI unsigned pk2(float lo, float hi) { bf2_t v = {(__bf16)lo, (__bf16)hi}; return __builtin_bit_cast(unsigned, v); }
DI int crow(int reg, int h) { return (reg & 3) + 8 * (reg >> 2) + 4 * h; }
DI float wave_sum(float v) {
#pragma unroll
    for (int o = 1; o < 64; o <<= 1) v += __shfl_xor(v, o);
    return v;
}
DI float max2f(float a, float b) { return __builtin_amdgcn_fmed3f(a, b, __builtin_inff()); }
DI float silu(float v) { return v / (1.f + expf(-v)); }
DI bf16_t* resid_row(const Params& P, int b, int p) {
    return p < CTXL ? (bf16_t*)(P.ws + OFF_XC) + (size_t)(b * CTXL + p) * DM : (bf16_t*)(P.out + (size_t)(b * SEQ + p - CTXL) * DM);
}
DI f32x4 bf4_to_f32(const u32x2 a) { f32x4 v; v.x = __uint_as_float(a.x << 16); v.y = __uint_as_float(a.x & 0xffff0000u); v.z = __uint_as_float(a.y << 16); v.w = __uint_as_float(a.y & 0xffff0000u); return v; }
DI u32x2 f32_to_bf4(const f32x4 v) { u32x2 w; w.x = pk2(v.x, v.y); w.y = pk2(v.z, v.w); return w; }
DI const float* input_row(const Params& P, int b, int p) {
    return p < CTXL ? P.ctx + (size_t)(b * CTXL + p) * DM : P.x + (size_t)(b * SEQ + p - CTXL) * DM;
}
DI const float* mod_row(const Params& P, int l, int mr) { return (const float*)(P.ws + OFF_MOD) + (size_t)(l * 9 + mr) * 6144; }

constexpr int TI_IN = 2 * 16 * 40, TI_OUT = 2 * 16 * 16, TI_G = 32 * 16 * 4, TI_U = TI_G, TI_D = 32 * 4 * 16, TI_ALL = TI_IN + TI_OUT + TI_G + TI_U + TI_D;
DI void titem_decode(const Params& P, int r, const float*& src, int& N, bf16_t*& dst, int& ldd, int& n0, int& kind) {
    kind = 0;
    if (r < TI_IN) { const int l = r / 640, q = r % 640, kb = q / 40, nbk = q % 40; N = INC; ldd = DM; n0 = nbk * 64; kind = 3;
        src = P.w_in + (size_t)l * DM * INC + (size_t)(kb * 64) * INC + n0; dst = (bf16_t*)(P.ws + OFF_WIN) + (size_t)l * INC * DM + kb * 64; return; }
    r -= TI_IN;
    if (r < TI_OUT) { const int l = r / 256, q = r % 256, kb = q / 16, nbk = q % 16; N = DM; ldd = DM; n0 = nbk * 64; kind = 4;
        src = P.w_out + (size_t)l * DM * DM + (size_t)(kb * 64) * DM + n0; dst = (bf16_t*)(P.ws + OFF_WOUT) + (size_t)l * DM * DM + kb * 64; return; }
    r -= TI_OUT;
    if (r < TI_G + TI_U) { const bool up = r >= TI_G; if (up) r -= TI_G; const int le = r / 64, q = r % 64, kb = q / 4, nbk = q % 4; N = DEXP; ldd = DM; n0 = nbk * 64; kind = up ? 2 : 1;
        src = (up ? P.w_up : P.w_gate) + (size_t)le * DM * DEXP + (size_t)(kb * 64) * DEXP + n0; dst = (bf16_t*)(P.ws + OFF_WGU) + (size_t)le * 512 * DM + kb * 64; return; }
    r -= TI_G + TI_U;
    { const int le = r / 64, q = r % 64, kb = q / 16, nbk = q % 16; N = DM; ldd = DEXP; n0 = nbk * 64; kind = 4;
        src = P.w_down + (size_t)le * DEXP * DM + (size_t)(kb * 64) * DM + n0; dst = (bf16_t*)(P.ws + OFF_WD) + (size_t)le * DM * DEXP + kb * 64; }
}

DI void phase_prologue(const Params& P, int bid, int nb, char* smem) {
    const int t = threadIdx.x;
    float* s = (float*)smem;
    {
        constexpr int NLD = 4096 / NTHREADS;
        float v[NLD];
        int it = bid;
        const float* src; bf16_t* dst; int N, ldd, n0, kind;
        if (it < TI_ALL) { titem_decode(P, it, src, N, dst, ldd, n0, kind);
#pragma unroll
            for (int i = 0; i < NLD; ++i) v[i] = src[(size_t)((t >> 6) + NW * i) * N + (t & 63)]; }
        while (it < TI_ALL) {
            __syncthreads();
#pragma unroll
            for (int i = 0; i < NLD; ++i) s[((t >> 6) + NW * i) * 65 + (t & 63)] = v[i];
            __syncthreads();
            bf16_t* cdst = dst; const int cldd = ldd, cn0 = n0, ckind = kind;
            it += nb;
            if (it < TI_ALL) { titem_decode(P, it, src, N, dst, ldd, n0, kind);
#pragma unroll
                for (int i = 0; i < NLD; ++i) v[i] = src[(size_t)((t >> 6) + NW * i) * N + (t & 63)]; }
            constexpr int KPT = 64 * 64 / NTHREADS;
            const int n = t / (64 / KPT), kc = (t % (64 / KPT)) * KPT;
            const int ng = cn0 + n;
            int drow = ng;
            if (ckind == 3) {
                const bool isv = (ng >= 1536 && ng < 2048) || (ng >= 2176 && ng < 2304) || ng >= 2432;
                const int w = (ng >> 6) & 3, d = ng & 63;
                const int bj = isv ? (d >> 3) & 1 : d >> 5, n = isv ? (d >> 2) & 1 : (d >> 4) & 1, fq = isv ? d >> 4 : (d >> 2) & 3, r = d & 3;
                drow = (ng & ~255) + 128 * bj + 32 * w + 16 * n + 4 * fq + r;
            }
            else if (ckind == 4) drow = (ng & ~31) + 16 * ((ng >> 2) & 1) + 4 * ((ng >> 3) & 3) + (ng & 3);
            else if (ckind != 0) drow = (ng >> 7) * 256 + (ckind == 2 ? 128 : 0) + (ng & 127);
            bf16_t* d = cdst + (size_t)drow * cldd + kc;
#pragma unroll
            for (int j = 0; j < KPT; j += 8) { u32x4 o;
                o.x = pk2(s[(kc + j + 0) * 65 + n], s[(kc + j + 1) * 65 + n]); o.y = pk2(s[(kc + j + 2) * 65 + n], s[(kc + j + 3) * 65 + n]);
                o.z = pk2(s[(kc + j + 4) * 65 + n], s[(kc + j + 5) * 65 + n]); o.w = pk2(s[(kc + j + 6) * 65 + n], s[(kc + j + 7) * 65 + n]);
                *(u32x4*)(d + j) = o; }
        }
    }
    {
        constexpr int I_MOD = 2 * 384, KG = NTHREADS / 16, KPG = DM / KG;
        bool have_silu = false;
        float* ssl = s;
        float* red = s + 9 * 1024;
        for (int it = bid; it < I_MOD; it += nb) {
            const int l = it / 384, col0 = (it % 384) * 16, cc = t & 15, kg = t >> 4;
            const float* W = P.w_ada + (size_t)l * DM * 6144 + col0 + cc + (size_t)(kg * KPG) * 6144;
            float w[KPG];
#pragma unroll
            for (int kk = 0; kk < KPG; ++kk) w[kk] = W[(size_t)kk * 6144];
            __syncthreads();
            if (!have_silu) { for (int i = t; i < 9 * 1024; i += NTHREADS) { const float cv = i < 8192 ? P.c[i] : P.c_ctx[i - 8192]; ssl[i] = silu(cv); } have_silu = true; }
            __syncthreads();
            float acc[9];
#pragma unroll
            for (int i = 0; i < 9; ++i) acc[i] = 0.f;
#pragma unroll
            for (int kk = 0; kk < KPG; ++kk) {
#pragma unroll
                for (int i = 0; i < 9; ++i) acc[i] += ssl[i * 1024 + kg * KPG + kk] * w[kk];
            }
#pragma unroll
            for (int i = 0; i < 9; ++i) red[(i * KG + kg) * 16 + cc] = acc[i];
            __syncthreads();
            if (t < 144) { const int i = t >> 4, c2 = t & 15; float a = P.b_ada[l * 6144 + col0 + c2];
                for (int g = 0; g < KG; ++g) a += red[(i * KG + g) * 16 + c2];
                ((float*)(P.ws + OFF_MOD))[(size_t)(l * 9 + i) * 6144 + col0 + c2] = a; }
        }
    }
    for (int idx = bid * NTHREADS + t; idx < 96 * 16; idx += nb * NTHREADS) {
        const int pi = idx >> 4, j = idx & 15, pos = pi < 32 ? pi : pi - 32;
        const float invf = powf(10000.f, -(float)j / 16.f);
        float sn, cs; sincosf((float)pos * invf, &sn, &cs);
        ((float*)(P.ws + OFF_ROPE))[idx] = cs; ((float*)(P.ws + OFF_ROPE))[96 * 16 + idx] = sn;
    }
}

struct RowIn { f32x4 x[4]; u32x2 xb[4], y0[4], y1[4]; };
template <bool COMBINE>
DI void row_load(const Params& P, int l, int tok, int lane, RowIn& r) {
    const int b = tok / TPB, p = tok % TPB;
    if (l == 0 && !COMBINE) { const f32x4* src = (const f32x4*)input_row(P, b, p) + lane;
#pragma unroll
        for (int j = 0; j < 4; ++j) r.x[j] = src[64 * j]; }
    else { const u32x2* src = (const u32x2*)resid_row(P, b, p) + lane;
#pragma unroll
        for (int j = 0; j < 4; ++j) r.xb[j] = src[64 * j]; }
    if (COMBINE) {
        const bf16_t* Y = (const bf16_t*)(P.ws + OFF_Y);
        const u32x2* y0 = (const u32x2*)(Y + (size_t)(2 * tok) * DM) + lane;
        const u32x2* y1 = (const u32x2*)(Y + (size_t)(2 * tok + 1) * DM) + lane;
#pragma unroll
        for (int j = 0; j < 4; ++j) { r.y0[j] = y0[64 * j]; r.y1[j] = y1[64 * j]; }
    }
}
DI f32x4 row_combine(const f32x4 xv, const f32x4 g, const u32x2 a, const u32x2 c2) {
    f32x4 yv;
    yv.x = __uint_as_float(a.x << 16) + __uint_as_float(c2.x << 16);
    yv.y = __uint_as_float(a.x & 0xffff0000u) + __uint_as_float(c2.x & 0xffff0000u);
    yv.z = __uint_as_float(a.y << 16) + __uint_as_float(c2.y << 16);
    yv.w = __uint_as_float(a.y & 0xffff0000u) + __uint_as_float(c2.y & 0xffff0000u);
    return xv + g * yv;
}
template <bool COMBINE>
DI void norm1_body(const Params& P, int l, int bid, int nb) {
    const int lane = threadIdx.x & 63, wave = threadIdx.x >> 6;
    bf16_t* HX = (bf16_t*)(P.ws + OFF_HX);
    const int per = (NTOK + nb - 1) / nb, tk0 = bid * per, ntk = min(NTOK, tk0 + per) - tk0;
    RowIn cur, nxt;
    f32x4 gs[4], hs[4], g2[4];
    int cur_mr = -1;
    if (wave < ntk) row_load<COMBINE>(P, l, tk0 + wave, lane, nxt);
    for (int i = wave; i < ntk; i += NW) {
        const int tok = tk0 + i, b = tok / TPB, p = tok % TPB, mr = p < CTXL ? 8 : b;
        cur = nxt;
        if (i + NW < ntk) row_load<COMBINE>(P, l, tok + NW, lane, nxt);
        if (mr != cur_mr) {
            const float* md = mod_row(P, l, mr);
            const f32x4* gn = (const f32x4*)(P.norm1_g + l * DM) + lane;
            const f32x4* sh = (const f32x4*)(md) + lane;
            const f32x4* sc = (const f32x4*)(md + 1024) + lane;
#pragma unroll
            for (int j = 0; j < 4; ++j) { gs[j] = gn[64 * j] * (1.f + sc[64 * j]); hs[j] = sh[64 * j]; }
            if (COMBINE) { const f32x4* gp = (const f32x4*)(mod_row(P, l - 1, mr) + 5120) + lane;
#pragma unroll
                for (int j = 0; j < 4; ++j) g2[j] = gp[64 * j]; }
            cur_mr = mr;
        }
        f32x4 v[4]; float ss = 0.f;
        u32x2* xr = (u32x2*)resid_row(P, b, p) + lane;
#pragma unroll
        for (int j = 0; j < 4; ++j) {
            v[j] = COMBINE ? row_combine(bf4_to_f32(cur.xb[j]), g2[j], cur.y0[j], cur.y1[j]) : cur.x[j];
            if (COMBINE) xr[64 * j] = f32_to_bf4(v[j]);
            ss += (v[j].x * v[j].x + v[j].y * v[j].y) + (v[j].z * v[j].z + v[j].w * v[j].w);
        }
        const float r = rsqrtf(wave_sum(ss) * (1.f / DM) + RMS_EPS);
        u32x2* o = (u32x2*)(HX + (size_t)tok * DM) + lane;
#pragma unroll
        for (int j = 0; j < 4; ++j) {
            const f32x4 y = v[j] * r * gs[j] + hs[j];
            u32x2 w; w.x = pk2(y.x, y.y); w.y = pk2(y.z, y.w);
            o[64 * j] = w;
        }
    }
}
DI void router_shift_consts(const Params& P, int l, int bid) {
    if (bid >= 9 || (threadIdx.x >> 6) != NW - 1) return;
    const int lane = threadIdx.x & 63;
    const float* sh = mod_row(P, l, bid) + 3072;
    float a[16];
#pragma unroll
    for (int e = 0; e < 16; ++e) a[e] = 0.f;
    for (int i = 0; i < 16; ++i) { const int k = lane + 64 * i; const float h = sh[k];
#pragma unroll
        for (int q = 0; q < 4; ++q) { const f32x4 w = *(const f32x4*)(P.w_router + k * 16 + 4 * q); a[4 * q] += h * w.x; a[4 * q + 1] += h * w.y; a[4 * q + 2] += h * w.z; a[4 * q + 3] += h * w.w; } }
#pragma unroll
    for (int e = 0; e < 16; ++e) a[e] = wave_sum(a[e]);
    if (lane == 0) { float* qe = (float*)(P.ws + OFF_QE) + (l * 9 + bid) * 16;
#pragma unroll
        for (int e = 0; e < 16; ++e) qe[e] = a[e]; }
}
DI void phase_norm1(const Params& P, int l, int bid, int nb) { router_shift_consts(P, l, bid); if (l == 0) norm1_body<false>(P, 0, bid, nb); else norm1_body<true>(P, l, bid, nb); }

DI void phase_final(const Params& P, int bid, int nb) {
    const int lane = threadIdx.x & 63, wave = threadIdx.x >> 6;
    const int per = (NB * SEQ + nb - 1) / nb, r0 = bid * per, nr = min(NB * SEQ, r0 + per) - r0;
    RowIn cur, nxt;
    f32x4 fg[4], g2[4];
    const f32x4* fgp = (const f32x4*)P.final_g + lane;
#pragma unroll
    for (int j = 0; j < 4; ++j) fg[j] = fgp[64 * j];
    int cur_b = -1;
    if (wave < nr) { const int r = r0 + wave; row_load<true>(P, 1, (r / SEQ) * TPB + CTXL + r % SEQ, lane, nxt); }
    for (int i = wave; i < nr; i += NW) {
        const int r = r0 + i, b = r / SEQ, p = CTXL + r % SEQ;
        cur = nxt;
        if (i + NW < nr) { const int r2 = r + NW; row_load<true>(P, 1, (r2 / SEQ) * TPB + CTXL + r2 % SEQ, lane, nxt); }
        if (b != cur_b) { const f32x4* gp = (const f32x4*)(mod_row(P, 1, b) + 5120) + lane;
#pragma unroll
            for (int j = 0; j < 4; ++j) g2[j] = gp[64 * j];
            cur_b = b; }
        f32x4 v[4]; float ss = 0.f;
#pragma unroll
        for (int j = 0; j < 4; ++j) { v[j] = row_combine(bf4_to_f32(cur.xb[j]), g2[j], cur.y0[j], cur.y1[j]); ss += (v[j].x * v[j].x + v[j].y * v[j].y) + (v[j].z * v[j].z + v[j].w * v[j].w); }
        const float rr = rsqrtf(wave_sum(ss) * (1.f / DM) + RMS_EPS);
        f32x4* xr = (f32x4*)(P.out + (size_t)r * DM) + lane;
#pragma unroll
        for (int j = 0; j < 4; ++j) xr[64 * j] = v[j] * rr * fg[j];
    }
}

namespace g8 {
constexpr int BK = 64, HALF = 128, HTB = HALF * BK * 2, STAGE_BYTES = 8 * HTB;
DI int lds_byte(int r, int c) { const int st = (r >> 4) * 2 + (c >> 5), rr = r & 15, cc = c & 31, ob = rr * 64 + cc * 2; return st * 1024 + (ob ^ (((ob >> 9) & 1) << 5)); }
DI void stage_rc(int b, int& R, int& C) { const int st = b / 1024, sb = b % 1024, swz = sb ^ (((sb >> 9) & 1) << 5); R = (st >> 1) * 16 + swz / 64; C = (st & 1) * 32 + (swz % 64) / 2; }
struct Unit { int a, b, c, d; const bf16_t* bt; };

template <class Sched, class Epi>
DI void gemm_phase(char* smem, const bf16_t* Abase, const int K, const Sched& S, const Epi& E) {
    LAS unsigned char* lds = (LAS unsigned char*)smem;
    const int tid = threadIdx.x, wid = __builtin_amdgcn_readfirstlane(tid >> 6), lane = tid & 63, wr = wid >> 2, wc = wid & 3, fr = lane & 15, fq = lane >> 4;
    const int nt = K / BK;
    int R[2], C[2];
    unsigned voffB[2], voffA[2];
#pragma unroll
    for (int i = 0; i < 2; ++i) { stage_rc(tid * 16 + i * 8192, R[i], C[i]); voffB[i] = (unsigned)(R[i] * K + C[i]) * 2u; voffA[i] = voffB[i]; }
    const size_t kstep = (size_t)(BK * 2);
    const size_t hstep = (size_t)HALF * K * 2;
    const unsigned ldsw = (unsigned)wid * 1024u;
    const int aoff = lds_byte(wr * 64 + fr, fq * 8), boff = lds_byte(wc * 32 + fr, fq * 8);
#define G8_SA(b, h) (((b) * 2 + (h)) * HTB)
#define G8_SB(b, h) ((4 + (b) * 2 + (h)) * HTB)
#define G8_STAGE_B(bufoff, gbase) do { _Pragma("unroll") for (int _i = 0; _i < 2; ++_i) \
        __builtin_amdgcn_global_load_lds((const unsigned*)((const char*)(gbase) + voffB[_i]), (LAS unsigned*)(lds + (bufoff) + ldsw + _i * 8192), 16, 0, 0); } while (0)
#define G8_GLDS(src, dstoff) __builtin_amdgcn_global_load_lds((const unsigned*)(src), (LAS unsigned*)(lds + (dstoff)), 16, 0, 0)
#define G8_STAGE_A(bufoff, hh, nx, kb) do { \
        if constexpr (Sched::GATHER) { const unsigned o0_ = (nx) ? avn[hh][0] : avc[hh][0], o1_ = (nx) ? avn[hh][1] : avc[hh][1]; \
            G8_GLDS(Ab + (size_t)o0_ + (kb), (bufoff) + ldsw); G8_GLDS(Ab + (size_t)o1_ + (kb), (bufoff) + ldsw + 8192); } \
        else { const char* ba_ = ((nx) ? nA : cA) + (size_t)(hh) * hstep + (kb); G8_GLDS(ba_ + voffA[0], (bufoff) + ldsw); G8_GLDS(ba_ + voffA[1], (bufoff) + ldsw + 8192); } } while (0)
#define G8_LDA(dst, b, h) do { _Pragma("unroll") for (int m = 0; m < 4; ++m) _Pragma("unroll") for (int k = 0; k < 2; ++k) dst[m][k] = *(const LAS bf16x8*)(lds + G8_SA(b, h) + aoff + m * 2048 + k * 1024); } while (0)
#define G8_LDB(dst, b, h) do { _Pragma("unroll") for (int n = 0; n < 2; ++n) _Pragma("unroll") for (int k = 0; k < 2; ++k) dst[n][k] = *(const LAS bf16x8*)(lds + G8_SB(b, h) + boff + n * 2048 + k * 1024); } while (0)
#define G8_MMA(ai, bj, At, Bt) do { __builtin_amdgcn_s_setprio(1); _Pragma("unroll") for (int m = 0; m < 4; ++m) _Pragma("unroll") for (int n = 0; n < 2; ++n) _Pragma("unroll") for (int k = 0; k < 2; ++k) \
        acc[ai][bj][m][n] = __builtin_amdgcn_mfma_f32_16x16x32_bf16(Bt[n][k], At[m][k], acc[ai][bj][m][n], 0, 0, 0); __builtin_amdgcn_s_setprio(0); } while (0)
#define G8_WAIT_V(n) asm volatile("s_waitcnt vmcnt(" #n ")" ::: "memory")
#define G8_WAIT_L(n) asm volatile("s_waitcnt lgkmcnt(" #n ")" ::: "memory")
#define G8_BAR __builtin_amdgcn_s_barrier()
#define G8_SCHED __builtin_amdgcn_sched_barrier(0)
    Unit cur, nxt; int ui = 0;
    if (!S.next(0, cur)) return;
    f32x4 acc[2][2][4][2];
#pragma unroll
    for (int a = 0; a < 2; ++a)
#pragma unroll
        for (int b = 0; b < 2; ++b)
#pragma unroll
            for (int m = 0; m < 4; ++m)
#pragma unroll
                for (int n = 0; n < 2; ++n) acc[a][b][m][n] = (f32x4){0.f, 0.f, 0.f, 0.f};
    bf16x8 At[4][2], B0[2][2], B1[2][2];
    const char* Ab = (const char*)Abase;
    unsigned avc[2][2], avn[2][2];
    const char *cA = Ab, *nA = Ab;
    S.a_ready(cur);
    if constexpr (Sched::GATHER) S.a_offsets(cur, R, C, avc); else cA = (const char*)S.a_base(cur);
    const char* cB = (const char*)cur.bt;
    G8_STAGE_B(G8_SB(0, 0), cB); G8_STAGE_B(G8_SB(0, 1), cB + hstep); G8_STAGE_A(G8_SA(0, 0), 0, false, 0); G8_STAGE_A(G8_SA(0, 1), 1, false, 0);
    if (wr == 1) G8_BAR;
    G8_WAIT_V(2); G8_BAR;
    G8_STAGE_B(G8_SB(1, 0), cB + kstep); G8_STAGE_A(G8_SA(1, 0), 0, false, kstep); G8_STAGE_B(G8_SB(1, 1), cB + hstep + kstep);
    G8_WAIT_V(6); G8_BAR;
    for (;;) {
        const bool has_next = S.next(ui + 1, nxt);
        if constexpr (Sched::GATHER) {
            if (has_next) S.a_offsets(nxt, R, C, avn);
            else {
#pragma unroll
                for (int hh = 0; hh < 2; ++hh)
#pragma unroll
                    for (int i = 0; i < 2; ++i) avn[hh][i] = avc[hh][i];
            }
        } else nA = has_next ? (const char*)S.a_base(nxt) : cA;
        const char* nB = has_next ? (const char*)nxt.bt : cB;
        for (int t = 0; t < nt; t += 2) {
            const bool last = (t == nt - 2);
            const size_t k1 = (size_t)(t + 1) * kstep;
            const size_t k2 = last ? 0 : (size_t)(t + 2) * kstep, k3 = k2 + kstep;
            const char* b2 = last ? nB : cB + k2; const char* b3 = b2 + kstep;
            G8_LDB(B0, 0, 0); G8_LDB(B1, 0, 1); G8_SCHED; G8_LDA(At, 0, 0); G8_STAGE_A(G8_SA(1, 1), 1, false, k1);
            G8_WAIT_V(8); G8_WAIT_L(0); G8_BAR; G8_MMA(0, 0, At, B0); G8_MMA(0, 1, At, B1); G8_BAR; G8_SCHED;
            G8_LDA(At, 0, 1); G8_STAGE_B(G8_SB(0, 0), b2); G8_STAGE_B(G8_SB(0, 1), b2 + hstep); G8_STAGE_A(G8_SA(0, 0), 0, last, k2);
            G8_WAIT_V(8); G8_WAIT_L(0); G8_BAR; G8_MMA(1, 0, At, B0); G8_MMA(1, 1, At, B1); G8_BAR; G8_SCHED;
            G8_LDB(B0, 1, 0); G8_LDB(B1, 1, 1); G8_SCHED; G8_LDA(At, 1, 0); G8_STAGE_A(G8_SA(0, 1), 1, last, k2);
            G8_WAIT_V(8); G8_WAIT_L(0); G8_BAR; G8_MMA(0, 0, At, B0); G8_MMA(0, 1, At, B1); G8_BAR; G8_SCHED;
            G8_LDA(At, 1, 1); G8_STAGE_B(G8_SB(1, 0), b3); G8_STAGE_B(G8_SB(1, 1), b3 + hstep); G8_STAGE_A(G8_SA(1, 0), 0, last, k3);
            G8_WAIT_V(8); G8_WAIT_L(0); G8_BAR; G8_MMA(1, 0, At, B0); G8_MMA(1, 1, At, B1); G8_BAR; G8_SCHED;
        }
        if (wr == 0) G8_BAR;
        if constexpr (!Epi::AFTER_DRAIN) E(acc, cur, wr, wc, fr, fq);
        if (!has_next) break;
#pragma unroll
        for (int a = 0; a < 2; ++a)
#pragma unroll
            for (int b = 0; b < 2; ++b)
#pragma unroll
                for (int m = 0; m < 4; ++m)
#pragma unroll
                    for (int n = 0; n < 2; ++n) acc[a][b][m][n] = (f32x4){0.f, 0.f, 0.f, 0.f};
        cur = nxt; cB = nB; cA = nA; ++ui;
        if constexpr (Sched::GATHER) {
#pragma unroll
            for (int hh = 0; hh < 2; ++hh)
#pragma unroll
                for (int i = 0; i < 2; ++i) avc[hh][i] = avn[hh][i];
        }
        if (wr == 1) G8_BAR;
    }
    G8_WAIT_V(0);
    G8_BAR;
    if constexpr (Epi::AFTER_DRAIN) E.fused(acc, cur, wr, wc, fr, fq, smem);
#undef G8_SA
#undef G8_SB
#undef G8_STAGE_A
#undef G8_GLDS
#undef G8_STAGE_B
#undef G8_LDA
#undef G8_LDB
#undef G8_MMA
#undef G8_WAIT_V
#undef G8_WAIT_L
#undef G8_BAR
#undef G8_SCHED
}

DI bool static_unit(int i, int G, int c, int nM, int nN, int& pm, int& pn) {
    const int nwg = nM * nN; const long L = (long)i * G + c; if (L >= nwg) return false;
    int wgid = (int)L; { const int q = nwg / 8, r = nwg % 8, xcd = wgid % 8, off = wgid / 8; wgid = (xcd < r ? xcd * (q + 1) : r * (q + 1) + (xcd - r) * q) + off; }
    const int nig = 8 * nN, gid = wgid / nig, fm = gid * 8, gsz = (nM - fm) < 8 ? (nM - fm) : 8;
    pm = fm + ((wgid % nig) % gsz); pn = (wgid % nig) / gsz; return true;
}
}

struct SchedQKV {
    const bf16_t *A, *Wt; int G, c;
    static constexpr bool GATHER = false;
    DI void a_ready(const g8::Unit&) const {}
    DI bool next(int i, g8::Unit& u) const { int pm, pn; if (!g8::static_unit(i, G, c, NTOK / 256, INC / 256, pm, pn)) return false; u.a = pm; u.b = pn; u.c = 0; u.d = 0; u.bt = Wt + (size_t)pn * 256 * DM; return true; }
    DI const bf16_t* a_base(const g8::Unit& u) const { return A + (size_t)u.a * 256 * DM; }
};
struct EpiQKV {
    static constexpr bool AFTER_DRAIN = false;
    bf16_t *QB, *KB, *VT; const float *ropec, *ropes, *qg, *kg;
    DI void operator()(const f32x4 (&acc)[2][2][4][2], const g8::Unit& u, int wr, int wc, int fr, int fq) const {
        const int pm = u.a, pn = u.b, b = pm / 9, p0 = (pm % 9) * 256;
        const bool isctx = p0 == 0;
        const int cw = pn * 256 + wc * 64;
        int kind, unit; const float* ng = nullptr;
        if (cw < 1024) { kind = 0; unit = cw >> 6; if (unit >= 8 && unit < 12) ng = qg; }
        else if (cw < 1536) { kind = 1; unit = (cw - 1024) >> 6; }
        else if (cw < 2048) { kind = 2; unit = cw - 1536; }
        else if (cw < 2176) { kind = 1; unit = 8 + ((cw - 2048) >> 6); ng = kg; }
        else if (cw < 2304) { kind = 2; unit = 512 + (cw - 2176); }
        else if (cw < 2432) { kind = 1; unit = 10 + ((cw - 2304) >> 6); }
        else { kind = 2; unit = 640 + (cw - 2432); }
        if (kind == 2) {
            const int vld = unit < 512 ? 128 : 64;
            const size_t vbase = unit < 512 ? (size_t)(unit >> 7) * TPB * 128 + (unit & 127) : (size_t)4 * TPB * 128 + (size_t)((unit - 512) >> 6) * TPB * 64;
            bf16_t* vb = VT + (size_t)b * VS + vbase + 16 * fq;
#pragma unroll
            for (int ai = 0; ai < 2; ++ai)
#pragma unroll
                for (int m = 0; m < 4; ++m) {
                    const int p = p0 + 128 * ai + 64 * wr + 16 * m + fr;
#pragma unroll
                    for (int bj = 0; bj < 2; ++bj) { const f32x4 v0 = acc[ai][bj][m][0], v1 = acc[ai][bj][m][1];
                        u32x4 o; o.x = pk2(v0.x, v0.y); o.y = pk2(v0.z, v0.w); o.z = pk2(v1.x, v1.y); o.w = pk2(v1.z, v1.w);
                        *(u32x4*)(vb + (size_t)p * vld + 8 * bj) = o; }
                }
            return;
        }
        const bool nrm = ng != nullptr;
        f32x4 g4[2][2];
#pragma unroll
        for (int bj = 0; bj < 2; ++bj)
#pragma unroll
            for (int n = 0; n < 2; ++n) g4[bj][n] = nrm ? *(const f32x4*)(ng + 32 * bj + 16 * n + 4 * fq) : (f32x4){1.f, 1.f, 1.f, 1.f};
        const float osc = kind == 0 ? QSCALE : 1.f;
        bf16_t* base = (kind == 0 ? QB + ((size_t)b * NQU + unit) * TPB * 64 : KB + ((size_t)b * NKU + unit) * TPB * 64) + 8 * fq;
#pragma unroll
        for (int ai = 0; ai < 2; ++ai)
#pragma unroll
            for (int m = 0; m < 4; ++m) {
                const int p = p0 + 128 * ai + 64 * wr + 16 * m + fr;
                f32x4 x[2][2];
#pragma unroll
                for (int bj = 0; bj < 2; ++bj)
#pragma unroll
                    for (int n = 0; n < 2; ++n) x[bj][n] = acc[ai][bj][m][n];
                if (nrm) {
                    float ss = 0.f;
#pragma unroll
                    for (int bj = 0; bj < 2; ++bj)
#pragma unroll
                        for (int n = 0; n < 2; ++n) ss += (x[bj][n].x * x[bj][n].x + x[bj][n].y * x[bj][n].y) + (x[bj][n].z * x[bj][n].z + x[bj][n].w * x[bj][n].w);
                    ss += __shfl_xor(ss, 16); ss += __shfl_xor(ss, 32);
                    const float r = rsqrtf(ss * (1.f / 64.f) + RMS_EPS);
#pragma unroll
                    for (int bj = 0; bj < 2; ++bj)
#pragma unroll
                        for (int n = 0; n < 2; ++n) x[bj][n] = x[bj][n] * r * g4[bj][n];
                }
                if (!isctx) {
                    const int t = p - CTXL;
#pragma unroll
                    for (int bj = 0; bj < 2; ++bj) {
                        const int idx = (bj == 0 ? (t >> 6) : 32 + (t & 63)) * 16 + 4 * fq;
                        const f32x4 c4 = *(const f32x4*)(ropec + idx), s4 = *(const f32x4*)(ropes + idx);
                        const f32x4 y0 = x[bj][0] * c4 - x[bj][1] * s4, y1 = x[bj][0] * s4 + x[bj][1] * c4;
                        x[bj][0] = y0; x[bj][1] = y1;
                    }
                }
#pragma unroll
                for (int bj = 0; bj < 2; ++bj) { u32x4 o; o.x = pk2(x[bj][0].x * osc, x[bj][0].y * osc); o.y = pk2(x[bj][0].z * osc, x[bj][0].w * osc);
                    o.z = pk2(x[bj][1].x * osc, x[bj][1].y * osc); o.w = pk2(x[bj][1].z * osc, x[bj][1].w * osc);
                    *(u32x4*)(base + (size_t)p * 64 + 32 * bj) = o; }
            }
    }
};
DI void phase_qkv(const Params& P, int l, int bid, int nb, char* smem) {
    __syncthreads();
    for (int i = threadIdx.x; i < 2 * 96 * 16 / 4; i += NTHREADS) ((f32x4*)(smem + LDS_MISC))[i] = ((const f32x4*)(P.ws + OFF_ROPE))[i];
    __syncthreads();
    SchedQKV S{(const bf16_t*)(P.ws + OFF_HX), (const bf16_t*)(P.ws + OFF_WIN) + (size_t)l * INC * DM, nb, bid};
    EpiQKV E{(bf16_t*)(P.ws + OFF_QB), (bf16_t*)(P.ws + OFF_KB), (bf16_t*)(P.ws + OFF_VT), (const float*)(smem + LDS_MISC), (const float*)(smem + LDS_MISC) + 96 * 16,
             P.q_norm_g + l * 64, P.k_norm_g + l * 64};
    g8::gemm_phase(smem, (const bf16_t*)(P.ws + OFF_HX), DM, S, E);
}


#ifndef PV_AHEAD
#define PV_AHEAD 8
#endif
#define MFMA32(a, b, c) __builtin_amdgcn_mfma_f32_32x32x16_bf16((a), (b), (c), 0, 0, 0)
template <int DV>
DI void flash_run(char* smem, const bf16_t* qrow, const bf16_t* Kb, const bf16_t* Vr, int n1, int base2, int n2, int tq, float m0, float l0,
                  f32x16 (&O)[DV / 32], float& lout) {
    constexpr int NT = DV / 32, KBYTES = 8192, RB = DV * 2, STAGE = KBYTES + 64 * RB, NVP = DV / 64, KP = 1024 / RB, LPR = RB / 16;
    LAS char* lds = (LAS char*)smem;
    const int t = threadIdx.x, wave = __builtin_amdgcn_readfirstlane(t >> 6);
    int lane = t & 63;
    asm volatile("" : "+v"(lane));
    const int h = lane >> 5, ln = lane & 31, sw = (ln >> 1) & 7;
    constexpr bool QLDS = DV == 128;
    LAS char* qb = lds + 4 * STAGE + wave * 4096 + lane * 16;
    bf16x8 qf[4];
#pragma unroll
    for (int s = 0; s < 4; ++s) qf[s] = *(const bf16x8*)(qrow + 16 * s + 8 * h);
    if (QLDS) {
#pragma unroll
        for (int s = 0; s < 4; ++s) *(LAS bf16x8*)(qb + s * 1024) = qf[s];
    }
#pragma unroll
    for (int tt = 0; tt < NT; ++tt)
#pragma unroll
        for (int i = 0; i < 16; ++i) O[tt][i] = 0.f;
    constexpr float THR = 8.f;
    constexpr int PVA = PV_AHEAD;
    float m = m0 > -1e29f ? m0 : 0.f, l = l0;
    f32x16 negm;
#pragma unroll
    for (int i = 0; i < 16; ++i) negm[i] = -m;
    const int ntile = n1 + n2;
    constexpr int VPM = DV == 128 ? 5 : 9;
    bf16x8 pfp[2][2];
#pragma unroll
    for (int x = 0; x < 2; ++x)
#pragma unroll
        for (int y = 0; y < 2; ++y) pfp[x][y] = (bf16x8){0, 0, 0, 0, 0, 0, 0, 0};
    const int krow = 8 * wave + (lane >> 3);
    const unsigned koff = (unsigned)(krow * 64 + (((lane & 7) ^ ((krow >> 1) & 7)) << 3)) * 2u;
    unsigned voff[NVP];
#pragma unroll
    for (int i = 0; i < NVP; ++i) { const int key = 8 * wave + KP * i + lane / LPR, cpos = lane % LPR, z = DV == 128 ? (key & 3) : ((key >> 1) & 1);
        voff[i] = (unsigned)(key * DV + ((cpos ^ (z << 2)) << 3)) * 2u; }
    const int tq_ = (lane & 15) >> 2, tp_ = lane & 3, gb_ = (lane >> 4) & 1, z_ = DV == 128 ? tq_ : ((tq_ >> 1) & 1);
    const int vlane = (4 * h + tq_) * RB + (2 * gb_ + (tp_ >> 1)) * 16 + (tp_ & 1) * 8;
#define FA_DMA(gsrc, ldsdst) do { unsigned keep_; asm volatile("s_mov_b32 %0, m0\n\ts_mov_b32 m0, %2\n\ts_nop 0\n\tglobal_load_lds_dwordx4 %1, off\n\ts_mov_b32 m0, %0" \
        : "=&s"(keep_) : "v"(gsrc), "s"(ldsdst) : "memory"); } while (0)
#define FA_ISSUE(j) do { const int j_ = (j); const int pj_ = j_ < n1 ? 64 * j_ : base2 + 64 * (j_ - n1); const int bo_ = (j_ & 3) * STAGE; \
        const char* kt_ = (const char*)Kb + (size_t)pj_ * 128; const char* vt_ = (const char*)Vr + (size_t)pj_ * RB; \
        FA_DMA(kt_ + koff, (unsigned)(size_t)(lds + bo_ + wave * 1024)); \
        _Pragma("unroll") for (int i_ = 0; i_ < NVP; ++i_) FA_DMA(vt_ + voff[i_], (unsigned)(size_t)(lds + bo_ + KBYTES + (8 * wave + KP * i_) * RB)); } while (0)
    asm volatile("s_waitcnt vmcnt(0)" ::: "memory");
    FA_ISSUE(0);
    if (ntile > 1) FA_ISSUE(1);
#define FA_PVCORE(VB_) do { \
_Pragma("unroll") \
        for (int tt = 0; tt < NT; ++tt) { \
            const LAS char* vt = (VB_) + ((tt ^ z_) << 6); \
_Pragma("unroll") \
            for (int x = 0; x < 2; ++x) \
_Pragma("unroll") \
                for (int y = 0; y < 2; ++y) { \
                    const s16x4 lo = __builtin_amdgcn_ds_read_tr16_b64_v4i16((LAS s16x4*)(vt + (32 * x + 16 * y) * RB)); \
                    const s16x4 hi = __builtin_amdgcn_ds_read_tr16_b64_v4i16((LAS s16x4*)(vt + (32 * x + 16 * y + 8) * RB)); \
                    const bf16x8 vf = __builtin_shufflevector(lo, hi, 0, 1, 2, 3, 4, 5, 6, 7); \
                    O[tt] = MFMA32(vf, pfp[x][y], O[tt]); \
                } \
        } \
 \
    } while (0)
#define FA_EXPCORE() do { \
_Pragma("unroll") \
        for (int i = 0; i < 16; i += 2) { \
            const float a0 = __builtin_amdgcn_exp2f(s0[i]), a1 = __builtin_amdgcn_exp2f(s0[i + 1]); \
            const float b0 = __builtin_amdgcn_exp2f(s1[i]), b1 = __builtin_amdgcn_exp2f(s1[i + 1]); \
            ps += (a0 + a1) + (b0 + b1); \
            w[i >> 1] = pk2(a0, a1); w[8 + (i >> 1)] = pk2(b0, b1); \
        } \
    } while (0)
    for (int it = 0; it < ntile; ++it) {
        const int p0 = it < n1 ? 64 * it : base2 + 64 * (it - n1);
        if (it + 1 < ntile) { if (NVP == 2) asm volatile("s_waitcnt vmcnt(3)" ::: "memory"); else asm volatile("s_waitcnt vmcnt(2)" ::: "memory"); }
        else asm volatile("s_waitcnt vmcnt(0)" ::: "memory");
        __builtin_amdgcn_s_barrier();
        asm volatile("" ::: "memory");
        if (it + 2 < ntile) FA_ISSUE(it + 2);
        int bo = (it & 3) * STAGE;
        asm volatile("" : "+s"(bo));
        const LAS char* kb = lds + bo;
        const LAS char* vb = kb + KBYTES + vlane;
        f32x16 s0 = negm, s1 = negm;
#pragma unroll
        for (int s = 0; s < 4; ++s) {
            const int co = ((2 * s + h) ^ sw) << 4;
            const bf16x8 k0 = *(const LAS bf16x8*)(kb + ln * 128 + co);
            const bf16x8 k1 = *(const LAS bf16x8*)(kb + (32 + ln) * 128 + co);
            const bf16x8 qs = QLDS ? *(const LAS bf16x8*)(qb + s * 1024) : qf[s];
            s0 = MFMA32(k0, qs, s0); s1 = MFMA32(k1, qs, s1);
        }
        if (it >= n1) {
            const int d0 = (p0 - CTXL) - tq + 4 * h + 128;
#pragma unroll
            for (int i = 0; i < 16; ++i) {
                const int dd = d0 + (i & 3) + 8 * (i >> 2);
                s0[i] = ((unsigned)dd <= 256u) ? s0[i] : -1e30f;
                s1[i] = ((unsigned)(dd + 32) <= 256u) ? s1[i] : -1e30f;
            }
        }
        float ps = 0.f;
        unsigned w[16];
        __builtin_amdgcn_sched_barrier(0);
        if (it > 0) {
            int bp = ((it - 1) & 3) * STAGE;
            asm volatile("" : "+s"(bp));
            const LAS char* vbp = lds + bp + KBYTES + vlane;
            FA_PVCORE(vbp);
            FA_EXPCORE();
            __builtin_amdgcn_sched_group_barrier(0x100, PVA, 0);
#pragma unroll
            for (int g = 0; g < 4 * NT; ++g) { __builtin_amdgcn_sched_group_barrier(0x008, 1, 0); __builtin_amdgcn_sched_group_barrier(0x002, VPM, 0);
                if (g < 4 * NT - PVA / 2) __builtin_amdgcn_sched_group_barrier(0x100, 2, 0); }
        } else {
            FA_EXPCORE();
        }
        __builtin_amdgcn_sched_barrier(0);
        if (__any(!(ps <= 1048576.f))) {
            float mx;
            {
                float t0 = max2f(s0[0], s1[0]), t1 = max2f(s0[1], s1[1]), t2 = max2f(s0[2], s1[2]), t3 = max2f(s0[3], s1[3]);
#pragma unroll
                for (int i = 4; i < 16; i += 4) { t0 = max2f(t0, max2f(s0[i], s1[i])); t1 = max2f(t1, max2f(s0[i + 1], s1[i + 1])); t2 = max2f(t2, max2f(s0[i + 2], s1[i + 2])); t3 = max2f(t3, max2f(s0[i + 3], s1[i + 3])); }
                mx = max2f(max2f(t0, t1), max2f(t2, t3));
            }
            mx = max2f(mx, __shfl_xor(mx, 32));
            const float d = fmaxf(mx, 0.f), alpha = __builtin_amdgcn_exp2f(-d);
            m += d; l *= alpha;
#pragma unroll
            for (int i = 0; i < 16; ++i) negm[i] -= d;
#pragma unroll
            for (int tt = 0; tt < NT; ++tt)
#pragma unroll
                for (int i = 0; i < 16; ++i) O[tt][i] *= alpha;
            ps = 0.f;
#pragma unroll
            for (int i = 0; i < 16; i += 2) {
                const float a0 = __builtin_amdgcn_exp2f(s0[i] - d), a1 = __builtin_amdgcn_exp2f(s0[i + 1] - d);
                const float b0 = __builtin_amdgcn_exp2f(s1[i] - d), b1 = __builtin_amdgcn_exp2f(s1[i + 1] - d);
                ps += (a0 + a1) + (b0 + b1);
                w[i >> 1] = pk2(a0, a1); w[8 + (i >> 1)] = pk2(b0, b1);
            }
        }
#pragma unroll
        for (int x = 0; x < 2; ++x)
#pragma unroll
            for (int y = 0; y < 2; ++y) { u32x4 q; q.x = w[8 * x + 4 * y]; q.y = w[8 * x + 4 * y + 1]; q.z = w[8 * x + 4 * y + 2]; q.w = w[8 * x + 4 * y + 3];
                pfp[x][y] = __builtin_bit_cast(bf16x8, q); }
        l += ps;
    }
    { int bp = ((ntile - 1) & 3) * STAGE; asm volatile("" : "+s"(bp)); const LAS char* vbp = lds + bp + KBYTES + vlane; FA_PVCORE(vbp); }
    __builtin_amdgcn_s_barrier();
#undef FA_ISSUE
#undef FA_PVCORE
#undef FA_EXPCORE
#undef FA_DMA
    lout = l + __shfl_xor(l, 32);
}

constexpr int CTX_EARLY_LO = 96, CTX_EARLY_N = 32;
DI bool ctx_early(int nb) { return nb >= CTX_EARLY_LO + CTX_EARLY_N; }
DI void outproj_run(const Params& P, int l, int mode, int c, int nb, char* smem);
DI void phase_attn(const Params& P, int l, int bid, int nb, char* smem) {
    const int t = threadIdx.x, wave = t >> 6;
    const bf16_t* QB = (const bf16_t*)(P.ws + OFF_QB); const bf16_t* KB = (const bf16_t*)(P.ws + OFF_KB); const bf16_t* VT = (const bf16_t*)(P.ws + OFF_VT);
    bf16_t* MIX = (bf16_t*)(P.ws + OFF_HX);
    const float lambda_init = l == 0 ? 0.2f : (0.8f - 0.6f * expf(-0.3f));
    float d1 = P.lam_q1[l * 64 + (t & 63)] * P.lam_k1[l * 64 + (t & 63)], d2 = P.lam_q2[l * 64 + (t & 63)] * P.lam_k2[l * 64 + (t & 63)];
    d1 = wave_sum(d1); d2 = wave_sum(d2);
    const float lam = expf(d1) - expf(d2) + lambda_init;
    const bool has_ctx = l == 0 && bid < 96;
    const int nmain = (768 - bid + nb - 1) / nb;
#pragma unroll 1
    for (int kk = 0; kk < nmain + (has_ctx ? 1 : 0); ++kk) {
        const int it = has_ctx ? (kk == 0 ? 768 + bid : bid + (kk - 1) * nb) : bid + kk * nb;
        int ty, b, hd, p0q, ncx;
        bool isctx;
        if (it < 768) {
            ty = it >> 8; const int idx = it & 255, xcd = idx & 7, r = idx >> 3, stream = xcd * 4 + (r >> 3);
            b = stream >> 2; hd = stream & 3; p0q = CTXL + (r & 7) * 256; isctx = false; ncx = TPB / 64;
        } else {
            const int i2 = it - 768, t12 = i2 % 12;
            b = i2 / 12; p0q = 0; ty = t12 >> 2; hd = t12 & 3; isctx = true; ncx = CTXL / 64;
        }
        int lane = t & 63;
        asm volatile("" : "+v"(lane));
        const int h = lane >> 5, ln = lane & 31;
        const int p = p0q + wave * 32 + ln, tok = b * TPB + p, tq = p - CTXL;
        if (ty == 0) {
            f32x16 O[4]; float lt;
            const bf16_t* V = VT + (size_t)b * VS + (size_t)hd * TPB * 128;
            flash_run<128>(smem, QB + (((size_t)b * NQU + 2 * hd + 1) * TPB + p) * 64, KB + ((size_t)b * NKU + 2 * hd + 1) * TPB * 64, V, ncx, 0, 0, tq, -1e30f, 0.f, O, lt);
            {
                int l2_ = t & 63; asm volatile("" : "+v"(l2_)); const int h2 = l2_ >> 5; bf16_t* orow = MIX + (size_t)(b * TPB + p0q + wave * 32 + (l2_ & 31)) * DM + hd * 128 + 4 * h2;
                const float f = -lam / lt;
#pragma unroll
                for (int tt = 0; tt < 4; ++tt)
#pragma unroll
                    for (int g = 0; g < 4; ++g) { u32x2 o; o.x = pk2(O[tt][4 * g] * f, O[tt][4 * g + 1] * f); o.y = pk2(O[tt][4 * g + 2] * f, O[tt][4 * g + 3] * f);
                        *(u32x2*)(orow + 32 * tt + 8 * g) = o; }
            }
            flash_run<128>(smem, QB + (((size_t)b * NQU + 2 * hd) * TPB + p) * 64, KB + ((size_t)b * NKU + 2 * hd) * TPB * 64, V, ncx, 0, 0, tq, -1e30f, 0.f, O, lt);
            {
                int l2_ = t & 63; asm volatile("" : "+v"(l2_)); const int h2 = l2_ >> 5; bf16_t* orow = MIX + (size_t)(b * TPB + p0q + wave * 32 + (l2_ & 31)) * DM + hd * 128 + 4 * h2;
                const float f = 1.f / lt; float ss = 0.f;
#pragma unroll
                for (int tt = 0; tt < 4; ++tt)
#pragma unroll
                    for (int g = 0; g < 4; ++g) {
                        const u32x2 st = *(const u32x2*)(orow + 32 * tt + 8 * g);
                        O[tt][4 * g + 0] = O[tt][4 * g + 0] * f + __uint_as_float(st.x << 16);
                        O[tt][4 * g + 1] = O[tt][4 * g + 1] * f + __uint_as_float(st.x & 0xffff0000u);
                        O[tt][4 * g + 2] = O[tt][4 * g + 2] * f + __uint_as_float(st.y << 16);
                        O[tt][4 * g + 3] = O[tt][4 * g + 3] * f + __uint_as_float(st.y & 0xffff0000u);
                        ss += (O[tt][4 * g] * O[tt][4 * g] + O[tt][4 * g + 1] * O[tt][4 * g + 1]) + (O[tt][4 * g + 2] * O[tt][4 * g + 2] + O[tt][4 * g + 3] * O[tt][4 * g + 3]);
                    }
                ss += __shfl_xor(ss, 32);
                const float r = rsqrtf(ss * (1.f / 128.f) + RMS_EPS) * (1.f - lambda_init);
                const float* sg = P.subln_g + l * 128 + 4 * h2;
#pragma unroll
                for (int tt = 0; tt < 4; ++tt)
#pragma unroll
                    for (int g = 0; g < 4; ++g) { const f32x4 gg = *(const f32x4*)(sg + 32 * tt + 8 * g);
                        u32x2 o; o.x = pk2(O[tt][4 * g] * r * gg.x, O[tt][4 * g + 1] * r * gg.y); o.y = pk2(O[tt][4 * g + 2] * r * gg.z, O[tt][4 * g + 3] * r * gg.w);
                        *(u32x2*)(orow + 32 * tt + 8 * g) = o; }
            }
        } else {
            const bool isC = ty == 2;
            f32x16 O[2]; float lt;
            const int qu = (isC ? 12 : 8) + hd, ku = (isC ? 10 : 8) + (hd >> 1);
            const bf16_t* V = VT + (size_t)b * VS + (size_t)4 * TPB * 128 + (size_t)((isC ? 2 : 0) + (hd >> 1)) * TPB * 64;
            int n1 = ncx, base2 = 0, n2 = 0;
            float m0 = -1e30f, l0 = 0.f;
            if (isC) {
                m0 = P.sink[l * 4 + hd] * 1.4426950408889634f; l0 = h == 0 ? 1.f : 0.f;
                if (!isctx) { const int n = (p0q - CTXL) >> 8; n1 = CTXL / 64; const int jlo = n == 0 ? 2 : 0, jhi = n == 7 ? 6 : 8;
                    base2 = CTXL + 256 * n - 128 + 64 * jlo; n2 = jhi - jlo; }
            }
            flash_run<64>(smem, QB + (((size_t)b * NQU + qu) * TPB + p) * 64, KB + ((size_t)b * NKU + ku) * TPB * 64, V, n1, base2, n2, tq, m0, l0, O, lt);
            const float f = 1.f / lt;
            int l2_ = t & 63; asm volatile("" : "+v"(l2_)); const int h2 = l2_ >> 5; bf16_t* orow = MIX + (size_t)(b * TPB + p0q + wave * 32 + (l2_ & 31)) * DM + (isC ? 768 : 512) + hd * 64 + 4 * h2;
#pragma unroll
            for (int tt = 0; tt < 2; ++tt)
#pragma unroll
                for (int g = 0; g < 4; ++g) { u32x2 o; o.x = pk2(O[tt][4 * g] * f, O[tt][4 * g + 1] * f); o.y = pk2(O[tt][4 * g + 2] * f, O[tt][4 * g + 3] * f);
                    *(u32x2*)(orow + 32 * tt + 8 * g) = o; }
        }
        if (it >= 768) {
            asm volatile("s_waitcnt vmcnt(0)" ::: "memory");
            __syncthreads();
            if (t == 0) { __builtin_amdgcn_fence(__ATOMIC_RELEASE, "agent"); asm volatile("s_waitcnt vmcnt(0)" ::: "memory");
                __hip_atomic_fetch_add((int*)(P.ws + OFF_RDYC) + ((it - 768) / 12) * 64, 1, __ATOMIC_RELAXED, __HIP_MEMORY_SCOPE_AGENT); }
        }
    }
    if (l == 0 && ctx_early(nb) && bid >= CTX_EARLY_LO && bid < CTX_EARLY_LO + CTX_EARLY_N) outproj_run(P, 0, 2, bid - CTX_EARLY_LO, nb, smem);
}

DI void phase_norm2_route(const Params& P, int l, int bid, int nb, char* smem) {
    const int t = threadIdx.x, lane = t & 63, wave = t >> 6;
    int* lcnt = (int*)(smem + LDS_MISC);
    int* lbase = lcnt + 16;
    int* rec = lcnt + 32;
    int* rec2 = rec + 160;
    float* recw = (float*)(rec2 + 160);
    __syncthreads();
    {
        int ts = t;
        asm volatile("" : "+v"(ts));
        f32x4 wv[4096 / NTHREADS];
#pragma unroll
        for (int i = 0; i < 4096 / NTHREADS; ++i) { const int idx = ts + NTHREADS * i; wv[i] = *(const f32x4*)(P.w_router + (idx >> 2) * 16 + (idx & 3) * 4); }
#pragma unroll
        for (int i = 0; i < 4096 / NTHREADS; ++i) { const int idx = ts + NTHREADS * i, k = idx >> 2, q = idx & 3;
            const int row = ((k >> 8) * 4 + (k & 3)) * 64 + ((k >> 2) & 63);
            *(f32x4*)(smem + row * 64 + ((q ^ ((row >> 2) & 3)) << 4)) = wv[i]; }
    }
    if (t < 16) lcnt[t] = 0;
    __syncthreads();
    bf16_t* HX = (bf16_t*)(P.ws + OFF_HX);
    int* cnt = (int*)(P.ws + OFF_CNT) + l * 16 * 64;
    int* list = (int*)(P.ws + OFF_LIST);
    float* tokw = (float*)(P.ws + OFF_TOKW);
    const int per = (NTOK + nb - 1) / nb;
    const int tk0 = bid * per, tk1 = min(NTOK, tk0 + per), ntk = tk1 - tk0;
    const int eme = ((lane >> 5) & 1) * 8 + ((lane >> 4) & 1) * 4 + ((lane >> 3) & 1) * 2 + ((lane >> 2) & 1);
    const float mybias = P.router_bias[eme];
    f32x4 v[4], vn[4], gs[4], hs[4];
    int cur_mr = -1;
    if (wave < ntk) { const int tok = tk0 + wave, b = tok / TPB, p = tok % TPB; const u32x2* xr = (const u32x2*)resid_row(P, b, p) + lane;
#pragma unroll
        for (int j = 0; j < 4; ++j) vn[j] = bf4_to_f32(xr[64 * j]); }
    for (int i = wave; i < ntk; i += NW) {
        const int tok = tk0 + i;
        const int b = tok / TPB, p = tok % TPB, mr = p < CTXL ? 8 : b;
#pragma unroll
        for (int j = 0; j < 4; ++j) v[j] = vn[j];
        if (i + NW < ntk) { const int tk2 = tok + NW, b2 = tk2 / TPB, p2 = tk2 % TPB; const u32x2* xr = (const u32x2*)resid_row(P, b2, p2) + lane;
#pragma unroll
            for (int j = 0; j < 4; ++j) vn[j] = bf4_to_f32(xr[64 * j]); }
        if (l == 1 && p < CTXL) { if (lane == 0) rec[i] = -1; continue; }
        float ss = 0.f;
#pragma unroll
        for (int j = 0; j < 4; ++j) ss += (v[j].x * v[j].x + v[j].y * v[j].y) + (v[j].z * v[j].z + v[j].w * v[j].w);
        const float r = rsqrtf(wave_sum(ss) * (1.f / DM) + RMS_EPS);
        if (mr != cur_mr) {
            const float* md = mod_row(P, l, mr);
            const f32x4* gn = (const f32x4*)(P.norm2_g + l * DM) + lane;
            const f32x4* sh = (const f32x4*)(md + 3072) + lane;
            const f32x4* sc = (const f32x4*)(md + 4096) + lane;
#pragma unroll
            for (int j = 0; j < 4; ++j) { const f32x4 g = gn[64 * j], s1 = sc[64 * j]; gs[j] = g * (1.f + s1); hs[j] = sh[64 * j]; }
            cur_mr = mr;
        }
        u32x2* o = (u32x2*)(HX + (size_t)tok * DM) + lane;
        float lg[16];
#pragma unroll
        for (int e = 0; e < 16; ++e) lg[e] = 0.f;
#pragma unroll
        for (int j = 0; j < 4; ++j) {
            float y[4];
            y[0] = v[j].x * r * gs[j].x + hs[j].x; y[1] = v[j].y * r * gs[j].y + hs[j].y;
            y[2] = v[j].z * r * gs[j].z + hs[j].z; y[3] = v[j].w * r * gs[j].w + hs[j].w;
            u32x2 w; w.x = pk2(y[0], y[1]); w.y = pk2(y[2], y[3]);
            o[64 * j] = w;
#pragma unroll
            for (int cc = 0; cc < 4; ++cc) {
                const int row = (j * 4 + cc) * 64 + lane;
#pragma unroll
                for (int q = 0; q < 4; ++q) {
                    const f32x4 wv = *(const f32x4*)(smem + row * 64 + ((q ^ ((row >> 2) & 3)) << 4));
                    lg[4 * q + 0] += y[cc] * wv.x; lg[4 * q + 1] += y[cc] * wv.y; lg[4 * q + 2] += y[cc] * wv.z; lg[4 * q + 3] += y[cc] * wv.w;
                }
            }
        }
        float a8[8], a4[4], a2[2], a1;
        { const bool hi = lane & 32;
#pragma unroll
          for (int j = 0; j < 8; ++j) { const float keep = hi ? lg[8 + j] : lg[j], send = hi ? lg[j] : lg[8 + j]; a8[j] = keep + __shfl_xor(send, 32); } }
        { const bool hi = lane & 16;
#pragma unroll
          for (int j = 0; j < 4; ++j) { const float keep = hi ? a8[4 + j] : a8[j], send = hi ? a8[j] : a8[4 + j]; a4[j] = keep + __shfl_xor(send, 16); } }
        { const bool hi = lane & 8;
#pragma unroll
          for (int j = 0; j < 2; ++j) { const float keep = hi ? a4[2 + j] : a4[j], send = hi ? a4[j] : a4[2 + j]; a2[j] = keep + __shfl_xor(send, 8); } }
        { const bool hi = lane & 4; const float keep = hi ? a2[1] : a2[0], send = hi ? a2[0] : a2[1]; a1 = keep + __shfl_xor(send, 4); }
        a1 += __shfl_xor(a1, 2); a1 += __shfl_xor(a1, 1);
        const float mysc = 1.f / (1.f + expf(-a1)), mysel = mysc + mybias;
        float scv[16], sel[16];
#pragma unroll
        for (int e = 0; e < 16; ++e) { const int src = ((e >> 3) & 1) * 32 + ((e >> 2) & 1) * 16 + ((e >> 1) & 1) * 8 + (e & 1) * 4;
            scv[e] = __int_as_float(__builtin_amdgcn_readlane(__float_as_int(mysc), src)); sel[e] = __int_as_float(__builtin_amdgcn_readlane(__float_as_int(mysel), src)); }
        float bestg = -1e30f; int be1 = 0, be2 = 1; float bw1 = 0.f, bw2 = 0.f;
#pragma unroll
        for (int g = 0; g < 4; ++g) {
            int i1 = 0; float v1 = sel[4 * g], w1 = scv[4 * g];
#pragma unroll
            for (int j = 1; j < 4; ++j) if (sel[4 * g + j] > v1) { v1 = sel[4 * g + j]; w1 = scv[4 * g + j]; i1 = j; }
            int i2 = -1; float v2 = -1e30f, w2 = 0.f;
#pragma unroll
            for (int j = 0; j < 4; ++j) if (j != i1 && sel[4 * g + j] > v2) { v2 = sel[4 * g + j]; w2 = scv[4 * g + j]; i2 = j; }
            const float gs = v1 + v2;
            if (gs > bestg) { bestg = gs; be1 = 4 * g + i1; be2 = 4 * g + i2; bw1 = w1; bw2 = w2; }
        }
        if (lane == 0) {
            const float inv = 1.f / (bw1 + bw2);
            const int r1 = atomicAdd(&lcnt[be1], 1), r2 = atomicAdd(&lcnt[be2], 1);
            rec[i] = be1 | (be2 << 8) | (r1 << 16); rec2[i] = r2;
            recw[i] = bw1 * inv; recw[160 + i] = bw2 * inv;
        }
    }
    __syncthreads();
    if (t < 16) { const int c = lcnt[t]; lbase[t] = c ? atomicAdd(&cnt[t * 64], c) : 0; }
    __syncthreads();
    for (int i = t; i < ntk; i += NTHREADS) {
        const int rc = rec[i];
        if (rc >= 0) { const int e1 = rc & 255, e2 = (rc >> 8) & 255, r1 = rc >> 16, r2 = rec2[i], tok = tk0 + i;
            list[e1 * NTOK + lbase[e1] + r1] = 2 * tok; list[e2 * NTOK + lbase[e2] + r2] = 2 * tok + 1;
            tokw[e1 * NTOK + lbase[e1] + r1] = recw[i]; tokw[e2 * NTOK + lbase[e2] + r2] = recw[160 + i]; }
    }
}

struct SchedOut {
    const bf16_t *A, *Wt; int G, c, mode;
    int* rdyc;
    static constexpr bool GATHER = false;
    DI void a_ready(const g8::Unit& u) const {
        if (mode != 2) return;
        if (__builtin_amdgcn_readfirstlane(threadIdx.x >> 6) == 0) {
            unsigned sp = 0;
            while (__hip_atomic_load(rdyc + (u.a / 9) * 64, __ATOMIC_RELAXED, __HIP_MEMORY_SCOPE_AGENT) < 12) { __builtin_amdgcn_s_sleep(2); if (++sp > (1u << 22)) break; }
            __builtin_amdgcn_fence(__ATOMIC_ACQUIRE, "agent");
            asm volatile("s_waitcnt vmcnt(0)" ::: "memory");
        }
        __builtin_amdgcn_s_barrier();
    }
    DI bool next(int i, g8::Unit& u) const {
        int pm, pn;
        if (mode == 2) { if (i != 0) return false; pm = 9 * (c >> 2); pn = c & 3; }
        else { if (!g8::static_unit(i, G, c, mode == 0 ? 72 : 64, 4, pm, pn)) return false; if (mode == 1) pm = 9 * (pm >> 3) + 1 + (pm & 7); }
        u.a = pm; u.b = pn; u.c = 0; u.d = 0; u.bt = Wt + (size_t)pn * 256 * DM; return true; }
    DI const bf16_t* a_base(const g8::Unit& u) const { return A + (size_t)u.a * 256 * DM; }
};
struct EpiOut {
    static constexpr bool AFTER_DRAIN = false;
    const float *x, *ctx; float *out, *xc; const float* mod; int l;
    DI void operator()(const f32x4 (&acc)[2][2][4][2], const g8::Unit& u, int wr, int wc, int fr, int fq) const {
        const int tok0 = u.a * 256, b = tok0 / TPB, p0 = tok0 % TPB;
        const bool isctx = p0 == 0;
        const float* g1 = mod + (size_t)(l * 9 + (isctx ? 8 : b)) * 6144 + 2048 + u.b * 256 + 32 * wc + 8 * fq;
        f32x4 g4[2][2];
#pragma unroll
        for (int bj = 0; bj < 2; ++bj)
#pragma unroll
            for (int n = 0; n < 2; ++n) g4[bj][n] = *(const f32x4*)(g1 + 128 * bj + 4 * n);
        const int cb = u.b * 256 + 32 * wc + 8 * fq;
#pragma unroll
        for (int ai = 0; ai < 2; ++ai)
#pragma unroll
            for (int m = 0; m < 4; ++m) {
                const int r = 128 * ai + 64 * wr + 16 * m + fr;
                const size_t ro = isctx ? (size_t)(b * CTXL + r) * DM : (size_t)(b * SEQ + p0 - CTXL + r) * DM;
                const float* xin = (isctx ? ctx : x) + ro + cb;
                bf16_t* xo = (isctx ? (bf16_t*)xc + ro : (bf16_t*)(out + ro)) + cb;
#pragma unroll
                for (int bj = 0; bj < 2; ++bj) { f32x4 x0, x1;
                    if (l == 0) { x0 = *(const f32x4*)(xin + 128 * bj); x1 = *(const f32x4*)(xin + 128 * bj + 4); }
                    else { const u32x4 q = *(const u32x4*)(xo + 128 * bj); x0 = bf4_to_f32((u32x2){q.x, q.y}); x1 = bf4_to_f32((u32x2){q.z, q.w}); }
                    const u32x2 o0 = f32_to_bf4(x0 + g4[bj][0] * acc[ai][bj][m][0]), o1 = f32_to_bf4(x1 + g4[bj][1] * acc[ai][bj][m][1]);
                    *(u32x4*)(xo + 128 * bj) = (u32x4){o0.x, o0.y, o1.x, o1.y}; }
                if (m & 1) asm volatile("" ::: "memory");
            }
    }
};
struct EpiOutF {
    static constexpr bool AFTER_DRAIN = true;
    const Params& P; int l;
    DI void operator()(const f32x4 (&)[2][2][4][2], const g8::Unit&, int, int, int, int) const {}
    DI void fused(f32x4 (&acc)[2][2][4][2], const g8::Unit& u, int wr, int wc, int fr, int fq, char* smem) const {
        const int tid = threadIdx.x;
        const int tok0 = u.a * 256, b = tok0 / TPB, p0 = tok0 % TPB, pn = u.b;
        const bool isctx = p0 == 0;
        const int mr = isctx ? 8 : b;
        const float* md = mod_row(P, l, mr);
        const int cb = pn * 256 + 32 * wc + 8 * fq;
        float* part = (float*)smem;
        float* rt = part + 256 * 4 * 17;
        int* lcnt = (int*)(rt + 256);
        int* lbase = lcnt + 16;
        const float* wtab = (const float*)(smem + LDS_MISC);
        float* xc = (float*)(P.ws + OFF_XC);
        {
            f32x4 g4[2][2];
#pragma unroll
            for (int bj = 0; bj < 2; ++bj)
#pragma unroll
                for (int n = 0; n < 2; ++n) g4[bj][n] = *(const f32x4*)(md + 2048 + cb + 128 * bj + 4 * n);
#pragma unroll
            for (int ai = 0; ai < 2; ++ai)
#pragma unroll
                for (int m = 0; m < 4; ++m) {
                    const int r = 128 * ai + 64 * wr + 16 * m + fr;
                    const size_t ro = isctx ? (size_t)(b * CTXL + r) * DM : (size_t)(b * SEQ + p0 - CTXL + r) * DM;
                    const float* xin = (isctx ? P.ctx : P.x) + ro + cb;
                    bf16_t* xo = (isctx ? (bf16_t*)xc + ro : (bf16_t*)(P.out + ro)) + cb;
#pragma unroll
                    for (int bj = 0; bj < 2; ++bj) { f32x4 x0, x1;
                        if (l == 0) { x0 = *(const f32x4*)(xin + 128 * bj); x1 = *(const f32x4*)(xin + 128 * bj + 4); }
                        else { const u32x4 q = *(const u32x4*)(xo + 128 * bj); x0 = bf4_to_f32((u32x2){q.x, q.y}); x1 = bf4_to_f32((u32x2){q.z, q.w}); }
                        acc[ai][bj][m][0] = x0 + g4[bj][0] * acc[ai][bj][m][0]; acc[ai][bj][m][1] = x1 + g4[bj][1] * acc[ai][bj][m][1];
                        const u32x2 o0 = f32_to_bf4(acc[ai][bj][m][0]), o1 = f32_to_bf4(acc[ai][bj][m][1]);
                        *(u32x4*)(xo + 128 * bj) = (u32x4){o0.x, o0.y, o1.x, o1.y}; }
                    if (m & 1) asm volatile("" ::: "memory");
                }
        }
        {
            float wb[2][2][4];
#pragma unroll
            for (int bj = 0; bj < 2; ++bj)
#pragma unroll
                for (int n = 0; n < 2; ++n)
#pragma unroll
                    for (int r = 0; r < 4; ++r) wb[bj][n][r] = wtab[(128 * bj + 32 * wc + 8 * fq + 4 * n + r) * 16 + fr];
#pragma unroll
            for (int ai = 0; ai < 2; ++ai)
#pragma unroll
                for (int m = 0; m < 4; ++m) {
                    f32x4 d = {0.f, 0.f, 0.f, 0.f}; float ss = 0.f;
#pragma unroll
                    for (int bj = 0; bj < 2; ++bj)
#pragma unroll
                        for (int n = 0; n < 2; ++n) { const f32x4 v = acc[ai][bj][m][n];
                            ss += (v.x * v.x + v.y * v.y) + (v.z * v.z + v.w * v.w);
                            d = __builtin_amdgcn_mfma_f32_16x16x4f32(v.x, wb[bj][n][0], d, 0, 0, 0);
                            d = __builtin_amdgcn_mfma_f32_16x16x4f32(v.y, wb[bj][n][1], d, 0, 0, 0);
                            d = __builtin_amdgcn_mfma_f32_16x16x4f32(v.z, wb[bj][n][2], d, 0, 0, 0);
                            d = __builtin_amdgcn_mfma_f32_16x16x4f32(v.w, wb[bj][n][3], d, 0, 0, 0); }
                    ss += __shfl_xor(ss, 16); ss += __shfl_xor(ss, 32);
                    const int rowb = 128 * ai + 64 * wr + 16 * m;
                    part[((rowb + 4 * fq + 0) * 4 + wc) * 17 + fr] = d.x;
                    part[((rowb + 4 * fq + 1) * 4 + wc) * 17 + fr] = d.y;
                    part[((rowb + 4 * fq + 2) * 4 + wc) * 17 + fr] = d.z;
                    part[((rowb + 4 * fq + 3) * 4 + wc) * 17 + fr] = d.w;
                    if (fq == 0) part[((rowb + fr) * 4 + wc) * 17 + 16] = ss;
                }
        }
        __syncthreads();
        float* xch = (float*)(P.ws + OFF_XCH) + (size_t)u.a * 4 * 256 * 20;
        { float* dst = xch + (size_t)pn * 256 * 20;
          for (int i = tid; i < 256 * 9; i += NTHREADS) { const int row = i / 9, k = i - row * 9; const float* pp = part + row * 68 + 2 * k;
              const float a = (pp[0] + pp[17]) + (pp[34] + pp[51]), c2 = k < 8 ? (pp[1] + pp[18]) + (pp[35] + pp[52]) : 0.f;
              __hip_atomic_store((unsigned long long*)(dst + row * 20 + 2 * k), (unsigned long long)__float_as_uint(a) | ((unsigned long long)__float_as_uint(c2) << 32), __ATOMIC_RELAXED, __HIP_MEMORY_SCOPE_AGENT); } }
        asm volatile("s_waitcnt vmcnt(0)" ::: "memory");
        __syncthreads();
        if (tid == 0) {
            int* xcn = (int*)(P.ws + OFF_XCNT) + (l * 72 + u.a) * 64;
            __hip_atomic_fetch_add(xcn, 1, __ATOMIC_RELAXED, __HIP_MEMORY_SCOPE_AGENT);
            unsigned sp = 0;
            while (__hip_atomic_load(xcn, __ATOMIC_RELAXED, __HIP_MEMORY_SCOPE_AGENT) < 4) { __builtin_amdgcn_s_sleep(1); if (++sp > (1u << 22)) break; }
            __builtin_amdgcn_fence(__ATOMIC_ACQUIRE, "agent");
            asm volatile("s_waitcnt vmcnt(0)" ::: "memory");
        }
        if (tid >= 64 && tid < 80) lcnt[tid - 64] = 0;
        __syncthreads();
        const bool router = (tid >> 6) == pn;
        int be1 = 0, be2 = 1, r1 = 0, r2 = 0; float w1 = 0.f, w2 = 0.f;
        const int rtok = tok0 + tid;
        if (tid < 256) {
            float sq = 0.f;
#pragma unroll
            for (int q = 0; q < 4; ++q) sq += xch[(size_t)(q * 256 + tid) * 20 + 16];
            f32x4 lg4[4];
            if (router) {
#pragma unroll
                for (int j = 0; j < 4; ++j) lg4[j] = (f32x4){0.f, 0.f, 0.f, 0.f};
#pragma unroll
                for (int q = 0; q < 4; ++q)
#pragma unroll
                    for (int j = 0; j < 4; ++j) lg4[j] += *(const f32x4*)(xch + (size_t)(q * 256 + tid) * 20 + 4 * j);
            }
            const float r = rsqrtf(sq * (1.f / DM) + RMS_EPS);
            rt[tid] = r;
            if (router) {
                const float* qe = (const float*)(P.ws + OFF_QE) + (l * 9 + mr) * 16;
                float scv[16], sel[16];
#pragma unroll
                for (int e = 0; e < 16; ++e) { const float a = lg4[e >> 2][e & 3] * r + qe[e]; scv[e] = 1.f / (1.f + expf(-a)); sel[e] = scv[e] + P.router_bias[e]; }
                float bestg = -1e30f; float bw1 = 0.f, bw2 = 0.f;
#pragma unroll
                for (int g = 0; g < 4; ++g) {
                    int i1 = 0; float v1 = sel[4 * g], x1 = scv[4 * g];
#pragma unroll
                    for (int j = 1; j < 4; ++j) if (sel[4 * g + j] > v1) { v1 = sel[4 * g + j]; x1 = scv[4 * g + j]; i1 = j; }
                    int i2 = -1; float v2 = -1e30f, x2 = 0.f;
#pragma unroll
                    for (int j = 0; j < 4; ++j) if (j != i1 && sel[4 * g + j] > v2) { v2 = sel[4 * g + j]; x2 = scv[4 * g + j]; i2 = j; }
                    const float gsum = v1 + v2;
                    if (gsum > bestg) { bestg = gsum; be1 = 4 * g + i1; be2 = 4 * g + i2; bw1 = x1; bw2 = x2; }
                }
                const float inv = 1.f / (bw1 + bw2);
                w1 = bw1 * inv; w2 = bw2 * inv;
                r1 = atomicAdd(&lcnt[be1], 1); r2 = atomicAdd(&lcnt[be2], 1);
            }
        }
        __syncthreads();
        if (tid < 16) { const int c = lcnt[tid]; int* cnt = (int*)(P.ws + OFF_CNT) + l * 16 * 64; lbase[tid] = c ? atomicAdd(&cnt[tid * 64], c) : 0; }
        {
            f32x4 gs[2][2], hs[2][2];
#pragma unroll
            for (int bj = 0; bj < 2; ++bj)
#pragma unroll
                for (int n = 0; n < 2; ++n) { const int c = cb + 128 * bj + 4 * n;
                    const f32x4 g = *(const f32x4*)(P.norm2_g + l * DM + c), s1 = *(const f32x4*)(md + 4096 + c);
                    gs[bj][n] = g * (1.f + s1); hs[bj][n] = *(const f32x4*)(md + 3072 + c); }
            bf16_t* HX = (bf16_t*)(P.ws + OFF_HX);
#pragma unroll
            for (int ai = 0; ai < 2; ++ai)
#pragma unroll
                for (int m = 0; m < 4; ++m) {
                    const int row = 128 * ai + 64 * wr + 16 * m + fr;
                    const float r = rt[row];
                    bf16_t* o = HX + (size_t)(tok0 + row) * DM + cb;
#pragma unroll
                    for (int bj = 0; bj < 2; ++bj) { u32x4 w;
                        { const f32x4 v = acc[ai][bj][m][0], g = gs[bj][0], h = hs[bj][0]; w.x = pk2(v.x * r * g.x + h.x, v.y * r * g.y + h.y); w.y = pk2(v.z * r * g.z + h.z, v.w * r * g.w + h.w); }
                        { const f32x4 v = acc[ai][bj][m][1], g = gs[bj][1], h = hs[bj][1]; w.z = pk2(v.x * r * g.x + h.x, v.y * r * g.y + h.y); w.w = pk2(v.z * r * g.z + h.z, v.w * r * g.w + h.w); }
                        *(u32x4*)(o + 128 * bj) = w; }
                }
        }
        __syncthreads();
        if (router) { int* list = (int*)(P.ws + OFF_LIST); float* lw = (float*)(P.ws + OFF_TOKW);
            const int i1 = be1 * NTOK + lbase[be1] + r1, i2 = be2 * NTOK + lbase[be2] + r2;
            list[i1] = 2 * rtok; list[i2] = 2 * rtok + 1; lw[i1] = w1; lw[i2] = w2; }
        __syncthreads();
    }
};
DI bool route_fused(int nb) { return nb == 256; }
DI void outproj_run(const Params& P, int l, int mode, int c, int nb, char* smem) {
    SchedOut S{(const bf16_t*)(P.ws + OFF_HX), (const bf16_t*)(P.ws + OFF_WOUT) + (size_t)l * DM * DM, nb, c, mode, (int*)(P.ws + OFF_RDYC)};
    if (route_fused(nb) && mode != 0) {
        g8::Unit u;
        if (S.next(0, u)) {
            const int tok0 = u.a * 256, mr = (tok0 % TPB == 0) ? 8 : tok0 / TPB;
            const float* md = mod_row(P, l, mr);
            float* wtab = (float*)(smem + LDS_MISC);
#pragma unroll
            for (int i = 0; i < 2; ++i) { const int idx = threadIdx.x + NTHREADS * i, cc = idx >> 2, q = idx & 3, col = u.b * 256 + cc;
                const float g = P.norm2_g[l * DM + col] * (1.f + md[4096 + col]);
                *(f32x4*)(wtab + cc * 16 + 4 * q) = g * *(const f32x4*)(P.w_router + col * 16 + 4 * q); }
        }
        EpiOutF E{P, l};
        g8::gemm_phase(smem, (const bf16_t*)(P.ws + OFF_HX), DM, S, E);
        return;
    }
    EpiOut E{P.x, P.ctx, P.out, (float*)(P.ws + OFF_XC), (const float*)(P.ws + OFF_MOD), l};
    g8::gemm_phase(smem, (const bf16_t*)(P.ws + OFF_HX), DM, S, E);
}
DI void phase_outproj(const Params& P, int l, int bid, int nb, char* smem) {
    outproj_run(P, l, (l == 1 || ctx_early(nb)) ? 1 : 0, bid, nb, smem);
}

constexpr int MAX_RT = 2 * NTOK / 256 + NEXP;
DI void build_tile_table(const int* cnt, char* smem) {
    int* cl = (int*)(smem + LDS_MISC);
    int* tab = cl + 16;
    const int t = threadIdx.x;
    __syncthreads();
    if (t < NEXP) cl[t] = cnt[t * 64];
    __syncthreads();
    if (t < MAX_RT) {
        int acc = 0, e = 0, ti = 0, n = 0, ok = 0;
#pragma unroll
        for (int i = 0; i < NEXP; ++i) { const int c = cl[i], nt = (c + 255) >> 8; const bool hit = !ok && t < acc + nt;
            e = hit ? i : e; ti = hit ? t - acc : ti; n = hit ? c : n; ok = hit ? 1 : ok; acc += nt; }
        tab[4 * t] = e; tab[4 * t + 1] = ti; tab[4 * t + 2] = n; tab[4 * t + 3] = ok;
    }
    __syncthreads();
}
DI bool expert_tile(const char* smem, int rt, int& e, int& ti, int& hbase, int& n) {
    if (rt >= MAX_RT) return false;
    const int* tab = (const int*)(smem + LDS_MISC) + 16 + 4 * rt;
    e = __builtin_amdgcn_readfirstlane(tab[0]); ti = __builtin_amdgcn_readfirstlane(tab[1]); n = __builtin_amdgcn_readfirstlane(tab[2]); hbase = rt * 256;
    return __builtin_amdgcn_readfirstlane(tab[3]) != 0;
}

struct SchedGU {
    const bf16_t* W; const char* tabs; const int* list; int G, c;
    static constexpr bool GATHER = true;
    DI void a_ready(const g8::Unit&) const {}
    DI bool next(int i, g8::Unit& u) const { const int w = i * G + c, rt = w >> 1, ct = w & 1; int e, ti, hb, n; if (!expert_tile(tabs, rt, e, ti, hb, n)) return false;
        u.a = e; u.b = ti | (ct << 16); u.c = hb; u.d = n; u.bt = W + ((size_t)e * 512 + ct * 256) * DM; return true; }
    DI void a_offsets(const g8::Unit& u, const int (&R)[2], const int (&C)[2], unsigned (&av)[2][2]) const {
        const int ti = u.b & 0xffff;
#pragma unroll
        for (int hh = 0; hh < 2; ++hh)
#pragma unroll
            for (int i = 0; i < 2; ++i) { const int li = ti * 256 + 128 * hh + R[i]; const int slot = li < u.d ? list[u.a * NTOK + li] : 0;
                av[hh][i] = (unsigned)((slot >> 1) * DM + C[i]) * 2u; }
    }
};
struct EpiGU {
    static constexpr bool AFTER_DRAIN = false;
    bf16_t* HB;
    DI void operator()(const f32x4 (&acc)[2][2][4][2], const g8::Unit& u, int wr, int wc, int fr, int fq) const {
        const int ct = u.b >> 16;
        bf16_t* hb = HB + (size_t)(u.c + 64 * wr + fr) * DEXP + 128 * ct + 32 * wc + 4 * fq;
#pragma unroll
        for (int ai = 0; ai < 2; ++ai)
#pragma unroll
            for (int m = 0; m < 4; ++m)
#pragma unroll
                for (int n = 0; n < 2; ++n) {
                    const f32x4 g = acc[ai][0][m][n], uu = acc[ai][1][m][n];
                    f32x4 hv;
                    hv.x = g.x / (1.f + __expf(-g.x)) * uu.x; hv.y = g.y / (1.f + __expf(-g.y)) * uu.y; hv.z = g.z / (1.f + __expf(-g.z)) * uu.z; hv.w = g.w / (1.f + __expf(-g.w)) * uu.w;
                    u32x2 o; o.x = pk2(hv.x, hv.y); o.y = pk2(hv.z, hv.w);
                    *(u32x2*)(hb + (size_t)(128 * ai + 16 * m) * DEXP + 16 * n) = o;
                }
    }
};
DI void phase_gateup(const Params& P, int l, int bid, int nb, char* smem) {
    build_tile_table((const int*)(P.ws + OFF_CNT) + l * 16 * 64, smem);
    SchedGU S{(const bf16_t*)(P.ws + OFF_WGU) + (size_t)l * 16 * 512 * DM, smem, (const int*)(P.ws + OFF_LIST), nb, bid};
    EpiGU E{(bf16_t*)(P.ws + OFF_HB)};
    g8::gemm_phase(smem, (const bf16_t*)(P.ws + OFF_HX), DM, S, E);
}

struct SchedDown {
    const bf16_t *A, *W; const char* tabs; int G, c;
    static constexpr bool GATHER = false;
    DI void a_ready(const g8::Unit&) const {}
    DI bool next(int i, g8::Unit& u) const { const int w = i * G + c, rt = w >> 2, ct = w & 3; int e, ti, hb, n; if (!expert_tile(tabs, rt, e, ti, hb, n)) return false;
        u.a = e; u.b = ti | (ct << 16); u.c = hb; u.d = n; u.bt = W + ((size_t)e * DM + ct * 256) * DEXP; return true; }
    DI const bf16_t* a_base(const g8::Unit& u) const { return A + (size_t)u.c * DEXP; }
};
struct EpiDown {
    static constexpr bool AFTER_DRAIN = false;
    bf16_t* Y; const int* list; const float* tokw;
    DI void operator()(const f32x4 (&acc)[2][2][4][2], const g8::Unit& u, int wr, int wc, int fr, int fq) const {
        const int ti = u.b & 0xffff, ct = u.b >> 16;
        int slot[2][4]; float wg[2][4];
        const int* le = list + u.a * NTOK;
        const int li0 = ti * 256 + 64 * wr + fr;
#pragma unroll
        for (int ai = 0; ai < 2; ++ai)
#pragma unroll
            for (int m = 0; m < 4; ++m) { const int ix = min(li0 + 128 * ai + 16 * m, u.d - 1); slot[ai][m] = le[ix]; wg[ai][m] = tokw[u.a * NTOK + ix]; }
#pragma unroll
        for (int ai = 0; ai < 2; ++ai)
#pragma unroll
            for (int m = 0; m < 4; ++m) {
                if (li0 + 128 * ai + 16 * m < u.d) {
                    const float w1 = wg[ai][m];
                    bf16_t* yr = Y + (size_t)slot[ai][m] * DM + 256 * ct + 32 * wc + 8 * fq;
#pragma unroll
                    for (int bj = 0; bj < 2; ++bj) { const f32x4 v0 = acc[ai][bj][m][0], v1 = acc[ai][bj][m][1]; u32x4 o;
                        o.x = pk2(w1 * v0.x, w1 * v0.y); o.y = pk2(w1 * v0.z, w1 * v0.w); o.z = pk2(w1 * v1.x, w1 * v1.y); o.w = pk2(w1 * v1.z, w1 * v1.w);
                        *(u32x4*)(yr + 128 * bj) = o; }
                }
            }
    }
};
DI void phase_down(const Params& P, int l, int bid, int nb, char* smem) {
    build_tile_table((const int*)(P.ws + OFF_CNT) + l * 16 * 64, smem);
    SchedDown S{(const bf16_t*)(P.ws + OFF_HB), (const bf16_t*)(P.ws + OFF_WD) + (size_t)l * 16 * DM * DEXP, smem, nb, bid};
    EpiDown E{(bf16_t*)(P.ws + OFF_Y), (const int*)(P.ws + OFF_LIST), (const float*)(P.ws + OFF_TOKW)};
    g8::gemm_phase(smem, (const bf16_t*)(P.ws + OFF_HB), DEXP, S, E);
}

#define XB_TMO      128
#define XB_XCNT(j)  (256  + 64 * (j))
#define XB_XSUB(j)  (1280 + 64 * (j))
#define XB_XGEN(j)  (2304 + 64 * (j))
#define XB_TOP      3328
#define XB_TOPGEN   3392
#define XCD_BAR_WORDS 3456
#define XB_SPIN_CAP (1u << 20)
DI unsigned xb_ld(unsigned* p)              { return __hip_atomic_load(p, __ATOMIC_RELAXED, __HIP_MEMORY_SCOPE_AGENT); }
DI unsigned xb_add(unsigned* p, unsigned v) { return __hip_atomic_fetch_add(p, v, __ATOMIC_RELAXED, __HIP_MEMORY_SCOPE_AGENT); }
DI unsigned xb_xcc_id() { return (unsigned)__builtin_amdgcn_s_getreg((3 << 11) | 20) & 0xFu; }
#define XB_SPIN(cond, bar) do { unsigned _sp = 0; while (cond) { __builtin_amdgcn_s_sleep(1); \
    if ((++_sp & 255u) == 0u) { if (xb_ld(&(bar)[XB_TMO])) break; if (_sp > XB_SPIN_CAP) { atomicAdd(&(bar)[XB_TMO], 1u); break; } } } } while (0)
struct XcdBarrier { unsigned* bar; unsigned x; volatile LAS unsigned* st; };
DI XcdBarrier xcd_barrier_post(unsigned* bar, volatile LAS unsigned* st) {
    XcdBarrier b; b.bar = bar; b.x = xb_xcc_id(); b.st = st;
    if (threadIdx.x == 0) (void)xb_add(&bar[XB_XCNT(b.x)], 1u);
    return b;
}
DI void xcd_barrier_complete(unsigned* bar, unsigned x, unsigned& nloc, unsigned& nx) {
    const unsigned G = gridDim.x * gridDim.y * gridDim.z;
    unsigned sum, cnt, mine, sp = 0u;
    for (;;) {
        sum = 0u; cnt = 0u; mine = 0u;
#pragma unroll
        for (unsigned j = 0; j < 16; ++j) { const unsigned c = xb_ld(&bar[XB_XCNT(j)]); sum += c; cnt += (c > 0u) ? 1u : 0u; mine = (j == x) ? c : mine; }
        if (sum == G) break;
        __builtin_amdgcn_s_sleep(1);
        if ((++sp & 255u) == 0u) { if (xb_ld(&bar[XB_TMO])) break; if (sp > XB_SPIN_CAP) { atomicAdd(&bar[XB_TMO], 1u); break; } }
    }
    nloc = mine > 0u ? mine : 1u; nx = cnt > 0u ? cnt : 1u;
}
DI void xcd_barrier(const XcdBarrier& b) {
    asm volatile("s_waitcnt vmcnt(0)" ::: "memory");
    __syncthreads();
    if (threadIdx.x == 0) {
        unsigned* bar = b.bar;
        __builtin_amdgcn_s_waitcnt(0);
        unsigned nloc = b.st[0], nx = b.st[1];
        if (nloc == 0u) { xcd_barrier_complete(bar, b.x, nloc, nx); b.st[0] = nloc; b.st[1] = nx; }
        const unsigned old = xb_add(&bar[XB_XSUB(b.x)], 1u);
        const unsigned gen = old / nloc;
        if (old + 1u == (gen + 1u) * nloc) {
            __builtin_amdgcn_fence(__ATOMIC_RELEASE, "agent");
            asm volatile("s_waitcnt vmcnt(0)" ::: "memory");
            const unsigned og = xb_add(&bar[XB_TOP], 1u);
            const unsigned tg = og / nx;
            if (og + 1u == (tg + 1u) * nx) xb_add(&bar[XB_TOPGEN], 1u);
            else XB_SPIN(xb_ld(&bar[XB_TOPGEN]) == tg, bar);
            __builtin_amdgcn_fence(__ATOMIC_ACQUIRE, "agent");
            xb_add(&bar[XB_XGEN(b.x)], 1u);
            asm volatile("s_waitcnt vmcnt(0)" ::: "memory");
        } else {
            XB_SPIN(xb_ld(&bar[XB_XGEN(b.x)]) == gen, bar);
            __builtin_amdgcn_fence(__ATOMIC_ACQUIRE, "agent");
            asm volatile("s_waitcnt vmcnt(0)" ::: "memory");
        }
    }
    __syncthreads();
}

constexpr int NPHASES = 16;
__global__ void __launch_bounds__(NTHREADS, 2) mk_fwd(Params P, int ph_lo, int ph_hi) {
    extern __shared__ __attribute__((aligned(16))) char smem[];
    const int bid = blockIdx.x, nb = gridDim.x;
    volatile LAS unsigned* xst = (volatile LAS unsigned*)(LAS char*)(smem + LDS_MAIN);
    if (threadIdx.x == 0) { xst[0] = 0u; xst[1] = 0u; }
    __syncthreads();
    XcdBarrier gbar; gbar.bar = (unsigned*)(P.ws + OFF_CTL); gbar.x = 0; gbar.st = xst;
    if (ph_hi - ph_lo > 1) gbar = xcd_barrier_post((unsigned*)(P.ws + OFF_CTL), xst);
#ifndef REPEAT_K
#define REPEAT_K -1
#endif
#ifndef REPEAT_N
#define REPEAT_N 1
#endif
#ifndef EXTRA_SYNCS
#define EXTRA_SYNCS 0
#endif
#define RUN(k, call) if (ph_lo <= (k) && (k) < ph_hi) { if ((k) == REPEAT_K) { for (int rep_ = 0; rep_ < REPEAT_N; ++rep_) { call; xcd_barrier(gbar); } } call; if ((k) + 1 < ph_hi) xcd_barrier(gbar); }
    for (int es_ = 0; es_ < EXTRA_SYNCS; ++es_) xcd_barrier(gbar);
    RUN(0, phase_prologue(P, bid, nb, smem))
    RUN(1, phase_norm1(P, 0, bid, nb))
    RUN(2, phase_qkv(P, 0, bid, nb, smem))
    RUN(3, phase_attn(P, 0, bid, nb, smem))
    RUN(4, phase_outproj(P, 0, bid, nb, smem))
    if (!route_fused(nb)) { RUN(5, phase_norm2_route(P, 0, bid, nb, smem)) }
    RUN(6, phase_gateup(P, 0, bid, nb, smem))
    RUN(7, phase_down(P, 0, bid, nb, smem))
    RUN(8, phase_norm1(P, 1, bid, nb))
    RUN(9, phase_qkv(P, 1, bid, nb, smem))
    RUN(10, phase_attn(P, 1, bid, nb, smem))
    RUN(11, phase_outproj(P, 1, bid, nb, smem))
    if (!route_fused(nb)) { RUN(12, phase_norm2_route(P, 1, bid, nb, smem)) }
    RUN(13, phase_gateup(P, 1, bid, nb, smem))
    RUN(14, phase_down(P, 1, bid, nb, smem))
    RUN(15, phase_final(P, bid, nb))
#undef RUN
}

extern "C" void kernel_launch(void* const* d_in, const int* in_sizes, int n_in, void* d_out, int out_size, void* d_ws, size_t ws_size, hipStream_t stream) {
    Params p{};
    const float** f = (const float**)&p;
    for (int i = 0; i < 24; ++i) f[i] = (const float*)d_in[i];
    p.out = (float*)d_out; p.ws = (unsigned char*)d_ws;
    if (ws_size < WS_END) { fprintf(stderr, "workspace too small: %zu < %zu\n", ws_size, (size_t)WS_END); return; }
#ifndef MULTI_LAUNCH
#define MULTI_LAUNCH 0
#endif
#if MULTI_LAUNCH
    (void)hipFuncSetAttribute((const void*)mk_fwd, hipFuncAttributeMaxDynamicSharedMemorySize, LDS_BYTES);
    (void)hipMemsetAsync((char*)d_ws + OFF_CTL, 0, CTL_BYTES, stream);
    for (int ph = 0; ph < NPHASES; ++ph) hipLaunchKernelGGL(mk_fwd, dim3(256), dim3(NTHREADS), LDS_BYTES, stream, p, ph, ph + 1);
#else
    static int grid_blocks = 0;
    if (!grid_blocks) {
        int dev = 0, cus = 0, per_cu = 0;
        (void)hipGetDevice(&dev);
        (void)hipDeviceGetAttribute(&cus, hipDeviceAttributeMultiprocessorCount, dev);
        (void)hipFuncSetAttribute((const void*)mk_fwd, hipFuncAttributeMaxDynamicSharedMemorySize, LDS_BYTES);
        (void)hipOccupancyMaxActiveBlocksPerMultiprocessor(&per_cu, mk_fwd, NTHREADS, LDS_BYTES);
        if (per_cu > 1) per_cu = 1;
        grid_blocks = cus * per_cu;
        if (grid_blocks <= 0) { fprintf(stderr, "occupancy query failed (%d x %d)\n", cus, per_cu); grid_blocks = 0; return; }
    }
    (void)hipMemsetAsync((char*)d_ws + OFF_CTL, 0, CTL_BYTES, stream);
    hipLaunchKernelGGL(mk_fwd, dim3(grid_blocks), dim3(NTHREADS), LDS_BYTES, stream, p, 0, NPHASES);
    hipError_t e = hipPeekAtLastError();
    if (e != hipSuccess) fprintf(stderr, "launch failed: %s (grid %d)\n", hipGetErrorString(e), grid_blocks);
#endif
}
```

```cpp
#include <hip/hip_runtime.h>
#include <stdint.h>
#include <stdio.h>


#define DI __device__ __forceinline__
#define LAS __attribute__((address_space(3)))
typedef unsigned short bf16_t;
typedef short bf16x8 __attribute__((ext_vector_type(8)));
typedef float f32x16 __attribute__((ext_vector_type(16)));
typedef float f32x4 __attribute__((ext_vector_type(4)));
typedef float f32x2 __attribute__((ext_vector_type(2)));
typedef unsigned u32x4 __attribute__((ext_vector_type(4)));
typedef unsigned u32x2 __attribute__((ext_vector_type(2)));
typedef short s16x4 __attribute__((ext_vector_type(4)));

constexpr int NB = 8, SEQ = 2048, CTXL = 256, TPB = SEQ + CTXL  , NTOK = NB * TPB  ;
constexpr int DM = 1024, INC = 2560, NEXP = 16, DEXP = 256;
constexpr int NQU = 16, NKU = 12, NVR = 768;
constexpr size_t VS = (size_t)NVR * TPB;
constexpr int NTHREADS = 512, NW = NTHREADS / 64;
constexpr int LDS_MAIN = 131072, LDS_MISC = LDS_MAIN + 64, LDS_BYTES = LDS_MISC + 16384;
constexpr float RMS_EPS = 1e-6f;
constexpr float QSCALE = 0.125f * 1.4426950408889634f;

constexpr size_t OFF_CTL  = 0;
constexpr size_t OFF_CNT  = 14336, OFF_RDYC = OFF_CNT + 8192, OFF_XCNT = 24576, CTL_BYTES = OFF_XCNT + 2 * 72 * 256;
constexpr size_t OFF_MOD  = CTL_BYTES;
constexpr size_t OFF_ROPE = OFF_MOD + (size_t)2 * 9 * 6144 * 4;
constexpr size_t OFF_WIN  = OFF_ROPE + 16384;
constexpr size_t OFF_WOUT = OFF_WIN + (size_t)2 * 2560 * 1024 * 2;
constexpr size_t OFF_WGU  = OFF_WOUT + (size_t)2 * 1024 * 1024 * 2;
constexpr size_t OFF_WD   = OFF_WGU + (size_t)2 * 16 * 512 * 1024 * 2;
constexpr size_t OFF_HX   = OFF_WD + (size_t)2 * 16 * 1024 * 256 * 2;
constexpr size_t OFF_QB   = OFF_HX + (size_t)NTOK * DM * 2;
constexpr size_t OFF_KB   = OFF_QB + (size_t)NB * NQU * TPB * 64 * 2;
constexpr size_t OFF_VT   = OFF_KB + (size_t)NB * NKU * TPB * 64 * 2;
constexpr size_t OFF_Y    = OFF_QB;
constexpr size_t OFF_XC   = OFF_VT + (size_t)NB * NVR * TPB * 2;
constexpr size_t HB_ROWS  = 2 * NTOK + NEXP * 256;
constexpr size_t OFF_HB   = OFF_XC + (size_t)NB * CTXL * DM * 4;
constexpr size_t OFF_LIST = OFF_HB + HB_ROWS * DEXP * 2;
constexpr size_t OFF_TOKW = OFF_LIST + (size_t)NEXP * NTOK * 4;
constexpr size_t OFF_XCH  = OFF_TOKW + (size_t)NEXP * NTOK * 4;
constexpr size_t OFF_QE   = OFF_ROPE + 12288;
constexpr size_t WS_END   = OFF_XCH + (size_t)72 * 4 * 256 * 20 * 4;
static_assert(WS_END <= (size_t)256 * 1024 * 1024, "workspace");
static_assert((size_t)2 * NTOK * DM * 2 <= OFF_XC - OFF_QB, "Y alias");

struct Params {
    const float *x, *c, *ctx, *c_ctx, *w_ada, *b_ada, *norm1_g, *norm2_g, *w_in, *w_out, *lam_q1, *lam_k1, *lam_q2, *lam_k2,
        *subln_g, *q_norm_g, *k_norm_g, *sink, *w_router, *router_bias, *w_gate, *w_up, *w_down, *final_g;
    float* out;
    unsigned char* ws;
};

DI float bf2f(bf16_t b) { return __uint_as_float(((unsigned)b) << 16); }
typedef __bf16 bf2_t __attribute__((ext_vector_type(2)));
DI bf16_t f2bf(float f) { return __builtin_bit_cast(bf16_t, (__bf16)f); }
DI unsigned pk2(float lo, float hi) { bf2_t v = {(__bf16)lo, (__bf16)hi}; return __builtin_bit_cast(unsigned, v); }
DI int crow(int reg, int h) { return (reg & 3) + 8 * (reg >> 2) + 4 * h; }
DI float wave_sum(float v) {
#pragma unroll
    for (int o = 1; o < 64; o <<= 1) v += __shfl_xor(v, o);
    return v;
}
DI float max2f(float a, float b) { return __builtin_amdgcn_fmed3f(a, b, __builtin_inff()); }
DI float silu(float v) { return v / (1.f + expf(-v)); }
DI bf16_t* resid_row(const Params& P, int b, int p) {
    return p < CTXL ? (bf16_t*)(P.ws + OFF_XC) + (size_t)(b * CTXL + p) * DM : (bf16_t*)(P.out + (size_t)(b * SEQ + p - CTXL) * DM);
}
DI f32x4 bf4_to_f32(const u32x2 a) { f32x4 v; v.x = __uint_as_float(a.x << 16); v.y = __uint_as_float(a.x & 0xffff0000u); v.z = __uint_as_float(a.y << 16); v.w = __uint_as_float(a.y & 0xffff0000u); return v; }
DI u32x2 f32_to_bf4(const f32x4 v) { u32x2 w; w.x = pk2(v.x, v.y); w.y = pk2(v.z, v.w); return w; }
DI void st16_pair(bf16_t* p, const u32x2 A, const u32x2 B) {
    const auto s0 = __builtin_amdgcn_permlane32_swap(A.x, B.x, false, false);
    const auto s1 = __builtin_amdgcn_permlane32_swap(A.y, B.y, false, false);
    *(u32x4*)p = (u32x4){s0[0], s1[0], s0[1], s1[1]};
}
DI void ld16_pair(const bf16_t* p, u32x2& A, u32x2& B) {
    const u32x4 q = *(const u32x4*)p;
    const auto s0 = __builtin_amdgcn_permlane32_swap(q.x, q.z, false, false);
    const auto s1 = __builtin_amdgcn_permlane32_swap(q.y, q.w, false, false);
    A = (u32x2){s0[0], s1[0]}; B = (u32x2){s0[1], s1[1]};
}
DI const float* input_row(const Params& P, int b, int p) {
    return p < CTXL ? P.ctx + (size_t)(b * CTXL + p) * DM : P.x + (size_t)(b * SEQ + p - CTXL) * DM;
}
DI const float* mod_row(const Params& P, int l, int mr) { return (const float*)(P.ws + OFF_MOD) + (size_t)(l * 9 + mr) * 6144; }

constexpr int TI_IN = 2 * 16 * 40, TI_OUT = 2 * 16 * 16, TI_G = 32 * 16 * 4, TI_U = TI_G, TI_D = 32 * 4 * 16, TI_ALL = TI_IN + TI_OUT + TI_G + TI_U + TI_D;
DI void titem_decode(const Params& P, int r, const float*& src, int& N, bf16_t*& dst, int& ldd, int& n0, int& kind) {
    kind = 0;
    if (r < TI_IN) { const int l = r / 640, q = r % 640, kb = q / 40, nbk = q % 40; N = INC; ldd = DM; n0 = nbk * 64; kind = 3;
        src = P.w_in + (size_t)l * DM * INC + (size_t)(kb * 64) * INC + n0; dst = (bf16_t*)(P.ws + OFF_WIN) + (size_t)l * INC * DM + kb * 64; return; }
    r -= TI_IN;
    if (r < TI_OUT) { const int l = r / 256, q = r % 256, kb = q / 16, nbk = q % 16; N = DM; ldd = DM; n0 = nbk * 64; kind = 4;
        src = P.w_out + (size_t)l * DM * DM + (size_t)(kb * 64) * DM + n0; dst = (bf16_t*)(P.ws + OFF_WOUT) + (size_t)l * DM * DM + kb * 64; return; }
    r -= TI_OUT;
    if (r < TI_G + TI_U) { const bool up = r >= TI_G; if (up) r -= TI_G; const int le = r / 64, q = r % 64, kb = q / 4, nbk = q % 4; N = DEXP; ldd = DM; n0 = nbk * 64; kind = up ? 2 : 1;
        src = (up ? P.w_up : P.w_gate) + (size_t)le * DM * DEXP + (size_t)(kb * 64) * DEXP + n0; dst = (bf16_t*)(P.ws + OFF_WGU) + (size_t)le * 512 * DM + kb * 64; return; }
    r -= TI_G + TI_U;
    { const int le = r / 64, q = r % 64, kb = q / 16, nbk = q % 16; N = DM; ldd = DEXP; n0 = nbk * 64; kind = 4;
        src = P.w_down + (size_t)le * DEXP * DM + (size_t)(kb * 64) * DM + n0; dst = (bf16_t*)(P.ws + OFF_WD) + (size_t)le * DM * DEXP + kb * 64; }
}

DI void phase_prologue(const Params& P, int bid, int nb, char* smem) {
    const int t = threadIdx.x;
    float* s = (float*)smem;
    {
        constexpr int NLD = 4096 / NTHREADS;
        float v[NLD];
        int it = bid;
        const float* src; bf16_t* dst; int N, ldd, n0, kind;
        if (it < TI_ALL) { titem_decode(P, it, src, N, dst, ldd, n0, kind);
#pragma unroll
            for (int i = 0; i < NLD; ++i) v[i] = src[(size_t)((t >> 6) + NW * i) * N + (t & 63)]; }
        while (it < TI_ALL) {
            __syncthreads();
#pragma unroll
            for (int i = 0; i < NLD; ++i) s[((t >> 6) + NW * i) * 65 + (t & 63)] = v[i];
            __syncthreads();
            bf16_t* cdst = dst; const int cldd = ldd, cn0 = n0, ckind = kind;
            it += nb;
            if (it < TI_ALL) { titem_decode(P, it, src, N, dst, ldd, n0, kind);
#pragma unroll
                for (int i = 0; i < NLD; ++i) v[i] = src[(size_t)((t >> 6) + NW * i) * N + (t & 63)]; }
            constexpr int KPT = 64 * 64 / NTHREADS;
            const int n = t / (64 / KPT), kc = (t % (64 / KPT)) * KPT;
            const int ng = cn0 + n;
            int drow = ng;
            if (ckind == 3) {
                const bool isv = (ng >= 1536 && ng < 2048) || (ng >= 2176 && ng < 2304) || ng >= 2432;
                const int w = (ng >> 6) & 3, d = ng & 63;
                const int bj = isv ? (d >> 3) & 1 : d >> 5, n = isv ? (d >> 2) & 1 : (d >> 4) & 1, fq = isv ? d >> 4 : (d >> 2) & 3, r = d & 3;
                drow = (ng & ~255) + 128 * bj + 32 * w + 16 * n + 4 * fq + r;
            }
            else if (ckind == 4) drow = (ng & ~31) + 16 * ((ng >> 2) & 1) + 4 * ((ng >> 3) & 3) + (ng & 3);
            else if (ckind != 0) drow = (ng >> 7) * 256 + (ckind == 2 ? 128 : 0) + (ng & 127);
            bf16_t* d = cdst + (size_t)drow * cldd + kc;
#pragma unroll
            for (int j = 0; j < KPT; j += 8) { u32x4 o;
                o.x = pk2(s[(kc + j + 0) * 65 + n], s[(kc + j + 1) * 65 + n]); o.y = pk2(s[(kc + j + 2) * 65 + n], s[(kc + j + 3) * 65 + n]);
                o.z = pk2(s[(kc + j + 4) * 65 + n], s[(kc + j + 5) * 65 + n]); o.w = pk2(s[(kc + j + 6) * 65 + n], s[(kc + j + 7) * 65 + n]);
                *(u32x4*)(d + j) = o; }
        }
    }
    {
        constexpr int I_MOD = 2 * 384, KG = NTHREADS / 16, KPG = DM / KG;
        bool have_silu = false;
        float* ssl = s;
        float* red = s + 9 * 1024;
        for (int it = bid; it < I_MOD; it += nb) {
            const int l = it / 384, col0 = (it % 384) * 16, cc = t & 15, kg = t >> 4;
            const float* W = P.w_ada + (size_t)l * DM * 6144 + col0 + cc + (size_t)(kg * KPG) * 6144;
            float w[KPG];
#pragma unroll
            for (int kk = 0; kk < KPG; ++kk) w[kk] = W[(size_t)kk * 6144];
            __syncthreads();
            if (!have_silu) { for (int i = t; i < 9 * 1024; i += NTHREADS) { const float cv = i < 8192 ? P.c[i] : P.c_ctx[i - 8192]; ssl[i] = silu(cv); } have_silu = true; }
            __syncthreads();
            float acc[9];
#pragma unroll
            for (int i = 0; i < 9; ++i) acc[i] = 0.f;
#pragma unroll
            for (int kk = 0; kk < KPG; ++kk) {
#pragma unroll
                for (int i = 0; i < 9; ++i) acc[i] += ssl[i * 1024 + kg * KPG + kk] * w[kk];
            }
#pragma unroll
            for (int i = 0; i < 9; ++i) red[(i * KG + kg) * 16 + cc] = acc[i];
            __syncthreads();
            if (t < 144) { const int i = t >> 4, c2 = t & 15; float a = P.b_ada[l * 6144 + col0 + c2];
                for (int g = 0; g < KG; ++g) a += red[(i * KG + g) * 16 + c2];
                ((float*)(P.ws + OFF_MOD))[(size_t)(l * 9 + i) * 6144 + col0 + c2] = a; }
        }
    }
    for (int idx = bid * NTHREADS + t; idx < 96 * 16; idx += nb * NTHREADS) {
        const int pi = idx >> 4, j = idx & 15, pos = pi < 32 ? pi : pi - 32;
        const float invf = powf(10000.f, -(float)j / 16.f);
        float sn, cs; sincosf((float)pos * invf, &sn, &cs);
        ((float*)(P.ws + OFF_ROPE))[idx] = cs; ((float*)(P.ws + OFF_ROPE))[96 * 16 + idx] = sn;
    }
}

struct RowIn { f32x4 x[4]; u32x2 xb[4], y0[4], y1[4]; };
template <bool COMBINE>
DI void row_load(const Params& P, int l, int tok, int lane, RowIn& r) {
    const int b = tok / TPB, p = tok % TPB;
    if (l == 0 && !COMBINE) { const f32x4* src = (const f32x4*)input_row(P, b, p) + lane;
#pragma unroll
        for (int j = 0; j < 4; ++j) r.x[j] = src[64 * j]; }
    else { const u32x2* src = (const u32x2*)resid_row(P, b, p) + lane;
#pragma unroll
        for (int j = 0; j < 4; ++j) r.xb[j] = src[64 * j]; }
    if (COMBINE) {
        const bf16_t* Y = (const bf16_t*)(P.ws + OFF_Y);
        const u32x2* y0 = (const u32x2*)(Y + (size_t)(2 * tok) * DM) + lane;
        const u32x2* y1 = (const u32x2*)(Y + (size_t)(2 * tok + 1) * DM) + lane;
#pragma unroll
        for (int j = 0; j < 4; ++j) { r.y0[j] = y0[64 * j]; r.y1[j] = y1[64 * j]; }
    }
}
DI f32x4 row_combine(const f32x4 xv, const f32x4 g, const u32x2 a, const u32x2 c2) {
    f32x4 yv;
    yv.x = __uint_as_float(a.x << 16) + __uint_as_float(c2.x << 16);
    yv.y = __uint_as_float(a.x & 0xffff0000u) + __uint_as_float(c2.x & 0xffff0000u);
    yv.z = __uint_as_float(a.y << 16) + __uint_as_float(c2.y << 16);
    yv.w = __uint_as_float(a.y & 0xffff0000u) + __uint_as_float(c2.y & 0xffff0000u);
    return xv + g * yv;
}
template <bool COMBINE>
DI void norm1_body(const Params& P, int l, int bid, int nb) {
    const int lane = threadIdx.x & 63, wave = threadIdx.x >> 6;
    bf16_t* HX = (bf16_t*)(P.ws + OFF_HX);
    const int per = (NTOK + nb - 1) / nb, tk0 = bid * per, ntk = min(NTOK, tk0 + per) - tk0;
    RowIn cur, nxt;
    f32x4 gs[4], hs[4], g2[4];
    int cur_mr = -1;
    if (wave < ntk) row_load<COMBINE>(P, l, tk0 + wave, lane, nxt);
    for (int i = wave; i < ntk; i += NW) {
        const int tok = tk0 + i, b = tok / TPB, p = tok % TPB, mr = p < CTXL ? 8 : b;
        cur = nxt;
        if (i + NW < ntk) row_load<COMBINE>(P, l, tok + NW, lane, nxt);
        if (mr != cur_mr) {
            const float* md = mod_row(P, l, mr);
            const f32x4* gn = (const f32x4*)(P.norm1_g + l * DM) + lane;
            const f32x4* sh = (const f32x4*)(md) + lane;
            const f32x4* sc = (const f32x4*)(md + 1024) + lane;
#pragma unroll
            for (int j = 0; j < 4; ++j) { gs[j] = gn[64 * j] * (1.f + sc[64 * j]); hs[j] = sh[64 * j]; }
            if (COMBINE) { const f32x4* gp = (const f32x4*)(mod_row(P, l - 1, mr) + 5120) + lane;
#pragma unroll
                for (int j = 0; j < 4; ++j) g2[j] = gp[64 * j]; }
            cur_mr = mr;
        }
        f32x4 v[4]; float ss = 0.f;
        u32x2* xr = (u32x2*)resid_row(P, b, p) + lane;
#pragma unroll
        for (int j = 0; j < 4; ++j) {
            v[j] = COMBINE ? row_combine(bf4_to_f32(cur.xb[j]), g2[j], cur.y0[j], cur.y1[j]) : cur.x[j];
            if (COMBINE) xr[64 * j] = f32_to_bf4(v[j]);
            ss += (v[j].x * v[j].x + v[j].y * v[j].y) + (v[j].z * v[j].z + v[j].w * v[j].w);
        }
        const float r = rsqrtf(wave_sum(ss) * (1.f / DM) + RMS_EPS);
        u32x2* o = (u32x2*)(HX + (size_t)tok * DM) + lane;
#pragma unroll
        for (int j = 0; j < 4; ++j) {
            const f32x4 y = v[j] * r * gs[j] + hs[j];
            u32x2 w; w.x = pk2(y.x, y.y); w.y = pk2(y.z, y.w);
            o[64 * j] = w;
        }
    }
}
DI void router_shift_consts(const Params& P, int l, int bid) {
    if (bid >= 9 || (threadIdx.x >> 6) != NW - 1) return;
    const int lane = threadIdx.x & 63;
    const float* sh = mod_row(P, l, bid) + 3072;
    float a[16];
#pragma unroll
    for (int e = 0; e < 16; ++e) a[e] = 0.f;
    for (int i = 0; i < 16; ++i) { const int k = lane + 64 * i; const float h = sh[k];
#pragma unroll
        for (int q = 0; q < 4; ++q) { const f32x4 w = *(const f32x4*)(P.w_router + k * 16 + 4 * q); a[4 * q] += h * w.x; a[4 * q + 1] += h * w.y; a[4 * q + 2] += h * w.z; a[4 * q + 3] += h * w.w; } }
#pragma unroll
    for (int e = 0; e < 16; ++e) a[e] = wave_sum(a[e]);
    if (lane == 0) { float* qe = (float*)(P.ws + OFF_QE) + (l * 9 + bid) * 16;
#pragma unroll
        for (int e = 0; e < 16; ++e) qe[e] = a[e]; }
}
DI void phase_norm1(const Params& P, int l, int bid, int nb) { router_shift_consts(P, l, bid); if (l == 0) norm1_body<false>(P, 0, bid, nb); else norm1_body<true>(P, l, bid, nb); }

DI void phase_final(const Params& P, int bid, int nb) {
    const int lane = threadIdx.x & 63, wave = threadIdx.x >> 6;
    const int per = (NB * SEQ + nb - 1) / nb, r0 = bid * per, nr = min(NB * SEQ, r0 + per) - r0;
    RowIn cur, nxt;
    f32x4 fg[4], g2[4];
    const f32x4* fgp = (const f32x4*)P.final_g + lane;
#pragma unroll
    for (int j = 0; j < 4; ++j) fg[j] = fgp[64 * j];
    int cur_b = -1;
    if (wave < nr) { const int r = r0 + wave; row_load<true>(P, 1, (r / SEQ) * TPB + CTXL + r % SEQ, lane, nxt); }
    for (int i = wave; i < nr; i += NW) {
        const int r = r0 + i, b = r / SEQ, p = CTXL + r % SEQ;
        cur = nxt;
        if (i + NW < nr) { const int r2 = r + NW; row_load<true>(P, 1, (r2 / SEQ) * TPB + CTXL + r2 % SEQ, lane, nxt); }
        if (b != cur_b) { const f32x4* gp = (const f32x4*)(mod_row(P, 1, b) + 5120) + lane;
#pragma unroll
            for (int j = 0; j < 4; ++j) g2[j] = gp[64 * j];
            cur_b = b; }
        f32x4 v[4]; float ss = 0.f;
#pragma unroll
        for (int j = 0; j < 4; ++j) { v[j] = row_combine(bf4_to_f32(cur.xb[j]), g2[j], cur.y0[j], cur.y1[j]); ss += (v[j].x * v[j].x + v[j].y * v[j].y) + (v[j].z * v[j].z + v[j].w * v[j].w); }
        const float rr = rsqrtf(wave_sum(ss) * (1.f / DM) + RMS_EPS);
        f32x4* xr = (f32x4*)(P.out + (size_t)r * DM) + lane;
#pragma unroll
        for (int j = 0; j < 4; ++j) xr[64 * j] = v[j] * rr * fg[j];
    }
}

namespace g8 {
constexpr int BK = 64, HALF = 128, HTB = HALF * BK * 2, STAGE_BYTES = 8 * HTB;
DI int lds_byte(int r, int c) { const int st = (r >> 4) * 2 + (c >> 5), rr = r & 15, cc = c & 31, ob = rr * 64 + cc * 2; return st * 1024 + (ob ^ (((ob >> 9) & 1) << 5)); }
DI void stage_rc(int b, int& R, int& C) { const int st = b / 1024, sb = b % 1024, swz = sb ^ (((sb >> 9) & 1) << 5); R = (st >> 1) * 16 + swz / 64; C = (st & 1) * 32 + (swz % 64) / 2; }
struct Unit { int a, b, c, d; const bf16_t* bt; };

template <class Sched, class Epi>
DI void gemm_phase(char* smem, const bf16_t* Abase, const int K, const Sched& S, const Epi& E) {
    LAS unsigned char* lds = (LAS unsigned char*)smem;
    const int tid = threadIdx.x, wid = __builtin_amdgcn_readfirstlane(tid >> 6), lane = tid & 63, wr = wid >> 2, wc = wid & 3, fr = lane & 15, fq = lane >> 4;
    const int nt = K / BK;
    int R[2], C[2];
    unsigned voffB[2], voffA[2];
#pragma unroll
    for (int i = 0; i < 2; ++i) { stage_rc(tid * 16 + i * 8192, R[i], C[i]); voffB[i] = (unsigned)(R[i] * K + C[i]) * 2u; voffA[i] = voffB[i]; }
    const size_t kstep = (size_t)(BK * 2);
    const size_t hstep = (size_t)HALF * K * 2;
    const unsigned ldsw = (unsigned)wid * 1024u;
    const int aoff = lds_byte(wr * 64 + fr, fq * 8), boff = lds_byte(wc * 32 + fr, fq * 8);
#define G8_SA(b, h) (((b) * 2 + (h)) * HTB)
#define G8_SB(b, h) ((4 + (b) * 2 + (h)) * HTB)
#define G8_STAGE_B(bufoff, gbase) do { _Pragma("unroll") for (int _i = 0; _i < 2; ++_i) \
        __builtin_amdgcn_global_load_lds((const unsigned*)((const char*)(gbase) + voffB[_i]), (LAS unsigned*)(lds + (bufoff) + ldsw + _i * 8192), 16, 0, 0); } while (0)
#define G8_GLDS(src, dstoff) __builtin_amdgcn_global_load_lds((const unsigned*)(src), (LAS unsigned*)(lds + (dstoff)), 16, 0, 0)
#define G8_STAGE_A(bufoff, hh, nx, kb) do { \
        if constexpr (Sched::GATHER) { const unsigned o0_ = (nx) ? avn[hh][0] : avc[hh][0], o1_ = (nx) ? avn[hh][1] : avc[hh][1]; \
            G8_GLDS(Ab + (size_t)o0_ + (kb), (bufoff) + ldsw); G8_GLDS(Ab + (size_t)o1_ + (kb), (bufoff) + ldsw + 8192); } \
        else { const char* ba_ = ((nx) ? nA : cA) + (size_t)(hh) * hstep + (kb); G8_GLDS(ba_ + voffA[0], (bufoff) + ldsw); G8_GLDS(ba_ + voffA[1], (bufoff) + ldsw + 8192); } } while (0)
#define G8_LDA(dst, b, h) do { _Pragma("unroll") for (int m = 0; m < 4; ++m) _Pragma("unroll") for (int k = 0; k < 2; ++k) dst[m][k] = *(const LAS bf16x8*)(lds + G8_SA(b, h) + aoff + m * 2048 + k * 1024); } while (0)
#define G8_LDB(dst, b, h) do { _Pragma("unroll") for (int n = 0; n < 2; ++n) _Pragma("unroll") for (int k = 0; k < 2; ++k) dst[n][k] = *(const LAS bf16x8*)(lds + G8_SB(b, h) + boff + n * 2048 + k * 1024); } while (0)
#define G8_MMA(ai, bj, At, Bt) do { __builtin_amdgcn_s_setprio(1); _Pragma("unroll") for (int m = 0; m < 4; ++m) _Pragma("unroll") for (int n = 0; n < 2; ++n) _Pragma("unroll") for (int k = 0; k < 2; ++k) \
        acc[ai][bj][m][n] = __builtin_amdgcn_mfma_f32_16x16x32_bf16(Bt[n][k], At[m][k], acc[ai][bj][m][n], 0, 0, 0); __builtin_amdgcn_s_setprio(0); } while (0)
#define G8_WAIT_V(n) asm volatile("s_waitcnt vmcnt(" #n ")" ::: "memory")
#define G8_WAIT_L(n) asm volatile("s_waitcnt lgkmcnt(" #n ")" ::: "memory")
#define G8_BAR __builtin_amdgcn_s_barrier()
#define G8_SCHED __builtin_amdgcn_sched_barrier(0)
    Unit cur, nxt; int ui = 0;
    if (!S.next(0, cur)) return;
    f32x4 acc[2][2][4][2];
#pragma unroll
    for (int a = 0; a < 2; ++a)
#pragma unroll
        for (int b = 0; b < 2; ++b)
#pragma unroll
            for (int m = 0; m < 4; ++m)
#pragma unroll
                for (int n = 0; n < 2; ++n) acc[a][b][m][n] = (f32x4){0.f, 0.f, 0.f, 0.f};
    bf16x8 At[4][2], B0[2][2], B1[2][2];
    const char* Ab = (const char*)Abase;
    unsigned avc[2][2], avn[2][2];
    const char *cA = Ab, *nA = Ab;
    S.a_ready(cur);
    if constexpr (Sched::GATHER) S.a_offsets(cur, R, C, avc); else cA = (const char*)S.a_base(cur);
    const char* cB = (const char*)cur.bt;
    G8_STAGE_B(G8_SB(0, 0), cB); G8_STAGE_B(G8_SB(0, 1), cB + hstep); G8_STAGE_A(G8_SA(0, 0), 0, false, 0); G8_STAGE_A(G8_SA(0, 1), 1, false, 0);
    if (wr == 1) G8_BAR;
    G8_WAIT_V(2); G8_BAR;
    G8_STAGE_B(G8_SB(1, 0), cB + kstep); G8_STAGE_A(G8_SA(1, 0), 0, false, kstep); G8_STAGE_B(G8_SB(1, 1), cB + hstep + kstep);
    G8_WAIT_V(6); G8_BAR;
    for (;;) {
        const bool has_next = S.next(ui + 1, nxt);
        if constexpr (Sched::GATHER) {
            if (has_next) S.a_offsets(nxt, R, C, avn);
            else {
#pragma unroll
                for (int hh = 0; hh < 2; ++hh)
#pragma unroll
                    for (int i = 0; i < 2; ++i) avn[hh][i] = avc[hh][i];
            }
        } else nA = has_next ? (const char*)S.a_base(nxt) : cA;
        const char* nB = has_next ? (const char*)nxt.bt : cB;
        for (int t = 0; t < nt; t += 2) {
            const bool last = (t == nt - 2);
            const size_t k1 = (size_t)(t + 1) * kstep;
            const size_t k2 = last ? 0 : (size_t)(t + 2) * kstep, k3 = k2 + kstep;
            const char* b2 = last ? nB : cB + k2; const char* b3 = b2 + kstep;
            G8_LDB(B0, 0, 0); G8_LDB(B1, 0, 1); G8_SCHED; G8_LDA(At, 0, 0); G8_STAGE_A(G8_SA(1, 1), 1, false, k1);
            G8_WAIT_V(8); G8_WAIT_L(0); G8_BAR; G8_MMA(0, 0, At, B0); G8_MMA(0, 1, At, B1); G8_BAR; G8_SCHED;
            G8_LDA(At, 0, 1); G8_STAGE_B(G8_SB(0, 0), b2); G8_STAGE_B(G8_SB(0, 1), b2 + hstep); G8_STAGE_A(G8_SA(0, 0), 0, last, k2);
            G8_WAIT_V(8); G8_WAIT_L(0); G8_BAR; G8_MMA(1, 0, At, B0); G8_MMA(1, 1, At, B1); G8_BAR; G8_SCHED;
            G8_LDB(B0, 1, 0); G8_LDB(B1, 1, 1); G8_SCHED; G8_LDA(At, 1, 0); G8_STAGE_A(G8_SA(0, 1), 1, last, k2);
            G8_WAIT_V(8); G8_WAIT_L(0); G8_BAR; G8_MMA(0, 0, At, B0); G8_MMA(0, 1, At, B1); G8_BAR; G8_SCHED;
            G8_LDA(At, 1, 1); G8_STAGE_B(G8_SB(1, 0), b3); G8_STAGE_B(G8_SB(1, 1), b3 + hstep); G8_STAGE_A(G8_SA(1, 0), 0, last, k3);
            G8_WAIT_V(8); G8_WAIT_L(0); G8_BAR; G8_MMA(1, 0, At, B0); G8_MMA(1, 1, At, B1); G8_BAR; G8_SCHED;
        }
        if (wr == 0) G8_BAR;
        if constexpr (!Epi::AFTER_DRAIN) E(acc, cur, wr, wc, fr, fq);
        if (!has_next) break;
#pragma unroll
        for (int a = 0; a < 2; ++a)
#pragma unroll
            for (int b = 0; b < 2; ++b)
#pragma unroll
                for (int m = 0; m < 4; ++m)
#pragma unroll
                    for (int n = 0; n < 2; ++n) acc[a][b][m][n] = (f32x4){0.f, 0.f, 0.f, 0.f};
        cur = nxt; cB = nB; cA = nA; ++ui;
        if constexpr (Sched::GATHER) {
#pragma unroll
            for (int hh = 0; hh < 2; ++hh)
#pragma unroll
                for (int i = 0; i < 2; ++i) avc[hh][i] = avn[hh][i];
        }
        if (wr == 1) G8_BAR;
    }
    G8_WAIT_V(0);
    G8_BAR;
    if constexpr (Epi::AFTER_DRAIN) E.fused(acc, cur, wr, wc, fr, fq, smem);
#undef G8_SA
#undef G8_SB
#undef G8_STAGE_A
#undef G8_GLDS
#undef G8_STAGE_B
#undef G8_LDA
#undef G8_LDB
#undef G8_MMA
#undef G8_WAIT_V
#undef G8_WAIT_L
#undef G8_BAR
#undef G8_SCHED
}

DI bool static_unit(int i, int G, int c, int nM, int nN, int& pm, int& pn) {
    const int nwg = nM * nN; const long L = (long)i * G + c; if (L >= nwg) return false;
    int wgid = (int)L; { const int q = nwg / 8, r = nwg % 8, xcd = wgid % 8, off = wgid / 8; wgid = (xcd < r ? xcd * (q + 1) : r * (q + 1) + (xcd - r) * q) + off; }
    const int nig = 8 * nN, gid = wgid / nig, fm = gid * 8, gsz = (nM - fm) < 8 ? (nM - fm) : 8;
    pm = fm + ((wgid % nig) % gsz); pn = (wgid % nig) / gsz; return true;
}
}

struct SchedQKV {
    const bf16_t *A, *Wt; int G, c;
    static constexpr bool GATHER = false;
    DI void a_ready(const g8::Unit&) const {}
    DI bool next(int i, g8::Unit& u) const { int pm, pn; if (!g8::static_unit(i, G, c, NTOK / 256, INC / 256, pm, pn)) return false; u.a = pm; u.b = pn; u.c = 0; u.d = 0; u.bt = Wt + (size_t)pn * 256 * DM; return true; }
    DI const bf16_t* a_base(const g8::Unit& u) const { return A + (size_t)u.a * 256 * DM; }
};
struct EpiQKV {
    static constexpr bool AFTER_DRAIN = false;
    bf16_t *QB, *KB, *VT; const float *ropec, *ropes, *qg, *kg;
    DI void operator()(const f32x4 (&acc)[2][2][4][2], const g8::Unit& u, int wr, int wc, int fr, int fq) const {
        const int pm = u.a, pn = u.b, b = pm / 9, p0 = (pm % 9) * 256;
        const bool isctx = p0 == 0;
        const int cw = pn * 256 + wc * 64;
        int kind, unit; const float* ng = nullptr;
        if (cw < 1024) { kind = 0; unit = cw >> 6; if (unit >= 8 && unit < 12) ng = qg; }
        else if (cw < 1536) { kind = 1; unit = (cw - 1024) >> 6; }
        else if (cw < 2048) { kind = 2; unit = cw - 1536; }
        else if (cw < 2176) { kind = 1; unit = 8 + ((cw - 2048) >> 6); ng = kg; }
        else if (cw < 2304) { kind = 2; unit = 512 + (cw - 2176); }
        else if (cw < 2432) { kind = 1; unit = 10 + ((cw - 2304) >> 6); }
        else { kind = 2; unit = 640 + (cw - 2432); }
        if (kind == 2) {
            const int vld = unit < 512 ? 128 : 64;
            const size_t vbase = unit < 512 ? (size_t)(unit >> 7) * TPB * 128 + (unit & 127) : (size_t)4 * TPB * 128 + (size_t)((unit - 512) >> 6) * TPB * 64;
            bf16_t* vb = VT + (size_t)b * VS + vbase + 16 * fq;
#pragma unroll
            for (int ai = 0; ai < 2; ++ai)
#pragma unroll
                for (int m = 0; m < 4; ++m) {
                    const int p = p0 + 128 * ai + 64 * wr + 16 * m + fr;
#pragma unroll
                    for (int bj = 0; bj < 2; ++bj) { const f32x4 v0 = acc[ai][bj][m][0], v1 = acc[ai][bj][m][1];
                        u32x4 o; o.x = pk2(v0.x, v0.y); o.y = pk2(v0.z, v0.w); o.z = pk2(v1.x, v1.y); o.w = pk2(v1.z, v1.w);
                        *(u32x4*)(vb + (size_t)p * vld + 8 * bj) = o; }
                }
            return;
        }
        const bool nrm = ng != nullptr;
        f32x4 g4[2][2];
#pragma unroll
        for (int bj = 0; bj < 2; ++bj)
#pragma unroll
            for (int n = 0; n < 2; ++n) g4[bj][n] = nrm ? *(const f32x4*)(ng + 32 * bj + 16 * n + 4 * fq) : (f32x4){1.f, 1.f, 1.f, 1.f};
        const float osc = kind == 0 ? QSCALE : 1.f;
        bf16_t* base = (kind == 0 ? QB + ((size_t)b * NQU + unit) * TPB * 64 : KB + ((size_t)b * NKU + unit) * TPB * 64) + 8 * fq;
#pragma unroll
        for (int ai = 0; ai < 2; ++ai)
#pragma unroll
            for (int m = 0; m < 4; ++m) {
                const int p = p0 + 128 * ai + 64 * wr + 16 * m + fr;
                f32x4 x[2][2];
#pragma unroll
                for (int bj = 0; bj < 2; ++bj)
#pragma unroll
                    for (int n = 0; n < 2; ++n) x[bj][n] = acc[ai][bj][m][n];
                if (nrm) {
                    float ss = 0.f;
#pragma unroll
                    for (int bj = 0; bj < 2; ++bj)
#pragma unroll
                        for (int n = 0; n < 2; ++n) ss += (x[bj][n].x * x[bj][n].x + x[bj][n].y * x[bj][n].y) + (x[bj][n].z * x[bj][n].z + x[bj][n].w * x[bj][n].w);
                    ss += __shfl_xor(ss, 16); ss += __shfl_xor(ss, 32);
                    const float r = rsqrtf(ss * (1.f / 64.f) + RMS_EPS);
#pragma unroll
                    for (int bj = 0; bj < 2; ++bj)
#pragma unroll
                        for (int n = 0; n < 2; ++n) x[bj][n] = x[bj][n] * r * g4[bj][n];
                }
                if (!isctx) {
                    const int t = p - CTXL;
#pragma unroll
                    for (int bj = 0; bj < 2; ++bj) {
                        const int idx = (bj == 0 ? (t >> 6) : 32 + (t & 63)) * 16 + 4 * fq;
                        const f32x4 c4 = *(const f32x4*)(ropec + idx), s4 = *(const f32x4*)(ropes + idx);
                        const f32x4 y0 = x[bj][0] * c4 - x[bj][1] * s4, y1 = x[bj][0] * s4 + x[bj][1] * c4;
                        x[bj][0] = y0; x[bj][1] = y1;
                    }
                }
#pragma unroll
                for (int bj = 0; bj < 2; ++bj) { u32x4 o; o.x = pk2(x[bj][0].x * osc, x[bj][0].y * osc); o.y = pk2(x[bj][0].z * osc, x[bj][0].w * osc);
                    o.z = pk2(x[bj][1].x * osc, x[bj][1].y * osc); o.w = pk2(x[bj][1].z * osc, x[bj][1].w * osc);
                    *(u32x4*)(base + (size_t)p * 64 + 32 * bj) = o; }
            }
    }
};
DI void phase_qkv(const Params& P, int l, int bid, int nb, char* smem) {
    __syncthreads();
    for (int i = threadIdx.x; i < 2 * 96 * 16 / 4; i += NTHREADS) ((f32x4*)(smem + LDS_MISC))[i] = ((const f32x4*)(P.ws + OFF_ROPE))[i];
    __syncthreads();
    SchedQKV S{(const bf16_t*)(P.ws + OFF_HX), (const bf16_t*)(P.ws + OFF_WIN) + (size_t)l * INC * DM, nb, bid};
    EpiQKV E{(bf16_t*)(P.ws + OFF_QB), (bf16_t*)(P.ws + OFF_KB), (bf16_t*)(P.ws + OFF_VT), (const float*)(smem + LDS_MISC), (const float*)(smem + LDS_MISC) + 96 * 16,
             P.q_norm_g + l * 64, P.k_norm_g + l * 64};
    g8::gemm_phase(smem, (const bf16_t*)(P.ws + OFF_HX), DM, S, E);
}


#ifndef PV_AHEAD
#define PV_AHEAD 8
#endif
#define MFMA32(a, b, c) __builtin_amdgcn_mfma_f32_32x32x16_bf16((a), (b), (c), 0, 0, 0)
template <int DV>
DI void flash_run(char* smem, const bf16_t* qrow, const bf16_t* Kb, const bf16_t* Vr, int n1, int base2, int n2, int tq, float m0, float l0,
                  f32x16 (&O)[DV / 32], float& lout) {
    constexpr int NT = DV / 32, KBYTES = 8192, RB = DV * 2, STAGE = KBYTES + 64 * RB, NVP = DV / 64, KP = 1024 / RB, LPR = RB / 16;
    LAS char* lds = (LAS char*)smem;
    const int t = threadIdx.x, wave = __builtin_amdgcn_readfirstlane(t >> 6);
    int lane = t & 63;
    asm volatile("" : "+v"(lane));
    const int h = lane >> 5, ln = lane & 31, sw = (ln >> 1) & 7;
    constexpr bool QLDS = DV == 128;
    LAS char* qb = lds + 4 * STAGE + wave * 4096 + lane * 16;
    bf16x8 qf[4];
#pragma unroll
    for (int s = 0; s < 4; ++s) qf[s] = *(const bf16x8*)(qrow + 16 * s + 8 * h);
    if (QLDS) {
#pragma unroll
        for (int s = 0; s < 4; ++s) *(LAS bf16x8*)(qb + s * 1024) = qf[s];
    }
#pragma unroll
    for (int tt = 0; tt < NT; ++tt)
#pragma unroll
        for (int i = 0; i < 16; ++i) O[tt][i] = 0.f;
    constexpr float THR = 8.f;
    constexpr int PVA = PV_AHEAD;
    float m = m0 > -1e29f ? m0 : 0.f, l = l0;
    f32x16 negm;
#pragma unroll
    for (int i = 0; i < 16; ++i) negm[i] = -m;
    const int ntile = n1 + n2;
    constexpr int VPM = DV == 128 ? 5 : 9;
    bf16x8 pfp[2][2];
#pragma unroll
    for (int x = 0; x < 2; ++x)
#pragma unroll
        for (int y = 0; y < 2; ++y) pfp[x][y] = (bf16x8){0, 0, 0, 0, 0, 0, 0, 0};
    const int krow = 8 * wave + (lane >> 3);
    const unsigned koff = (unsigned)(krow * 64 + (((lane & 7) ^ ((krow >> 1) & 7)) << 3)) * 2u;
    unsigned voff[NVP];
#pragma unroll
    for (int i = 0; i < NVP; ++i) { const int key = 8 * wave + KP * i + lane / LPR, cpos = lane % LPR, z = DV == 128 ? (key & 3) : ((key >> 1) & 1);
        voff[i] = (unsigned)(key * DV + ((cpos ^ (z << 2)) << 3)) * 2u; }
    const int tq_ = (lane & 15) >> 2, tp_ = lane & 3, gb_ = (lane >> 4) & 1, z_ = DV == 128 ? tq_ : ((tq_ >> 1) & 1);
    const int vlane = (4 * h + tq_) * RB + (2 * gb_ + (tp_ >> 1)) * 16 + (tp_ & 1) * 8;
#define FA_DMA(gsrc, ldsdst) do { unsigned keep_; asm volatile("s_mov_b32 %0, m0\n\ts_mov_b32 m0, %2\n\ts_nop 0\n\tglobal_load_lds_dwordx4 %1, off\n\ts_mov_b32 m0, %0" \
        : "=&s"(keep_) : "v"(gsrc), "s"(ldsdst) : "memory"); } while (0)
#define FA_ISSUE(j) do { const int j_ = (j); const int pj_ = j_ < n1 ? 64 * j_ : base2 + 64 * (j_ - n1); const int bo_ = (j_ & 3) * STAGE; \
        const char* kt_ = (const char*)Kb + (size_t)pj_ * 128; const char* vt_ = (const char*)Vr + (size_t)pj_ * RB; \
        FA_DMA(kt_ + koff, (unsigned)(size_t)(lds + bo_ + wave * 1024)); \
        _Pragma("unroll") for (int i_ = 0; i_ < NVP; ++i_) FA_DMA(vt_ + voff[i_], (unsigned)(size_t)(lds + bo_ + KBYTES + (8 * wave + KP * i_) * RB)); } while (0)
    asm volatile("s_waitcnt vmcnt(0)" ::: "memory");
    FA_ISSUE(0);
    if (ntile > 1) FA_ISSUE(1);
#define FA_PVCORE(VB_) do { \
_Pragma("unroll") \
        for (int tt = 0; tt < NT; ++tt) { \
            const LAS char* vt = (VB_) + ((tt ^ z_) << 6); \
_Pragma("unroll") \
            for (int x = 0; x < 2; ++x) \
_Pragma("unroll") \
                for (int y = 0; y < 2; ++y) { \
                    const s16x4 lo = __builtin_amdgcn_ds_read_tr16_b64_v4i16((LAS s16x4*)(vt + (32 * x + 16 * y) * RB)); \
                    const s16x4 hi = __builtin_amdgcn_ds_read_tr16_b64_v4i16((LAS s16x4*)(vt + (32 * x + 16 * y + 8) * RB)); \
                    const bf16x8 vf = __builtin_shufflevector(lo, hi, 0, 1, 2, 3, 4, 5, 6, 7); \
                    O[tt] = MFMA32(vf, pfp[x][y], O[tt]); \
                } \
        } \
 \
    } while (0)
#define FA_EXPCORE() do { \
_Pragma("unroll") \
        for (int i = 0; i < 16; i += 2) { \
            const float a0 = __builtin_amdgcn_exp2f(s0[i]), a1 = __builtin_amdgcn_exp2f(s0[i + 1]); \
            const float b0 = __builtin_amdgcn_exp2f(s1[i]), b1 = __builtin_amdgcn_exp2f(s1[i + 1]); \
            ps += (a0 + a1) + (b0 + b1); \
            w[i >> 1] = pk2(a0, a1); w[8 + (i >> 1)] = pk2(b0, b1); \
        } \
    } while (0)
    for (int it = 0; it < ntile; ++it) {
        const int p0 = it < n1 ? 64 * it : base2 + 64 * (it - n1);
        if (it + 1 < ntile) { if (NVP == 2) asm volatile("s_waitcnt vmcnt(3)" ::: "memory"); else asm volatile("s_waitcnt vmcnt(2)" ::: "memory"); }
        else asm volatile("s_waitcnt vmcnt(0)" ::: "memory");
        __builtin_amdgcn_s_barrier();
        asm volatile("" ::: "memory");
        if (it + 2 < ntile) FA_ISSUE(it + 2);
        int bo = (it & 3) * STAGE;
        asm volatile("" : "+s"(bo));
        const LAS char* kb = lds + bo;
        const LAS char* vb = kb + KBYTES + vlane;
        f32x16 s0 = negm, s1 = negm;
#pragma unroll
        for (int s = 0; s < 4; ++s) {
            const int co = ((2 * s + h) ^ sw) << 4;
            const bf16x8 k0 = *(const LAS bf16x8*)(kb + ln * 128 + co);
            const bf16x8 k1 = *(const LAS bf16x8*)(kb + (32 + ln) * 128 + co);
            const bf16x8 qs = QLDS ? *(const LAS bf16x8*)(qb + s * 1024) : qf[s];
            s0 = MFMA32(k0, qs, s0); s1 = MFMA32(k1, qs, s1);
        }
        if (it >= n1) {
            const int d0 = (p0 - CTXL) - tq + 4 * h + 128;
#pragma unroll
            for (int i = 0; i < 16; ++i) {
                const int dd = d0 + (i & 3) + 8 * (i >> 2);
                s0[i] = ((unsigned)dd <= 256u) ? s0[i] : -1e30f;
                s1[i] = ((unsigned)(dd + 32) <= 256u) ? s1[i] : -1e30f;
            }
        }
        float ps = 0.f;
        unsigned w[16];
        __builtin_amdgcn_sched_barrier(0);
        if (it > 0) {
            int bp = ((it - 1) & 3) * STAGE;
            asm volatile("" : "+s"(bp));
            const LAS char* vbp = lds + bp + KBYTES + vlane;
            FA_PVCORE(vbp);
            FA_EXPCORE();
            __builtin_amdgcn_sched_group_barrier(0x100, PVA, 0);
#pragma unroll
            for (int g = 0; g < 4 * NT; ++g) { __builtin_amdgcn_sched_group_barrier(0x008, 1, 0); __builtin_amdgcn_sched_group_barrier(0x002, VPM, 0);
                if (g < 4 * NT - PVA / 2) __builtin_amdgcn_sched_group_barrier(0x100, 2, 0); }
        } else {
            FA_EXPCORE();
        }
        __builtin_amdgcn_sched_barrier(0);
        if (__any(!(ps <= 1048576.f))) {
            float mx;
            {
                float t0 = max2f(s0[0], s1[0]), t1 = max2f(s0[1], s1[1]), t2 = max2f(s0[2], s1[2]), t3 = max2f(s0[3], s1[3]);
#pragma unroll
                for (int i = 4; i < 16; i += 4) { t0 = max2f(t0, max2f(s0[i], s1[i])); t1 = max2f(t1, max2f(s0[i + 1], s1[i + 1])); t2 = max2f(t2, max2f(s0[i + 2], s1[i + 2])); t3 = max2f(t3, max2f(s0[i + 3], s1[i + 3])); }
                mx = max2f(max2f(t0, t1), max2f(t2, t3));
            }
            mx = max2f(mx, __shfl_xor(mx, 32));
            const float d = fmaxf(mx, 0.f), alpha = __builtin_amdgcn_exp2f(-d);
            m += d; l *= alpha;
#pragma unroll
            for (int i = 0; i < 16; ++i) negm[i] -= d;
#pragma unroll
            for (int tt = 0; tt < NT; ++tt)
#pragma unroll
                for (int i = 0; i < 16; ++i) O[tt][i] *= alpha;
            ps = 0.f;
#pragma unroll
            for (int i = 0; i < 16; i += 2) {
                const float a0 = __builtin_amdgcn_exp2f(s0[i] - d), a1 = __builtin_amdgcn_exp2f(s0[i + 1] - d);
                const float b0 = __builtin_amdgcn_exp2f(s1[i] - d), b1 = __builtin_amdgcn_exp2f(s1[i + 1] - d);
                ps += (a0 + a1) + (b0 + b1);
                w[i >> 1] = pk2(a0, a1); w[8 + (i >> 1)] = pk2(b0, b1);
            }
        }
#pragma unroll
        for (int x = 0; x < 2; ++x)
#pragma unroll
            for (int y = 0; y < 2; ++y) { u32x4 q; q.x = w[8 * x + 4 * y]; q.y = w[8 * x + 4 * y + 1]; q.z = w[8 * x + 4 * y + 2]; q.w = w[8 * x + 4 * y + 3];
                pfp[x][y] = __builtin_bit_cast(bf16x8, q); }
        l += ps;
    }
    { int bp = ((ntile - 1) & 3) * STAGE; asm volatile("" : "+s"(bp)); const LAS char* vbp = lds + bp + KBYTES + vlane; FA_PVCORE(vbp); }
    __builtin_amdgcn_s_barrier();
#undef FA_ISSUE
#undef FA_PVCORE
#undef FA_EXPCORE
#undef FA_DMA
    lout = l + __shfl_xor(l, 32);
}

constexpr int CTX_EARLY_LO = 96, CTX_EARLY_N = 32;
DI bool ctx_early(int nb) { return nb >= CTX_EARLY_LO + CTX_EARLY_N; }
DI void outproj_run(const Params& P, int l, int mode, int c, int nb, char* smem);
DI void phase_attn(const Params& P, int l, int bid, int nb, char* smem) {
    const int t = threadIdx.x, wave = t >> 6;
    const bf16_t* QB = (const bf16_t*)(P.ws + OFF_QB); const bf16_t* KB = (const bf16_t*)(P.ws + OFF_KB); const bf16_t* VT = (const bf16_t*)(P.ws + OFF_VT);
    bf16_t* MIX = (bf16_t*)(P.ws + OFF_HX);
    const float lambda_init = l == 0 ? 0.2f : (0.8f - 0.6f * expf(-0.3f));
    float d1 = P.lam_q1[l * 64 + (t & 63)] * P.lam_k1[l * 64 + (t & 63)], d2 = P.lam_q2[l * 64 + (t & 63)] * P.lam_k2[l * 64 + (t & 63)];
    d1 = wave_sum(d1); d2 = wave_sum(d2);
    const float lam = expf(d1) - expf(d2) + lambda_init;
    const bool has_ctx = l == 0 && bid < 96;
    const int nmain = (768 - bid + nb - 1) / nb;
#pragma unroll 1
    for (int kk = 0; kk < nmain + (has_ctx ? 1 : 0); ++kk) {
        const int it = has_ctx ? (kk == 0 ? 768 + bid : bid + (kk - 1) * nb) : bid + kk * nb;
        int ty, b, hd, p0q, ncx;
        bool isctx;
        if (it < 768) {
            ty = it >> 8; const int idx = it & 255, xcd = idx & 7, r = idx >> 3, stream = xcd * 4 + (r >> 3);
            b = stream >> 2; hd = stream & 3; p0q = CTXL + (r & 7) * 256; isctx = false; ncx = TPB / 64;
        } else {
            const int i2 = it - 768, t12 = i2 % 12;
            b = i2 / 12; p0q = 0; ty = t12 >> 2; hd = t12 & 3; isctx = true; ncx = CTXL / 64;
        }
        int lane = t & 63;
        asm volatile("" : "+v"(lane));
        const int h = lane >> 5, ln = lane & 31;
        const int p = p0q + wave * 32 + ln, tok = b * TPB + p, tq = p - CTXL;
        if (ty == 0) {
            f32x16 O[4]; float lt;
            const bf16_t* V = VT + (size_t)b * VS + (size_t)hd * TPB * 128;
            flash_run<128>(smem, QB + (((size_t)b * NQU + 2 * hd + 1) * TPB + p) * 64, KB + ((size_t)b * NKU + 2 * hd + 1) * TPB * 64, V, ncx, 0, 0, tq, -1e30f, 0.f, O, lt);
            {
                int l2_ = t & 63; asm volatile("" : "+v"(l2_)); const int h2 = l2_ >> 5; bf16_t* orow = MIX + (size_t)(b * TPB + p0q + wave * 32 + (l2_ & 31)) * DM + hd * 128 + 8 * h2;
                const float f = -lam / lt;
#pragma unroll
                for (int tt = 0; tt < 4; ++tt)
#pragma unroll
                    for (int j = 0; j < 2; ++j) { u32x2 a, c2; a.x = pk2(O[tt][8 * j] * f, O[tt][8 * j + 1] * f); a.y = pk2(O[tt][8 * j + 2] * f, O[tt][8 * j + 3] * f);
                        c2.x = pk2(O[tt][8 * j + 4] * f, O[tt][8 * j + 5] * f); c2.y = pk2(O[tt][8 * j + 6] * f, O[tt][8 * j + 7] * f);
                        st16_pair(orow + 32 * tt + 16 * j, a, c2); }
            }
            flash_run<128>(smem, QB + (((size_t)b * NQU + 2 * hd) * TPB + p) * 64, KB + ((size_t)b * NKU + 2 * hd) * TPB * 64, V, ncx, 0, 0, tq, -1e30f, 0.f, O, lt);
            {
                int l2_ = t & 63; asm volatile("" : "+v"(l2_)); const int h2 = l2_ >> 5; bf16_t* orow = MIX + (size_t)(b * TPB + p0q + wave * 32 + (l2_ & 31)) * DM + hd * 128 + 8 * h2;
                const float f = 1.f / lt; float ss = 0.f; u32x2 stB_keep = {0u, 0u};
#pragma unroll
                for (int tt = 0; tt < 4; ++tt)
#pragma unroll
                    for (int g = 0; g < 4; ++g) {
                        u32x2 stA, stB; if ((g & 1) == 0) ld16_pair(orow + 32 * tt + 8 * g, stA, stB);
                        const u32x2 st = (g & 1) ? stB_keep : stA; if ((g & 1) == 0) stB_keep = stB;
                        O[tt][4 * g + 0] = O[tt][4 * g + 0] * f + __uint_as_float(st.x << 16);
                        O[tt][4 * g + 1] = O[tt][4 * g + 1] * f + __uint_as_float(st.x & 0xffff0000u);
                        O[tt][4 * g + 2] = O[tt][4 * g + 2] * f + __uint_as_float(st.y << 16);
                        O[tt][4 * g + 3] = O[tt][4 * g + 3] * f + __uint_as_float(st.y & 0xffff0000u);
                        ss += (O[tt][4 * g] * O[tt][4 * g] + O[tt][4 * g + 1] * O[tt][4 * g + 1]) + (O[tt][4 * g + 2] * O[tt][4 * g + 2] + O[tt][4 * g + 3] * O[tt][4 * g + 3]);
                    }
                ss += __shfl_xor(ss, 32);
                const float r = rsqrtf(ss * (1.f / 128.f) + RMS_EPS) * (1.f - lambda_init);
                const float* sg = P.subln_g + l * 128 + 4 * h2;
#pragma unroll
                for (int tt = 0; tt < 4; ++tt)
#pragma unroll
                    for (int j = 0; j < 2; ++j) { u32x2 o[2];
#pragma unroll
                        for (int q = 0; q < 2; ++q) { const int g = 2 * j + q; const f32x4 gg = *(const f32x4*)(sg + 32 * tt + 8 * g);
                            o[q].x = pk2(O[tt][4 * g] * r * gg.x, O[tt][4 * g + 1] * r * gg.y); o[q].y = pk2(O[tt][4 * g + 2] * r * gg.z, O[tt][4 * g + 3] * r * gg.w); }
                        st16_pair(orow + 32 * tt + 16 * j, o[0], o[1]); }
            }
        } else {
            const bool isC = ty == 2;
            f32x16 O[2]; float lt;
            const int qu = (isC ? 12 : 8) + hd, ku = (isC ? 10 : 8) + (hd >> 1);
            const bf16_t* V = VT + (size_t)b * VS + (size_t)4 * TPB * 128 + (size_t)((isC ? 2 : 0) + (hd >> 1)) * TPB * 64;
            int n1 = ncx, base2 = 0, n2 = 0;
            float m0 = -1e30f, l0 = 0.f;
            if (isC) {
                m0 = P.sink[l * 4 + hd] * 1.4426950408889634f; l0 = h == 0 ? 1.f : 0.f;
                if (!isctx) { const int n = (p0q - CTXL) >> 8; n1 = CTXL / 64; const int jlo = n == 0 ? 2 : 0, jhi = n == 7 ? 6 : 8;
                    base2 = CTXL + 256 * n - 128 + 64 * jlo; n2 = jhi - jlo; }
            }
            flash_run<64>(smem, QB + (((size_t)b * NQU + qu) * TPB + p) * 64, KB + ((size_t)b * NKU + ku) * TPB * 64, V, n1, base2, n2, tq, m0, l0, O, lt);
            const float f = 1.f / lt;
            int l2_ = t & 63; asm volatile("" : "+v"(l2_)); const int h2 = l2_ >> 5; bf16_t* orow = MIX + (size_t)(b * TPB + p0q + wave * 32 + (l2_ & 31)) * DM + (isC ? 768 : 512) + hd * 64 + 8 * h2;
#pragma unroll
            for (int tt = 0; tt < 2; ++tt)
#pragma unroll
                for (int j = 0; j < 2; ++j) { u32x2 a, c2; a.x = pk2(O[tt][8 * j] * f, O[tt][8 * j + 1] * f); a.y = pk2(O[tt][8 * j + 2] * f, O[tt][8 * j + 3] * f);
                    c2.x = pk2(O[tt][8 * j + 4] * f, O[tt][8 * j + 5] * f); c2.y = pk2(O[tt][8 * j + 6] * f, O[tt][8 * j + 7] * f);
                    st16_pair(orow + 32 * tt + 16 * j, a, c2); }
        }
        if (it >= 768) {
            asm volatile("s_waitcnt vmcnt(0)" ::: "memory");
            __syncthreads();
            if (t == 0) { __builtin_amdgcn_fence(__ATOMIC_RELEASE, "agent"); asm volatile("s_waitcnt vmcnt(0)" ::: "memory");
                __hip_atomic_fetch_add((int*)(P.ws + OFF_RDYC) + ((it - 768) / 12) * 64, 1, __ATOMIC_RELAXED, __HIP_MEMORY_SCOPE_AGENT); }
        }
    }
    if (l == 0 && ctx_early(nb) && bid >= CTX_EARLY_LO && bid < CTX_EARLY_LO + CTX_EARLY_N) outproj_run(P, 0, 2, bid - CTX_EARLY_LO, nb, smem);
}

DI void phase_norm2_route(const Params& P, int l, int bid, int nb, char* smem) {
    const int t = threadIdx.x, lane = t & 63, wave = t >> 6;
    int* lcnt = (int*)(smem + LDS_MISC);
    int* lbase = lcnt + 16;
    int* rec = lcnt + 32;
    int* rec2 = rec + 160;
    float* recw = (float*)(rec2 + 160);
    __syncthreads();
    {
        int ts = t;
        asm volatile("" : "+v"(ts));
        f32x4 wv[4096 / NTHREADS];
#pragma unroll
        for (int i = 0; i < 4096 / NTHREADS; ++i) { const int idx = ts + NTHREADS * i; wv[i] = *(const f32x4*)(P.w_router + (idx >> 2) * 16 + (idx & 3) * 4); }
#pragma unroll
        for (int i = 0; i < 4096 / NTHREADS; ++i) { const int idx = ts + NTHREADS * i, k = idx >> 2, q = idx & 3;
            const int row = ((k >> 8) * 4 + (k & 3)) * 64 + ((k >> 2) & 63);
            *(f32x4*)(smem + row * 64 + ((q ^ ((row >> 2) & 3)) << 4)) = wv[i]; }
    }
    if (t < 16) lcnt[t] = 0;
    __syncthreads();
    bf16_t* HX = (bf16_t*)(P.ws + OFF_HX);
    int* cnt = (int*)(P.ws + OFF_CNT) + l * 16 * 64;
    int* list = (int*)(P.ws + OFF_LIST);
    float* tokw = (float*)(P.ws + OFF_TOKW);
    const int per = (NTOK + nb - 1) / nb;
    const int tk0 = bid * per, tk1 = min(NTOK, tk0 + per), ntk = tk1 - tk0;
    const int eme = ((lane >> 5) & 1) * 8 + ((lane >> 4) & 1) * 4 + ((lane >> 3) & 1) * 2 + ((lane >> 2) & 1);
    const float mybias = P.router_bias[eme];
    f32x4 v[4], vn[4], gs[4], hs[4];
    int cur_mr = -1;
    if (wave < ntk) { const int tok = tk0 + wave, b = tok / TPB, p = tok % TPB; const u32x2* xr = (const u32x2*)resid_row(P, b, p) + lane;
#pragma unroll
        for (int j = 0; j < 4; ++j) vn[j] = bf4_to_f32(xr[64 * j]); }
    for (int i = wave; i < ntk; i += NW) {
        const int tok = tk0 + i;
        const int b = tok / TPB, p = tok % TPB, mr = p < CTXL ? 8 : b;
#pragma unroll
        for (int j = 0; j < 4; ++j) v[j] = vn[j];
        if (i + NW < ntk) { const int tk2 = tok + NW, b2 = tk2 / TPB, p2 = tk2 % TPB; const u32x2* xr = (const u32x2*)resid_row(P, b2, p2) + lane;
#pragma unroll
            for (int j = 0; j < 4; ++j) vn[j] = bf4_to_f32(xr[64 * j]); }
        if (l == 1 && p < CTXL) { if (lane == 0) rec[i] = -1; continue; }
        float ss = 0.f;
#pragma unroll
        for (int j = 0; j < 4; ++j) ss += (v[j].x * v[j].x + v[j].y * v[j].y) + (v[j].z * v[j].z + v[j].w * v[j].w);
        const float r = rsqrtf(wave_sum(ss) * (1.f / DM) + RMS_EPS);
        if (mr != cur_mr) {
            const float* md = mod_row(P, l, mr);
            const f32x4* gn = (const f32x4*)(P.norm2_g + l * DM) + lane;
            const f32x4* sh = (const f32x4*)(md + 3072) + lane;
            const f32x4* sc = (const f32x4*)(md + 4096) + lane;
#pragma unroll
            for (int j = 0; j < 4; ++j) { const f32x4 g = gn[64 * j], s1 = sc[64 * j]; gs[j] = g * (1.f + s1); hs[j] = sh[64 * j]; }
            cur_mr = mr;
        }
        u32x2* o = (u32x2*)(HX + (size_t)tok * DM) + lane;
        float lg[16];
#pragma unroll
        for (int e = 0; e < 16; ++e) lg[e] = 0.f;
#pragma unroll
        for (int j = 0; j < 4; ++j) {
            float y[4];
            y[0] = v[j].x * r * gs[j].x + hs[j].x; y[1] = v[j].y * r * gs[j].y + hs[j].y;
            y[2] = v[j].z * r * gs[j].z + hs[j].z; y[3] = v[j].w * r * gs[j].w + hs[j].w;
            u32x2 w; w.x = pk2(y[0], y[1]); w.y = pk2(y[2], y[3]);
            o[64 * j] = w;
#pragma unroll
            for (int cc = 0; cc < 4; ++cc) {
                const int row = (j * 4 + cc) * 64 + lane;
#pragma unroll
                for (int q = 0; q < 4; ++q) {
                    const f32x4 wv = *(const f32x4*)(smem + row * 64 + ((q ^ ((row >> 2) & 3)) << 4));
                    lg[4 * q + 0] += y[cc] * wv.x; lg[4 * q + 1] += y[cc] * wv.y; lg[4 * q + 2] += y[cc] * wv.z; lg[4 * q + 3] += y[cc] * wv.w;
                }
            }
        }
        float a8[8], a4[4], a2[2], a1;
        { const bool hi = lane & 32;
#pragma unroll
          for (int j = 0; j < 8; ++j) { const float keep = hi ? lg[8 + j] : lg[j], send = hi ? lg[j] : lg[8 + j]; a8[j] = keep + __shfl_xor(send, 32); } }
        { const bool hi = lane & 16;
#pragma unroll
          for (int j = 0; j < 4; ++j) { const float keep = hi ? a8[4 + j] : a8[j], send = hi ? a8[j] : a8[4 + j]; a4[j] = keep + __shfl_xor(send, 16); } }
        { const bool hi = lane & 8;
#pragma unroll
          for (int j = 0; j < 2; ++j) { const float keep = hi ? a4[2 + j] : a4[j], send = hi ? a4[j] : a4[2 + j]; a2[j] = keep + __shfl_xor(send, 8); } }
        { const bool hi = lane & 4; const float keep = hi ? a2[1] : a2[0], send = hi ? a2[0] : a2[1]; a1 = keep + __shfl_xor(send, 4); }
        a1 += __shfl_xor(a1, 2); a1 += __shfl_xor(a1, 1);
        const float mysc = 1.f / (1.f + expf(-a1)), mysel = mysc + mybias;
        float scv[16], sel[16];
#pragma unroll
        for (int e = 0; e < 16; ++e) { const int src = ((e >> 3) & 1) * 32 + ((e >> 2) & 1) * 16 + ((e >> 1) & 1) * 8 + (e & 1) * 4;
            scv[e] = __int_as_float(__builtin_amdgcn_readlane(__float_as_int(mysc), src)); sel[e] = __int_as_float(__builtin_amdgcn_readlane(__float_as_int(mysel), src)); }
        float bestg = -1e30f; int be1 = 0, be2 = 1; float bw1 = 0.f, bw2 = 0.f;
#pragma unroll
        for (int g = 0; g < 4; ++g) {
            int i1 = 0; float v1 = sel[4 * g], w1 = scv[4 * g];
#pragma unroll
            for (int j = 1; j < 4; ++j) if (sel[4 * g + j] > v1) { v1 = sel[4 * g + j]; w1 = scv[4 * g + j]; i1 = j; }
            int i2 = -1; float v2 = -1e30f, w2 = 0.f;
#pragma unroll
            for (int j = 0; j < 4; ++j) if (j != i1 && sel[4 * g + j] > v2) { v2 = sel[4 * g + j]; w2 = scv[4 * g + j]; i2 = j; }
            const float gs = v1 + v2;
            if (gs > bestg) { bestg = gs; be1 = 4 * g + i1; be2 = 4 * g + i2; bw1 = w1; bw2 = w2; }
        }
        if (lane == 0) {
            const float inv = 1.f / (bw1 + bw2);
            const int r1 = atomicAdd(&lcnt[be1], 1), r2 = atomicAdd(&lcnt[be2], 1);
            rec[i] = be1 | (be2 << 8) | (r1 << 16); rec2[i] = r2;
            recw[i] = bw1 * inv; recw[160 + i] = bw2 * inv;
        }
    }
    __syncthreads();
    if (t < 16) { const int c = lcnt[t]; lbase[t] = c ? atomicAdd(&cnt[t * 64], c) : 0; }
    __syncthreads();
    for (int i = t; i < ntk; i += NTHREADS) {
        const int rc = rec[i];
        if (rc >= 0) { const int e1 = rc & 255, e2 = (rc >> 8) & 255, r1 = rc >> 16, r2 = rec2[i], tok = tk0 + i;
            list[e1 * NTOK + lbase[e1] + r1] = 2 * tok; list[e2 * NTOK + lbase[e2] + r2] = 2 * tok + 1;
            tokw[e1 * NTOK + lbase[e1] + r1] = recw[i]; tokw[e2 * NTOK + lbase[e2] + r2] = recw[160 + i]; }
    }
}

struct SchedOut {
    const bf16_t *A, *Wt; int G, c, mode;
    int* rdyc;
    static constexpr bool GATHER = false;
    DI void a_ready(const g8::Unit& u) const {
        if (mode != 2) return;
        if (__builtin_amdgcn_readfirstlane(threadIdx.x >> 6) == 0) {
            unsigned sp = 0;
            while (__hip_atomic_load(rdyc + (u.a / 9) * 64, __ATOMIC_RELAXED, __HIP_MEMORY_SCOPE_AGENT) < 12) { __builtin_amdgcn_s_sleep(2); if (++sp > (1u << 22)) break; }
            __builtin_amdgcn_fence(__ATOMIC_ACQUIRE, "agent");
            asm volatile("s_waitcnt vmcnt(0)" ::: "memory");
        }
        __builtin_amdgcn_s_barrier();
    }
    DI bool next(int i, g8::Unit& u) const {
        int pm, pn;
        if (mode == 2) { if (i != 0) return false; pm = 9 * (c >> 2); pn = c & 3; }
        else { if (!g8::static_unit(i, G, c, mode == 0 ? 72 : 64, 4, pm, pn)) return false; if (mode == 1) pm = 9 * (pm >> 3) + 1 + (pm & 7); }
        u.a = pm; u.b = pn; u.c = 0; u.d = 0; u.bt = Wt + (size_t)pn * 256 * DM; return true; }
    DI const bf16_t* a_base(const g8::Unit& u) const { return A + (size_t)u.a * 256 * DM; }
};
struct EpiOut {
    static constexpr bool AFTER_DRAIN = false;
    const float *x, *ctx; float *out, *xc; const float* mod; int l;
    DI void operator()(const f32x4 (&acc)[2][2][4][2], const g8::Unit& u, int wr, int wc, int fr, int fq) const {
        const int tok0 = u.a * 256, b = tok0 / TPB, p0 = tok0 % TPB;
        const bool isctx = p0 == 0;
        const float* g1 = mod + (size_t)(l * 9 + (isctx ? 8 : b)) * 6144 + 2048 + u.b * 256 + 32 * wc + 8 * fq;
        f32x4 g4[2][2];
#pragma unroll
        for (int bj = 0; bj < 2; ++bj)
#pragma unroll
            for (int n = 0; n < 2; ++n) g4[bj][n] = *(const f32x4*)(g1 + 128 * bj + 4 * n);
        const int cb = u.b * 256 + 32 * wc + 8 * fq;
#pragma unroll
        for (int ai = 0; ai < 2; ++ai)
#pragma unroll
            for (int m = 0; m < 4; ++m) {
                const int r = 128 * ai + 64 * wr + 16 * m + fr;
                const size_t ro = isctx ? (size_t)(b * CTXL + r) * DM : (size_t)(b * SEQ + p0 - CTXL + r) * DM;
                const float* xin = (isctx ? ctx : x) + ro + cb;
                bf16_t* xo = (isctx ? (bf16_t*)xc + ro : (bf16_t*)(out + ro)) + cb;
#pragma unroll
                for (int bj = 0; bj < 2; ++bj) { f32x4 x0, x1;
                    if (l == 0) { x0 = *(const f32x4*)(xin + 128 * bj); x1 = *(const f32x4*)(xin + 128 * bj + 4); }
                    else { const u32x4 q = *(const u32x4*)(xo + 128 * bj); x0 = bf4_to_f32((u32x2){q.x, q.y}); x1 = bf4_to_f32((u32x2){q.z, q.w}); }
                    const u32x2 o0 = f32_to_bf4(x0 + g4[bj][0] * acc[ai][bj][m][0]), o1 = f32_to_bf4(x1 + g4[bj][1] * acc[ai][bj][m][1]);
                    *(u32x4*)(xo + 128 * bj) = (u32x4){o0.x, o0.y, o1.x, o1.y}; }
                if (m & 1) asm volatile("" ::: "memory");
            }
    }
};
struct EpiOutF {
    static constexpr bool AFTER_DRAIN = true;
    const Params& P; int l;
    DI void operator()(const f32x4 (&)[2][2][4][2], const g8::Unit&, int, int, int, int) const {}
    DI void fused(f32x4 (&acc)[2][2][4][2], const g8::Unit& u, int wr, int wc, int fr, int fq, char* smem) const {
        const int tid = threadIdx.x;
        const int tok0 = u.a * 256, b = tok0 / TPB, p0 = tok0 % TPB, pn = u.b;
        const bool isctx = p0 == 0;
        const int mr = isctx ? 8 : b;
        const float* md = mod_row(P, l, mr);
        const int cb = pn * 256 + 32 * wc + 8 * fq;
        float* part = (float*)smem;
        float* rt = part + 256 * 4 * 17;
        int* lcnt = (int*)(rt + 256);
        int* lbase = lcnt + 16;
        const float* wtab = (const float*)(smem + LDS_MISC);
        float* xc = (float*)(P.ws + OFF_XC);
        {
            f32x4 g4[2][2];
#pragma unroll
            for (int bj = 0; bj < 2; ++bj)
#pragma unroll
                for (int n = 0; n < 2; ++n) g4[bj][n] = *(const f32x4*)(md + 2048 + cb + 128 * bj + 4 * n);
#pragma unroll
            for (int ai = 0; ai < 2; ++ai)
#pragma unroll
                for (int m = 0; m < 4; ++m) {
                    const int r = 128 * ai + 64 * wr + 16 * m + fr;
                    const size_t ro = isctx ? (size_t)(b * CTXL + r) * DM : (size_t)(b * SEQ + p0 - CTXL + r) * DM;
                    const float* xin = (isctx ? P.ctx : P.x) + ro + cb;
                    bf16_t* xo = (isctx ? (bf16_t*)xc + ro : (bf16_t*)(P.out + ro)) + cb;
#pragma unroll
                    for (int bj = 0; bj < 2; ++bj) { f32x4 x0, x1;
                        if (l == 0) { x0 = *(const f32x4*)(xin + 128 * bj); x1 = *(const f32x4*)(xin + 128 * bj + 4); }
                        else { const u32x4 q = *(const u32x4*)(xo + 128 * bj); x0 = bf4_to_f32((u32x2){q.x, q.y}); x1 = bf4_to_f32((u32x2){q.z, q.w}); }
                        acc[ai][bj][m][0] = x0 + g4[bj][0] * acc[ai][bj][m][0]; acc[ai][bj][m][1] = x1 + g4[bj][1] * acc[ai][bj][m][1];
                        const u32x2 o0 = f32_to_bf4(acc[ai][bj][m][0]), o1 = f32_to_bf4(acc[ai][bj][m][1]);
                        *(u32x4*)(xo + 128 * bj) = (u32x4){o0.x, o0.y, o1.x, o1.y}; }
                    if (m & 1) asm volatile("" ::: "memory");
                }
        }
        {
            float wb[2][2][4];
#pragma unroll
            for (int bj = 0; bj < 2; ++bj)
#pragma unroll
                for (int n = 0; n < 2; ++n)
#pragma unroll
                    for (int r = 0; r < 4; ++r) wb[bj][n][r] = wtab[(128 * bj + 32 * wc + 8 * fq + 4 * n + r) * 16 + fr];
#pragma unroll
            for (int ai = 0; ai < 2; ++ai)
#pragma unroll
                for (int m = 0; m < 4; ++m) {
                    f32x4 d = {0.f, 0.f, 0.f, 0.f}; float ss = 0.f;
#pragma unroll
                    for (int bj = 0; bj < 2; ++bj)
#pragma unroll
                        for (int n = 0; n < 2; ++n) { const f32x4 v = acc[ai][bj][m][n];
                            ss += (v.x * v.x + v.y * v.y) + (v.z * v.z + v.w * v.w);
                            d = __builtin_amdgcn_mfma_f32_16x16x4f32(v.x, wb[bj][n][0], d, 0, 0, 0);
                            d = __builtin_amdgcn_mfma_f32_16x16x4f32(v.y, wb[bj][n][1], d, 0, 0, 0);
                            d = __builtin_amdgcn_mfma_f32_16x16x4f32(v.z, wb[bj][n][2], d, 0, 0, 0);
                            d = __builtin_amdgcn_mfma_f32_16x16x4f32(v.w, wb[bj][n][3], d, 0, 0, 0); }
                    ss += __shfl_xor(ss, 16); ss += __shfl_xor(ss, 32);
                    const int rowb = 128 * ai + 64 * wr + 16 * m;
                    part[((rowb + 4 * fq + 0) * 4 + wc) * 17 + fr] = d.x;
                    part[((rowb + 4 * fq + 1) * 4 + wc) * 17 + fr] = d.y;
                    part[((rowb + 4 * fq + 2) * 4 + wc) * 17 + fr] = d.z;
                    part[((rowb + 4 * fq + 3) * 4 + wc) * 17 + fr] = d.w;
                    if (fq == 0) part[((rowb + fr) * 4 + wc) * 17 + 16] = ss;
                }
        }
        __syncthreads();
        float* xch = (float*)(P.ws + OFF_XCH) + (size_t)u.a * 4 * 256 * 20;
        { float* dst = xch + (size_t)pn * 256 * 20;
          for (int i = tid; i < 256 * 9; i += NTHREADS) { const int row = i / 9, k = i - row * 9; const float* pp = part + row * 68 + 2 * k;
              const float a = (pp[0] + pp[17]) + (pp[34] + pp[51]), c2 = k < 8 ? (pp[1] + pp[18]) + (pp[35] + pp[52]) : 0.f;
              __hip_atomic_store((unsigned long long*)(dst + row * 20 + 2 * k), (unsigned long long)__float_as_uint(a) | ((unsigned long long)__float_as_uint(c2) << 32), __ATOMIC_RELAXED, __HIP_MEMORY_SCOPE_AGENT); } }
        asm volatile("s_waitcnt vmcnt(0)" ::: "memory");
        __syncthreads();
        if (tid == 0) {
            int* xcn = (int*)(P.ws + OFF_XCNT) + (l * 72 + u.a) * 64;
            __hip_atomic_fetch_add(xcn, 1, __ATOMIC_RELAXED, __HIP_MEMORY_SCOPE_AGENT);
            unsigned sp = 0;
            while (__hip_atomic_load(xcn, __ATOMIC_RELAXED, __HIP_MEMORY_SCOPE_AGENT) < 4) { __builtin_amdgcn_s_sleep(1); if (++sp > (1u << 22)) break; }
            __builtin_amdgcn_fence(__ATOMIC_ACQUIRE, "agent");
            asm volatile("s_waitcnt vmcnt(0)" ::: "memory");
        }
        if (tid >= 64 && tid < 80) lcnt[tid - 64] = 0;
        __syncthreads();
        const bool router = (tid >> 6) == pn;
        int be1 = 0, be2 = 1, r1 = 0, r2 = 0; float w1 = 0.f, w2 = 0.f;
        const int rtok = tok0 + tid;
        if (tid < 256) {
            float sq = 0.f;
#pragma unroll
            for (int q = 0; q < 4; ++q) sq += xch[(size_t)(q * 256 + tid) * 20 + 16];
            f32x4 lg4[4];
            if (router) {
#pragma unroll
                for (int j = 0; j < 4; ++j) lg4[j] = (f32x4){0.f, 0.f, 0.f, 0.f};
#pragma unroll
                for (int q = 0; q < 4; ++q)
#pragma unroll
                    for (int j = 0; j < 4; ++j) lg4[j] += *(const f32x4*)(xch + (size_t)(q * 256 + tid) * 20 + 4 * j);
            }
            const float r = rsqrtf(sq * (1.f / DM) + RMS_EPS);
            rt[tid] = r;
            if (router) {
                const float* qe = (const float*)(P.ws + OFF_QE) + (l * 9 + mr) * 16;
                float scv[16], sel[16];
#pragma unroll
                for (int e = 0; e < 16; ++e) { const float a = lg4[e >> 2][e & 3] * r + qe[e]; scv[e] = 1.f / (1.f + expf(-a)); sel[e] = scv[e] + P.router_bias[e]; }
                float bestg = -1e30f; float bw1 = 0.f, bw2 = 0.f;
#pragma unroll
                for (int g = 0; g < 4; ++g) {
                    int i1 = 0; float v1 = sel[4 * g], x1 = scv[4 * g];
#pragma unroll
                    for (int j = 1; j < 4; ++j) if (sel[4 * g + j] > v1) { v1 = sel[4 * g + j]; x1 = scv[4 * g + j]; i1 = j; }
                    int i2 = -1; float v2 = -1e30f, x2 = 0.f;
#pragma unroll
                    for (int j = 0; j < 4; ++j) if (j != i1 && sel[4 * g + j] > v2) { v2 = sel[4 * g + j]; x2 = scv[4 * g + j]; i2 = j; }
                    const float gsum = v1 + v2;
                    if (gsum > bestg) { bestg = gsum; be1 = 4 * g + i1; be2 = 4 * g + i2; bw1 = x1; bw2 = x2; }
                }
                const float inv = 1.f / (bw1 + bw2);
                w1 = bw1 * inv; w2 = bw2 * inv;
                r1 = atomicAdd(&lcnt[be1], 1); r2 = atomicAdd(&lcnt[be2], 1);
            }
        }
        __syncthreads();
        if (tid < 16) { const int c = lcnt[tid]; int* cnt = (int*)(P.ws + OFF_CNT) + l * 16 * 64; lbase[tid] = c ? atomicAdd(&cnt[tid * 64], c) : 0; }
        {
            f32x4 gs[2][2], hs[2][2];
#pragma unroll
            for (int bj = 0; bj < 2; ++bj)
#pragma unroll
                for (int n = 0; n < 2; ++n) { const int c = cb + 128 * bj + 4 * n;
                    const f32x4 g = *(const f32x4*)(P.norm2_g + l * DM + c), s1 = *(const f32x4*)(md + 4096 + c);
                    gs[bj][n] = g * (1.f + s1); hs[bj][n] = *(const f32x4*)(md + 3072 + c); }
            bf16_t* HX = (bf16_t*)(P.ws + OFF_HX);
#pragma unroll
            for (int ai = 0; ai < 2; ++ai)
#pragma unroll
                for (int m = 0; m < 4; ++m) {
                    const int row = 128 * ai + 64 * wr + 16 * m + fr;
                    const float r = rt[row];
                    bf16_t* o = HX + (size_t)(tok0 + row) * DM + cb;
#pragma unroll
                    for (int bj = 0; bj < 2; ++bj) { u32x4 w;
                        { const f32x4 v = acc[ai][bj][m][0], g = gs[bj][0], h = hs[bj][0]; w.x = pk2(v.x * r * g.x + h.x, v.y * r * g.y + h.y); w.y = pk2(v.z * r * g.z + h.z, v.w * r * g.w + h.w); }
                        { const f32x4 v = acc[ai][bj][m][1], g = gs[bj][1], h = hs[bj][1]; w.z = pk2(v.x * r * g.x + h.x, v.y * r * g.y + h.y); w.w = pk2(v.z * r * g.z + h.z, v.w * r * g.w + h.w); }
                        *(u32x4*)(o + 128 * bj) = w; }
                }
        }
        __syncthreads();
        if (router) { int* list = (int*)(P.ws + OFF_LIST); float* lw = (float*)(P.ws + OFF_TOKW);
            const int i1 = be1 * NTOK + lbase[be1] + r1, i2 = be2 * NTOK + lbase[be2] + r2;
            list[i1] = 2 * rtok; list[i2] = 2 * rtok + 1; lw[i1] = w1; lw[i2] = w2; }
        __syncthreads();
    }
};
DI bool route_fused(int nb) { return nb == 256; }
DI void outproj_run(const Params& P, int l, int mode, int c, int nb, char* smem) {
    SchedOut S{(const bf16_t*)(P.ws + OFF_HX), (const bf16_t*)(P.ws + OFF_WOUT) + (size_t)l * DM * DM, nb, c, mode, (int*)(P.ws + OFF_RDYC)};
    if (route_fused(nb) && mode != 0) {
        g8::Unit u;
        if (S.next(0, u)) {
            const int tok0 = u.a * 256, mr = (tok0 % TPB == 0) ? 8 : tok0 / TPB;
            const float* md = mod_row(P, l, mr);
            float* wtab = (float*)(smem + LDS_MISC);
#pragma unroll
            for (int i = 0; i < 2; ++i) { const int idx = threadIdx.x + NTHREADS * i, cc = idx >> 2, q = idx & 3, col = u.b * 256 + cc;
                const float g = P.norm2_g[l * DM + col] * (1.f + md[4096 + col]);
                *(f32x4*)(wtab + cc * 16 + 4 * q) = g * *(const f32x4*)(P.w_router + col * 16 + 4 * q); }
        }
        EpiOutF E{P, l};
        g8::gemm_phase(smem, (const bf16_t*)(P.ws + OFF_HX), DM, S, E);
        return;
    }
    EpiOut E{P.x, P.ctx, P.out, (float*)(P.ws + OFF_XC), (const float*)(P.ws + OFF_MOD), l};
    g8::gemm_phase(smem, (const bf16_t*)(P.ws + OFF_HX), DM, S, E);
}
DI void phase_outproj(const Params& P, int l, int bid, int nb, char* smem) {
    outproj_run(P, l, (l == 1 || ctx_early(nb)) ? 1 : 0, bid, nb, smem);
}

constexpr int MAX_RT = 2 * NTOK / 256 + NEXP;
DI void build_tile_table(const int* cnt, char* smem) {
    int* cl = (int*)(smem + LDS_MISC);
    int* tab = cl + 16;
    const int t = threadIdx.x;
    __syncthreads();
    if (t < NEXP) cl[t] = cnt[t * 64];
    __syncthreads();
    if (t < MAX_RT) {
        int acc = 0, e = 0, ti = 0, n = 0, ok = 0;
#pragma unroll
        for (int i = 0; i < NEXP; ++i) { const int c = cl[i], nt = (c + 255) >> 8; const bool hit = !ok && t < acc + nt;
            e = hit ? i : e; ti = hit ? t - acc : ti; n = hit ? c : n; ok = hit ? 1 : ok; acc += nt; }
        tab[4 * t] = e; tab[4 * t + 1] = ti; tab[4 * t + 2] = n; tab[4 * t + 3] = ok;
    }
    __syncthreads();
}
DI bool expert_tile(const char* smem, int rt, int& e, int& ti, int& hbase, int& n) {
    if (rt >= MAX_RT) return false;
    const int* tab = (const int*)(smem + LDS_MISC) + 16 + 4 * rt;
    e = __builtin_amdgcn_readfirstlane(tab[0]); ti = __builtin_amdgcn_readfirstlane(tab[1]); n = __builtin_amdgcn_readfirstlane(tab[2]); hbase = rt * 256;
    return __builtin_amdgcn_readfirstlane(tab[3]) != 0;
}

struct SchedGU {
    const bf16_t* W; const char* tabs; const int* list; int G, c;
    static constexpr bool GATHER = true;
    DI void a_ready(const g8::Unit&) const {}
    DI bool next(int i, g8::Unit& u) const { const int w = i * G + c, rt = w >> 1, ct = w & 1; int e, ti, hb, n; if (!expert_tile(tabs, rt, e, ti, hb, n)) return false;
        u.a = e; u.b = ti | (ct << 16); u.c = hb; u.d = n; u.bt = W + ((size_t)e * 512 + ct * 256) * DM; return true; }
    DI void a_offsets(const g8::Unit& u, const int (&R)[2], const int (&C)[2], unsigned (&av)[2][2]) const {
        const int ti = u.b & 0xffff;
#pragma unroll
        for (int hh = 0; hh < 2; ++hh)
#pragma unroll
            for (int i = 0; i < 2; ++i) { const int li = ti * 256 + 128 * hh + R[i]; const int slot = li < u.d ? list[u.a * NTOK + li] : 0;
                av[hh][i] = (unsigned)((slot >> 1) * DM + C[i]) * 2u; }
    }
};
struct EpiGU {
    static constexpr bool AFTER_DRAIN = false;
    bf16_t* HB;
    DI void operator()(const f32x4 (&acc)[2][2][4][2], const g8::Unit& u, int wr, int wc, int fr, int fq) const {
        const int ct = u.b >> 16;
        bf16_t* hb = HB + (size_t)(u.c + 64 * wr + fr) * DEXP + 128 * ct + 32 * wc + 4 * fq;
#pragma unroll
        for (int ai = 0; ai < 2; ++ai)
#pragma unroll
            for (int m = 0; m < 4; ++m)
#pragma unroll
                for (int n = 0; n < 2; ++n) {
                    const f32x4 g = acc[ai][0][m][n], uu = acc[ai][1][m][n];
                    f32x4 hv;
                    hv.x = g.x / (1.f + __expf(-g.x)) * uu.x; hv.y = g.y / (1.f + __expf(-g.y)) * uu.y; hv.z = g.z / (1.f + __expf(-g.z)) * uu.z; hv.w = g.w / (1.f + __expf(-g.w)) * uu.w;
                    u32x2 o; o.x = pk2(hv.x, hv.y); o.y = pk2(hv.z, hv.w);
                    *(u32x2*)(hb + (size_t)(128 * ai + 16 * m) * DEXP + 16 * n) = o;
                }
    }
};
DI void phase_gateup(const Params& P, int l, int bid, int nb, char* smem) {
    build_tile_table((const int*)(P.ws + OFF_CNT) + l * 16 * 64, smem);
    SchedGU S{(const bf16_t*)(P.ws + OFF_WGU) + (size_t)l * 16 * 512 * DM, smem, (const int*)(P.ws + OFF_LIST), nb, bid};
    EpiGU E{(bf16_t*)(P.ws + OFF_HB)};
    g8::gemm_phase(smem, (const bf16_t*)(P.ws + OFF_HX), DM, S, E);
}

struct SchedDown {
    const bf16_t *A, *W; const char* tabs; int G, c;
    static constexpr bool GATHER = false;
    DI void a_ready(const g8::Unit&) const {}
    DI bool next(int i, g8::Unit& u) const { const int w = i * G + c, rt = w >> 2, ct = w & 3; int e, ti, hb, n; if (!expert_tile(tabs, rt, e, ti, hb, n)) return false;
        u.a = e; u.b = ti | (ct << 16); u.c = hb; u.d = n; u.bt = W + ((size_t)e * DM + ct * 256) * DEXP; return true; }
    DI const bf16_t* a_base(const g8::Unit& u) const { return A + (size_t)u.c * DEXP; }
};
struct EpiDown {
    static constexpr bool AFTER_DRAIN = false;
    bf16_t* Y; const int* list; const float* tokw;
    DI void operator()(const f32x4 (&acc)[2][2][4][2], const g8::Unit& u, int wr, int wc, int fr, int fq) const {
        const int ti = u.b & 0xffff, ct = u.b >> 16;
        int slot[2][4]; float wg[2][4];
        const int* le = list + u.a * NTOK;
        const int li0 = ti * 256 + 64 * wr + fr;
#pragma unroll
        for (int ai = 0; ai < 2; ++ai)
#pragma unroll
            for (int m = 0; m < 4; ++m) { const int ix = min(li0 + 128 * ai + 16 * m, u.d - 1); slot[ai][m] = le[ix]; wg[ai][m] = tokw[u.a * NTOK + ix]; }
#pragma unroll
        for (int ai = 0; ai < 2; ++ai)
#pragma unroll
            for (int m = 0; m < 4; ++m) {
                if (li0 + 128 * ai + 16 * m < u.d) {
                    const float w1 = wg[ai][m];
                    bf16_t* yr = Y + (size_t)slot[ai][m] * DM + 256 * ct + 32 * wc + 8 * fq;
#pragma unroll
                    for (int bj = 0; bj < 2; ++bj) { const f32x4 v0 = acc[ai][bj][m][0], v1 = acc[ai][bj][m][1]; u32x4 o;
                        o.x = pk2(w1 * v0.x, w1 * v0.y); o.y = pk2(w1 * v0.z, w1 * v0.w); o.z = pk2(w1 * v1.x, w1 * v1.y); o.w = pk2(w1 * v1.z, w1 * v1.w);
                        *(u32x4*)(yr + 128 * bj) = o; }
                }
            }
    }
};
DI void phase_down(const Params& P, int l, int bid, int nb, char* smem) {
    build_tile_table((const int*)(P.ws + OFF_CNT) + l * 16 * 64, smem);
    SchedDown S{(const bf16_t*)(P.ws + OFF_HB), (const bf16_t*)(P.ws + OFF_WD) + (size_t)l * 16 * DM * DEXP, smem, nb, bid};
    EpiDown E{(bf16_t*)(P.ws + OFF_Y), (const int*)(P.ws + OFF_LIST), (const float*)(P.ws + OFF_TOKW)};
    g8::gemm_phase(smem, (const bf16_t*)(P.ws + OFF_HB), DEXP, S, E);
}

#define XB_TMO      128
#define XB_XCNT(j)  (256  + 64 * (j))
#define XB_XSUB(j)  (1280 + 64 * (j))
#define XB_XGEN(j)  (2304 + 64 * (j))
#define XB_TOP      3328
#define XB_TOPGEN   3392
#define XCD_BAR_WORDS 3456
#define XB_SPIN_CAP (1u << 20)
DI unsigned xb_ld(unsigned* p)              { return __hip_atomic_load(p, __ATOMIC_RELAXED, __HIP_MEMORY_SCOPE_AGENT); }
DI unsigned xb_add(unsigned* p, unsigned v) { return __hip_atomic_fetch_add(p, v, __ATOMIC_RELAXED, __HIP_MEMORY_SCOPE_AGENT); }
DI unsigned xb_xcc_id() { return (unsigned)__builtin_amdgcn_s_getreg((3 << 11) | 20) & 0xFu; }
#define XB_SPIN(cond, bar) do { unsigned _sp = 0; while (cond) { __builtin_amdgcn_s_sleep(1); \
    if ((++_sp & 255u) == 0u) { if (xb_ld(&(bar)[XB_TMO])) break; if (_sp > XB_SPIN_CAP) { atomicAdd(&(bar)[XB_TMO], 1u); break; } } } } while (0)
struct XcdBarrier { unsigned* bar; unsigned x; volatile LAS unsigned* st; };
DI XcdBarrier xcd_barrier_post(unsigned* bar, volatile LAS unsigned* st) {
    XcdBarrier b; b.bar = bar; b.x = xb_xcc_id(); b.st = st;
    if (threadIdx.x == 0) (void)xb_add(&bar[XB_XCNT(b.x)], 1u);
    return b;
}
DI void xcd_barrier_complete(unsigned* bar, unsigned x, unsigned& nloc, unsigned& nx) {
    const unsigned G = gridDim.x * gridDim.y * gridDim.z;
    unsigned sum, cnt, mine, sp = 0u;
    for (;;) {
        sum = 0u; cnt = 0u; mine = 0u;
#pragma unroll
        for (unsigned j = 0; j < 16; ++j) { const unsigned c = xb_ld(&bar[XB_XCNT(j)]); sum += c; cnt += (c > 0u) ? 1u : 0u; mine = (j == x) ? c : mine; }
        if (sum == G) break;
        __builtin_amdgcn_s_sleep(1);
        if ((++sp & 255u) == 0u) { if (xb_ld(&bar[XB_TMO])) break; if (sp > XB_SPIN_CAP) { atomicAdd(&bar[XB_TMO], 1u); break; } }
    }
    nloc = mine > 0u ? mine : 1u; nx = cnt > 0u ? cnt : 1u;
}
DI void xcd_barrier(const XcdBarrier& b) {
    asm volatile("s_waitcnt vmcnt(0)" ::: "memory");
    __syncthreads();
    if (threadIdx.x == 0) {
        unsigned* bar = b.bar;
        __builtin_amdgcn_s_waitcnt(0);
        unsigned nloc = b.st[0], nx = b.st[1];
        if (nloc == 0u) { xcd_barrier_complete(bar, b.x, nloc, nx); b.st[0] = nloc; b.st[1] = nx; }
        const unsigned old = xb_add(&bar[XB_XSUB(b.x)], 1u);
        const unsigned gen = old / nloc;
        if (old + 1u == (gen + 1u) * nloc) {
            __builtin_amdgcn_fence(__ATOMIC_RELEASE, "agent");
            asm volatile("s_waitcnt vmcnt(0)" ::: "memory");
            const unsigned og = xb_add(&bar[XB_TOP], 1u);
            const unsigned tg = og / nx;
            if (og + 1u == (tg + 1u) * nx) xb_add(&bar[XB_TOPGEN], 1u);
            else XB_SPIN(xb_ld(&bar[XB_TOPGEN]) == tg, bar);
            __builtin_amdgcn_fence(__ATOMIC_ACQUIRE, "agent");
            xb_add(&bar[XB_XGEN(b.x)], 1u);
            asm volatile("s_waitcnt vmcnt(0)" ::: "memory");
        } else {
            XB_SPIN(xb_ld(&bar[XB_XGEN(b.x)]) == gen, bar);
            __builtin_amdgcn_fence(__ATOMIC_ACQUIRE, "agent");
            asm volatile("s_waitcnt vmcnt(0)" ::: "memory");
        }
    }
    __syncthreads();
}

constexpr int NPHASES = 16;
__global__ void __launch_bounds__(NTHREADS, 2) mk_fwd(Params P, int ph_lo, int ph_hi) {
    extern __shared__ __attribute__((aligned(16))) char smem[];
    const int bid = blockIdx.x, nb = gridDim.x;
    volatile LAS unsigned* xst = (volatile LAS unsigned*)(LAS char*)(smem + LDS_MAIN);
    if (threadIdx.x == 0) { xst[0] = 0u; xst[1] = 0u; }
    __syncthreads();
    XcdBarrier gbar; gbar.bar = (unsigned*)(P.ws + OFF_CTL); gbar.x = 0; gbar.st = xst;
    if (ph_hi - ph_lo > 1) gbar = xcd_barrier_post((unsigned*)(P.ws + OFF_CTL), xst);
#ifndef REPEAT_K
#define REPEAT_K -1
#endif
#ifndef REPEAT_N
#define REPEAT_N 1
#endif
#ifndef EXTRA_SYNCS
#define EXTRA_SYNCS 0
#endif
#define RUN(k, call) if (ph_lo <= (k) && (k) < ph_hi) { if ((k) == REPEAT_K) { for (int rep_ = 0; rep_ < REPEAT_N; ++rep_) { call; xcd_barrier(gbar); } } call; if ((k) + 1 < ph_hi) xcd_barrier(gbar); }
    for (int es_ = 0; es_ < EXTRA_SYNCS; ++es_) xcd_barrier(gbar);
    RUN(0, phase_prologue(P, bid, nb, smem))
    RUN(1, phase_norm1(P, 0, bid, nb))
    RUN(2, phase_qkv(P, 0, bid, nb, smem))
    RUN(3, phase_attn(P, 0, bid, nb, smem))
    RUN(4, phase_outproj(P, 0, bid, nb, smem))
    if (!route_fused(nb)) { RUN(5, phase_norm2_route(P, 0, bid, nb, smem)) }
    RUN(6, phase_gateup(P, 0, bid, nb, smem))
    RUN(7, phase_down(P, 0, bid, nb, smem))
    RUN(8, phase_norm1(P, 1, bid, nb))
    RUN(9, phase_qkv(P, 1, bid, nb, smem))
    RUN(10, phase_attn(P, 1, bid, nb, smem))
    RUN(11, phase_outproj(P, 1, bid, nb, smem))
    if (!route_fused(nb)) { RUN(12, phase_norm2_route(P, 1, bid, nb, smem)) }
    RUN(13, phase_gateup(P, 1, bid, nb, smem))
    RUN(14, phase_down(P, 1, bid, nb, smem))
    RUN(15, phase_final(P, bid, nb))
#undef RUN
}

extern "C" void kernel_launch(void* const* d_in, const int* in_sizes, int n_in, void* d_out, int out_size, void* d_ws, size_t ws_size, hipStream_t stream) {
    Params p{};
    const float** f = (const float**)&p;
    for (int i = 0; i < 24; ++i) f[i] = (const float*)d_in[i];
    p.out = (float*)d_out; p.ws = (unsigned char*)d_ws;
    if (ws_size < WS_END) { fprintf(stderr, "workspace too small: %zu < %zu\n", ws_size, (size_t)WS_END); return; }
#ifndef MULTI_LAUNCH
#define MULTI_LAUNCH 0
#endif
#if MULTI_LAUNCH
    (void)hipFuncSetAttribute((const void*)mk_fwd, hipFuncAttributeMaxDynamicSharedMemorySize, LDS_BYTES);
    (void)hipMemsetAsync((char*)d_ws + OFF_CTL, 0, CTL_BYTES, stream);
    for (int ph = 0; ph < NPHASES; ++ph) hipLaunchKernelGGL(mk_fwd, dim3(256), dim3(NTHREADS), LDS_BYTES, stream, p, ph, ph + 1);
#else
    static int grid_blocks = 0;
    if (!grid_blocks) {
        int dev = 0, cus = 0, per_cu = 0;
        (void)hipGetDevice(&dev);
        (void)hipDeviceGetAttribute(&cus, hipDeviceAttributeMultiprocessorCount, dev);
        (void)hipFuncSetAttribute((const void*)mk_fwd, hipFuncAttributeMaxDynamicSharedMemorySize, LDS_BYTES);
        (void)hipOccupancyMaxActiveBlocksPerMultiprocessor(&per_cu, mk_fwd, NTHREADS, LDS_BYTES);
        if (per_cu > 1) per_cu = 1;
        grid_blocks = cus * per_cu;
        if (grid_blocks <= 0) { fprintf(stderr, "occupancy query failed (%d x %d)\n", cus, per_cu); grid_blocks = 0; return; }
    }
    (void)hipMemsetAsync((char*)d_ws + OFF_CTL, 0, CTL_BYTES, stream);
    hipLaunchKernelGGL(mk_fwd, dim3(grid_blocks), dim3(NTHREADS), LDS_BYTES, stream, p, 0, NPHASES);
    hipError_t e = hipPeekAtLastError();
    if (e != hipSuccess) fprintf(stderr, "launch failed: %s (grid %d)\n", hipGetErrorString(e), grid_blocks);
#endif
}
```

```cpp
#include <hip/hip_runtime.h>
#include <stdint.h>
#include <stdio.h>


#define DI __device__ __forceinline__
#define LAS __attribute__((address_space(3)))
typedef unsigned short bf16_t;
typedef short bf16x8 __attribute__((ext_vector_type(8)));
typedef float f32x16 __attribute__((ext_vector_type(16)));
typedef float f32x4 __attribute__((ext_vector_type(4)));
typedef float f32x2 __attribute__((ext_vector_type(2)));
typedef unsigned u32x4 __attribute__((ext_vector_type(4)));
typedef unsigned u32x2 __attribute__((ext_vector_type(2)));
typedef short s16x4 __attribute__((ext_vector_type(4)));

constexpr int NB = 8, SEQ = 2048, CTXL = 256, TPB = SEQ + CTXL  , NTOK = NB * TPB  ;
constexpr int DM = 1024, INC = 2560, NEXP = 16, DEXP = 256;
constexpr int NQU = 16, NKU = 12, NVR = 768;
constexpr size_t VS = (size_t)NVR * TPB;
constexpr int NTHREADS = 512, NW = NTHREADS / 64;
constexpr int LDS_MAIN = 131072, LDS_MISC = LDS_MAIN + 64, LDS_BYTES = LDS_MISC + 16384;
constexpr float RMS_EPS = 1e-6f;
constexpr float QSCALE = 0.125f * 1.4426950408889634f;

constexpr size_t OFF_CTL  = 0;
constexpr size_t OFF_CNT  = 14336, OFF_RDYC = OFF_CNT + 8192, OFF_XCNT = 24576, OFF_RDY = OFF_XCNT + 2 * 72 * 256, CTL_BYTES = OFF_RDY + 2 * 160 * 64;
constexpr size_t OFF_MOD  = CTL_BYTES;
constexpr size_t OFF_ROPE = OFF_MOD + (size_t)2 * 9 * 6144 * 4;
constexpr size_t OFF_WIN  = OFF_ROPE + 16384;
constexpr size_t OFF_WOUT = OFF_WIN + (size_t)2 * 2560 * 1024 * 2;
constexpr size_t OFF_WGU  = OFF_WOUT + (size_t)2 * 1024 * 1024 * 2;
constexpr size_t OFF_WD   = OFF_WGU + (size_t)2 * 16 * 512 * 1024 * 2;
constexpr size_t OFF_HX   = OFF_WD + (size_t)2 * 16 * 1024 * 256 * 2;
constexpr size_t OFF_QB   = OFF_HX + (size_t)NTOK * DM * 2;
constexpr size_t OFF_KB   = OFF_QB + (size_t)NB * NQU * TPB * 64 * 2;
constexpr size_t OFF_VT   = OFF_KB + (size_t)NB * NKU * TPB * 64 * 2;
constexpr size_t OFF_Y    = OFF_QB;
constexpr size_t OFF_XC   = OFF_VT + (size_t)NB * NVR * TPB * 2;
constexpr size_t HB_ROWS  = 2 * NTOK + NEXP * 256;
constexpr size_t OFF_HB   = OFF_XC + (size_t)NB * CTXL * DM * 4;
constexpr size_t OFF_LIST = OFF_HB + HB_ROWS * DEXP * 2;
constexpr size_t OFF_TOKW = OFF_LIST + (size_t)NEXP * NTOK * 4;
constexpr size_t OFF_XCH  = OFF_TOKW + (size_t)NEXP * NTOK * 4;
constexpr size_t OFF_QE   = OFF_ROPE + 12288;
constexpr size_t WS_END   = OFF_XCH + (size_t)72 * 4 * 256 * 20 * 4;
static_assert(WS_END <= (size_t)256 * 1024 * 1024, "workspace");
static_assert((size_t)2 * NTOK * DM * 2 <= OFF_XC - OFF_QB, "Y alias");

struct Params {
    const float *x, *c, *ctx, *c_ctx, *w_ada, *b_ada, *norm1_g, *norm2_g, *w_in, *w_out, *lam_q1, *lam_k1, *lam_q2, *lam_k2,
        *subln_g, *q_norm_g, *k_norm_g, *sink, *w_router, *router_bias, *w_gate, *w_up, *w_down, *final_g;
    float* out;
    unsigned char* ws;
};

DI float bf2f(bf16_t b) { return __uint_as_float(((unsigned)b) << 16); }
typedef __bf16 bf2_t __attribute__((ext_vector_type(2)));
DI bf16_t f2bf(float f) { return __builtin_bit_cast(bf16_t, (__bf16)f); }
DI unsigned pk2(float lo, float hi) { bf2_t v = {(__bf16)lo, (__bf16)hi}; return __builtin_bit_cast(unsigned, v); }
DI int crow(int reg, int h) { return (reg & 3) + 8 * (reg >> 2) + 4 * h; }
DI float wave_sum(float v) {
#pragma unroll
    for (int o = 1; o < 64; o <<= 1) v += __shfl_xor(v, o);
    return v;
}
DI float max2f(float a, float b) { return __builtin_amdgcn_fmed3f(a, b, __builtin_inff()); }
DI float silu(float v) { return v / (1.f + expf(-v)); }
DI bf16_t* resid_row(const Params& P, int b, int p) {
    return p < CTXL ? (bf16_t*)(P.ws + OFF_XC) + (size_t)(b * CTXL + p) * DM : (bf16_t*)(P.out + (size_t)(b * SEQ + p - CTXL) * DM);
}
DI f32x4 bf4_to_f32(const u32x2 a) { f32x4 v; v.x = __uint_as_float(a.x << 16); v.y = __uint_as_float(a.x & 0xffff0000u); v.z = __uint_as_float(a.y << 16); v.w = __uint_as_float(a.y & 0xffff0000u); return v; }
DI void store16_wt(void* p, const u32x4 v) { asm volatile("global_store_dwordx4 %0, %1, off sc1\n\ts_nop 1" :: "v"(p), "v"(v) : "memory"); }
DI u32x2 f32_to_bf4(const f32x4 v) { u32x2 w; w.x = pk2(v.x, v.y); w.y = pk2(v.z, v.w); return w; }
DI void st16_pair(bf16_t* p, const u32x2 A, const u32x2 B) {
    const auto s0 = __builtin_amdgcn_permlane32_swap(A.x, B.x, false, false);
    const auto s1 = __builtin_amdgcn_permlane32_swap(A.y, B.y, false, false);
    *(u32x4*)p = (u32x4){s0[0], s1[0], s0[1], s1[1]};
}
DI void ld16_pair(const bf16_t* p, u32x2& A, u32x2& B) {
    const u32x4 q = *(const u32x4*)p;
    const auto s0 = __builtin_amdgcn_permlane32_swap(q.x, q.z, false, false);
    const auto s1 = __builtin_amdgcn_permlane32_swap(q.y, q.w, false, false);
    A = (u32x2){s0[0], s1[0]}; B = (u32x2){s0[1], s1[1]};
}
DI const float* input_row(const Params& P, int b, int p) {
    return p < CTXL ? P.ctx + (size_t)(b * CTXL + p) * DM : P.x + (size_t)(b * SEQ + p - CTXL) * DM;
}
DI const float* mod_row(const Params& P, int l, int mr) { return (const float*)(P.ws + OFF_MOD) + (size_t)(l * 9 + mr) * 6144; }

constexpr int TI_IN = 2 * 16 * 40, TI_OUT = 2 * 16 * 16, TI_G = 32 * 16 * 4, TI_U = TI_G, TI_D = 32 * 4 * 16, TI_ALL = TI_IN + TI_OUT + TI_G + TI_U + TI_D;
DI void titem_decode(const Params& P, int r, const float*& src, int& N, bf16_t*& dst, int& ldd, int& n0, int& kind) {
    kind = 0;
    if (r < TI_IN) { const int l = r / 640, q = r % 640, kb = q / 40, nbk = q % 40; N = INC; ldd = DM; n0 = nbk * 64; kind = 3;
        src = P.w_in + (size_t)l * DM * INC + (size_t)(kb * 64) * INC + n0; dst = (bf16_t*)(P.ws + OFF_WIN) + (size_t)l * INC * DM + kb * 64; return; }
    r -= TI_IN;
    if (r < TI_OUT) { const int l = r / 256, q = r % 256, kb = q / 16, nbk = q % 16; N = DM; ldd = DM; n0 = nbk * 64; kind = 4;
        src = P.w_out + (size_t)l * DM * DM + (size_t)(kb * 64) * DM + n0; dst = (bf16_t*)(P.ws + OFF_WOUT) + (size_t)l * DM * DM + kb * 64; return; }
    r -= TI_OUT;
    if (r < TI_G + TI_U) { const bool up = r >= TI_G; if (up) r -= TI_G; const int le = r / 64, q = r % 64, kb = q / 4, nbk = q % 4; N = DEXP; ldd = DM; n0 = nbk * 64; kind = up ? 2 : 1;
        src = (up ? P.w_up : P.w_gate) + (size_t)le * DM * DEXP + (size_t)(kb * 64) * DEXP + n0; dst = (bf16_t*)(P.ws + OFF_WGU) + (size_t)le * 512 * DM + kb * 64; return; }
    r -= TI_G + TI_U;
    { const int le = r / 64, q = r % 64, kb = q / 16, nbk = q % 16; N = DM; ldd = DEXP; n0 = nbk * 64; kind = 4;
        src = P.w_down + (size_t)le * DEXP * DM + (size_t)(kb * 64) * DM + n0; dst = (bf16_t*)(P.ws + OFF_WD) + (size_t)le * DM * DEXP + kb * 64; }
}

DI void phase_prologue(const Params& P, int bid, int nb, char* smem) {
    const int t = threadIdx.x;
    float* s = (float*)smem;
    {
        constexpr int NLD = 4096 / NTHREADS;
        float v[NLD];
        int it = bid;
        const float* src; bf16_t* dst; int N, ldd, n0, kind;
        if (it < TI_ALL) { titem_decode(P, it, src, N, dst, ldd, n0, kind);
#pragma unroll
            for (int i = 0; i < NLD; ++i) v[i] = src[(size_t)((t >> 6) + NW * i) * N + (t & 63)]; }
        while (it < TI_ALL) {
            __syncthreads();
#pragma unroll
            for (int i = 0; i < NLD; ++i) s[((t >> 6) + NW * i) * 65 + (t & 63)] = v[i];
            __syncthreads();
            bf16_t* cdst = dst; const int cldd = ldd, cn0 = n0, ckind = kind;
            it += nb;
            if (it < TI_ALL) { titem_decode(P, it, src, N, dst, ldd, n0, kind);
#pragma unroll
                for (int i = 0; i < NLD; ++i) v[i] = src[(size_t)((t >> 6) + NW * i) * N + (t & 63)]; }
            constexpr int KPT = 64 * 64 / NTHREADS;
            const int n = t / (64 / KPT), kc = (t % (64 / KPT)) * KPT;
            const int ng = cn0 + n;
            int drow = ng;
            if (ckind == 3) {
                const bool isv = (ng >= 1536 && ng < 2048) || (ng >= 2176 && ng < 2304) || ng >= 2432;
                const int w = (ng >> 6) & 3, d = ng & 63;
                const int bj = d >> 5, n = isv ? (d >> 2) & 1 : (d >> 4) & 1, fq = isv ? (d >> 3) & 3 : (d >> 2) & 3, r = d & 3;
                drow = (ng & ~255) + 128 * bj + 32 * w + 16 * n + 4 * fq + r;
            }
            else if (ckind == 4) drow = (ng & ~31) + 16 * ((ng >> 2) & 1) + 4 * ((ng >> 3) & 3) + (ng & 3);
            else if (ckind != 0) drow = (ng >> 7) * 256 + (ckind == 2 ? 128 : 0) + (ng & 96) + 16 * ((ng >> 2) & 1) + 4 * ((ng >> 3) & 3) + (ng & 3);
            bf16_t* d = cdst + (size_t)drow * cldd + kc;
#pragma unroll
            for (int j = 0; j < KPT; j += 8) { u32x4 o;
                o.x = pk2(s[(kc + j + 0) * 65 + n], s[(kc + j + 1) * 65 + n]); o.y = pk2(s[(kc + j + 2) * 65 + n], s[(kc + j + 3) * 65 + n]);
                o.z = pk2(s[(kc + j + 4) * 65 + n], s[(kc + j + 5) * 65 + n]); o.w = pk2(s[(kc + j + 6) * 65 + n], s[(kc + j + 7) * 65 + n]);
                *(u32x4*)(d + j) = o; }
        }
    }
    {
        constexpr int I_MOD = 2 * 384, KG = NTHREADS / 16, KPG = DM / KG;
        bool have_silu = false;
        float* ssl = s;
        float* red = s + 9 * 1024;
        for (int it = bid; it < I_MOD; it += nb) {
            const int l = it / 384, col0 = (it % 384) * 16, cc = t & 15, kg = t >> 4;
            const float* W = P.w_ada + (size_t)l * DM * 6144 + col0 + cc + (size_t)(kg * KPG) * 6144;
            float w[KPG];
#pragma unroll
            for (int kk = 0; kk < KPG; ++kk) w[kk] = W[(size_t)kk * 6144];
            __syncthreads();
            if (!have_silu) { for (int i = t; i < 9 * 1024; i += NTHREADS) { const float cv = i < 8192 ? P.c[i] : P.c_ctx[i - 8192]; ssl[i] = silu(cv); } have_silu = true; }
            __syncthreads();
            float acc[9];
#pragma unroll
            for (int i = 0; i < 9; ++i) acc[i] = 0.f;
#pragma unroll
            for (int kk = 0; kk < KPG; ++kk) {
#pragma unroll
                for (int i = 0; i < 9; ++i) acc[i] += ssl[i * 1024 + kg * KPG + kk] * w[kk];
            }
#pragma unroll
            for (int i = 0; i < 9; ++i) red[(i * KG + kg) * 16 + cc] = acc[i];
            __syncthreads();
            if (t < 144) { const int i = t >> 4, c2 = t & 15; float a = P.b_ada[l * 6144 + col0 + c2];
                for (int g = 0; g < KG; ++g) a += red[(i * KG + g) * 16 + c2];
                ((float*)(P.ws + OFF_MOD))[(size_t)(l * 9 + i) * 6144 + col0 + c2] = a; }
        }
    }
    for (int idx = bid * NTHREADS + t; idx < 96 * 16; idx += nb * NTHREADS) {
        const int pi = idx >> 4, j = idx & 15, pos = pi < 32 ? pi : pi - 32;
        const float invf = powf(10000.f, -(float)j / 16.f);
        float sn, cs; sincosf((float)pos * invf, &sn, &cs);
        ((float*)(P.ws + OFF_ROPE))[idx] = cs; ((float*)(P.ws + OFF_ROPE))[96 * 16 + idx] = sn;
    }
}

struct RowIn { f32x4 x[4]; u32x2 xb[4], y0[4], y1[4]; };
template <bool COMBINE>
DI void row_load(const Params& P, int l, int tok, int lane, RowIn& r) {
    const int b = tok / TPB, p = tok % TPB;
    if (l == 0 && !COMBINE) { const f32x4* src = (const f32x4*)input_row(P, b, p) + lane;
#pragma unroll
        for (int j = 0; j < 4; ++j) r.x[j] = src[64 * j]; }
    else { const u32x2* src = (const u32x2*)resid_row(P, b, p) + lane;
#pragma unroll
        for (int j = 0; j < 4; ++j) r.xb[j] = src[64 * j]; }
    if (COMBINE) {
        const bf16_t* Y = (const bf16_t*)(P.ws + OFF_Y);
        const u32x2* y0 = (const u32x2*)(Y + (size_t)(2 * tok) * DM) + lane;
        const u32x2* y1 = (const u32x2*)(Y + (size_t)(2 * tok + 1) * DM) + lane;
#pragma unroll
        for (int j = 0; j < 4; ++j) { r.y0[j] = y0[64 * j]; r.y1[j] = y1[64 * j]; }
    }
}
DI f32x4 row_combine(const f32x4 xv, const f32x4 g, const u32x2 a, const u32x2 c2) {
    f32x4 yv;
    yv.x = __uint_as_float(a.x << 16) + __uint_as_float(c2.x << 16);
    yv.y = __uint_as_float(a.x & 0xffff0000u) + __uint_as_float(c2.x & 0xffff0000u);
    yv.z = __uint_as_float(a.y << 16) + __uint_as_float(c2.y << 16);
    yv.w = __uint_as_float(a.y & 0xffff0000u) + __uint_as_float(c2.y & 0xffff0000u);
    return xv + g * yv;
}
template <bool COMBINE>
DI void norm1_body(const Params& P, int l, int bid, int nb) {
    const int lane = threadIdx.x & 63, wave = threadIdx.x >> 6;
    bf16_t* HX = (bf16_t*)(P.ws + OFF_HX);
    const int per = (NTOK + nb - 1) / nb, tk0 = bid * per, ntk = min(NTOK, tk0 + per) - tk0;
    RowIn cur, nxt;
    f32x4 gs[4], hs[4], g2[4];
    int cur_mr = -1;
    if (wave < ntk) row_load<COMBINE>(P, l, tk0 + wave, lane, nxt);
    for (int i = wave; i < ntk; i += NW) {
        const int tok = tk0 + i, b = tok / TPB, p = tok % TPB, mr = p < CTXL ? 8 : b;
        cur = nxt;
        if (i + NW < ntk) row_load<COMBINE>(P, l, tok + NW, lane, nxt);
        if (mr != cur_mr) {
            const float* md = mod_row(P, l, mr);
            const f32x4* gn = (const f32x4*)(P.norm1_g + l * DM) + lane;
            const f32x4* sh = (const f32x4*)(md) + lane;
            const f32x4* sc = (const f32x4*)(md + 1024) + lane;
#pragma unroll
            for (int j = 0; j < 4; ++j) { gs[j] = gn[64 * j] * (1.f + sc[64 * j]); hs[j] = sh[64 * j]; }
            if (COMBINE) { const f32x4* gp = (const f32x4*)(mod_row(P, l - 1, mr) + 5120) + lane;
#pragma unroll
                for (int j = 0; j < 4; ++j) g2[j] = gp[64 * j]; }
            cur_mr = mr;
        }
        f32x4 v[4]; float ss = 0.f;
        u32x2* xr = (u32x2*)resid_row(P, b, p) + lane;
#pragma unroll
        for (int j = 0; j < 4; ++j) {
            v[j] = COMBINE ? row_combine(bf4_to_f32(cur.xb[j]), g2[j], cur.y0[j], cur.y1[j]) : cur.x[j];
            if (COMBINE) xr[64 * j] = f32_to_bf4(v[j]);
            ss += (v[j].x * v[j].x + v[j].y * v[j].y) + (v[j].z * v[j].z + v[j].w * v[j].w);
        }
        const float r = rsqrtf(wave_sum(ss) * (1.f / DM) + RMS_EPS);
        u32x2* o = (u32x2*)(HX + (size_t)tok * DM) + lane;
#pragma unroll
        for (int j = 0; j < 4; ++j) {
            const f32x4 y = v[j] * r * gs[j] + hs[j];
            u32x2 w; w.x = pk2(y.x, y.y); w.y = pk2(y.z, y.w);
            o[64 * j] = w;
        }
    }
}
DI void router_shift_consts(const Params& P, int l, int bid) {
    if (bid >= 9 || (threadIdx.x >> 6) != NW - 1) return;
    const int lane = threadIdx.x & 63;
    const float* sh = mod_row(P, l, bid) + 3072;
    float a[16];
#pragma unroll
    for (int e = 0; e < 16; ++e) a[e] = 0.f;
    for (int i = 0; i < 16; ++i) { const int k = lane + 64 * i; const float h = sh[k];
#pragma unroll
        for (int q = 0; q < 4; ++q) { const f32x4 w = *(const f32x4*)(P.w_router + k * 16 + 4 * q); a[4 * q] += h * w.x; a[4 * q + 1] += h * w.y; a[4 * q + 2] += h * w.z; a[4 * q + 3] += h * w.w; } }
#pragma unroll
    for (int e = 0; e < 16; ++e) a[e] = wave_sum(a[e]);
    if (lane == 0) { float* qe = (float*)(P.ws + OFF_QE) + (l * 9 + bid) * 16;
#pragma unroll
        for (int e = 0; e < 16; ++e) qe[e] = a[e]; }
}
DI void phase_norm1(const Params& P, int l, int bid, int nb) { router_shift_consts(P, l, bid); if (l == 0) norm1_body<false>(P, 0, bid, nb); else norm1_body<true>(P, l, bid, nb); }

DI void phase_final(const Params& P, int bid, int nb) {
    const int lane = threadIdx.x & 63, wave = threadIdx.x >> 6;
    const int per = (NB * SEQ + nb - 1) / nb, r0 = bid * per, nr = min(NB * SEQ, r0 + per) - r0;
    RowIn cur, nxt;
    f32x4 fg[4], g2[4];
    const f32x4* fgp = (const f32x4*)P.final_g + lane;
#pragma unroll
    for (int j = 0; j < 4; ++j) fg[j] = fgp[64 * j];
    int cur_b = -1;
    if (wave < nr) { const int r = r0 + wave; row_load<true>(P, 1, (r / SEQ) * TPB + CTXL + r % SEQ, lane, nxt); }
    for (int i = wave; i < nr; i += NW) {
        const int r = r0 + i, b = r / SEQ, p = CTXL + r % SEQ;
        cur = nxt;
        if (i + NW < nr) { const int r2 = r + NW; row_load<true>(P, 1, (r2 / SEQ) * TPB + CTXL + r2 % SEQ, lane, nxt); }
        if (b != cur_b) { const f32x4* gp = (const f32x4*)(mod_row(P, 1, b) + 5120) + lane;
#pragma unroll
            for (int j = 0; j < 4; ++j) g2[j] = gp[64 * j];
            cur_b = b; }
        f32x4 v[4]; float ss = 0.f;
#pragma unroll
        for (int j = 0; j < 4; ++j) { v[j] = row_combine(bf4_to_f32(cur.xb[j]), g2[j], cur.y0[j], cur.y1[j]); ss += (v[j].x * v[j].x + v[j].y * v[j].y) + (v[j].z * v[j].z + v[j].w * v[j].w); }
        const float rr = rsqrtf(wave_sum(ss) * (1.f / DM) + RMS_EPS);
        f32x4* xr = (f32x4*)(P.out + (size_t)r * DM) + lane;
#pragma unroll
        for (int j = 0; j < 4; ++j) xr[64 * j] = v[j] * rr * fg[j];
    }
}

namespace g8 {
constexpr int BK = 64, HALF = 128, HTB = HALF * BK * 2, STAGE_BYTES = 8 * HTB;
DI int lds_byte(int r, int c) { const int st = (r >> 4) * 2 + (c >> 5), rr = r & 15, cc = c & 31, ob = rr * 64 + cc * 2; return st * 1024 + (ob ^ (((ob >> 9) & 1) << 5)); }
DI void stage_rc(int b, int& R, int& C) { const int st = b / 1024, sb = b % 1024, swz = sb ^ (((sb >> 9) & 1) << 5); R = (st >> 1) * 16 + swz / 64; C = (st & 1) * 32 + (swz % 64) / 2; }
struct Unit { int a, b, c, d; const bf16_t* bt; };

template <class Sched, class Epi>
DI void gemm_phase(char* smem, const bf16_t* Abase, const int K, const Sched& S, const Epi& E) {
    LAS unsigned char* lds = (LAS unsigned char*)smem;
    const int tid = threadIdx.x, wid = __builtin_amdgcn_readfirstlane(tid >> 6), lane = tid & 63, wr = wid >> 2, wc = wid & 3, fr = lane & 15, fq = lane >> 4;
    const int nt = K / BK;
    int R[2], C[2];
    unsigned voffB[2], voffA[2];
#pragma unroll
    for (int i = 0; i < 2; ++i) { stage_rc(tid * 16 + i * 8192, R[i], C[i]); voffB[i] = (unsigned)(R[i] * K + C[i]) * 2u; voffA[i] = voffB[i]; }
    const size_t kstep = (size_t)(BK * 2);
    const size_t hstep = (size_t)HALF * K * 2;
    const unsigned ldsw = (unsigned)wid * 1024u;
    const int aoff = lds_byte(wr * 64 + fr, fq * 8), boff = lds_byte(wc * 32 + fr, fq * 8);
#define G8_SA(b, h) (((b) * 2 + (h)) * HTB)
#define G8_SB(b, h) ((4 + (b) * 2 + (h)) * HTB)
#define G8_STAGE_B(bufoff, gbase) do { _Pragma("unroll") for (int _i = 0; _i < 2; ++_i) \
        __builtin_amdgcn_global_load_lds((const unsigned*)((const char*)(gbase) + voffB[_i]), (LAS unsigned*)(lds + (bufoff) + ldsw + _i * 8192), 16, 0, 0); } while (0)
#define G8_GLDS(src, dstoff) __builtin_amdgcn_global_load_lds((const unsigned*)(src), (LAS unsigned*)(lds + (dstoff)), 16, 0, 0)
#define G8_STAGE_A(bufoff, hh, nx, kb) do { \
        if constexpr (Sched::GATHER) { const unsigned o0_ = (nx) ? avn[hh][0] : avc[hh][0], o1_ = (nx) ? avn[hh][1] : avc[hh][1]; \
            G8_GLDS(Ab + (size_t)o0_ + (kb), (bufoff) + ldsw); G8_GLDS(Ab + (size_t)o1_ + (kb), (bufoff) + ldsw + 8192); } \
        else { const char* ba_ = ((nx) ? nA : cA) + (size_t)(hh) * hstep + (kb); G8_GLDS(ba_ + voffA[0], (bufoff) + ldsw); G8_GLDS(ba_ + voffA[1], (bufoff) + ldsw + 8192); } } while (0)
#define G8_LDA(dst, b, h) do { _Pragma("unroll") for (int m = 0; m < 4; ++m) _Pragma("unroll") for (int k = 0; k < 2; ++k) dst[m][k] = *(const LAS bf16x8*)(lds + G8_SA(b, h) + aoff + m * 2048 + k * 1024); } while (0)
#define G8_LDB(dst, b, h) do { _Pragma("unroll") for (int n = 0; n < 2; ++n) _Pragma("unroll") for (int k = 0; k < 2; ++k) dst[n][k] = *(const LAS bf16x8*)(lds + G8_SB(b, h) + boff + n * 2048 + k * 1024); } while (0)
#define G8_MMA(ai, bj, At, Bt) do { __builtin_amdgcn_s_setprio(1); _Pragma("unroll") for (int m = 0; m < 4; ++m) _Pragma("unroll") for (int n = 0; n < 2; ++n) _Pragma("unroll") for (int k = 0; k < 2; ++k) \
        acc[ai][bj][m][n] = __builtin_amdgcn_mfma_f32_16x16x32_bf16(Bt[n][k], At[m][k], acc[ai][bj][m][n], 0, 0, 0); __builtin_amdgcn_s_setprio(0); } while (0)
#define G8_WAIT_V(n) asm volatile("s_waitcnt vmcnt(" #n ")" ::: "memory")
#define G8_WAIT_L(n) asm volatile("s_waitcnt lgkmcnt(" #n ")" ::: "memory")
#define G8_BAR __builtin_amdgcn_s_barrier()
#define G8_SCHED __builtin_amdgcn_sched_barrier(0)
    Unit cur, nxt; int ui = 0;
    if (!S.next(0, cur)) return;
    f32x4 acc[2][2][4][2];
#pragma unroll
    for (int a = 0; a < 2; ++a)
#pragma unroll
        for (int b = 0; b < 2; ++b)
#pragma unroll
            for (int m = 0; m < 4; ++m)
#pragma unroll
                for (int n = 0; n < 2; ++n) acc[a][b][m][n] = (f32x4){0.f, 0.f, 0.f, 0.f};
    bf16x8 At[4][2], B0[2][2], B1[2][2];
    const char* Ab = (const char*)Abase;
    unsigned avc[2][2], avn[2][2];
    const char *cA = Ab, *nA = Ab;
    S.a_ready(cur);
    if constexpr (Sched::GATHER) S.a_offsets(cur, R, C, avc); else cA = (const char*)S.a_base(cur);
    const char* cB = (const char*)cur.bt;
    G8_STAGE_B(G8_SB(0, 0), cB); G8_STAGE_B(G8_SB(0, 1), cB + hstep); G8_STAGE_A(G8_SA(0, 0), 0, false, 0); G8_STAGE_A(G8_SA(0, 1), 1, false, 0);
    if (wr == 1) G8_BAR;
    G8_WAIT_V(2); G8_BAR;
    G8_STAGE_B(G8_SB(1, 0), cB + kstep); G8_STAGE_A(G8_SA(1, 0), 0, false, kstep); G8_STAGE_B(G8_SB(1, 1), cB + hstep + kstep);
    G8_WAIT_V(6); G8_BAR;
    for (;;) {
        const bool has_next = S.next(ui + 1, nxt);
        if constexpr (Sched::GATHER) {
            if (has_next) S.a_offsets(nxt, R, C, avn);
            else {
#pragma unroll
                for (int hh = 0; hh < 2; ++hh)
#pragma unroll
                    for (int i = 0; i < 2; ++i) avn[hh][i] = avc[hh][i];
            }
        } else nA = has_next ? (const char*)S.a_base(nxt) : cA;
        const char* nB = has_next ? (const char*)nxt.bt : cB;
#pragma unroll 1
        for (int t = 0; t < nt; t += 2) {
            const bool last = (t == nt - 2);
            if (last && has_next) S.a_ready(nxt);
            const size_t k1 = (size_t)(t + 1) * kstep;
            const size_t k2 = last ? 0 : (size_t)(t + 2) * kstep, k3 = k2 + kstep;
            const char* b2 = last ? nB : cB + k2; const char* b3 = b2 + kstep;
            G8_LDB(B0, 0, 0); G8_LDB(B1, 0, 1); G8_SCHED; G8_LDA(At, 0, 0); G8_STAGE_A(G8_SA(1, 1), 1, false, k1);
            G8_WAIT_V(8); G8_WAIT_L(0); G8_BAR; G8_MMA(0, 0, At, B0); G8_MMA(0, 1, At, B1); G8_BAR; G8_SCHED;
            G8_LDA(At, 0, 1); G8_STAGE_B(G8_SB(0, 0), b2); G8_STAGE_B(G8_SB(0, 1), b2 + hstep); G8_STAGE_A(G8_SA(0, 0), 0, last, k2);
            G8_WAIT_V(8); G8_WAIT_L(0); G8_BAR; G8_MMA(1, 0, At, B0); G8_MMA(1, 1, At, B1); G8_BAR; G8_SCHED;
            G8_LDB(B0, 1, 0); G8_LDB(B1, 1, 1); G8_SCHED; G8_LDA(At, 1, 0); G8_STAGE_A(G8_SA(0, 1), 1, last, k2);
            G8_WAIT_V(8); G8_WAIT_L(0); G8_BAR; G8_MMA(0, 0, At, B0); G8_MMA(0, 1, At, B1); G8_BAR; G8_SCHED;
            G8_LDA(At, 1, 1); G8_STAGE_B(G8_SB(1, 0), b3); G8_STAGE_B(G8_SB(1, 1), b3 + hstep); G8_STAGE_A(G8_SA(1, 0), 0, last, k3);
            G8_WAIT_V(8); G8_WAIT_L(0); G8_BAR; G8_MMA(1, 0, At, B0); G8_MMA(1, 1, At, B1); G8_BAR; G8_SCHED;
        }
        if (wr == 0) G8_BAR;
        if constexpr (!Epi::AFTER_DRAIN) { int le_ = tid & 63; asm volatile("" : "+v"(le_));
            E(acc, cur, wr, wc, le_ & 15, le_ >> 4); }
        if (!has_next) break;
#pragma unroll
        for (int a = 0; a < 2; ++a)
#pragma unroll
            for (int b = 0; b < 2; ++b)
#pragma unroll
                for (int m = 0; m < 4; ++m)
#pragma unroll
                    for (int n = 0; n < 2; ++n) acc[a][b][m][n] = (f32x4){0.f, 0.f, 0.f, 0.f};
        cur = nxt; cB = nB; cA = nA; ++ui;
        if constexpr (Sched::GATHER) {
#pragma unroll
            for (int hh = 0; hh < 2; ++hh)
#pragma unroll
                for (int i = 0; i < 2; ++i) avc[hh][i] = avn[hh][i];
        }
        if (wr == 1) G8_BAR;
    }
    G8_WAIT_V(0);
    G8_BAR;
    if constexpr (Epi::AFTER_DRAIN) E.fused(acc, cur, wr, wc, fr, fq, smem);
#undef G8_SA
#undef G8_SB
#undef G8_STAGE_A
#undef G8_GLDS
#undef G8_STAGE_B
#undef G8_LDA
#undef G8_LDB
#undef G8_MMA
#undef G8_WAIT_V
#undef G8_WAIT_L
#undef G8_BAR
#undef G8_SCHED
}

DI bool static_unit(int i, int G, int c, int nM, int nN, int& pm, int& pn) {
    const int nwg = nM * nN; const long L = (long)i * G + c; if (L >= nwg) return false;
    int wgid = (int)L; { const int q = nwg / 8, r = nwg % 8, xcd = wgid % 8, off = wgid / 8; wgid = (xcd < r ? xcd * (q + 1) : r * (q + 1) + (xcd - r) * q) + off; }
    const int nig = 8 * nN, gid = wgid / nig, fm = gid * 8, gsz = (nM - fm) < 8 ? (nM - fm) : 8;
    pm = fm + ((wgid % nig) % gsz); pn = (wgid % nig) / gsz; return true;
}
}

struct SchedQKV {
    const bf16_t *A, *Wt; int G, c;
    static constexpr bool GATHER = false;
    DI void a_ready(const g8::Unit&) const {}
    DI bool next(int i, g8::Unit& u) const { int pm, pn; if (!g8::static_unit(i, G, c, NTOK / 256, INC / 256, pm, pn)) return false; u.a = pm; u.b = pn; u.c = 0; u.d = 0; u.bt = Wt + (size_t)pn * 256 * DM; return true; }
    DI const bf16_t* a_base(const g8::Unit& u) const { return A + (size_t)u.a * 256 * DM; }
};
struct EpiQKV {
    static constexpr bool AFTER_DRAIN = false;
    bf16_t *QB, *KB, *VT; const float *ropec, *ropes, *qg, *kg;
    DI void operator()(const f32x4 (&acc)[2][2][4][2], const g8::Unit& u, int wr, int wc, int fr, int fq) const {
        const int pm = u.a, pn = u.b, b = pm / 9, p0 = (pm % 9) * 256;
        const bool isctx = p0 == 0;
        const int cw = pn * 256 + wc * 64;
        int kind, unit; const float* ng = nullptr;
        if (cw < 1024) { kind = 0; unit = cw >> 6; if (unit >= 8 && unit < 12) ng = qg; }
        else if (cw < 1536) { kind = 1; unit = (cw - 1024) >> 6; }
        else if (cw < 2048) { kind = 2; unit = cw - 1536; }
        else if (cw < 2176) { kind = 1; unit = 8 + ((cw - 2048) >> 6); ng = kg; }
        else if (cw < 2304) { kind = 2; unit = 512 + (cw - 2176); }
        else if (cw < 2432) { kind = 1; unit = 10 + ((cw - 2304) >> 6); }
        else { kind = 2; unit = 640 + (cw - 2432); }
        if (kind == 2) {
            const int vld = unit < 512 ? 128 : 64;
            const size_t vbase = unit < 512 ? (size_t)(unit >> 7) * TPB * 128 + (unit & 127) : (size_t)4 * TPB * 128 + (size_t)((unit - 512) >> 6) * TPB * 64;
            bf16_t* vb = VT + (size_t)b * VS + vbase + 8 * fq;
#pragma unroll
            for (int ai = 0; ai < 2; ++ai)
#pragma unroll
                for (int m = 0; m < 4; ++m) {
                    const int p = p0 + 128 * ai + 64 * wr + 16 * m + fr;
#pragma unroll
                    for (int bj = 0; bj < 2; ++bj) { const f32x4 v0 = acc[ai][bj][m][0], v1 = acc[ai][bj][m][1];
                        u32x4 o; o.x = pk2(v0.x, v0.y); o.y = pk2(v0.z, v0.w); o.z = pk2(v1.x, v1.y); o.w = pk2(v1.z, v1.w);
                        *(u32x4*)(vb + (size_t)p * vld + 32 * bj) = o; }
                }
            return;
        }
        const bool nrm = ng != nullptr;
        f32x4 g4[2][2];
#pragma unroll
        for (int bj = 0; bj < 2; ++bj)
#pragma unroll
            for (int n = 0; n < 2; ++n) g4[bj][n] = nrm ? *(const f32x4*)(ng + 32 * bj + 16 * n + 4 * fq) : (f32x4){1.f, 1.f, 1.f, 1.f};
        const float osc = kind == 0 ? QSCALE : 1.f;
        bf16_t* base = (kind == 0 ? QB + ((size_t)b * NQU + unit) * TPB * 64 : KB + ((size_t)b * NKU + unit) * TPB * 64) + 8 * fq;
#pragma unroll
        for (int ai = 0; ai < 2; ++ai)
#pragma unroll
            for (int m = 0; m < 4; ++m) {
                const int p = p0 + 128 * ai + 64 * wr + 16 * m + fr;
                f32x4 x[2][2];
#pragma unroll
                for (int bj = 0; bj < 2; ++bj)
#pragma unroll
                    for (int n = 0; n < 2; ++n) x[bj][n] = acc[ai][bj][m][n];
                if (nrm) {
                    float ss = 0.f;
#pragma unroll
                    for (int bj = 0; bj < 2; ++bj)
#pragma unroll
                        for (int n = 0; n < 2; ++n) ss += (x[bj][n].x * x[bj][n].x + x[bj][n].y * x[bj][n].y) + (x[bj][n].z * x[bj][n].z + x[bj][n].w * x[bj][n].w);
                    ss += __shfl_xor(ss, 16); ss += __shfl_xor(ss, 32);
                    const float r = rsqrtf(ss * (1.f / 64.f) + RMS_EPS);
#pragma unroll
                    for (int bj = 0; bj < 2; ++bj)
#pragma unroll
                        for (int n = 0; n < 2; ++n) x[bj][n] = x[bj][n] * r * g4[bj][n];
                }
                if (!isctx) {
                    const int t = p - CTXL;
#pragma unroll
                    for (int bj = 0; bj < 2; ++bj) {
                        const int idx = (bj == 0 ? (t >> 6) : 32 + (t & 63)) * 16 + 4 * fq;
                        const f32x4 c4 = *(const f32x4*)(ropec + idx), s4 = *(const f32x4*)(ropes + idx);
                        const f32x4 y0 = x[bj][0] * c4 - x[bj][1] * s4, y1 = x[bj][0] * s4 + x[bj][1] * c4;
                        x[bj][0] = y0; x[bj][1] = y1;
                    }
                }
#pragma unroll
                for (int bj = 0; bj < 2; ++bj) { u32x4 o; o.x = pk2(x[bj][0].x * osc, x[bj][0].y * osc); o.y = pk2(x[bj][0].z * osc, x[bj][0].w * osc);
                    o.z = pk2(x[bj][1].x * osc, x[bj][1].y * osc); o.w = pk2(x[bj][1].z * osc, x[bj][1].w * osc);
                    *(u32x4*)(base + (size_t)p * 64 + 32 * bj) = o; }
            }
    }
};
DI void phase_qkv(const Params& P, int l, int bid, int nb, char* smem) {
    __syncthreads();
    for (int i = threadIdx.x; i < 2 * 96 * 16 / 4; i += NTHREADS) ((f32x4*)(smem + LDS_MISC))[i] = ((const f32x4*)(P.ws + OFF_ROPE))[i];
    __syncthreads();
    SchedQKV S{(const bf16_t*)(P.ws + OFF_HX), (const bf16_t*)(P.ws + OFF_WIN) + (size_t)l * INC * DM, nb, bid};
    EpiQKV E{(bf16_t*)(P.ws + OFF_QB), (bf16_t*)(P.ws + OFF_KB), (bf16_t*)(P.ws + OFF_VT), (const float*)(smem + LDS_MISC), (const float*)(smem + LDS_MISC) + 96 * 16,
             P.q_norm_g + l * 64, P.k_norm_g + l * 64};
    g8::gemm_phase(smem, (const bf16_t*)(P.ws + OFF_HX), DM, S, E);
}


#ifndef PV_AHEAD
#define PV_AHEAD 8
#endif
#define MFMA32(a, b, c) __builtin_amdgcn_mfma_f32_32x32x16_bf16((a), (b), (c), 0, 0, 0)
template <int DV>
DI void flash_run(char* smem, const bf16_t* qrow, const bf16_t* Kb, const bf16_t* Vr, int n1, int base2, int n2, int tq, float m0, float l0,
                  f32x16 (&O)[DV / 32], float& lout) {
    constexpr int NT = DV / 32, KBYTES = 8192, RB = DV * 2, STAGE = KBYTES + 64 * RB, NVP = DV / 64, KP = 1024 / RB, LPR = RB / 16;
    LAS char* lds = (LAS char*)smem;
    const int t = threadIdx.x, wave = __builtin_amdgcn_readfirstlane(t >> 6);
    int lane = t & 63;
    asm volatile("" : "+v"(lane));
    const int h = lane >> 5, ln = lane & 31, sw = (ln >> 1) & 7;
    constexpr bool QLDS = DV == 128;
    LAS char* qb = lds + 4 * STAGE + wave * 4096 + lane * 16;
    bf16x8 qf[4];
#pragma unroll
    for (int s = 0; s < 4; ++s) qf[s] = *(const bf16x8*)(qrow + 16 * s + 8 * h);
    if (QLDS) {
#pragma unroll
        for (int s = 0; s < 4; ++s) *(LAS bf16x8*)(qb + s * 1024) = qf[s];
    }
#pragma unroll
    for (int tt = 0; tt < NT; ++tt)
#pragma unroll
        for (int i = 0; i < 16; ++i) O[tt][i] = 0.f;
    constexpr float THR = 8.f;
    constexpr int PVA = PV_AHEAD;
    float m = m0 > -1e29f ? m0 : 0.f, l = l0;
    f32x16 negm;
#pragma unroll
    for (int i = 0; i < 16; ++i) negm[i] = -m;
    const int ntile = n1 + n2;
    constexpr int VPM = DV == 128 ? 5 : 9;
    bf16x8 pfp[2][2];
#pragma unroll
    for (int x = 0; x < 2; ++x)
#pragma unroll
        for (int y = 0; y < 2; ++y) pfp[x][y] = (bf16x8){0, 0, 0, 0, 0, 0, 0, 0};
    const int krow = 8 * wave + (lane >> 3);
    const unsigned koff = (unsigned)(krow * 64 + (((lane & 7) ^ ((krow >> 1) & 7)) << 3)) * 2u;
    unsigned voff[NVP];
#pragma unroll
    for (int i = 0; i < NVP; ++i) { const int key = 8 * wave + KP * i + lane / LPR, cpos = lane % LPR, z = DV == 128 ? (key & 3) : ((key >> 1) & 1);
        voff[i] = (unsigned)(key * DV + ((cpos ^ (z << 2)) << 3)) * 2u; }
    const int tq_ = (lane & 15) >> 2, tp_ = lane & 3, gb_ = (lane >> 4) & 1, z_ = DV == 128 ? tq_ : ((tq_ >> 1) & 1);
    const int vlane = (4 * h + tq_) * RB + (2 * gb_ + (tp_ >> 1)) * 16 + (tp_ & 1) * 8;
#define FA_DMA(gsrc, ldsdst) do { unsigned keep_; asm volatile("s_mov_b32 %0, m0\n\ts_mov_b32 m0, %2\n\ts_nop 0\n\tglobal_load_lds_dwordx4 %1, off\n\ts_mov_b32 m0, %0" \
        : "=&s"(keep_) : "v"(gsrc), "s"(ldsdst) : "memory"); } while (0)
#define FA_ISSUE(j) do { const int j_ = (j); const int pj_ = j_ < n1 ? 64 * j_ : base2 + 64 * (j_ - n1); const int bo_ = (j_ & 3) * STAGE; \
        const char* kt_ = (const char*)Kb + (size_t)pj_ * 128; const char* vt_ = (const char*)Vr + (size_t)pj_ * RB; \
        FA_DMA(kt_ + koff, (unsigned)(size_t)(lds + bo_ + wave * 1024)); \
        _Pragma("unroll") for (int i_ = 0; i_ < NVP; ++i_) FA_DMA(vt_ + voff[i_], (unsigned)(size_t)(lds + bo_ + KBYTES + (8 * wave + KP * i_) * RB)); } while (0)
    asm volatile("s_waitcnt vmcnt(0)" ::: "memory");
    FA_ISSUE(0);
    if (ntile > 1) FA_ISSUE(1);
#define FA_PVCORE(VB_) do { \
_Pragma("unroll") \
        for (int tt = 0; tt < NT; ++tt) { \
            const LAS char* vt = (VB_) + ((tt ^ z_) << 6); \
_Pragma("unroll") \
            for (int x = 0; x < 2; ++x) \
_Pragma("unroll") \
                for (int y = 0; y < 2; ++y) { \
                    const s16x4 lo = __builtin_amdgcn_ds_read_tr16_b64_v4i16((LAS s16x4*)(vt + (32 * x + 16 * y) * RB)); \
                    const s16x4 hi = __builtin_amdgcn_ds_read_tr16_b64_v4i16((LAS s16x4*)(vt + (32 * x + 16 * y + 8) * RB)); \
                    const bf16x8 vf = __builtin_shufflevector(lo, hi, 0, 1, 2, 3, 4, 5, 6, 7); \
                    O[tt] = MFMA32(vf, pfp[x][y], O[tt]); \
                } \
        } \
 \
    } while (0)
#define FA_EXPCORE() do { \
_Pragma("unroll") \
        for (int i = 0; i < 16; i += 2) { \
            const float a0 = __builtin_amdgcn_exp2f(s0[i]), a1 = __builtin_amdgcn_exp2f(s0[i + 1]); \
            const float b0 = __builtin_amdgcn_exp2f(s1[i]), b1 = __builtin_amdgcn_exp2f(s1[i + 1]); \
            ps += (a0 + a1) + (b0 + b1); \
            w[i >> 1] = pk2(a0, a1); w[8 + (i >> 1)] = pk2(b0, b1); \
        } \
    } while (0)
    for (int it = 0; it < ntile; ++it) {
        const int p0 = it < n1 ? 64 * it : base2 + 64 * (it - n1);
        if (it + 1 < ntile) { if (NVP == 2) asm volatile("s_waitcnt vmcnt(3)" ::: "memory"); else asm volatile("s_waitcnt vmcnt(2)" ::: "memory"); }
        else asm volatile("s_waitcnt vmcnt(0)" ::: "memory");
        __builtin_amdgcn_s_barrier();
        asm volatile("" ::: "memory");
        if (it + 2 < ntile) FA_ISSUE(it + 2);
        int bo = (it & 3) * STAGE;
        asm volatile("" : "+s"(bo));
        const LAS char* kb = lds + bo;
        const LAS char* vb = kb + KBYTES + vlane;
        f32x16 s0 = negm, s1 = negm;
#pragma unroll
        for (int s = 0; s < 4; ++s) {
            const int co = ((2 * s + h) ^ sw) << 4;
            const bf16x8 k0 = *(const LAS bf16x8*)(kb + ln * 128 + co);
            const bf16x8 k1 = *(const LAS bf16x8*)(kb + (32 + ln) * 128 + co);
            const bf16x8 qs = QLDS ? *(const LAS bf16x8*)(qb + s * 1024) : qf[s];
            s0 = MFMA32(k0, qs, s0); s1 = MFMA32(k1, qs, s1);
        }
        if (it >= n1) {
            const int d0 = (p0 - CTXL) - tq + 4 * h + 128;
#pragma unroll
            for (int i = 0; i < 16; ++i) {
                const int dd = d0 + (i & 3) + 8 * (i >> 2);
                s0[i] = ((unsigned)dd <= 256u) ? s0[i] : -1e30f;
                s1[i] = ((unsigned)(dd + 32) <= 256u) ? s1[i] : -1e30f;
            }
        }
        float ps = 0.f;
        unsigned w[16];
        __builtin_amdgcn_sched_barrier(0);
        if (it > 0) {
            int bp = ((it - 1) & 3) * STAGE;
            asm volatile("" : "+s"(bp));
            const LAS char* vbp = lds + bp + KBYTES + vlane;
            FA_PVCORE(vbp);
            FA_EXPCORE();
            __builtin_amdgcn_sched_group_barrier(0x100, PVA, 0);
#pragma unroll
            for (int g = 0; g < 4 * NT; ++g) { __builtin_amdgcn_sched_group_barrier(0x008, 1, 0); __builtin_amdgcn_sched_group_barrier(0x002, VPM, 0);
                if (g < 4 * NT - PVA / 2) __builtin_amdgcn_sched_group_barrier(0x100, 2, 0); }
        } else {
            FA_EXPCORE();
        }
        __builtin_amdgcn_sched_barrier(0);
        if (__any(!(ps <= 1048576.f))) {
            float mx;
            {
                float t0 = max2f(s0[0], s1[0]), t1 = max2f(s0[1], s1[1]), t2 = max2f(s0[2], s1[2]), t3 = max2f(s0[3], s1[3]);
#pragma unroll
                for (int i = 4; i < 16; i += 4) { t0 = max2f(t0, max2f(s0[i], s1[i])); t1 = max2f(t1, max2f(s0[i + 1], s1[i + 1])); t2 = max2f(t2, max2f(s0[i + 2], s1[i + 2])); t3 = max2f(t3, max2f(s0[i + 3], s1[i + 3])); }
                mx = max2f(max2f(t0, t1), max2f(t2, t3));
            }
            mx = max2f(mx, __shfl_xor(mx, 32));
            const float d = fmaxf(mx, 0.f), alpha = __builtin_amdgcn_exp2f(-d);
            m += d; l *= alpha;
#pragma unroll
            for (int i = 0; i < 16; ++i) negm[i] -= d;
#pragma unroll
            for (int tt = 0; tt < NT; ++tt)
#pragma unroll
                for (int i = 0; i < 16; ++i) O[tt][i] *= alpha;
            ps = 0.f;
#pragma unroll
            for (int i = 0; i < 16; i += 2) {
                const float a0 = __builtin_amdgcn_exp2f(s0[i] - d), a1 = __builtin_amdgcn_exp2f(s0[i + 1] - d);
                const float b0 = __builtin_amdgcn_exp2f(s1[i] - d), b1 = __builtin_amdgcn_exp2f(s1[i + 1] - d);
                ps += (a0 + a1) + (b0 + b1);
                w[i >> 1] = pk2(a0, a1); w[8 + (i >> 1)] = pk2(b0, b1);
            }
        }
#pragma unroll
        for (int x = 0; x < 2; ++x)
#pragma unroll
            for (int y = 0; y < 2; ++y) { u32x4 q; q.x = w[8 * x + 4 * y]; q.y = w[8 * x + 4 * y + 1]; q.z = w[8 * x + 4 * y + 2]; q.w = w[8 * x + 4 * y + 3];
                pfp[x][y] = __builtin_bit_cast(bf16x8, q); }
        l += ps;
    }
    { int bp = ((ntile - 1) & 3) * STAGE; asm volatile("" : "+s"(bp)); const LAS char* vbp = lds + bp + KBYTES + vlane; FA_PVCORE(vbp); }
    __builtin_amdgcn_s_barrier();
#undef FA_ISSUE
#undef FA_PVCORE
#undef FA_EXPCORE
#undef FA_DMA
    lout = l + __shfl_xor(l, 32);
}

constexpr int CTX_EARLY_LO = 96, CTX_EARLY_N = 32;
DI bool ctx_early(int nb) { return nb >= CTX_EARLY_LO + CTX_EARLY_N; }
DI void outproj_run(const Params& P, int l, int mode, int c, int nb, char* smem);
DI void phase_attn(const Params& P, int l, int bid, int nb, char* smem) {
    const int t = threadIdx.x, wave = t >> 6;
    const bf16_t* QB = (const bf16_t*)(P.ws + OFF_QB); const bf16_t* KB = (const bf16_t*)(P.ws + OFF_KB); const bf16_t* VT = (const bf16_t*)(P.ws + OFF_VT);
    bf16_t* MIX = (bf16_t*)(P.ws + OFF_HX);
    const float lambda_init = l == 0 ? 0.2f : (0.8f - 0.6f * expf(-0.3f));
    float d1 = P.lam_q1[l * 64 + (t & 63)] * P.lam_k1[l * 64 + (t & 63)], d2 = P.lam_q2[l * 64 + (t & 63)] * P.lam_k2[l * 64 + (t & 63)];
    d1 = wave_sum(d1); d2 = wave_sum(d2);
    const float lam = expf(d1) - expf(d2) + lambda_init;
    const bool has_ctx = l == 0 && bid < 96;
    const int nmain = (768 - bid + nb - 1) / nb;
#pragma unroll 1
    for (int kk = 0; kk < nmain + (has_ctx ? 1 : 0); ++kk) {
        const int it = has_ctx ? (kk == 0 ? 768 + bid : bid + (kk - 1) * nb) : bid + kk * nb;
        int ty, b, hd, p0q, ncx;
        bool isctx;
        if (it < 768) {
            ty = it >> 8; const int idx = it & 255, xcd = idx & 7, r = idx >> 3, stream = xcd * 4 + (r >> 3);
            b = stream >> 2; hd = stream & 3; p0q = CTXL + (r & 7) * 256; isctx = false; ncx = TPB / 64;
        } else {
            const int i2 = it - 768, t12 = i2 % 12;
            b = i2 / 12; p0q = 0; ty = t12 >> 2; hd = t12 & 3; isctx = true; ncx = CTXL / 64;
        }
        int lane = t & 63;
        asm volatile("" : "+v"(lane));
        const int h = lane >> 5, ln = lane & 31;
        const int p = p0q + wave * 32 + ln, tok = b * TPB + p, tq = p - CTXL;
        if (ty == 0) {
            f32x16 O[4]; float lt;
            const bf16_t* V = VT + (size_t)b * VS + (size_t)hd * TPB * 128;
            flash_run<128>(smem, QB + (((size_t)b * NQU + 2 * hd + 1) * TPB + p) * 64, KB + ((size_t)b * NKU + 2 * hd + 1) * TPB * 64, V, ncx, 0, 0, tq, -1e30f, 0.f, O, lt);
            {
                int l2_ = t & 63; asm volatile("" : "+v"(l2_)); const int h2 = l2_ >> 5; bf16_t* orow = MIX + (size_t)(b * TPB + p0q + wave * 32 + (l2_ & 31)) * DM + hd * 128 + 8 * h2;
                const float f = -lam / lt;
#pragma unroll
                for (int tt = 0; tt < 4; ++tt)
#pragma unroll
                    for (int j = 0; j < 2; ++j) { u32x2 a, c2; a.x = pk2(O[tt][8 * j] * f, O[tt][8 * j + 1] * f); a.y = pk2(O[tt][8 * j + 2] * f, O[tt][8 * j + 3] * f);
                        c2.x = pk2(O[tt][8 * j + 4] * f, O[tt][8 * j + 5] * f); c2.y = pk2(O[tt][8 * j + 6] * f, O[tt][8 * j + 7] * f);
                        st16_pair(orow + 32 * tt + 16 * j, a, c2); }
            }
            flash_run<128>(smem, QB + (((size_t)b * NQU + 2 * hd) * TPB + p) * 64, KB + ((size_t)b * NKU + 2 * hd) * TPB * 64, V, ncx, 0, 0, tq, -1e30f, 0.f, O, lt);
            {
                int l2_ = t & 63; asm volatile("" : "+v"(l2_)); const int h2 = l2_ >> 5; bf16_t* orow = MIX + (size_t)(b * TPB + p0q + wave * 32 + (l2_ & 31)) * DM + hd * 128 + 8 * h2;
                const float f = 1.f / lt; float ss = 0.f; u32x2 stB_keep = {0u, 0u};
#pragma unroll
                for (int tt = 0; tt < 4; ++tt)
#pragma unroll
                    for (int g = 0; g < 4; ++g) {
                        u32x2 stA, stB; if ((g & 1) == 0) ld16_pair(orow + 32 * tt + 8 * g, stA, stB);
                        const u32x2 st = (g & 1) ? stB_keep : stA; if ((g & 1) == 0) stB_keep = stB;
                        O[tt][4 * g + 0] = O[tt][4 * g + 0] * f + __uint_as_float(st.x << 16);
                        O[tt][4 * g + 1] = O[tt][4 * g + 1] * f + __uint_as_float(st.x & 0xffff0000u);
                        O[tt][4 * g + 2] = O[tt][4 * g + 2] * f + __uint_as_float(st.y << 16);
                        O[tt][4 * g + 3] = O[tt][4 * g + 3] * f + __uint_as_float(st.y & 0xffff0000u);
                        ss += (O[tt][4 * g] * O[tt][4 * g] + O[tt][4 * g + 1] * O[tt][4 * g + 1]) + (O[tt][4 * g + 2] * O[tt][4 * g + 2] + O[tt][4 * g + 3] * O[tt][4 * g + 3]);
                    }
                ss += __shfl_xor(ss, 32);
                const float r = rsqrtf(ss * (1.f / 128.f) + RMS_EPS) * (1.f - lambda_init);
                const float* sg = P.subln_g + l * 128 + 4 * h2;
#pragma unroll
                for (int tt = 0; tt < 4; ++tt)
#pragma unroll
                    for (int j = 0; j < 2; ++j) { u32x2 o[2];
#pragma unroll
                        for (int q = 0; q < 2; ++q) { const int g = 2 * j + q; const f32x4 gg = *(const f32x4*)(sg + 32 * tt + 8 * g);
                            o[q].x = pk2(O[tt][4 * g] * r * gg.x, O[tt][4 * g + 1] * r * gg.y); o[q].y = pk2(O[tt][4 * g + 2] * r * gg.z, O[tt][4 * g + 3] * r * gg.w); }
                        st16_pair(orow + 32 * tt + 16 * j, o[0], o[1]); }
            }
        } else {
            const bool isC = ty == 2;
            f32x16 O[2]; float lt;
            const int qu = (isC ? 12 : 8) + hd, ku = (isC ? 10 : 8) + (hd >> 1);
            const bf16_t* V = VT + (size_t)b * VS + (size_t)4 * TPB * 128 + (size_t)((isC ? 2 : 0) + (hd >> 1)) * TPB * 64;
            int n1 = ncx, base2 = 0, n2 = 0;
            float m0 = -1e30f, l0 = 0.f;
            if (isC) {
                m0 = P.sink[l * 4 + hd] * 1.4426950408889634f; l0 = h == 0 ? 1.f : 0.f;
                if (!isctx) { const int n = (p0q - CTXL) >> 8; n1 = CTXL / 64; const int jlo = n == 0 ? 2 : 0, jhi = n == 7 ? 6 : 8;
                    base2 = CTXL + 256 * n - 128 + 64 * jlo; n2 = jhi - jlo; }
            }
            flash_run<64>(smem, QB + (((size_t)b * NQU + qu) * TPB + p) * 64, KB + ((size_t)b * NKU + ku) * TPB * 64, V, n1, base2, n2, tq, m0, l0, O, lt);
            const float f = 1.f / lt;
            int l2_ = t & 63; asm volatile("" : "+v"(l2_)); const int h2 = l2_ >> 5; bf16_t* orow = MIX + (size_t)(b * TPB + p0q + wave * 32 + (l2_ & 31)) * DM + (isC ? 768 : 512) + hd * 64 + 8 * h2;
#pragma unroll
            for (int tt = 0; tt < 2; ++tt)
#pragma unroll
                for (int j = 0; j < 2; ++j) { u32x2 a, c2; a.x = pk2(O[tt][8 * j] * f, O[tt][8 * j + 1] * f); a.y = pk2(O[tt][8 * j + 2] * f, O[tt][8 * j + 3] * f);
                    c2.x = pk2(O[tt][8 * j + 4] * f, O[tt][8 * j + 5] * f); c2.y = pk2(O[tt][8 * j + 6] * f, O[tt][8 * j + 7] * f);
                    st16_pair(orow + 32 * tt + 16 * j, a, c2); }
        }
        if (it >= 768) {
            asm volatile("s_waitcnt vmcnt(0)" ::: "memory");
            __syncthreads();
            if (t == 0) { __builtin_amdgcn_fence(__ATOMIC_RELEASE, "agent"); asm volatile("s_waitcnt vmcnt(0)" ::: "memory");
                __hip_atomic_fetch_add((int*)(P.ws + OFF_RDYC) + ((it - 768) / 12) * 64, 1, __ATOMIC_RELAXED, __HIP_MEMORY_SCOPE_AGENT); }
        }
    }
    if (l == 0 && ctx_early(nb) && bid >= CTX_EARLY_LO && bid < CTX_EARLY_LO + CTX_EARLY_N) outproj_run(P, 0, 2, bid - CTX_EARLY_LO, nb, smem);
}

DI void phase_norm2_route(const Params& P, int l, int bid, int nb, char* smem) {
    const int t = threadIdx.x, lane = t & 63, wave = t >> 6;
    int* lcnt = (int*)(smem + LDS_MISC);
    int* lbase = lcnt + 16;
    int* rec = lcnt + 32;
    int* rec2 = rec + 160;
    float* recw = (float*)(rec2 + 160);
    __syncthreads();
    {
        int ts = t;
        asm volatile("" : "+v"(ts));
        f32x4 wv[4096 / NTHREADS];
#pragma unroll
        for (int i = 0; i < 4096 / NTHREADS; ++i) { const int idx = ts + NTHREADS * i; wv[i] = *(const f32x4*)(P.w_router + (idx >> 2) * 16 + (idx & 3) * 4); }
#pragma unroll
        for (int i = 0; i < 4096 / NTHREADS; ++i) { const int idx = ts + NTHREADS * i, k = idx >> 2, q = idx & 3;
            const int row = ((k >> 8) * 4 + (k & 3)) * 64 + ((k >> 2) & 63);
            *(f32x4*)(smem + row * 64 + ((q ^ ((row >> 2) & 3)) << 4)) = wv[i]; }
    }
    if (t < 16) lcnt[t] = 0;
    __syncthreads();
    bf16_t* HX = (bf16_t*)(P.ws + OFF_HX);
    int* cnt = (int*)(P.ws + OFF_CNT) + l * 16 * 64;
    int* list = (int*)(P.ws + OFF_LIST);
    float* tokw = (float*)(P.ws + OFF_TOKW);
    const int per = (NTOK + nb - 1) / nb;
    const int tk0 = bid * per, tk1 = min(NTOK, tk0 + per), ntk = tk1 - tk0;
    const int eme = ((lane >> 5) & 1) * 8 + ((lane >> 4) & 1) * 4 + ((lane >> 3) & 1) * 2 + ((lane >> 2) & 1);
    const float mybias = P.router_bias[eme];
    f32x4 v[4], vn[4], gs[4], hs[4];
    int cur_mr = -1;
    if (wave < ntk) { const int tok = tk0 + wave, b = tok / TPB, p = tok % TPB; const u32x2* xr = (const u32x2*)resid_row(P, b, p) + lane;
#pragma unroll
        for (int j = 0; j < 4; ++j) vn[j] = bf4_to_f32(xr[64 * j]); }
    for (int i = wave; i < ntk; i += NW) {
        const int tok = tk0 + i;
        const int b = tok / TPB, p = tok % TPB, mr = p < CTXL ? 8 : b;
#pragma unroll
        for (int j = 0; j < 4; ++j) v[j] = vn[j];
        if (i + NW < ntk) { const int tk2 = tok + NW, b2 = tk2 / TPB, p2 = tk2 % TPB; const u32x2* xr = (const u32x2*)resid_row(P, b2, p2) + lane;
#pragma unroll
            for (int j = 0; j < 4; ++j) vn[j] = bf4_to_f32(xr[64 * j]); }
        if (l == 1 && p < CTXL) { if (lane == 0) rec[i] = -1; continue; }
        float ss = 0.f;
#pragma unroll
        for (int j = 0; j < 4; ++j) ss += (v[j].x * v[j].x + v[j].y * v[j].y) + (v[j].z * v[j].z + v[j].w * v[j].w);
        const float r = rsqrtf(wave_sum(ss) * (1.f / DM) + RMS_EPS);
        if (mr != cur_mr) {
            const float* md = mod_row(P, l, mr);
            const f32x4* gn = (const f32x4*)(P.norm2_g + l * DM) + lane;
            const f32x4* sh = (const f32x4*)(md + 3072) + lane;
            const f32x4* sc = (const f32x4*)(md + 4096) + lane;
#pragma unroll
            for (int j = 0; j < 4; ++j) { const f32x4 g = gn[64 * j], s1 = sc[64 * j]; gs[j] = g * (1.f + s1); hs[j] = sh[64 * j]; }
            cur_mr = mr;
        }
        u32x2* o = (u32x2*)(HX + (size_t)tok * DM) + lane;
        float lg[16];
#pragma unroll
        for (int e = 0; e < 16; ++e) lg[e] = 0.f;
#pragma unroll
        for (int j = 0; j < 4; ++j) {
            float y[4];
            y[0] = v[j].x * r * gs[j].x + hs[j].x; y[1] = v[j].y * r * gs[j].y + hs[j].y;
            y[2] = v[j].z * r * gs[j].z + hs[j].z; y[3] = v[j].w * r * gs[j].w + hs[j].w;
            u32x2 w; w.x = pk2(y[0], y[1]); w.y = pk2(y[2], y[3]);
            o[64 * j] = w;
#pragma unroll
            for (int cc = 0; cc < 4; ++cc) {
                const int row = (j * 4 + cc) * 64 + lane;
#pragma unroll
                for (int q = 0; q < 4; ++q) {
                    const f32x4 wv = *(const f32x4*)(smem + row * 64 + ((q ^ ((row >> 2) & 3)) << 4));
                    lg[4 * q + 0] += y[cc] * wv.x; lg[4 * q + 1] += y[cc] * wv.y; lg[4 * q + 2] += y[cc] * wv.z; lg[4 * q + 3] += y[cc] * wv.w;
                }
            }
        }
        float a8[8], a4[4], a2[2], a1;
        { const bool hi = lane & 32;
#pragma unroll
          for (int j = 0; j < 8; ++j) { const float keep = hi ? lg[8 + j] : lg[j], send = hi ? lg[j] : lg[8 + j]; a8[j] = keep + __shfl_xor(send, 32); } }
        { const bool hi = lane & 16;
#pragma unroll
          for (int j = 0; j < 4; ++j) { const float keep = hi ? a8[4 + j] : a8[j], send = hi ? a8[j] : a8[4 + j]; a4[j] = keep + __shfl_xor(send, 16); } }
        { const bool hi = lane & 8;
#pragma unroll
          for (int j = 0; j < 2; ++j) { const float keep = hi ? a4[2 + j] : a4[j], send = hi ? a4[j] : a4[2 + j]; a2[j] = keep + __shfl_xor(send, 8); } }
        { const bool hi = lane & 4; const float keep = hi ? a2[1] : a2[0], send = hi ? a2[0] : a2[1]; a1 = keep + __shfl_xor(send, 4); }
        a1 += __shfl_xor(a1, 2); a1 += __shfl_xor(a1, 1);
        const float mysc = 1.f / (1.f + expf(-a1)), mysel = mysc + mybias;
        float scv[16], sel[16];
#pragma unroll
        for (int e = 0; e < 16; ++e) { const int src = ((e >> 3) & 1) * 32 + ((e >> 2) & 1) * 16 + ((e >> 1) & 1) * 8 + (e & 1) * 4;
            scv[e] = __int_as_float(__builtin_amdgcn_readlane(__float_as_int(mysc), src)); sel[e] = __int_as_float(__builtin_amdgcn_readlane(__float_as_int(mysel), src)); }
        float bestg = -1e30f; int be1 = 0, be2 = 1; float bw1 = 0.f, bw2 = 0.f;
#pragma unroll
        for (int g = 0; g < 4; ++g) {
            int i1 = 0; float v1 = sel[4 * g], w1 = scv[4 * g];
#pragma unroll
            for (int j = 1; j < 4; ++j) if (sel[4 * g + j] > v1) { v1 = sel[4 * g + j]; w1 = scv[4 * g + j]; i1 = j; }
            int i2 = -1; float v2 = -1e30f, w2 = 0.f;
#pragma unroll
            for (int j = 0; j < 4; ++j) if (j != i1 && sel[4 * g + j] > v2) { v2 = sel[4 * g + j]; w2 = scv[4 * g + j]; i2 = j; }
            const float gs = v1 + v2;
            if (gs > bestg) { bestg = gs; be1 = 4 * g + i1; be2 = 4 * g + i2; bw1 = w1; bw2 = w2; }
        }
        if (lane == 0) {
            const float inv = 1.f / (bw1 + bw2);
            const int r1 = atomicAdd(&lcnt[be1], 1), r2 = atomicAdd(&lcnt[be2], 1);
            rec[i] = be1 | (be2 << 8) | (r1 << 16); rec2[i] = r2;
            recw[i] = bw1 * inv; recw[160 + i] = bw2 * inv;
        }
    }
    __syncthreads();
    if (t < 16) { const int c = lcnt[t]; lbase[t] = c ? atomicAdd(&cnt[t * 64], c) : 0; }
    __syncthreads();
    for (int i = t; i < ntk; i += NTHREADS) {
        const int rc = rec[i];
        if (rc >= 0) { const int e1 = rc & 255, e2 = (rc >> 8) & 255, r1 = rc >> 16, r2 = rec2[i], tok = tk0 + i;
            list[e1 * NTOK + lbase[e1] + r1] = 2 * tok; list[e2 * NTOK + lbase[e2] + r2] = 2 * tok + 1;
            tokw[e1 * NTOK + lbase[e1] + r1] = recw[i]; tokw[e2 * NTOK + lbase[e2] + r2] = recw[160 + i]; }
    }
}

struct SchedOut {
    const bf16_t *A, *Wt; int G, c, mode;
    int* rdyc;
    static constexpr bool GATHER = false;
    DI void a_ready(const g8::Unit& u) const {
        if (mode != 2) return;
        if (__builtin_amdgcn_readfirstlane(threadIdx.x >> 6) == 0) {
            unsigned sp = 0;
            while (__hip_atomic_load(rdyc + (u.a / 9) * 64, __ATOMIC_RELAXED, __HIP_MEMORY_SCOPE_AGENT) < 12) { __builtin_amdgcn_s_sleep(2); if (++sp > (1u << 22)) break; }
            __builtin_amdgcn_fence(__ATOMIC_ACQUIRE, "agent");
            asm volatile("s_waitcnt vmcnt(0)" ::: "memory");
        }
        __builtin_amdgcn_s_barrier();
    }
    DI bool next(int i, g8::Unit& u) const {
        int pm, pn;
        if (mode == 2) { if (i != 0) return false; pm = 9 * (c >> 2); pn = c & 3; }
        else { if (!g8::static_unit(i, G, c, mode == 0 ? 72 : 64, 4, pm, pn)) return false; if (mode == 1) pm = 9 * (pm >> 3) + 1 + (pm & 7); }
        u.a = pm; u.b = pn; u.c = 0; u.d = 0; u.bt = Wt + (size_t)pn * 256 * DM; return true; }
    DI const bf16_t* a_base(const g8::Unit& u) const { return A + (size_t)u.a * 256 * DM; }
};
struct EpiOut {
    static constexpr bool AFTER_DRAIN = false;
    const float *x, *ctx; float *out, *xc; const float* mod; int l;
    DI void operator()(const f32x4 (&acc)[2][2][4][2], const g8::Unit& u, int wr, int wc, int fr, int fq) const {
        const int tok0 = u.a * 256, b = tok0 / TPB, p0 = tok0 % TPB;
        const bool isctx = p0 == 0;
        const float* g1 = mod + (size_t)(l * 9 + (isctx ? 8 : b)) * 6144 + 2048 + u.b * 256 + 32 * wc + 8 * fq;
        f32x4 g4[2][2];
#pragma unroll
        for (int bj = 0; bj < 2; ++bj)
#pragma unroll
            for (int n = 0; n < 2; ++n) g4[bj][n] = *(const f32x4*)(g1 + 128 * bj + 4 * n);
        const int cb = u.b * 256 + 32 * wc + 8 * fq;
#pragma unroll
        for (int ai = 0; ai < 2; ++ai)
#pragma unroll
            for (int m = 0; m < 4; ++m) {
                const int r = 128 * ai + 64 * wr + 16 * m + fr;
                const size_t ro = isctx ? (size_t)(b * CTXL + r) * DM : (size_t)(b * SEQ + p0 - CTXL + r) * DM;
                const float* xin = (isctx ? ctx : x) + ro + cb;
                bf16_t* xo = (isctx ? (bf16_t*)xc + ro : (bf16_t*)(out + ro)) + cb;
#pragma unroll
                for (int bj = 0; bj < 2; ++bj) { f32x4 x0, x1;
                    if (l == 0) { x0 = *(const f32x4*)(xin + 128 * bj); x1 = *(const f32x4*)(xin + 128 * bj + 4); }
                    else { const u32x4 q = *(const u32x4*)(xo + 128 * bj); x0 = bf4_to_f32((u32x2){q.x, q.y}); x1 = bf4_to_f32((u32x2){q.z, q.w}); }
                    const u32x2 o0 = f32_to_bf4(x0 + g4[bj][0] * acc[ai][bj][m][0]), o1 = f32_to_bf4(x1 + g4[bj][1] * acc[ai][bj][m][1]);
                    *(u32x4*)(xo + 128 * bj) = (u32x4){o0.x, o0.y, o1.x, o1.y}; }
                if (m & 1) asm volatile("" ::: "memory");
            }
    }
};
struct EpiOutF {
    static constexpr bool AFTER_DRAIN = true;
    const Params& P; int l;
    DI void operator()(const f32x4 (&)[2][2][4][2], const g8::Unit&, int, int, int, int) const {}
    DI void fused(f32x4 (&acc)[2][2][4][2], const g8::Unit& u, int wr, int wc, int fr, int fq, char* smem) const {
        const int tid = threadIdx.x;
        const int tok0 = u.a * 256, b = tok0 / TPB, p0 = tok0 % TPB, pn = u.b;
        const bool isctx = p0 == 0;
        const int mr = isctx ? 8 : b;
        const float* md = mod_row(P, l, mr);
        const int cb = pn * 256 + 32 * wc + 8 * fq;
        float* part = (float*)smem;
        float* rt = part + 256 * 4 * 17;
        int* lcnt = (int*)(rt + 256);
        int* lbase = lcnt + 16;
        const float* wtab = (const float*)(smem + LDS_MISC);
        float* xc = (float*)(P.ws + OFF_XC);
        {
            f32x4 g4[2][2];
#pragma unroll
            for (int bj = 0; bj < 2; ++bj)
#pragma unroll
                for (int n = 0; n < 2; ++n) g4[bj][n] = *(const f32x4*)(md + 2048 + cb + 128 * bj + 4 * n);
#pragma unroll
            for (int ai = 0; ai < 2; ++ai)
#pragma unroll
                for (int m = 0; m < 4; ++m) {
                    const int r = 128 * ai + 64 * wr + 16 * m + fr;
                    const size_t ro = isctx ? (size_t)(b * CTXL + r) * DM : (size_t)(b * SEQ + p0 - CTXL + r) * DM;
                    const float* xin = (isctx ? P.ctx : P.x) + ro + cb;
                    bf16_t* xo = (isctx ? (bf16_t*)xc + ro : (bf16_t*)(P.out + ro)) + cb;
#pragma unroll
                    for (int bj = 0; bj < 2; ++bj) { f32x4 x0, x1;
                        if (l == 0) { x0 = *(const f32x4*)(xin + 128 * bj); x1 = *(const f32x4*)(xin + 128 * bj + 4); }
                        else { const u32x4 q = *(const u32x4*)(xo + 128 * bj); x0 = bf4_to_f32((u32x2){q.x, q.y}); x1 = bf4_to_f32((u32x2){q.z, q.w}); }
                        acc[ai][bj][m][0] = x0 + g4[bj][0] * acc[ai][bj][m][0]; acc[ai][bj][m][1] = x1 + g4[bj][1] * acc[ai][bj][m][1];
                        const u32x2 o0 = f32_to_bf4(acc[ai][bj][m][0]), o1 = f32_to_bf4(acc[ai][bj][m][1]);
                        *(u32x4*)(xo + 128 * bj) = (u32x4){o0.x, o0.y, o1.x, o1.y}; }
                    if (m & 1) asm volatile("" ::: "memory");
                }
        }
        {
            float wb[2][2][4];
#pragma unroll
            for (int bj = 0; bj < 2; ++bj)
#pragma unroll
                for (int n = 0; n < 2; ++n)
#pragma unroll
                    for (int r = 0; r < 4; ++r) wb[bj][n][r] = wtab[(128 * bj + 32 * wc + 8 * fq + 4 * n + r) * 16 + fr];
#pragma unroll
            for (int ai = 0; ai < 2; ++ai)
#pragma unroll
                for (int m = 0; m < 4; ++m) {
                    f32x4 d = {0.f, 0.f, 0.f, 0.f}; float ss = 0.f;
#pragma unroll
                    for (int bj = 0; bj < 2; ++bj)
#pragma unroll
                        for (int n = 0; n < 2; ++n) { const f32x4 v = acc[ai][bj][m][n];
                            ss += (v.x * v.x + v.y * v.y) + (v.z * v.z + v.w * v.w);
                            d = __builtin_amdgcn_mfma_f32_16x16x4f32(v.x, wb[bj][n][0], d, 0, 0, 0);
                            d = __builtin_amdgcn_mfma_f32_16x16x4f32(v.y, wb[bj][n][1], d, 0, 0, 0);
                            d = __builtin_amdgcn_mfma_f32_16x16x4f32(v.z, wb[bj][n][2], d, 0, 0, 0);
                            d = __builtin_amdgcn_mfma_f32_16x16x4f32(v.w, wb[bj][n][3], d, 0, 0, 0); }
                    ss += __shfl_xor(ss, 16); ss += __shfl_xor(ss, 32);
                    const int rowb = 128 * ai + 64 * wr + 16 * m;
                    part[((rowb + 4 * fq + 0) * 4 + wc) * 17 + fr] = d.x;
                    part[((rowb + 4 * fq + 1) * 4 + wc) * 17 + fr] = d.y;
                    part[((rowb + 4 * fq + 2) * 4 + wc) * 17 + fr] = d.z;
                    part[((rowb + 4 * fq + 3) * 4 + wc) * 17 + fr] = d.w;
                    if (fq == 0) part[((rowb + fr) * 4 + wc) * 17 + 16] = ss;
                }
        }
        __syncthreads();
        float* xch = (float*)(P.ws + OFF_XCH) + (size_t)u.a * 4 * 256 * 20;
        { float* dst = xch + (size_t)pn * 256 * 20;
          for (int i = tid; i < 256 * 9; i += NTHREADS) { const int row = i / 9, k = i - row * 9; const float* pp = part + row * 68 + 2 * k;
              const float a = (pp[0] + pp[17]) + (pp[34] + pp[51]), c2 = k < 8 ? (pp[1] + pp[18]) + (pp[35] + pp[52]) : 0.f;
              __hip_atomic_store((unsigned long long*)(dst + row * 20 + 2 * k), (unsigned long long)__float_as_uint(a) | ((unsigned long long)__float_as_uint(c2) << 32), __ATOMIC_RELAXED, __HIP_MEMORY_SCOPE_AGENT); } }
        asm volatile("s_waitcnt vmcnt(0)" ::: "memory");
        __syncthreads();
        if (tid == 0) {
            int* xcn = (int*)(P.ws + OFF_XCNT) + (l * 72 + u.a) * 64;
            __hip_atomic_fetch_add(xcn, 1, __ATOMIC_RELAXED, __HIP_MEMORY_SCOPE_AGENT);
            unsigned sp = 0;
            while (__hip_atomic_load(xcn, __ATOMIC_RELAXED, __HIP_MEMORY_SCOPE_AGENT) < 4) { __builtin_amdgcn_s_sleep(1); if (++sp > (1u << 22)) break; }
            __builtin_amdgcn_fence(__ATOMIC_ACQUIRE, "agent");
            asm volatile("s_waitcnt vmcnt(0)" ::: "memory");
        }
        if (tid >= 64 && tid < 80) lcnt[tid - 64] = 0;
        __syncthreads();
        const bool router = (tid >> 6) == pn;
        int be1 = 0, be2 = 1, r1 = 0, r2 = 0; float w1 = 0.f, w2 = 0.f;
        const int rtok = tok0 + tid;
        if (tid < 256) {
            float sq = 0.f;
#pragma unroll
            for (int q = 0; q < 4; ++q) sq += xch[(size_t)(q * 256 + tid) * 20 + 16];
            f32x4 lg4[4];
            if (router) {
#pragma unroll
                for (int j = 0; j < 4; ++j) lg4[j] = (f32x4){0.f, 0.f, 0.f, 0.f};
#pragma unroll
                for (int q = 0; q < 4; ++q)
#pragma unroll
                    for (int j = 0; j < 4; ++j) lg4[j] += *(const f32x4*)(xch + (size_t)(q * 256 + tid) * 20 + 4 * j);
            }
            const float r = rsqrtf(sq * (1.f / DM) + RMS_EPS);
            rt[tid] = r;
            if (router) {
                const float* qe = (const float*)(P.ws + OFF_QE) + (l * 9 + mr) * 16;
                float scv[16], sel[16];
#pragma unroll
                for (int e = 0; e < 16; ++e) { const float a = lg4[e >> 2][e & 3] * r + qe[e]; scv[e] = 1.f / (1.f + expf(-a)); sel[e] = scv[e] + P.router_bias[e]; }
                float bestg = -1e30f; float bw1 = 0.f, bw2 = 0.f;
#pragma unroll
                for (int g = 0; g < 4; ++g) {
                    int i1 = 0; float v1 = sel[4 * g], x1 = scv[4 * g];
#pragma unroll
                    for (int j = 1; j < 4; ++j) if (sel[4 * g + j] > v1) { v1 = sel[4 * g + j]; x1 = scv[4 * g + j]; i1 = j; }
                    int i2 = -1; float v2 = -1e30f, x2 = 0.f;
#pragma unroll
                    for (int j = 0; j < 4; ++j) if (j != i1 && sel[4 * g + j] > v2) { v2 = sel[4 * g + j]; x2 = scv[4 * g + j]; i2 = j; }
                    const float gsum = v1 + v2;
                    if (gsum > bestg) { bestg = gsum; be1 = 4 * g + i1; be2 = 4 * g + i2; bw1 = x1; bw2 = x2; }
                }
                const float inv = 1.f / (bw1 + bw2);
                w1 = bw1 * inv; w2 = bw2 * inv;
                r1 = atomicAdd(&lcnt[be1], 1); r2 = atomicAdd(&lcnt[be2], 1);
            }
        }
        __syncthreads();
        if (tid < 16) { const int c = lcnt[tid]; int* cnt = (int*)(P.ws + OFF_CNT) + l * 16 * 64; lbase[tid] = c ? atomicAdd(&cnt[tid * 64], c) : 0; }
        {
            f32x4 gs[2][2], hs[2][2];
#pragma unroll
            for (int bj = 0; bj < 2; ++bj)
#pragma unroll
                for (int n = 0; n < 2; ++n) { const int c = cb + 128 * bj + 4 * n;
                    const f32x4 g = *(const f32x4*)(P.norm2_g + l * DM + c), s1 = *(const f32x4*)(md + 4096 + c);
                    gs[bj][n] = g * (1.f + s1); hs[bj][n] = *(const f32x4*)(md + 3072 + c); }
            bf16_t* HX = (bf16_t*)(P.ws + OFF_HX);
#pragma unroll
            for (int ai = 0; ai < 2; ++ai)
#pragma unroll
                for (int m = 0; m < 4; ++m) {
                    const int row = 128 * ai + 64 * wr + 16 * m + fr;
                    const float r = rt[row];
                    bf16_t* o = HX + (size_t)(tok0 + row) * DM + cb;
#pragma unroll
                    for (int bj = 0; bj < 2; ++bj) { u32x4 w;
                        { const f32x4 v = acc[ai][bj][m][0], g = gs[bj][0], h = hs[bj][0]; w.x = pk2(v.x * r * g.x + h.x, v.y * r * g.y + h.y); w.y = pk2(v.z * r * g.z + h.z, v.w * r * g.w + h.w); }
                        { const f32x4 v = acc[ai][bj][m][1], g = gs[bj][1], h = hs[bj][1]; w.z = pk2(v.x * r * g.x + h.x, v.y * r * g.y + h.y); w.w = pk2(v.z * r * g.z + h.z, v.w * r * g.w + h.w); }
                        *(u32x4*)(o + 128 * bj) = w; }
                }
        }
        __syncthreads();
        if (router) { int* list = (int*)(P.ws + OFF_LIST); float* lw = (float*)(P.ws + OFF_TOKW);
            const int i1 = be1 * NTOK + lbase[be1] + r1, i2 = be2 * NTOK + lbase[be2] + r2;
            list[i1] = 2 * rtok; list[i2] = 2 * rtok + 1; lw[i1] = w1; lw[i2] = w2; }
        __syncthreads();
    }
};
DI bool route_fused(int nb) { return nb == 256; }
DI void outproj_run(const Params& P, int l, int mode, int c, int nb, char* smem) {
    SchedOut S{(const bf16_t*)(P.ws + OFF_HX), (const bf16_t*)(P.ws + OFF_WOUT) + (size_t)l * DM * DM, nb, c, mode, (int*)(P.ws + OFF_RDYC)};
    if (route_fused(nb) && mode != 0) {
        g8::Unit u;
        if (S.next(0, u)) {
            const int tok0 = u.a * 256, mr = (tok0 % TPB == 0) ? 8 : tok0 / TPB;
            const float* md = mod_row(P, l, mr);
            float* wtab = (float*)(smem + LDS_MISC);
#pragma unroll
            for (int i = 0; i < 2; ++i) { const int idx = threadIdx.x + NTHREADS * i, cc = idx >> 2, q = idx & 3, col = u.b * 256 + cc;
                const float g = P.norm2_g[l * DM + col] * (1.f + md[4096 + col]);
                *(f32x4*)(wtab + cc * 16 + 4 * q) = g * *(const f32x4*)(P.w_router + col * 16 + 4 * q); }
        }
        EpiOutF E{P, l};
        g8::gemm_phase(smem, (const bf16_t*)(P.ws + OFF_HX), DM, S, E);
        return;
    }
    EpiOut E{P.x, P.ctx, P.out, (float*)(P.ws + OFF_XC), (const float*)(P.ws + OFF_MOD), l};
    g8::gemm_phase(smem, (const bf16_t*)(P.ws + OFF_HX), DM, S, E);
}
DI void phase_outproj(const Params& P, int l, int bid, int nb, char* smem) {
    outproj_run(P, l, (l == 1 || ctx_early(nb)) ? 1 : 0, bid, nb, smem);
}

constexpr int MAX_RT = 2 * NTOK / 256 + NEXP;
DI void build_tile_table(const int* cnt, char* smem) {
    int* cl = (int*)(smem + LDS_MISC);
    int* tab = cl + 16;
    const int t = threadIdx.x;
    __syncthreads();
    if (t < NEXP) cl[t] = cnt[t * 64];
    __syncthreads();
    if (t < MAX_RT) {
        int acc = 0, e = 0, ti = 0, n = 0, ok = 0;
#pragma unroll
        for (int i = 0; i < NEXP; ++i) { const int c = cl[i], nt = (c + 255) >> 8; const bool hit = !ok && t < acc + nt;
            e = hit ? i : e; ti = hit ? t - acc : ti; n = hit ? c : n; ok = hit ? 1 : ok; acc += nt; }
        tab[4 * t] = e; tab[4 * t + 1] = ti; tab[4 * t + 2] = n; tab[4 * t + 3] = ok;
    }
    if (t == MAX_RT) { int a = 0;
#pragma unroll
        for (int i = 0; i < NEXP; ++i) a += (cl[i] + 255) >> 8;
        tab[4 * MAX_RT] = a; }
    __syncthreads();
}
DI int total_row_tiles(const char* smem) { return __builtin_amdgcn_readfirstlane(((const int*)(smem + LDS_MISC))[16 + 4 * MAX_RT]); }
DI bool expert_tile(const char* smem, int rt, int& e, int& ti, int& hbase, int& n) {
    if (rt >= MAX_RT) return false;
    const int* tab = (const int*)(smem + LDS_MISC) + 16 + 4 * rt;
    e = __builtin_amdgcn_readfirstlane(tab[0]); ti = __builtin_amdgcn_readfirstlane(tab[1]); n = __builtin_amdgcn_readfirstlane(tab[2]); hbase = rt * 256;
    return __builtin_amdgcn_readfirstlane(tab[3]) != 0;
}

struct SchedGU {
    const bf16_t* W; const char* tabs; const int* list; int G, c;
    static constexpr bool GATHER = true;
    DI void a_ready(const g8::Unit&) const {}
    DI bool next(int i, g8::Unit& u) const { const int w = i * G + c, rt = w >> 1, ct = w & 1; int e, ti, hb, n; if (!expert_tile(tabs, rt, e, ti, hb, n)) return false;
        u.a = e; u.b = ti | (ct << 16); u.c = hb; u.d = n; u.bt = W + ((size_t)e * 512 + ct * 256) * DM; return true; }
    DI void a_offsets(const g8::Unit& u, const int (&R)[2], const int (&C)[2], unsigned (&av)[2][2]) const {
        const int ti = u.b & 0xffff;
#pragma unroll
        for (int hh = 0; hh < 2; ++hh)
#pragma unroll
            for (int i = 0; i < 2; ++i) { const int li = ti * 256 + 128 * hh + R[i]; const int slot = li < u.d ? list[u.a * NTOK + li] : 0;
                av[hh][i] = (unsigned)((slot >> 1) * DM + C[i]) * 2u; }
    }
};
struct EpiGU {
    static constexpr bool AFTER_DRAIN = false;
    bf16_t* HB; int* rdy;
    DI void operator()(const f32x4 (&acc)[2][2][4][2], const g8::Unit& u, int wr, int wc, int fr, int fq) const {
        const int ct = u.b >> 16;
        bf16_t* hb = HB + (size_t)(u.c + 64 * wr + fr) * DEXP + 128 * ct + 32 * wc + 8 * fq;
#pragma unroll
        for (int ai = 0; ai < 2; ++ai)
#pragma unroll
            for (int m = 0; m < 4; ++m) {
                u32x2 o[2];
#pragma unroll
                for (int n = 0; n < 2; ++n) {
                    const f32x4 g = acc[ai][0][m][n], uu = acc[ai][1][m][n];
                    f32x4 hv;
                    hv.x = g.x / (1.f + __expf(-g.x)) * uu.x; hv.y = g.y / (1.f + __expf(-g.y)) * uu.y; hv.z = g.z / (1.f + __expf(-g.z)) * uu.z; hv.w = g.w / (1.f + __expf(-g.w)) * uu.w;
                    o[n].x = pk2(hv.x, hv.y); o[n].y = pk2(hv.z, hv.w);
                }
                const u32x4 ov = {o[0].x, o[0].y, o[1].x, o[1].y};
                if (rdy) store16_wt(hb + (size_t)(128 * ai + 16 * m) * DEXP, ov); else *(u32x4*)(hb + (size_t)(128 * ai + 16 * m) * DEXP) = ov;
            }
        if (rdy) {
            asm volatile("s_waitcnt vmcnt(0)" ::: "memory");
            if ((threadIdx.x & 63) == 0) __hip_atomic_fetch_add(rdy + (u.c >> 8) * 16, 1, __ATOMIC_RELAXED, __HIP_MEMORY_SCOPE_AGENT);
        }
    }
};

struct SchedDown {
    const bf16_t *A, *W; const char* tabs; int G, c;
    int* rdy; int G2, D;
    static constexpr bool GATHER = false;
    DI void a_ready(const g8::Unit& u) const {
        if (!rdy) return;
        if (__builtin_amdgcn_readfirstlane(threadIdx.x >> 6) == 0) {
            unsigned sp = 0;
            while (__hip_atomic_load(rdy + (u.c >> 8) * 16, __ATOMIC_RELAXED, __HIP_MEMORY_SCOPE_AGENT) < 16) { __builtin_amdgcn_s_sleep(1); if (++sp > (1u << 22)) break; }
            __builtin_amdgcn_fence(__ATOMIC_ACQUIRE, "agent");
            asm volatile("s_waitcnt vmcnt(0)" ::: "memory");
        }
        __builtin_amdgcn_s_barrier();
    }
    DI bool next(int i, g8::Unit& u) const {
        int w = i * G + c;
        if (rdy) { if (c < G2) { if (i != 0) return false; w = D - G2 + c; } else { w = (c - G2) + i * (G - G2); if (w >= D - G2) return false; } }
        const int rt = w >> 2, ct = w & 3; int e, ti, hb, n; if (!expert_tile(tabs, rt, e, ti, hb, n)) return false;
        u.a = e; u.b = ti | (ct << 16); u.c = hb; u.d = n; u.bt = W + ((size_t)e * DM + ct * 256) * DEXP; return true; }
    DI const bf16_t* a_base(const g8::Unit& u) const { return A + (size_t)u.c * DEXP; }
};
struct EpiDown {
    static constexpr bool AFTER_DRAIN = false;
    bf16_t* Y; const int* list; const float* tokw;
    DI void operator()(const f32x4 (&acc)[2][2][4][2], const g8::Unit& u, int wr, int wc, int fr, int fq) const {
        const int ti = u.b & 0xffff, ct = u.b >> 16;
        int slot[2][4]; float wg[2][4];
        const int* le = list + u.a * NTOK;
        const int li0 = ti * 256 + 64 * wr + fr;
#pragma unroll
        for (int ai = 0; ai < 2; ++ai)
#pragma unroll
            for (int m = 0; m < 4; ++m) { const int ix = min(li0 + 128 * ai + 16 * m, u.d - 1); slot[ai][m] = le[ix]; wg[ai][m] = tokw[u.a * NTOK + ix]; }
#pragma unroll
        for (int ai = 0; ai < 2; ++ai)
#pragma unroll
            for (int m = 0; m < 4; ++m) {
                if (li0 + 128 * ai + 16 * m < u.d) {
                    const float w1 = wg[ai][m];
                    bf16_t* yr = Y + (size_t)slot[ai][m] * DM + 256 * ct + 32 * wc + 8 * fq;
#pragma unroll
                    for (int bj = 0; bj < 2; ++bj) { const f32x4 v0 = acc[ai][bj][m][0], v1 = acc[ai][bj][m][1]; u32x4 o;
                        o.x = pk2(w1 * v0.x, w1 * v0.y); o.y = pk2(w1 * v0.z, w1 * v0.w); o.z = pk2(w1 * v1.x, w1 * v1.y); o.w = pk2(w1 * v1.z, w1 * v1.w);
                        *(u32x4*)(yr + 128 * bj) = o; }
                }
            }
    }
};
DI void phase_moe(const Params& P, int l, int bid, int nb, char* smem) {
    build_tile_table((const int*)(P.ws + OFF_CNT) + l * 16 * 64, smem);
    int* rdy = (int*)(P.ws + OFF_RDY) + l * 160 * 16;
    {
        SchedGU S{(const bf16_t*)(P.ws + OFF_WGU) + (size_t)l * 16 * 512 * DM, smem, (const int*)(P.ws + OFF_LIST), nb, bid};
        EpiGU E{(bf16_t*)(P.ws + OFF_HB), rdy};
        g8::gemm_phase(smem, (const bf16_t*)(P.ws + OFF_HX), DM, S, E);
    }
    {
        const int nrt = total_row_tiles(smem);
        const int g2 = (2 * nrt > nb && 2 * nrt <= 2 * nb) ? 2 * nrt - nb : 0;
        SchedDown S{(const bf16_t*)(P.ws + OFF_HB), (const bf16_t*)(P.ws + OFF_WD) + (size_t)l * 16 * DM * DEXP, smem, nb, bid, rdy, g2, 4 * nrt};
        EpiDown E{(bf16_t*)(P.ws + OFF_Y), (const int*)(P.ws + OFF_LIST), (const float*)(P.ws + OFF_TOKW)};
        g8::gemm_phase(smem, (const bf16_t*)(P.ws + OFF_HB), DEXP, S, E);
    }
}

#define XB_TMO      128
#define XB_XCNT(j)  (256  + 64 * (j))
#define XB_XSUB(j)  (1280 + 64 * (j))
#define XB_XGEN(j)  (2304 + 64 * (j))
#define XB_TOP      3328
#define XB_TOPGEN   3392
#define XCD_BAR_WORDS 3456
#define XB_SPIN_CAP (1u << 20)
DI unsigned xb_ld(unsigned* p)              { return __hip_atomic_load(p, __ATOMIC_RELAXED, __HIP_MEMORY_SCOPE_AGENT); }
DI unsigned xb_add(unsigned* p, unsigned v) { return __hip_atomic_fetch_add(p, v, __ATOMIC_RELAXED, __HIP_MEMORY_SCOPE_AGENT); }
DI unsigned xb_xcc_id() { return (unsigned)__builtin_amdgcn_s_getreg((3 << 11) | 20) & 0xFu; }
#define XB_SPIN(cond, bar) do { unsigned _sp = 0; while (cond) { __builtin_amdgcn_s_sleep(1); \
    if ((++_sp & 255u) == 0u) { if (xb_ld(&(bar)[XB_TMO])) break; if (_sp > XB_SPIN_CAP) { atomicAdd(&(bar)[XB_TMO], 1u); break; } } } } while (0)
struct XcdBarrier { unsigned* bar; unsigned x; volatile LAS unsigned* st; };
DI XcdBarrier xcd_barrier_post(unsigned* bar, volatile LAS unsigned* st) {
    XcdBarrier b; b.bar = bar; b.x = xb_xcc_id(); b.st = st;
    if (threadIdx.x == 0) (void)xb_add(&bar[XB_XCNT(b.x)], 1u);
    return b;
}
DI void xcd_barrier_complete(unsigned* bar, unsigned x, unsigned& nloc, unsigned& nx) {
    const unsigned G = gridDim.x * gridDim.y * gridDim.z;
    unsigned sum, cnt, mine, sp = 0u;
    for (;;) {
        sum = 0u; cnt = 0u; mine = 0u;
#pragma unroll
        for (unsigned j = 0; j < 16; ++j) { const unsigned c = xb_ld(&bar[XB_XCNT(j)]); sum += c; cnt += (c > 0u) ? 1u : 0u; mine = (j == x) ? c : mine; }
        if (sum == G) break;
        __builtin_amdgcn_s_sleep(1);
        if ((++sp & 255u) == 0u) { if (xb_ld(&bar[XB_TMO])) break; if (sp > XB_SPIN_CAP) { atomicAdd(&bar[XB_TMO], 1u); break; } }
    }
    nloc = mine > 0u ? mine : 1u; nx = cnt > 0u ? cnt : 1u;
}
DI void xcd_barrier(const XcdBarrier& b) {
    asm volatile("s_waitcnt vmcnt(0)" ::: "memory");
    __syncthreads();
    if (threadIdx.x == 0) {
        unsigned* bar = b.bar;
        __builtin_amdgcn_s_waitcnt(0);
        unsigned nloc = b.st[0], nx = b.st[1];
        if (nloc == 0u) { xcd_barrier_complete(bar, b.x, nloc, nx); b.st[0] = nloc; b.st[1] = nx; }
        const unsigned old = xb_add(&bar[XB_XSUB(b.x)], 1u);
        const unsigned gen = old / nloc;
        if (old + 1u == (gen + 1u) * nloc) {
            __builtin_amdgcn_fence(__ATOMIC_RELEASE, "agent");
            asm volatile("s_waitcnt vmcnt(0)" ::: "memory");
            const unsigned og = xb_add(&bar[XB_TOP], 1u);
            const unsigned tg = og / nx;
            if (og + 1u == (tg + 1u) * nx) xb_add(&bar[XB_TOPGEN], 1u);
            else XB_SPIN(xb_ld(&bar[XB_TOPGEN]) == tg, bar);
            __builtin_amdgcn_fence(__ATOMIC_ACQUIRE, "agent");
            xb_add(&bar[XB_XGEN(b.x)], 1u);
            asm volatile("s_waitcnt vmcnt(0)" ::: "memory");
        } else {
            XB_SPIN(xb_ld(&bar[XB_XGEN(b.x)]) == gen, bar);
            __builtin_amdgcn_fence(__ATOMIC_ACQUIRE, "agent");
            asm volatile("s_waitcnt vmcnt(0)" ::: "memory");
        }
    }
    __syncthreads();
}

constexpr int NPHASES = 16;
__global__ void __launch_bounds__(NTHREADS, 2) mk_fwd(Params P, int ph_lo, int ph_hi) {
    extern __shared__ __attribute__((aligned(16))) char smem[];
    const int bid = blockIdx.x, nb = gridDim.x;
    volatile LAS unsigned* xst = (volatile LAS unsigned*)(LAS char*)(smem + LDS_MAIN);
    if (threadIdx.x == 0) { xst[0] = 0u; xst[1] = 0u; }
    __syncthreads();
    XcdBarrier gbar; gbar.bar = (unsigned*)(P.ws + OFF_CTL); gbar.x = 0; gbar.st = xst;
    if (ph_hi - ph_lo > 1) gbar = xcd_barrier_post((unsigned*)(P.ws + OFF_CTL), xst);
#ifndef REPEAT_K
#define REPEAT_K -1
#endif
#ifndef REPEAT_N
#define REPEAT_N 1
#endif
#ifndef EXTRA_SYNCS
#define EXTRA_SYNCS 0
#endif
#define RUN(k, call) if (ph_lo <= (k) && (k) < ph_hi) { if ((k) == REPEAT_K) { for (int rep_ = 0; rep_ < REPEAT_N; ++rep_) { call; xcd_barrier(gbar); } } call; if ((k) + 1 < ph_hi) xcd_barrier(gbar); }
    for (int es_ = 0; es_ < EXTRA_SYNCS; ++es_) xcd_barrier(gbar);
    RUN(0, phase_prologue(P, bid, nb, smem))
    RUN(1, phase_norm1(P, 0, bid, nb))
    RUN(2, phase_qkv(P, 0, bid, nb, smem))
    RUN(3, phase_attn(P, 0, bid, nb, smem))
    RUN(4, phase_outproj(P, 0, bid, nb, smem))
    if (!route_fused(nb)) { RUN(5, phase_norm2_route(P, 0, bid, nb, smem)) }
    RUN(7, phase_moe(P, 0, bid, nb, smem))
    RUN(8, phase_norm1(P, 1, bid, nb))
    RUN(9, phase_qkv(P, 1, bid, nb, smem))
    RUN(10, phase_attn(P, 1, bid, nb, smem))
    RUN(11, phase_outproj(P, 1, bid, nb, smem))
    if (!route_fused(nb)) { RUN(12, phase_norm2_route(P, 1, bid, nb, smem)) }
    RUN(14, phase_moe(P, 1, bid, nb, smem))
    RUN(15, phase_final(P, bid, nb))
#undef RUN
}

extern "C" void kernel_launch(void* const* d_in, const int* in_sizes, int n_in, void* d_out, int out_size, void* d_ws, size_t ws_size, hipStream_t stream) {
    Params p{};
    const float** f = (const float**)&p;
    for (int i = 0; i < 24; ++i) f[i] = (const float*)d_in[i];
    p.out = (float*)d_out; p.ws = (unsigned char*)d_ws;
    if (ws_size < WS_END) { fprintf(stderr, "workspace too small: %zu < %zu\n", ws_size, (size_t)WS_END); return; }
#ifndef MULTI_LAUNCH
#define MULTI_LAUNCH 0
#endif
#if MULTI_LAUNCH
    (void)hipFuncSetAttribute((const void*)mk_fwd, hipFuncAttributeMaxDynamicSharedMemorySize, LDS_BYTES);
    (void)hipMemsetAsync((char*)d_ws + OFF_CTL, 0, CTL_BYTES, stream);
    for (int ph = 0; ph < NPHASES; ++ph) hipLaunchKernelGGL(mk_fwd, dim3(256), dim3(NTHREADS), LDS_BYTES, stream, p, ph, ph + 1);
#else
    static int grid_blocks = 0;
    if (!grid_blocks) {
        int dev = 0, cus = 0, per_cu = 0;
        (void)hipGetDevice(&dev);
        (void)hipDeviceGetAttribute(&cus, hipDeviceAttributeMultiprocessorCount, dev);
        (void)hipFuncSetAttribute((const void*)mk_fwd, hipFuncAttributeMaxDynamicSharedMemorySize, LDS_BYTES);
        (void)hipOccupancyMaxActiveBlocksPerMultiprocessor(&per_cu, mk_fwd, NTHREADS, LDS_BYTES);
        if (per_cu > 1) per_cu = 1;
        grid_blocks = cus * per_cu;
        if (grid_blocks <= 0) { fprintf(stderr, "occupancy query failed (%d x %d)\n", cus, per_cu); grid_blocks = 0; return; }
    }
    (void)hipMemsetAsync((char*)d_ws + OFF_CTL, 0, CTL_BYTES, stream);
    hipLaunchKernelGGL(mk_fwd, dim3(grid_blocks), dim3(NTHREADS), LDS_BYTES, stream, p, 0, NPHASES);
    hipError_t e = hipPeekAtLastError();
    if (e != hipSuccess) fprintf(stderr, "launch failed: %s (grid %d)\n", hipGetErrorString(e), grid_blocks);
#endif
}
```
